# Optimizing an MI355X kernel written in HIP

```python
import math
import jax, jax.numpy as jnp
from jax import lax
import numpy as np

D_MODEL = 2048
BATCH = 1
SEQ = 16384
DEPTH = 1

DN_HEADS = 8
DN_DK = 128
DN_DV = 128
DN_CONV = 4
DN_CHUNK = 64
ATT_HEADS = 8
ATT_DIM = 128
IDX_HEADS = 8
IDX_DIM = 64
TOPK_MAX = 256
Q_BLOCK = 128
ROPE_THETA = 500000.0
ROPE_FRACTION = 4
N_GROUPS = 8
EXPERTS_PER_GROUP = 8
N_EXPERTS = N_GROUPS * EXPERTS_PER_GROUP
TOPK_IN_GROUP = 2
EXPERT_HIDDEN = 512
MOE_BLOCK = 128
EPS = 1e-6

DN_QKV_COLS = 2 * DN_HEADS * DN_DK + DN_HEADS * DN_DV
SPLIT_SIZES = (
    DN_QKV_COLS,
    DN_HEADS * DN_DV,
    DN_HEADS,
    DN_HEADS,
    ATT_HEADS * ATT_DIM,
    ATT_HEADS * ATT_DIM,
    ATT_HEADS * ATT_DIM,
    IDX_HEADS * IDX_DIM,
    IDX_DIM,
    IDX_HEADS,
    2 * D_MODEL,
)
IN_COLS = sum(SPLIT_SIZES)

kernel_name = "hybrid_gdn_dsa_hmoe_block"


def rmsnorm(x, gain):
    xf = x.astype(jnp.float32)
    y = xf * lax.rsqrt(jnp.mean(xf * xf, axis=-1, keepdims=True) + EPS)
    return (y * gain.astype(jnp.float32)).astype(x.dtype)


def l2norm(x):
    xf = x.astype(jnp.float32)
    return (xf * lax.rsqrt(jnp.sum(xf * xf, axis=-1, keepdims=True) + EPS)).astype(x.dtype)


def partial_rope(x, positions):
    d = x.shape[-1]
    rot = d // ROPE_FRACTION
    half = rot // 2
    inv_freq = jnp.float32(ROPE_THETA) ** (-jnp.arange(half, dtype=jnp.float32) * 2.0 / rot)
    ang = positions.astype(jnp.float32)[..., None] * inv_freq
    cos = jnp.cos(ang)[:, :, None, :]
    sin = jnp.sin(ang)[:, :, None, :]
    xf = x.astype(jnp.float32)
    x1, x2 = xf[..., :half], xf[..., half:rot]
    out = jnp.concatenate([x1 * cos - x2 * sin, x2 * cos + x1 * sin, xf[..., rot:]], axis=-1)
    return out.astype(x.dtype)


def causal_depthwise_conv(x, w):
    c = x.shape[-1]
    y = lax.conv_general_dilated(
        x, w[:, None, :].astype(x.dtype), window_strides=(1,), padding=[(DN_CONV - 1, 0)],
        dimension_numbers=("NWC", "WIO", "NWC"), feature_group_count=c)
    return jax.nn.silu(y)


def chunked_gated_delta_rule(q, k, v, g, beta):
    B_, L, H, Dk = q.shape
    Dv = v.shape[-1]
    C = DN_CHUNK
    N = L // C
    f32 = jnp.float32

    def to_chunks(t):
        return t.astype(f32).reshape(B_, N, C, H, -1).transpose(0, 3, 1, 2, 4)

    q, k, v = to_chunks(q), to_chunks(k), to_chunks(v)
    g = g.astype(f32).reshape(B_, N, C, H).transpose(0, 3, 1, 2)
    beta = beta.astype(f32).reshape(B_, N, C, H).transpose(0, 3, 1, 2)
    G = jnp.cumsum(g, axis=-1)

    tri_incl = jnp.tril(jnp.ones((C, C), dtype=bool))
    tri_strict = jnp.tril(jnp.ones((C, C), dtype=bool), -1)
    decay = jnp.exp(jnp.where(tri_incl, G[..., :, None] - G[..., None, :], -jnp.inf))

    kk = jnp.einsum("bhnid,bhnjd->bhnij", k, k)
    A = jnp.where(tri_strict, beta[..., :, None] * kk * decay, 0.0)
    unit_lower = A + jnp.eye(C, dtype=f32)
    rhs = jnp.concatenate([k * (beta * jnp.exp(G))[..., None], v * beta[..., None]], axis=-1)
    sol = lax.linalg.triangular_solve(unit_lower, rhs, left_side=True, lower=True, unit_diagonal=True)
    w, u = sol[..., :Dk], sol[..., Dk:]

    attn = jnp.einsum("bhnid,bhnjd->bhnij", q, k) * decay
    q_dec = q * jnp.exp(G)[..., None]
    k_dec = k * jnp.exp(G[..., -1:] - G)[..., None]
    g_last = jnp.exp(G[..., -1])

    def step(S, inp):
        q_c, w_c, u_c, a_c, k_c, gl = inp
        v_new = u_c - jnp.einsum("bhcd,bhde->bhce", w_c, S)
        o = jnp.einsum("bhcd,bhde->bhce", q_c, S) + jnp.einsum("bhij,bhje->bhie", a_c, v_new)
        S = gl[..., None, None] * S + jnp.einsum("bhcd,bhce->bhde", k_c, v_new)
        return S, o

    xs = tuple(jnp.moveaxis(t, 2, 0) for t in (q_dec, w, u, attn, k_dec, g_last))
    S0 = jnp.zeros((B_, H, Dk, Dv), f32)
    _, o = lax.scan(step, S0, xs)
    return o.transpose(1, 0, 3, 2, 4).reshape(B_, L, H, Dv)


def gated_deltanet_branch(qkv, z, b, a, conv_w, a_log, dt_bias, norm_w):
    B_, L, _ = qkv.shape
    dtype = qkv.dtype
    qkv = causal_depthwise_conv(qkv, conv_w)
    q, k, v = jnp.split(qkv, [DN_HEADS * DN_DK, 2 * DN_HEADS * DN_DK], axis=-1)
    q = l2norm(q.reshape(B_, L, DN_HEADS, DN_DK)) * (DN_DK ** -0.5)
    k = l2norm(k.reshape(B_, L, DN_HEADS, DN_DK))
    v = v.reshape(B_, L, DN_HEADS, DN_DV)
    beta = jax.nn.sigmoid(b.astype(jnp.float32))
    g = -jnp.exp(a_log.astype(jnp.float32)) * jax.nn.softplus(a.astype(jnp.float32) + dt_bias.astype(jnp.float32))
    o = chunked_gated_delta_rule(q, k, v, g, beta)
    o = rmsnorm(o, norm_w) * jax.nn.silu(z.astype(jnp.float32).reshape(B_, L, DN_HEADS, DN_DV))
    return o.reshape(B_, L, DN_HEADS * DN_DV).astype(dtype)


def dsa_branch(q, k, v, q_idx, k_idx, w_idx, positions, idx_k_norm):
    B_, L, _ = q.shape
    dtype = q.dtype
    q = partial_rope(q.reshape(B_, L, ATT_HEADS, ATT_DIM), positions)
    k = partial_rope(k.reshape(B_, L, ATT_HEADS, ATT_DIM), positions)
    v = v.reshape(B_, L, ATT_HEADS, ATT_DIM)
    q_idx = partial_rope(q_idx.reshape(B_, L, IDX_HEADS, IDX_DIM), positions)
    k_idx = partial_rope(rmsnorm(k_idx, idx_k_norm)[:, :, None, :], positions)[:, :, 0, :]
    w_idx = w_idx * (IDX_HEADS ** -0.5 * IDX_DIM ** -0.5)

    topk = min(TOPK_MAX, L // 4)
    nb = L // Q_BLOCK
    key_pos = jnp.arange(L)
    scale = ATT_DIM ** -0.5

    def blocks(t):
        return jnp.moveaxis(t.reshape((B_, nb, Q_BLOCK) + t.shape[2:]), 1, 0)

    def one_block(args):
        i, qb, qib, wb = args
        qpos = i * Q_BLOCK + jnp.arange(Q_BLOCK)
        causal = key_pos[None, :] <= qpos[:, None]
        s_idx = jax.nn.relu(jnp.einsum("bqhd,bsd->bqhs", qib, k_idx))
        score = jnp.einsum("bqh,bqhs->bqs", wb, s_idx).astype(jnp.float32)
        score = jnp.where(causal[None], score, -jnp.inf)
        _, sel = lax.top_k(score, topk)
        valid = sel <= qpos[None, :, None]
        k_sel = jax.vmap(lambda kk, ii: kk[ii])(k, sel)
        v_sel = jax.vmap(lambda vv, ii: vv[ii])(v, sel)
        logits = jnp.einsum("bqhd,bqkhd->bhqk", qb, k_sel).astype(jnp.float32) * scale
        logits = jnp.where(valid[:, None], logits, -jnp.inf)
        p = jax.nn.softmax(logits, axis=-1)
        return jnp.einsum("bhqk,bqkhd->bqhd", p.astype(dtype), v_sel)

    out = lax.map(one_block, (jnp.arange(nb), blocks(q), blocks(q_idx), blocks(w_idx)))
    return jnp.moveaxis(out, 0, 1).reshape(B_, L, ATT_HEADS * ATT_DIM)


def hierarchical_moe(h, w_group, b_group, w_router, b_router, w_gate, w_up, w_down):
    B_, L, D = h.shape
    T = B_ * L
    hf = h.reshape(T, D)
    p_grp = jax.nn.softmax((hf @ w_group).astype(jnp.float32) + b_group.astype(jnp.float32), axis=-1)
    p_g_sel, g_sel = lax.top_k(p_grp, 1)
    e_logits = ((hf @ w_router).astype(jnp.float32) + b_router.astype(jnp.float32)).reshape(T, N_GROUPS, EXPERTS_PER_GROUP)
    e_logits = jnp.take_along_axis(e_logits, g_sel[:, :, None], axis=1)[:, 0]
    top_p, top_i = lax.top_k(jax.nn.softmax(e_logits, axis=-1), TOPK_IN_GROUP)
    weights = p_g_sel * top_p / jnp.sum(top_p, axis=-1, keepdims=True)
    expert = g_sel * EXPERTS_PER_GROUP + top_i

    A = T * TOPK_IN_GROUP
    flat_e = expert.reshape(A)
    flat_w = weights.reshape(A)
    flat_tok = jnp.repeat(jnp.arange(T, dtype=jnp.int32), TOPK_IN_GROUP)
    order = jnp.argsort(flat_e)
    se, stok, sw = flat_e[order], flat_tok[order], flat_w[order]
    counts = jnp.zeros((N_EXPERTS,), jnp.int32).at[flat_e].add(1)
    start = jnp.cumsum(counts) - counts
    padded = (counts + MOE_BLOCK - 1) // MOE_BLOCK * MOE_BLOCK
    pad_end = jnp.cumsum(padded)
    pad_start = pad_end - padded
    dest = pad_start[se] + (jnp.arange(A, dtype=jnp.int32) - start[se])
    P = (A + N_EXPERTS * (MOE_BLOCK - 1) + MOE_BLOCK - 1) // MOE_BLOCK * MOE_BLOCK
    n_blk = P // MOE_BLOCK
    tok_buf = jnp.full((P,), T, jnp.int32).at[dest].set(stok)
    w_buf = jnp.zeros((P,), jnp.float32).at[dest].set(sw)
    blk_e = jnp.minimum(jnp.searchsorted(pad_end, jnp.arange(n_blk, dtype=jnp.int32) * MOE_BLOCK, side="right"),
                        N_EXPERTS - 1)
    h_pad = jnp.concatenate([hf, jnp.zeros((1, D), hf.dtype)], axis=0)
    x_blocks = h_pad[tok_buf].reshape(n_blk, MOE_BLOCK, D)

    def expert_block(args):
        xb, e = args
        return (jax.nn.silu(xb @ w_gate[e]) * (xb @ w_up[e])) @ w_down[e]

    y = lax.map(expert_block, (x_blocks, blk_e)).reshape(P, D)
    out = jnp.zeros((T + 1, D), jnp.float32).at[tok_buf].add(y.astype(jnp.float32) * w_buf[:, None])[:T]
    return out.reshape(B_, L, D).astype(h.dtype)


def setup_inputs(seed: int = 0) -> dict:
    key = jax.random.key(seed)
    ks = jax.random.split(key, 24)
    f32 = jnp.float32
    nrm = lambda k, shape, s: jax.random.normal(k, shape, f32) * s
    dt = jnp.exp(jax.random.uniform(ks[6], (DEPTH, DN_HEADS), f32, math.log(1e-3), math.log(1e-1)))
    return {
        "x": jax.random.normal(ks[0], (BATCH, SEQ, D_MODEL), f32),
        "positions": jnp.broadcast_to(jnp.arange(SEQ, dtype=jnp.int32), (BATCH, SEQ)),
        "norm_mix": 1.0 + nrm(ks[1], (DEPTH, D_MODEL), 0.1),
        "w_in": nrm(ks[2], (DEPTH, D_MODEL, IN_COLS), D_MODEL ** -0.5),
        "b_gates": nrm(ks[3], (DEPTH, 2 * D_MODEL), 0.1),
        "dn_conv_w": nrm(ks[4], (DEPTH, DN_CONV, DN_QKV_COLS), DN_CONV ** -0.5),
        "dn_a_log": jnp.log(jax.random.uniform(ks[5], (DEPTH, DN_HEADS), f32, 1.0, 16.0)),
        "dn_dt_bias": dt + jnp.log(-jnp.expm1(-dt)),
        "dn_norm_w": 1.0 + nrm(ks[7], (DEPTH, DN_DV), 0.1),
        "idx_k_norm": 1.0 + nrm(ks[8], (DEPTH, IDX_DIM), 0.1),
        "w_proj_dn": nrm(ks[9], (DEPTH, DN_HEADS * DN_DV, D_MODEL), (DN_HEADS * DN_DV) ** -0.5),
        "w_proj_att": nrm(ks[10], (DEPTH, ATT_HEADS * ATT_DIM, D_MODEL), (ATT_HEADS * ATT_DIM) ** -0.5),
        "w_out": nrm(ks[11], (DEPTH, D_MODEL, D_MODEL), D_MODEL ** -0.5),
        "norm_ffn": 1.0 + nrm(ks[12], (DEPTH, D_MODEL), 0.1),
        "w_group": nrm(ks[13], (DEPTH, D_MODEL, N_GROUPS), D_MODEL ** -0.5),
        "b_group": nrm(ks[14], (DEPTH, N_GROUPS), 0.01),
        "w_router": nrm(ks[15], (DEPTH, D_MODEL, N_EXPERTS), D_MODEL ** -0.5),
        "b_router": nrm(ks[16], (DEPTH, N_EXPERTS), 0.01),
        "w_exp_gate": nrm(ks[17], (DEPTH, N_EXPERTS, D_MODEL, EXPERT_HIDDEN), D_MODEL ** -0.5),
        "w_exp_up": nrm(ks[18], (DEPTH, N_EXPERTS, D_MODEL, EXPERT_HIDDEN), D_MODEL ** -0.5),
        "w_exp_down": nrm(ks[19], (DEPTH, N_EXPERTS, EXPERT_HIDDEN, D_MODEL), EXPERT_HIDDEN ** -0.5),
        "norm_final": 1.0 + nrm(ks[20], (D_MODEL,), 0.1),
    }


def reference(x, positions, norm_mix, w_in, b_gates, dn_conv_w, dn_a_log, dn_dt_bias, dn_norm_w,
              idx_k_norm, w_proj_dn, w_proj_att, w_out, norm_ffn, w_group, b_group, w_router, b_router,
              w_exp_gate, w_exp_up, w_exp_down, norm_final):
    B_, L, _ = x.shape
    split_at = [int(s) for s in np.cumsum(SPLIT_SIZES)[:-1]]
    for l in range(DEPTH):
        h = rmsnorm(x, norm_mix[l])
        proj = h @ w_in[l]
        (dn_qkv, dn_z, dn_b, dn_a, at_q, at_k, at_v, ix_q, ix_k, ix_w, gate_cols) = jnp.split(proj, split_at, axis=-1)
        y_dn = gated_deltanet_branch(dn_qkv, dn_z, dn_b, dn_a, dn_conv_w[l], dn_a_log[l], dn_dt_bias[l], dn_norm_w[l])
        y_at = dsa_branch(at_q, at_k, at_v, ix_q, ix_k, ix_w, positions, idx_k_norm[l])
        gates = jax.nn.sigmoid((gate_cols + b_gates[l]).astype(jnp.float32)).reshape(B_, L, 2, D_MODEL)
        merged = (gates[:, :, 0] * (y_dn @ w_proj_dn[l]).astype(jnp.float32)
                  + gates[:, :, 1] * (y_at @ w_proj_att[l]).astype(jnp.float32)).astype(x.dtype)
        x = x + merged @ w_out[l]
        h2 = rmsnorm(x, norm_ffn[l])
        x = x + hierarchical_moe(h2, w_group[l], b_group[l], w_router[l], b_router[l],
                                 w_exp_gate[l], w_exp_up[l], w_exp_down[l])
    return rmsnorm(x, norm_final)
```

```cpp
#include <hip/hip_runtime.h>
#include <hip/hip_cooperative_groups.h>
#include <cstdio>
namespace cg = cooperative_groups;

#define LAS __attribute__((address_space(3)))
typedef unsigned short bf16_t;
typedef short bf16x8 __attribute__((ext_vector_type(8)));
typedef float f32x4 __attribute__((ext_vector_type(4)));
typedef float f32x2 __attribute__((ext_vector_type(2)));
typedef unsigned u32x4 __attribute__((ext_vector_type(4)));
typedef unsigned u32x2 __attribute__((ext_vector_type(2)));

#ifndef SINGLE_LAUNCH
#define SINGLE_LAUNCH 0
#endif

constexpr int T_ = 16384, D_ = 2048, IN_COLS = 11864, LDP = 12032;
constexpr int C_DNQ = 0, C_DNK = 1024, C_DNV = 2048, C_Z = 3072, C_AQ = 4096, C_AK = 5120, C_AV = 6144, C_IQ = 7168,
              C_G0 = 7680, C_G1 = 9728, C_IK = 11776, C_B = 11840, C_A = 11848, C_IW = 11856;
constexpr int NITEM = 2048;
constexpr int PMAX = 49152;
constexpr float EPS = 1e-6f;
constexpr int LDS_BYTES = 140 * 1024;
constexpr int NPHASE = 12;

constexpr size_t MB = 1ull << 20;
constexpr size_t OFF_WT_IN  = 0;
constexpr size_t OFF_WT_DN  = 50 * MB;
constexpr size_t OFF_WT_AT  = 55 * MB;
constexpr size_t OFF_WT_OUT = 60 * MB;
constexpr size_t OFF_SMALL  = 69 * MB;
constexpr size_t OFF_H      = 72 * MB;
constexpr size_t OFF_PROJ   = 136 * MB;
constexpr size_t OFF_DNP    = 512 * MB;
constexpr size_t OFF_SCAN   = 656 * MB;
constexpr size_t OFF_Y      = 752 * MB;
constexpr size_t OFF_X1     = 816 * MB;
constexpr size_t WS_NEED    = 944 * MB;
constexpr size_t OFF_WGU    = 136 * MB;
constexpr size_t OFF_WDT    = 392 * MB;
constexpr size_t OFF_XS     = 520 * MB;
constexpr size_t OFF_ACT    = 712 * MB;
constexpr size_t OFF_YE     = 520 * MB;
constexpr size_t SM_KIDX   = 0;
constexpr size_t SM_WQ     = 2 * MB;
constexpr size_t SM_ROUTE  = 2 * MB + 512 * 1024;
constexpr size_t SM_GLAST  = 2 * MB + 960 * 1024;
constexpr size_t SM_CTRL   = 2 * MB + 1000 * 1024;
constexpr size_t DNP_W = 0, DNP_UT = 32 * MB, DNP_QD = 64 * MB, DNP_KDT = 96 * MB, DNP_ATT = 128 * MB;

struct Params {
    const float* x; const int* positions; const float* norm_mix; const float* w_in; const float* b_gates; const float* conv_w;
    const float* a_log; const float* dt_bias; const float* dn_norm_w; const float* idx_k_norm; const float* w_proj_dn;
    const float* w_proj_att; const float* w_out; const float* norm_ffn; const float* w_group; const float* b_group;
    const float* w_router; const float* b_router; const float* w_exp_gate; const float* w_exp_up; const float* w_exp_down;
    const float* norm_final; float* out; unsigned char* ws; int ph_lo, ph_hi;
};

__device__ __forceinline__ int tid_() { int t = threadIdx.x; asm volatile("" : "+v"(t)); return t; }
__device__ __forceinline__ unsigned char* opq(unsigned char* q) { asm volatile("" : "+s"(q)); return q; }
__device__ __forceinline__ bf16_t f2bf(float f) { unsigned u = __float_as_uint(f); u += 0x7fffu + ((u >> 16) & 1u); return (bf16_t)(u >> 16); }
__device__ __forceinline__ float bf2f(bf16_t b) { return __uint_as_float(((unsigned)b) << 16); }
__device__ __forceinline__ unsigned pack2(float lo, float hi) { return (unsigned)f2bf(lo) | ((unsigned)f2bf(hi) << 16); }
__device__ __forceinline__ float bflo(unsigned w) { return __uint_as_float(w << 16); }
__device__ __forceinline__ float bfhi(unsigned w) { return __uint_as_float(w & 0xffff0000u); }
__device__ __forceinline__ float sigmoidf_(float x) { return 1.0f / (1.0f + __expf(-x)); }
__device__ __forceinline__ float siluf_(float x) { return x / (1.0f + __expf(-x)); }
template <int CTRL> __device__ __forceinline__ float dpp_f(float v) { return __int_as_float(__builtin_amdgcn_update_dpp(0, __float_as_int(v), CTRL, 0xf, 0xf, true)); }
__device__ __forceinline__ float sum16(float v) {
    v += dpp_f<0xB1>(v); v += dpp_f<0x4E>(v); v += dpp_f<0x141>(v); v += dpp_f<0x140>(v); return v;
}
__device__ __forceinline__ float wave_sum(float v) { for (int o = 32; o >= 1; o >>= 1) v += __shfl_xor(v, o); return v; }

namespace pg8 {
constexpr int BM = 256, BK = 64, HALF = 128, HTB = HALF * BK * 2, STAGE_BYTES = 8 * HTB, NXCD = 8, WGM = 8;
__device__ __forceinline__ int lds_byte(int r, int c) { const int st = (r >> 4) * 2 + (c >> 5), rr = r & 15, cc = c & 31, ob = rr * 64 + cc * 2; return st * 1024 + (ob ^ (((ob >> 9) & 1) << 5)); }
__device__ __forceinline__ void stage_rc(int b, int& R, int& C) { const int st = b / 1024, sb = b % 1024, swz = sb ^ (((sb >> 9) & 1) << 5); R = (st >> 1) * 16 + swz / 64; C = (st & 1) * 32 + (swz % 64) / 2; }
__device__ __forceinline__ int perm32(int rho) { const int n = rho >> 4, i = rho & 15; return 8 * (i >> 2) + 4 * n + (i & 3); }

struct Unit { int pm, pn; const char* A; const char* B; };

struct DenseOrder {
    int nM, nN, nwg, G, c, K; const char* A; const char* Bt;
    __device__ void init(const void* A_, const void* Bt_, int M, int N, int K_, int G_, int c_) { A = (const char*)A_; Bt = (const char*)Bt_; nM = M / BM; nN = N / BM; nwg = nM * nN; G = G_; c = c_; K = K_; }
    __device__ bool next(int i, Unit& u) const {
        const long L = (long)i * G + c; if (L >= nwg) return false;
        int wgid = (int)L; { const int q = nwg / NXCD, r = nwg % NXCD, xcd = wgid % NXCD, off = wgid / NXCD; wgid = (xcd < r ? xcd * (q + 1) : r * (q + 1) + (xcd - r) * q) + off; }
        const int nig = WGM * nN, gid = wgid / nig, fm = gid * WGM, gsz = (nM - fm) < WGM ? (nM - fm) : WGM;
        u.pm = fm + ((wgid % nig) % gsz); u.pn = (wgid % nig) / gsz;
        u.A = A + (size_t)u.pm * 256 * K * 2; u.B = Bt + (size_t)u.pn * 256 * K * 2; return true;
    }
};
struct GroupedOrder {
    const int* tile_e; int n_mt, nN, G, c, K; const char* A; const char* Bt; size_t bstride;
    __device__ bool next(int i, Unit& u) const {
        const long L = (long)i * G + c; if (L >= (long)n_mt * nN) return false;
        u.pn = (int)(L / n_mt); u.pm = (int)(L % n_mt);
        const int e = tile_e[u.pm];
        u.A = A + (size_t)u.pm * 256 * K * 2; u.B = Bt + (size_t)e * bstride + (size_t)u.pn * 256 * K * 2; return true;
    }
};

template <class Epi, class Sched>
__device__ __forceinline__ void gemm_phase(LAS unsigned char* lds, const int K, const Sched& S, const Epi& E) {
    const int tid = tid_(), wid = __builtin_amdgcn_readfirstlane(tid >> 6), lane = tid & 63, wr = wid >> 2, wc = wid & 3, fr = lane & 15, fq = lane >> 4;
    const int nt = K / BK;
    unsigned voffA[2], voffB[2];
#pragma unroll
    for (int i = 0; i < 2; ++i) { int R, C; stage_rc(tid * 16 + i * 8192, R, C); const int Rb = Epi::PERM ? ((R & ~31) + perm32(R & 31)) : R;
        voffA[i] = (unsigned)(R * K + C) * 2u; voffB[i] = (unsigned)(Rb * K + C) * 2u; }
    const size_t kstep = (size_t)(BK * 2);
    const size_t hstep = (size_t)HALF * K * 2;
    const unsigned ldsw = (unsigned)wid * 1024u;
    const int aoff = lds_byte(wr * 64 + fr, fq * 8), boff = lds_byte(wc * 32 + fr, fq * 8);
#define PG8_SA(b, h) (((b) * 2 + (h)) * HTB)
#define PG8_SB(b, h) ((4 + (b) * 2 + (h)) * HTB)
#define PG8_STAGE(bufoff, gbase, voff) do { _Pragma("unroll") for (int _i = 0; _i < 2; ++_i) \
        __builtin_amdgcn_global_load_lds((const unsigned*)((const char*)(gbase) + (voff)[_i]), (LAS unsigned*)(lds + (bufoff) + ldsw + _i * 8192), 16, 0, 0); } while (0)
#define PG8_LDA(dst, b, h) do { _Pragma("unroll") for (int m = 0; m < 4; ++m) _Pragma("unroll") for (int k = 0; k < 2; ++k) dst[m][k] = *(const LAS bf16x8*)(lds + PG8_SA(b, h) + aoff + m * 2048 + k * 1024); } while (0)
#define PG8_LDB(dst, b, h) do { _Pragma("unroll") for (int n = 0; n < 2; ++n) _Pragma("unroll") for (int k = 0; k < 2; ++k) dst[n][k] = *(const LAS bf16x8*)(lds + PG8_SB(b, h) + boff + n * 2048 + k * 1024); } while (0)
#define PG8_MMA(ai, bj, At, Bt) do { __builtin_amdgcn_s_setprio(1); _Pragma("unroll") for (int m = 0; m < 4; ++m) _Pragma("unroll") for (int n = 0; n < 2; ++n) _Pragma("unroll") for (int k = 0; k < 2; ++k) \
        acc[ai][bj][m][n] = __builtin_amdgcn_mfma_f32_16x16x32_bf16(Bt[n][k], At[m][k], acc[ai][bj][m][n], 0, 0, 0); __builtin_amdgcn_s_setprio(0); } while (0)
#define PG8_WAIT_V(n) asm volatile("s_waitcnt vmcnt(" #n ")" ::: "memory")
#define PG8_WAIT_L(n) asm volatile("s_waitcnt lgkmcnt(" #n ")" ::: "memory")
#define PG8_BAR __builtin_amdgcn_s_barrier()
#define PG8_SCHED __builtin_amdgcn_sched_barrier(0)
    Unit cur, nxt; int ui = 0;
    if (!S.next(0, cur)) return;
    f32x4 acc[2][2][4][2];
#pragma unroll
    for (int a = 0; a < 2; ++a)
#pragma unroll
        for (int b = 0; b < 2; ++b)
#pragma unroll
            for (int m = 0; m < 4; ++m)
#pragma unroll
                for (int n = 0; n < 2; ++n) acc[a][b][m][n] = (f32x4){0.f, 0.f, 0.f, 0.f};
    bf16x8 At[4][2], B0[2][2], B1[2][2];
    const char* cA = cur.A; const char* cB = cur.B;
    PG8_STAGE(PG8_SB(0, 0), cB, voffB); PG8_STAGE(PG8_SA(0, 0), cA, voffA); PG8_STAGE(PG8_SB(0, 1), cB + hstep, voffB); PG8_STAGE(PG8_SA(0, 1), cA + hstep, voffA);
    if (wr == 1) PG8_BAR;
    PG8_WAIT_V(4); PG8_BAR;
    PG8_STAGE(PG8_SB(1, 0), cB + kstep, voffB); PG8_STAGE(PG8_SA(1, 0), cA + kstep, voffA); PG8_STAGE(PG8_SB(1, 1), cB + hstep + kstep, voffB);
    PG8_WAIT_V(6); PG8_BAR;
    for (;;) {
        const bool has_next = S.next(ui + 1, nxt);
        const char* nA = has_next ? nxt.A : cA; const char* nB = has_next ? nxt.B : cB;
        for (int t = 0; t < nt; t += 2) {
            const bool last = (t == nt - 2);
            const char* a1 = cA + (size_t)(t + 1) * kstep;
            const char* a2 = last ? nA : cA + (size_t)(t + 2) * kstep; const char* b2 = last ? nB : cB + (size_t)(t + 2) * kstep;
            const char* a3 = a2 + kstep; const char* b3 = b2 + kstep;
            PG8_LDB(B0, 0, 0); PG8_SCHED; PG8_LDA(At, 0, 0); PG8_STAGE(PG8_SA(1, 1), a1 + hstep, voffA);
            PG8_WAIT_L(8); PG8_BAR; PG8_WAIT_L(0); PG8_MMA(0, 0, At, B0); PG8_BAR; PG8_SCHED;
            PG8_LDB(B1, 0, 1); PG8_STAGE(PG8_SB(0, 0), b2, voffB);
            PG8_BAR; PG8_WAIT_L(0); PG8_MMA(0, 1, At, B1); PG8_BAR;
            PG8_LDA(At, 0, 1); PG8_STAGE(PG8_SA(0, 0), a2, voffA);
            PG8_BAR; PG8_WAIT_L(0); PG8_MMA(1, 0, At, B0); PG8_BAR; PG8_SCHED;
            PG8_STAGE(PG8_SB(0, 1), b2 + hstep, voffB);
            PG8_WAIT_V(6); PG8_BAR; PG8_MMA(1, 1, At, B1); PG8_BAR;
            PG8_LDB(B0, 1, 0); PG8_SCHED; PG8_LDA(At, 1, 0); PG8_STAGE(PG8_SA(0, 1), a2 + hstep, voffA);
            PG8_WAIT_L(8); PG8_BAR; PG8_WAIT_L(0); PG8_MMA(0, 0, At, B0); PG8_BAR; PG8_SCHED;
            PG8_LDB(B1, 1, 1); PG8_STAGE(PG8_SB(1, 0), b3, voffB);
            PG8_BAR; PG8_WAIT_L(0); PG8_MMA(0, 1, At, B1); PG8_BAR;
            PG8_LDA(At, 1, 1); PG8_STAGE(PG8_SA(1, 0), a3, voffA);
            PG8_BAR; PG8_WAIT_L(0); PG8_MMA(1, 0, At, B0); PG8_BAR; PG8_SCHED;
            PG8_STAGE(PG8_SB(1, 1), b3 + hstep, voffB);
            PG8_WAIT_V(6); PG8_BAR; PG8_MMA(1, 1, At, B1); PG8_BAR;
        }
        E(acc, cur, wr, wc, fr, fq);
        if (!has_next) break;
#pragma unroll
        for (int a = 0; a < 2; ++a)
#pragma unroll
            for (int b = 0; b < 2; ++b)
#pragma unroll
                for (int m = 0; m < 4; ++m)
#pragma unroll
                    for (int n = 0; n < 2; ++n) acc[a][b][m][n] = (f32x4){0.f, 0.f, 0.f, 0.f};
        cur = nxt; cA = nA; cB = nB; ++ui;
    }
    PG8_WAIT_V(0);
    if (wr == 0) PG8_BAR;
    PG8_BAR;
#undef PG8_SA
#undef PG8_SB
#undef PG8_STAGE
#undef PG8_LDA
#undef PG8_LDB
#undef PG8_MMA
#undef PG8_WAIT_V
#undef PG8_WAIT_L
#undef PG8_BAR
#undef PG8_SCHED
}
}
using pg8::Unit;

struct EpiProj {
    static constexpr bool PERM = true; bf16_t* O;
    __device__ __forceinline__ void operator()(const f32x4 (&acc)[2][2][4][2], const Unit& u, int wr, int wc, int fr, int fq) const {
        const int row0 = u.pm * 256 + wr * 64 + fr, col0 = u.pn * 256 + wc * 32 + 8 * fq;
#pragma unroll
        for (int ai = 0; ai < 2; ++ai)
#pragma unroll
            for (int m = 0; m < 4; ++m) { bf16_t* rowp = O + (size_t)(row0 + ai * 128 + m * 16) * LDP + col0;
#pragma unroll
                for (int bj = 0; bj < 2; ++bj) { const f32x4 v0 = acc[ai][bj][m][0], v1 = acc[ai][bj][m][1];
                    u32x4 w; w.x = pack2(v0[0], v0[1]); w.y = pack2(v0[2], v0[3]); w.z = pack2(v1[0], v1[1]); w.w = pack2(v1[2], v1[3]);
                    *(u32x4*)(rowp + bj * 128) = w; } }
    }
};
template <int PASS> struct EpiMerge {
    static constexpr bool PERM = true; bf16_t* M; const bf16_t* proj; const float* bg;
    __device__ __forceinline__ void operator()(const f32x4 (&acc)[2][2][4][2], const Unit& u, int wr, int wc, int fr, int fq) const {
        const int row0 = u.pm * 256 + wr * 64 + fr, col0 = u.pn * 256 + wc * 32 + 8 * fq;
#pragma unroll
        for (int ai = 0; ai < 2; ++ai)
#pragma unroll
            for (int m = 0; m < 4; ++m) { const int row = row0 + ai * 128 + m * 16;
#pragma unroll
                for (int bj = 0; bj < 2; ++bj)
#pragma unroll
                    for (int n = 0; n < 2; ++n) { const int col = col0 + bj * 128 + 4 * n;
                        const u32x2 gw = *(const u32x2*)(proj + (size_t)row * LDP + (PASS ? C_G1 : C_G0) + col);
                        const f32x4 b0 = *(const f32x4*)(bg + PASS * 2048 + col);
                        bf16_t* dst = M + (size_t)row * 2048 + col;
                        u32x2 old = {0u, 0u}; if (PASS) old = *(const u32x2*)dst;
                        const f32x4 v = acc[ai][bj][m][n];
                        const float r0 = bflo(old.x) + sigmoidf_(bflo(gw.x) + b0[0]) * v[0], r1 = bfhi(old.x) + sigmoidf_(bfhi(gw.x) + b0[1]) * v[1];
                        const float r2 = bflo(old.y) + sigmoidf_(bflo(gw.y) + b0[2]) * v[2], r3 = bfhi(old.y) + sigmoidf_(bfhi(gw.y) + b0[3]) * v[3];
                        u32x2 w; w.x = pack2(r0, r1); w.y = pack2(r2, r3);
                        *(u32x2*)dst = w; }
                asm volatile("" ::: "memory"); }
    }
};
struct EpiResid {
    static constexpr bool PERM = false; float* X1; const float* X;
    __device__ __forceinline__ void operator()(const f32x4 (&acc)[2][2][4][2], const Unit& u, int wr, int wc, int fr, int fq) const {
        const int row0 = u.pm * 256 + wr * 64 + fr, col0 = u.pn * 256 + wc * 32 + 4 * fq;
#pragma unroll
        for (int ai = 0; ai < 2; ++ai)
#pragma unroll
            for (int m = 0; m < 4; ++m) { const size_t ro = (size_t)(row0 + ai * 128 + m * 16) * 2048 + col0;
#pragma unroll
                for (int bj = 0; bj < 2; ++bj)
#pragma unroll
                    for (int n = 0; n < 2; ++n) { const size_t o = ro + bj * 128 + n * 16; *(f32x4*)(X1 + o) = *(const f32x4*)(X + o) + acc[ai][bj][m][n]; } }
    }
};
struct EpiGateUp {
    static constexpr bool PERM = false; bf16_t* ACT;
    __device__ __forceinline__ void operator()(const f32x4 (&acc)[2][2][4][2], const Unit& u, int wr, int wc, int fr, int fq) const {
        const int row0 = u.pm * 256 + wr * 64 + fr, hid0 = u.pn * 128 + wc * 16 + 4 * fq;
#pragma unroll
        for (int ai = 0; ai < 2; ++ai)
#pragma unroll
            for (int m = 0; m < 4; ++m) { bf16_t* rowp = ACT + (size_t)(row0 + ai * 128 + m * 16) * 512 + hid0;
#pragma unroll
                for (int bj = 0; bj < 2; ++bj) { const f32x4 g = acc[ai][bj][m][0], up = acc[ai][bj][m][1];
                    u32x2 w; w.x = pack2(siluf_(g[0]) * up[0], siluf_(g[1]) * up[1]); w.y = pack2(siluf_(g[2]) * up[2], siluf_(g[3]) * up[3]);
                    *(u32x2*)(rowp + bj * 64) = w; } }
    }
};
struct EpiDown {
    static constexpr bool PERM = true; bf16_t* O;
    __device__ __forceinline__ void operator()(const f32x4 (&acc)[2][2][4][2], const Unit& u, int wr, int wc, int fr, int fq) const {
        const int row0 = u.pm * 256 + wr * 64 + fr, col0 = u.pn * 256 + wc * 32 + 8 * fq;
#pragma unroll
        for (int ai = 0; ai < 2; ++ai)
#pragma unroll
            for (int m = 0; m < 4; ++m) { bf16_t* rowp = O + (size_t)(row0 + ai * 128 + m * 16) * 2048 + col0;
#pragma unroll
                for (int bj = 0; bj < 2; ++bj) { const f32x4 v0 = acc[ai][bj][m][0], v1 = acc[ai][bj][m][1];
                    u32x4 w; w.x = pack2(v0[0], v0[1]); w.y = pack2(v0[2], v0[3]); w.z = pack2(v1[0], v1[1]); w.w = pack2(v1[2], v1[3]);
                    *(u32x4*)(rowp + bj * 128) = w; } }
    }
};

template <class ColSrc, class DstRow>
__device__ void transpose_tiles(LAS float* tile  , bf16_t* dst, int K, int Npad, int lds_src, ColSrc colsrc, DstRow dstrow, int first, int stride, int& tile_counter) {
    const int tid = tid_(), nk = K / 64, nn = Npad / 64, total = nk * nn;
    for (int tt = 0; tt < total; ++tt) {
        const int gidx = tile_counter + tt;
        if ((gidx % stride) != first) continue;
        const int kt = tt % nk, ntile = tt / nk, k0 = kt * 64, n0 = ntile * 64;
        __syncthreads();
        { const int nl = tid & 63, kk0 = tid >> 6; const float* cp = colsrc(n0 + nl);
#pragma unroll
          for (int i = 0; i < 8; ++i) { const int kk = kk0 + 8 * i; tile[kk * 65 + nl] = cp ? cp[(size_t)(k0 + kk) * lds_src] : 0.f; } }
        __syncthreads();
        { const int nl = tid >> 3, kc = tid & 7; float v[8];
#pragma unroll
          for (int j = 0; j < 8; ++j) v[j] = tile[(kc * 8 + j) * 65 + nl];
          u32x4 w; w.x = pack2(v[0], v[1]); w.y = pack2(v[2], v[3]); w.z = pack2(v[4], v[5]); w.w = pack2(v[6], v[7]);
          *(u32x4*)(dst + (size_t)dstrow(n0 + nl) * K + k0 + kc * 8) = w; }
    }
    tile_counter += total;
}

__device__ __forceinline__ int in_col_map(int n) {
    if (n < 4096) return n;
    if (n < 7680) return n + 16;
    if (n < 11776) return n + 88;
    if (n < 11840) return 7696 + (n - 11776);
    if (n < 11848) return 4096 + (n - 11840);
    if (n < 11856) return 4104 + (n - 11848);
    if (n < 11864) return 7760 + (n - 11856);
    return -1;
}

__device__ void phase0(const Params& p, LAS unsigned char* lds) {
    const int G = gridDim.x, c = blockIdx.x, tid = tid_();
    unsigned char* ws = opq(p.ws);
    if (c == 0 && tid < 256) ((unsigned*)(ws + OFF_SMALL + SM_CTRL))[tid] = 0u;
    int counter = 0;
    { const float* w = p.w_in; transpose_tiles((LAS float*)lds, (bf16_t*)(ws + OFF_WT_IN), 2048, LDP, IN_COLS, [w](int n) -> const float* { const int o = in_col_map(n); return o < 0 ? nullptr : w + o; }, [](int n) { return n; }, c, G, counter); }
    { const float* w = p.w_proj_dn; transpose_tiles((LAS float*)lds, (bf16_t*)(ws + OFF_WT_DN), 1024, 2048, 2048, [w](int n) -> const float* { return w + n; }, [](int n) { return n; }, c, G, counter); }
    { const float* w = p.w_proj_att; transpose_tiles((LAS float*)lds, (bf16_t*)(ws + OFF_WT_AT), 1024, 2048, 2048, [w](int n) -> const float* { return w + n; }, [](int n) { return n; }, c, G, counter); }
    { const float* w = p.w_out; transpose_tiles((LAS float*)lds, (bf16_t*)(ws + OFF_WT_OUT), 2048, 2048, 2048, [w](int n) -> const float* { return w + n; }, [](int n) { return n; }, c, G, counter); }
    const int wid = tid >> 6, lane = tid & 63; bf16_t* h = (bf16_t*)(ws + OFF_H);
    for (int row = c * 8 + wid; row < T_; row += G * 8) {
        const float* xr = p.x + (size_t)row * 2048; f32x4 v[8]; float ss = 0.f;
#pragma unroll
        for (int i = 0; i < 8; ++i) { v[i] = *(const f32x4*)(xr + i * 256 + 4 * lane); ss += v[i][0] * v[i][0] + v[i][1] * v[i][1] + v[i][2] * v[i][2] + v[i][3] * v[i][3]; }
        ss = wave_sum(ss); const float rs = rsqrtf(ss * (1.0f / 2048.0f) + EPS);
#pragma unroll
        for (int i = 0; i < 8; ++i) { const f32x4 g = *(const f32x4*)(p.norm_mix + i * 256 + 4 * lane);
            u32x2 w; w.x = pack2(v[i][0] * rs * g[0], v[i][1] * rs * g[1]); w.y = pack2(v[i][2] * rs * g[2], v[i][3] * rs * g[3]);
            *(u32x2*)(h + (size_t)row * 2048 + i * 256 + 4 * lane) = w; }
    }
}

__device__ void phase_rope(const Params& p) {
    const int G = gridDim.x, c = blockIdx.x, tid = tid_(), wid = tid >> 6, lane = tid & 63;
    unsigned char* ws = opq(p.ws); bf16_t* proj = (bf16_t*)(ws + OFF_PROJ); bf16_t* kidx = (bf16_t*)(ws + OFF_SMALL + SM_KIDX); float* wq = (float*)(ws + OFF_SMALL + SM_WQ);
    const float invf = exp2f(-(float)(lane & 15) * 1.1832230355827609f);
    for (int t = c * 8 + wid; t < T_; t += G * 8) {
        const float pos = (float)p.positions[t];
        const float ang = pos * invf;
        double r = (double)ang * 0.15915494309189535; r -= floor(r);
        const float cs = __builtin_amdgcn_cosf((float)r), sn = __builtin_amdgcn_sinf((float)r);
        bf16_t* row = proj + (size_t)t * LDP;
#pragma unroll
        for (int tsel = 0; tsel < 2; ++tsel)
#pragma unroll
            for (int rep = 0; rep < 2; ++rep) { const int pr = lane + 64 * rep, hh = pr >> 4, i = pr & 15;
                const float cc = __shfl(cs, i), ss = __shfl(sn, i);
                bf16_t* q = row + (tsel ? C_AK : C_AQ) + hh * 128 + i; const float x1 = bf2f(q[0]), x2 = bf2f(q[16]);
                q[0] = f2bf(x1 * cc - x2 * ss); q[16] = f2bf(x2 * cc + x1 * ss); }
        { const int hh = lane >> 3, i = lane & 7; const float cc = __shfl(cs, 2 * i), ss = __shfl(sn, 2 * i);
          bf16_t* q = row + C_IQ + hh * 64 + i; const float x1 = bf2f(q[0]), x2 = bf2f(q[8]);
          q[0] = f2bf(x1 * cc - x2 * ss); q[8] = f2bf(x2 * cc + x1 * ss); }
        { float v = bf2f(row[C_IK + lane]); const float ss2 = wave_sum(v * v); v = v * rsqrtf(ss2 * (1.0f / 64.0f) + EPS) * p.idx_k_norm[lane];
          const float oth = __shfl_xor(v, 8); const int i = lane & 7; const float cc = __shfl(cs, 2 * i), ss = __shfl(sn, 2 * i);
          float o = v; if (lane < 8) o = v * cc - oth * ss; else if (lane < 16) o = v * cc + oth * ss;
          kidx[(size_t)t * 64 + lane] = f2bf(o); }
        if (lane < 8) wq[(size_t)t * 8 + lane] = bf2f(row[C_IW + lane]) * 0.044194173824159216f;
    }
}

__device__ void dn_prep_item(const Params& p, int item, LAS float* L) {
    const int tid = tid_(), n = item >> 3, h = item & 7, t0 = n * 64;
    unsigned char* ws = opq(p.ws); const bf16_t* proj = (const bf16_t*)(ws + OFF_PROJ);
    LAS float* qs = L; LAS float* ks = qs + 64 * 129; LAS float* vs = ks + 64 * 129; LAS float* Am = vs + 64 * 129; LAS float* Gs = Am + 64 * 65; LAS float* bs = Gs + 64; LAS float* eg = bs + 64;
    __syncthreads();
    { const int d = tid & 127, grp = tid >> 7;
#pragma unroll
      for (int sel = 0; sel < 3; ++sel) { const int col = sel * 1024 + h * 128 + d; LAS float* dst = sel == 0 ? qs : (sel == 1 ? ks : vs);
          const float w0 = p.conv_w[col], w1 = p.conv_w[3072 + col], w2 = p.conv_w[6144 + col], w3 = p.conv_w[9216 + col];
          const int tb = t0 + grp * 16; float xm3 = tb >= 3 ? bf2f(proj[(size_t)(tb - 3) * LDP + col]) : 0.f, xm2 = tb >= 2 ? bf2f(proj[(size_t)(tb - 2) * LDP + col]) : 0.f, xm1 = tb >= 1 ? bf2f(proj[(size_t)(tb - 1) * LDP + col]) : 0.f;
          for (int i = 0; i < 16; ++i) { const float xt = bf2f(proj[(size_t)(tb + i) * LDP + col]); const float y = w0 * xm3 + w1 * xm2 + w2 * xm1 + w3 * xt;
              dst[(grp * 16 + i) * 129 + d] = siluf_(y); xm3 = xm2; xm2 = xm1; xm1 = xt; } } }
    if (tid < 64) { const int t = t0 + tid; const float bl = bf2f(proj[(size_t)t * LDP + C_B + h]), al = bf2f(proj[(size_t)t * LDP + C_A + h]) + p.dt_bias[h];
        const float sp = fmaxf(al, 0.f) + log1pf(__expf(-fabsf(al))); float g = -__expf(p.a_log[h]) * sp;
        for (int o = 1; o < 64; o <<= 1) { const float u = __shfl_up(g, o); if (tid >= o) g += u; }
        Gs[tid] = g; bs[tid] = sigmoidf_(bl); eg[tid] = __expf(g); }
    __syncthreads();
    { const int i = tid >> 3, part = tid & 7; float sq = 0.f, sk = 0.f;
#pragma unroll
      for (int dd = 0; dd < 16; ++dd) { const float a = qs[i * 129 + part * 16 + dd], b = ks[i * 129 + part * 16 + dd]; sq += a * a; sk += b * b; }
      sq += __shfl_xor(sq, 1); sq += __shfl_xor(sq, 2); sq += __shfl_xor(sq, 4); sk += __shfl_xor(sk, 1); sk += __shfl_xor(sk, 2); sk += __shfl_xor(sk, 4);
      const float rq = rsqrtf(sq + EPS) * 0.08838834764831845f, rk = rsqrtf(sk + EPS);
#pragma unroll
      for (int dd = 0; dd < 16; ++dd) { qs[i * 129 + part * 16 + dd] *= rq; ks[i * 129 + part * 16 + dd] *= rk; } }
    __syncthreads();
    { const int i = tid >> 3, jb = tid & 7; float akk[8], aqk[8];
#pragma unroll
      for (int jj = 0; jj < 8; ++jj) { akk[jj] = 0.f; aqk[jj] = 0.f; }
      for (int d = 0; d < 128; ++d) { const float ki = ks[i * 129 + d], qi = qs[i * 129 + d];
#pragma unroll
          for (int jj = 0; jj < 8; ++jj) { const float kj = ks[(jb * 8 + jj) * 129 + d]; akk[jj] += ki * kj; aqk[jj] += qi * kj; } }
      bf16_t* attn = (bf16_t*)(ws + OFF_DNP + DNP_ATT) + (size_t)item * 4096; const float Gi = Gs[i], bi = bs[i];
#pragma unroll
      for (int jj = 0; jj < 8; ++jj) { const int j = jb * 8 + jj; const float dec = j <= i ? __expf(Gi - Gs[j]) : 0.f;
          Am[i * 65 + j] = j < i ? bi * akk[jj] * dec : 0.f; attn[i * 64 + j] = f2bf(aqk[jj] * dec); } }
    { bf16_t* qd = (bf16_t*)(ws + OFF_DNP + DNP_QD) + (size_t)item * 8192; const int d = tid & 127, grp = tid >> 7;
      for (int i = grp * 16; i < grp * 16 + 16; ++i) qd[i * 128 + d] = f2bf(qs[i * 129 + d] * eg[i]);
      bf16_t* kdT = (bf16_t*)(ws + OFF_DNP + DNP_KDT) + (size_t)item * 8192; const int i2 = tid & 63, dg = tid >> 6; const float f = __expf(Gs[63] - Gs[i2]);
      for (int dk = dg * 16; dk < dg * 16 + 16; ++dk) kdT[dk * 64 + i2] = f2bf(ks[i2 * 129 + dk] * f);
      if (tid == 0) ((float*)(ws + OFF_SMALL + SM_GLAST))[item] = eg[63]; }
    __syncthreads();
    { const int d = tid & 127, grp = tid >> 7;
      for (int i = grp * 16; i < grp * 16 + 16; ++i) { const float b = bs[i]; ks[i * 129 + d] *= b * eg[i]; vs[i * 129 + d] *= b; } }
    __syncthreads();
    if (tid < 256) { LAS float* buf = tid < 128 ? ks : vs; const int cc = tid & 127;
        for (int i = 1; i < 64; ++i) { float a0 = 0.f, a1 = 0.f, a2 = 0.f, a3 = 0.f; int j = 0;
            for (; j + 4 <= i; j += 4) { a0 += Am[i * 65 + j] * buf[j * 129 + cc]; a1 += Am[i * 65 + j + 1] * buf[(j + 1) * 129 + cc]; a2 += Am[i * 65 + j + 2] * buf[(j + 2) * 129 + cc]; a3 += Am[i * 65 + j + 3] * buf[(j + 3) * 129 + cc]; }
            for (; j < i; ++j) a0 += Am[i * 65 + j] * buf[j * 129 + cc];
            buf[i * 129 + cc] -= (a0 + a1) + (a2 + a3); } }
    __syncthreads();
    { bf16_t* wb = (bf16_t*)(ws + OFF_DNP + DNP_W) + (size_t)item * 8192; const int d = tid & 127, grp = tid >> 7;
      for (int i = grp * 16; i < grp * 16 + 16; ++i) wb[i * 128 + d] = f2bf(ks[i * 129 + d]);
      bf16_t* uT = (bf16_t*)(ws + OFF_DNP + DNP_UT) + (size_t)item * 8192; const int i2 = tid & 63, dg = tid >> 6;
      for (int dv = dg * 16; dv < dg * 16 + 16; ++dv) uT[dv * 64 + i2] = f2bf(vs[i2 * 129 + dv]); }
}

__device__ void dn_scan(const Params& p, int b, LAS unsigned char* lds) {
    const int tid = tid_(), w = tid >> 6, lane = tid & 63, fr = lane & 15, fq = lane >> 4, h = b >> 3, e0 = (b & 7) * 16;
    unsigned char* ws = opq(p.ws);
    const bf16_t* wbuf = (const bf16_t*)(ws + OFF_DNP + DNP_W); const bf16_t* uT = (const bf16_t*)(ws + OFF_DNP + DNP_UT); const bf16_t* kdT = (const bf16_t*)(ws + OFF_DNP + DNP_KDT);
    const float* glast = (const float*)(ws + OFF_SMALL + SM_GLAST);
    bf16_t* Sold = (bf16_t*)(ws + OFF_SCAN); bf16_t* vnT = (bf16_t*)(ws + OFF_SCAN + 64 * MB);
    LAS bf16_t* Sb = (LAS bf16_t*)lds;
    LAS bf16_t* Vn = (LAS bf16_t*)(lds + 16 * 136 * 2);
    f32x4 S = {0.f, 0.f, 0.f, 0.f};
    __syncthreads();
    for (int n = 0; n < 256; ++n) {
        const int item = n * 8 + h;
        bf16x8 kd[2], wf[4]; u32x2 u4 = {0u, 0u};
#pragma unroll
        for (int kk = 0; kk < 2; ++kk) kd[kk] = *(const bf16x8*)(kdT + (size_t)item * 8192 + (16 * w + fr) * 64 + kk * 32 + 8 * fq);
        if (w < 4) {
#pragma unroll
            for (int kk = 0; kk < 4; ++kk) wf[kk] = *(const bf16x8*)(wbuf + (size_t)item * 8192 + (16 * w + fr) * 128 + kk * 32 + 8 * fq);
            u4 = *(const u32x2*)(uT + (size_t)item * 8192 + (e0 + fr) * 64 + 16 * w + 4 * fq); }
        const float gl = glast[item];
        { u32x2 sw; sw.x = pack2(S[0], S[1]); sw.y = pack2(S[2], S[3]);
          *(LAS u32x2*)(Sb + fr * 136 + 16 * w + 4 * fq) = sw;
          *(u32x2*)(Sold + (size_t)item * 16384 + (e0 + fr) * 128 + 16 * w + 4 * fq) = sw; }
        __syncthreads();
        if (w < 4) { f32x4 va = {0.f, 0.f, 0.f, 0.f};
#pragma unroll
            for (int kk = 0; kk < 4; ++kk) { const bf16x8 bb = *(const LAS bf16x8*)(Sb + fr * 136 + kk * 32 + 8 * fq); va = __builtin_amdgcn_mfma_f32_16x16x32_bf16(wf[kk], bb, va, 0, 0, 0); }
            u32x2 vw; vw.x = pack2(bflo(u4.x) - va[0], bfhi(u4.x) - va[1]); vw.y = pack2(bflo(u4.y) - va[2], bfhi(u4.y) - va[3]);
            *(LAS u32x2*)(Vn + fr * 72 + 16 * w + 4 * fq) = vw;
            *(u32x2*)(vnT + (size_t)item * 8192 + (e0 + fr) * 64 + 16 * w + 4 * fq) = vw; }
        __syncthreads();
        S = S * gl;
#pragma unroll
        for (int kk = 0; kk < 2; ++kk) { const bf16x8 bb = *(const LAS bf16x8*)(Vn + fr * 72 + kk * 32 + 8 * fq); S = __builtin_amdgcn_mfma_f32_16x16x32_bf16(kd[kk], bb, S, 0, 0, 0); }
    }
}

__device__ __forceinline__ unsigned sortable(float f) { const unsigned u = __float_as_uint(f); return (u & 0x80000000u) ? ~u : (u | 0x80000000u); }

__device__ void compact_query(LAS unsigned* ckey, LAS unsigned* cidx, LAS unsigned* cnt, LAS unsigned* tau, int q, int lane) {
    const int n = (int)cnt[q]; LAS unsigned* kq = ckey + q * 512; LAS unsigned* iq = cidx + q * 512;
    unsigned key[8], idx[8]; bool val[8];
#pragma unroll
    for (int i = 0; i < 8; ++i) { const int e = lane + 64 * i; val[i] = e < n; key[i] = val[i] ? kq[e] : 0u; idx[i] = val[i] ? iq[e] : 0xffffffffu; }
    unsigned th = 0u;
    for (int b = 31; b >= 0; --b) { const unsigned cand = th | (1u << b); int c = 0;
#pragma unroll
        for (int i = 0; i < 8; ++i) c += __popcll(__ballot(val[i] && key[i] >= cand));
        if (c >= 256) th = cand; }
    int cgt = 0, ceq = 0;
#pragma unroll
    for (int i = 0; i < 8; ++i) { cgt += __popcll(__ballot(val[i] && key[i] > th)); ceq += __popcll(__ballot(val[i] && key[i] == th)); }
    const int need = 256 - cgt; unsigned beta = 0xffffffffu;
    if (ceq > need) { beta = 0u;
        for (int b = 14; b >= 0; --b) { const unsigned cand = beta | (1u << b); int c = 0;
#pragma unroll
            for (int i = 0; i < 8; ++i) c += __popcll(__ballot(val[i] && key[i] == th && idx[i] < cand));
            if (c < need) beta = cand; } }
    int base = 0;
#pragma unroll
    for (int i = 0; i < 8; ++i) { const bool keep = val[i] && (key[i] > th || (key[i] == th && idx[i] <= beta)); const unsigned long long m = __ballot(keep);
        const int pos = base + __popcll(m & ((1ull << lane) - 1ull)); if (keep) { kq[pos] = key[i]; iq[pos] = idx[i]; } base += __popcll(m); }
    if (lane == 0) { cnt[q] = 256u; tau[q] = th; }
}

__device__ void dsa_block(const Params& p, int qb, LAS unsigned char* lds) {
    const int tid = tid_(), w = tid >> 6, lane = tid & 63, fr = lane & 15, fq = lane >> 4, t0 = qb * 16;
    unsigned char* ws = opq(p.ws); const bf16_t* proj = (const bf16_t*)(ws + OFF_PROJ); const bf16_t* kidx = (const bf16_t*)(ws + OFF_SMALL + SM_KIDX); const float* wq = (const float*)(ws + OFF_SMALL + SM_WQ);
    bf16_t* yat = (bf16_t*)(ws + OFF_Y + 32 * MB);
    LAS unsigned* ckey = (LAS unsigned*)lds;
    LAS unsigned* cidx = (LAS unsigned*)(lds + 32768);
    LAS float* lg = (LAS float*)(lds + 65536);
    LAS unsigned* cnt = (LAS unsigned*)(lds + 131072);
    LAS unsigned* tau = cnt + 16;
    __syncthreads();
    if (tid < 16) { cnt[tid] = 0u; tau[tid] = 0u; }
    bf16x8 af[8][2]; f32x4 wr4[8];
#pragma unroll
    for (int m = 0; m < 8; ++m) {
#pragma unroll
        for (int kk = 0; kk < 2; ++kk) af[m][kk] = *(const bf16x8*)(proj + (size_t)(t0 + 2 * m + (fr >> 3)) * LDP + C_IQ + (fr & 7) * 64 + kk * 32 + 8 * fq);
        wr4[m] = *(const f32x4*)(wq + (size_t)(t0 + 2 * m + (fq >> 1)) * 8 + 4 * (fq & 1)); }
    __syncthreads();
    const int ntile = (t0 + 15) / 128 + 1; const int mb = 4 * (fq & 1), qh = fq >> 1;
#pragma unroll 1
    for (int kt = 0; kt < ntile; ++kt) {
        const int s = kt * 128 + 16 * w + fr;
        bf16x8 bfr[2];
#pragma unroll
        for (int kk = 0; kk < 2; ++kk) bfr[kk] = *(const bf16x8*)(kidx + (size_t)s * 64 + kk * 32 + 8 * fq);
        float pt[8];
#pragma unroll
        for (int m = 0; m < 8; ++m) { f32x4 a = {0.f, 0.f, 0.f, 0.f};
            a = __builtin_amdgcn_mfma_f32_16x16x32_bf16(af[m][0], bfr[0], a, 0, 0, 0); a = __builtin_amdgcn_mfma_f32_16x16x32_bf16(af[m][1], bfr[1], a, 0, 0, 0);
            pt[m] = wr4[m][0] * fmaxf(a[0], 0.f) + wr4[m][1] * fmaxf(a[1], 0.f) + wr4[m][2] * fmaxf(a[2], 0.f) + wr4[m][3] * fmaxf(a[3], 0.f); }
        const unsigned msk = (fq & 1) ? 0xffffffffu : 0u;
#pragma unroll
        for (int i = 0; i < 4; ++i) { const unsigned lo = __float_as_uint(pt[i]), hi = __float_as_uint(pt[4 + i]);
            const float keep = __uint_as_float((lo & ~msk) | (hi & msk)), send = __uint_as_float((hi & ~msk) | (lo & msk));
            const float v = keep + __shfl_xor(send, 16); const int qq = 2 * (mb + i) + qh;
            const unsigned sk = sortable(v);
            if (s <= t0 + qq && sk > tau[qq]) { const unsigned pos = __hip_atomic_fetch_add(cnt + qq, 1u, __ATOMIC_RELAXED, __HIP_MEMORY_SCOPE_WORKGROUP); ckey[qq * 512 + pos] = sk; cidx[qq * 512 + pos] = (unsigned)s; } }
        __syncthreads();
        const bool lastt = kt == ntile - 1;
#pragma unroll
        for (int rep = 0; rep < 2; ++rep) { const int q = w + 8 * rep; const unsigned cq = cnt[q]; if (cq > (lastt ? 256u : 384u)) compact_query(ckey, cidx, cnt, tau, q, lane); }
        __syncthreads();
    }
    LAS float* lgw = lg + w * 2048;
#pragma unroll 1
    for (int rep = 0; rep < 2; ++rep) {
        const int q = w + 8 * rep, t = t0 + q; const int n = min((int)cnt[q], 256); const LAS unsigned* iq = cidx + q * 512;
        const bf16_t* qrow = proj + (size_t)t * LDP + C_AQ + 8 * lane;
        const u32x4 qa = *(const u32x4*)qrow, qb2 = *(const u32x4*)(qrow + 512);
        const float sc = 0.08838834764831845f * 1.4426950408889634f;
        float q0[8] = {bflo(qa.x) * sc, bfhi(qa.x) * sc, bflo(qa.y) * sc, bfhi(qa.y) * sc, bflo(qa.z) * sc, bfhi(qa.z) * sc, bflo(qa.w) * sc, bfhi(qa.w) * sc};
        float q1[8] = {bflo(qb2.x) * sc, bfhi(qb2.x) * sc, bflo(qb2.y) * sc, bfhi(qb2.y) * sc, bflo(qb2.z) * sc, bfhi(qb2.z) * sc, bflo(qb2.w) * sc, bfhi(qb2.w) * sc};
#pragma unroll 1
        for (int j0 = 0; j0 < n; j0 += 4) {
            u32x4 ka[4], kb[4];
#pragma unroll
            for (int u = 0; u < 4; ++u) { const int j = min(j0 + u, n - 1); const int s = __builtin_amdgcn_readfirstlane((int)iq[j]);
                const bf16_t* kr = proj + (size_t)s * LDP + C_AK + 8 * lane; ka[u] = *(const u32x4*)kr; kb[u] = *(const u32x4*)(kr + 512); }
#pragma unroll
            for (int u = 0; u < 4; ++u) {
                float d0 = q0[0] * bflo(ka[u].x) + q0[1] * bfhi(ka[u].x) + q0[2] * bflo(ka[u].y) + q0[3] * bfhi(ka[u].y) + q0[4] * bflo(ka[u].z) + q0[5] * bfhi(ka[u].z) + q0[6] * bflo(ka[u].w) + q0[7] * bfhi(ka[u].w);
                float d1 = q1[0] * bflo(kb[u].x) + q1[1] * bfhi(kb[u].x) + q1[2] * bflo(kb[u].y) + q1[3] * bfhi(kb[u].y) + q1[4] * bflo(kb[u].z) + q1[5] * bfhi(kb[u].z) + q1[6] * bflo(kb[u].w) + q1[7] * bfhi(kb[u].w);
                d0 = sum16(d0); d1 = sum16(d1);
                if (fr == 0 && j0 + u < n) { lgw[(j0 + u) * 8 + fq] = d0; lgw[(j0 + u) * 8 + 4 + fq] = d1; } }
        }
        float inv0, inv1;
        { const int hh = lane & 7, c = lane >> 3; float mx = -3.0e38f;
          for (int i = 0; i < 32; ++i) { const int j = i * 8 + c; if (j < n) mx = fmaxf(mx, lgw[j * 8 + hh]); }
          mx = fmaxf(mx, __shfl_xor(mx, 8)); mx = fmaxf(mx, __shfl_xor(mx, 16)); mx = fmaxf(mx, __shfl_xor(mx, 32));
          float sm = 0.f;
          for (int i = 0; i < 32; ++i) { const int j = i * 8 + c; if (j < n) { const float e = exp2f(lgw[j * 8 + hh] - mx); lgw[j * 8 + hh] = e; sm += e; } }
          sm += __shfl_xor(sm, 8); sm += __shfl_xor(sm, 16); sm += __shfl_xor(sm, 32);
          const float inv = 1.0f / sm; inv0 = __shfl(inv, fq); inv1 = __shfl(inv, fq + 4); }
        float o0[8], o1[8];
#pragma unroll
        for (int d = 0; d < 8; ++d) { o0[d] = 0.f; o1[d] = 0.f; }
#pragma unroll 1
        for (int j0 = 0; j0 < n; j0 += 4) {
            u32x4 va[4], vb[4]; float p0[4], p1[4];
#pragma unroll
            for (int u = 0; u < 4; ++u) { const int j = min(j0 + u, n - 1); const int s = __builtin_amdgcn_readfirstlane((int)iq[j]);
                const bf16_t* vr = proj + (size_t)s * LDP + C_AV + 8 * lane; va[u] = *(const u32x4*)vr; vb[u] = *(const u32x4*)(vr + 512);
                const bool ok = j0 + u < n; p0[u] = ok ? lgw[j * 8 + fq] : 0.f; p1[u] = ok ? lgw[j * 8 + 4 + fq] : 0.f; }
#pragma unroll
            for (int u = 0; u < 4; ++u) {
                o0[0] += p0[u] * bflo(va[u].x); o0[1] += p0[u] * bfhi(va[u].x); o0[2] += p0[u] * bflo(va[u].y); o0[3] += p0[u] * bfhi(va[u].y);
                o0[4] += p0[u] * bflo(va[u].z); o0[5] += p0[u] * bfhi(va[u].z); o0[6] += p0[u] * bflo(va[u].w); o0[7] += p0[u] * bfhi(va[u].w);
                o1[0] += p1[u] * bflo(vb[u].x); o1[1] += p1[u] * bfhi(vb[u].x); o1[2] += p1[u] * bflo(vb[u].y); o1[3] += p1[u] * bfhi(vb[u].y);
                o1[4] += p1[u] * bflo(vb[u].z); o1[5] += p1[u] * bfhi(vb[u].z); o1[6] += p1[u] * bflo(vb[u].w); o1[7] += p1[u] * bfhi(vb[u].w); }
        }
        u32x4 w0, w1;
        w0.x = pack2(o0[0] * inv0, o0[1] * inv0); w0.y = pack2(o0[2] * inv0, o0[3] * inv0); w0.z = pack2(o0[4] * inv0, o0[5] * inv0); w0.w = pack2(o0[6] * inv0, o0[7] * inv0);
        w1.x = pack2(o1[0] * inv1, o1[1] * inv1); w1.y = pack2(o1[2] * inv1, o1[3] * inv1); w1.z = pack2(o1[4] * inv1, o1[5] * inv1); w1.w = pack2(o1[6] * inv1, o1[7] * inv1);
        *(u32x4*)(yat + (size_t)t * 1024 + 8 * lane) = w0; *(u32x4*)(yat + (size_t)t * 1024 + 512 + 8 * lane) = w1;
    }
}

__device__ void phase3(const Params& p, LAS unsigned char* lds) {
    const int c = blockIdx.x, tid = tid_();
    if (c < 64) dn_scan(p, c, lds);
    unsigned* queue = (unsigned*)(opq(p.ws) + OFF_SMALL + SM_CTRL) + 200;
    LAS int* tk = (LAS int*)(lds + 131072 + 256);
    for (;;) {
        __syncthreads();
        if (tid == 0) *tk = (int)atomicAdd(queue, 1u);
        __syncthreads();
        const int ticket = *tk;
        if (ticket >= 1024) break;
        dsa_block(p, 1023 - ticket, lds);
    }
}

__device__ void dn_out_item(const Params& p, int item, LAS unsigned char* lds) {
    const int tid = tid_(), w = tid >> 6, lane = tid & 63, fr = lane & 15, fq = lane >> 4, m = w & 3, nh = w >> 2, n = item >> 3, h = item & 7;
    unsigned char* ws = opq(p.ws); const bf16_t* proj = (const bf16_t*)(ws + OFF_PROJ);
    const bf16_t* qd = (const bf16_t*)(ws + OFF_DNP + DNP_QD) + (size_t)item * 8192; const bf16_t* attn = (const bf16_t*)(ws + OFF_DNP + DNP_ATT) + (size_t)item * 4096;
    const bf16_t* Sold = (const bf16_t*)(ws + OFF_SCAN) + (size_t)item * 16384; const bf16_t* vnT = (const bf16_t*)(ws + OFF_SCAN + 64 * MB) + (size_t)item * 8192;
    bf16_t* ydn = (bf16_t*)(ws + OFF_Y);
    LAS float* red = (LAS float*)lds;
    f32x4 acc[4];
#pragma unroll
    for (int nt = 0; nt < 4; ++nt) acc[nt] = (f32x4){0.f, 0.f, 0.f, 0.f};
#pragma unroll
    for (int kk = 0; kk < 4; ++kk) { const bf16x8 a = *(const bf16x8*)(qd + (16 * m + fr) * 128 + kk * 32 + 8 * fq);
#pragma unroll
        for (int nt = 0; nt < 4; ++nt) { const bf16x8 b = *(const bf16x8*)(Sold + (size_t)(16 * (4 * nh + nt) + fr) * 128 + kk * 32 + 8 * fq); acc[nt] = __builtin_amdgcn_mfma_f32_16x16x32_bf16(a, b, acc[nt], 0, 0, 0); } }
#pragma unroll
    for (int kk = 0; kk < 2; ++kk) { const bf16x8 a = *(const bf16x8*)(attn + (16 * m + fr) * 64 + kk * 32 + 8 * fq);
#pragma unroll
        for (int nt = 0; nt < 4; ++nt) { const bf16x8 b = *(const bf16x8*)(vnT + (size_t)(16 * (4 * nh + nt) + fr) * 64 + kk * 32 + 8 * fq); acc[nt] = __builtin_amdgcn_mfma_f32_16x16x32_bf16(a, b, acc[nt], 0, 0, 0); } }
    float ssq[4];
#pragma unroll
    for (int j = 0; j < 4; ++j) { float s = 0.f;
#pragma unroll
        for (int nt = 0; nt < 4; ++nt) s += acc[nt][j] * acc[nt][j];
        ssq[j] = sum16(s); }
    __syncthreads();
    if (fr == 0) {
#pragma unroll
        for (int j = 0; j < 4; ++j) red[(16 * m + 4 * fq + j) * 2 + nh] = ssq[j]; }
    __syncthreads();
#pragma unroll
    for (int j = 0; j < 4; ++j) { const int i = 16 * m + 4 * fq + j, t = n * 64 + i; const float rs = rsqrtf((red[i * 2] + red[i * 2 + 1]) * (1.0f / 128.0f) + EPS);
#pragma unroll
        for (int nt = 0; nt < 4; ++nt) { const int dv = 16 * (4 * nh + nt) + fr; const float z = bf2f(proj[(size_t)t * LDP + C_Z + h * 128 + dv]);
            ydn[(size_t)t * 1024 + h * 128 + dv] = f2bf(acc[nt][j] * rs * p.dn_norm_w[dv] * siluf_(z)); } }
}

__device__ void phase_router(const Params& p, LAS unsigned char* lds) {
    const int G = gridDim.x, c = blockIdx.x, tid = tid_(), w = tid >> 6, lane = tid & 63;
    unsigned char* ws = opq(p.ws); const float* x1 = (const float*)(ws + OFF_X1); bf16_t* h2 = (bf16_t*)(ws + OFF_H);
    int* rexp = (int*)(ws + OFF_SMALL + SM_ROUTE); float* rwt = (float*)(ws + OFF_SMALL + SM_ROUTE + 128 * 1024);
    unsigned* ecnt = (unsigned*)(ws + OFF_SMALL + SM_CTRL);
    LAS float* hs = (LAS float*)lds;
    LAS float* red = hs + 2048 * 8;
    LAS float* lgt = red + 8 * 8 * 72;
    for (int it = c; it < T_ / 8; it += G) {
        const int tb = it * 8;
        __syncthreads();
        { const int t = tb + w; const float* xr = x1 + (size_t)t * 2048; f32x4 v[8]; float ss = 0.f;
#pragma unroll
          for (int i = 0; i < 8; ++i) { v[i] = *(const f32x4*)(xr + i * 256 + 4 * lane); ss += v[i][0] * v[i][0] + v[i][1] * v[i][1] + v[i][2] * v[i][2] + v[i][3] * v[i][3]; }
          ss = wave_sum(ss); const float rs = rsqrtf(ss * (1.0f / 2048.0f) + EPS);
#pragma unroll
          for (int i = 0; i < 8; ++i) { const f32x4 g = *(const f32x4*)(p.norm_ffn + i * 256 + 4 * lane); const int k = i * 256 + 4 * lane;
              const float a0 = v[i][0] * rs * g[0], a1 = v[i][1] * rs * g[1], a2 = v[i][2] * rs * g[2], a3 = v[i][3] * rs * g[3];
              u32x2 pk; pk.x = pack2(a0, a1); pk.y = pack2(a2, a3); *(u32x2*)(h2 + (size_t)t * 2048 + k) = pk;
              hs[(k + 0) * 8 + w] = a0; hs[(k + 1) * 8 + w] = a1; hs[(k + 2) * 8 + w] = a2; hs[(k + 3) * 8 + w] = a3; } }
        __syncthreads();
        { float ar[8]; float ag = 0.f;
#pragma unroll
          for (int tt = 0; tt < 8; ++tt) ar[tt] = 0.f;
          const int tg = lane >> 3, gg = lane & 7;
          for (int k = w * 256; k < w * 256 + 256; ++k) { const float wv = p.w_router[(size_t)k * 64 + lane]; const f32x4 ha = *(const LAS f32x4*)(hs + k * 8), hb = *(const LAS f32x4*)(hs + k * 8 + 4);
              ar[0] += ha[0] * wv; ar[1] += ha[1] * wv; ar[2] += ha[2] * wv; ar[3] += ha[3] * wv; ar[4] += hb[0] * wv; ar[5] += hb[1] * wv; ar[6] += hb[2] * wv; ar[7] += hb[3] * wv;
              ag += hs[k * 8 + tg] * p.w_group[(size_t)k * 8 + gg]; }
#pragma unroll
          for (int tt = 0; tt < 8; ++tt) red[(w * 8 + tt) * 72 + lane] = ar[tt];
          red[(w * 8 + tg) * 72 + 64 + gg] = ag; }
        __syncthreads();
        for (int o = tid; o < 8 * 72; o += 512) { const int tt = o / 72, e = o % 72; float s = 0.f;
#pragma unroll
            for (int ww = 0; ww < 8; ++ww) s += red[(ww * 8 + tt) * 72 + e];
            lgt[tt * 72 + e] = s; }
        __syncthreads();
        if (tid < 8) { const int t = tb + tid; LAS float* l = lgt + tid * 72;
            float gmax = -3.0e38f; int gs = 0; float gl[8];
#pragma unroll
            for (int g = 0; g < 8; ++g) { gl[g] = l[64 + g] + p.b_group[g]; if (gl[g] > gmax) { gmax = gl[g]; gs = g; } }
            float gsum = 0.f;
#pragma unroll
            for (int g = 0; g < 8; ++g) gsum += __expf(gl[g] - gmax);
            const float pg = 1.0f / gsum;
            float el[8]; float m1 = -3.0e38f, m2 = -3.0e38f; int i1 = 0, i2 = 0;
#pragma unroll
            for (int e = 0; e < 8; ++e) { el[e] = l[gs * 8 + e] + p.b_router[gs * 8 + e]; }
#pragma unroll
            for (int e = 0; e < 8; ++e) if (el[e] > m1) { m1 = el[e]; i1 = e; }
#pragma unroll
            for (int e = 0; e < 8; ++e) if (e != i1 && el[e] > m2) { m2 = el[e]; i2 = e; }
            const float e2 = __expf(m2 - m1); const float w1 = pg / (1.0f + e2), w2 = pg * e2 / (1.0f + e2);
            const int ex1 = gs * 8 + i1, ex2 = gs * 8 + i2;
            rexp[t * 2] = ex1; rexp[t * 2 + 1] = ex2; rwt[t * 2] = w1; rwt[t * 2 + 1] = w2;
            atomicAdd(ecnt + ex1, 1u); atomicAdd(ecnt + ex2, 1u); }
    }
    int counter = 0;
    for (int e = 0; e < 64; ++e) {
        const float* wg = p.w_exp_gate + (size_t)e * 2048 * 512; const float* wu = p.w_exp_up + (size_t)e * 2048 * 512;
        transpose_tiles((LAS float*)lds, (bf16_t*)(ws + OFF_WGU) + (size_t)e * 1024 * 2048, 2048, 512, 512, [wg](int n) -> const float* { return wg + n; }, [](int n) { return (n >> 4) * 32 + (n & 15); }, c, G, counter);
        transpose_tiles((LAS float*)lds, (bf16_t*)(ws + OFF_WGU) + (size_t)e * 1024 * 2048, 2048, 512, 512, [wu](int n) -> const float* { return wu + n; }, [](int n) { return (n >> 4) * 32 + 16 + (n & 15); }, c, G, counter);
        const float* wd = p.w_exp_down + (size_t)e * 512 * 2048;
        transpose_tiles((LAS float*)lds, (bf16_t*)(ws + OFF_WDT) + (size_t)e * 2048 * 512, 512, 2048, 2048, [wd](int n) -> const float* { return wd + n; }, [](int n) { return n; }, c, G, counter);
    }
}

__device__ void phase_slots(const Params& p, LAS unsigned char* lds) {
    const int G = gridDim.x, c = blockIdx.x, tid = tid_(), w = tid >> 6, lane = tid & 63;
    unsigned char* ws = opq(p.ws); const unsigned* ecnt = (const unsigned*)(ws + OFF_SMALL + SM_CTRL); unsigned* fill = (unsigned*)(ws + OFF_SMALL + SM_CTRL) + 64;
    int* meta = (int*)(ws + OFF_SMALL + SM_CTRL) + 256;
    const int* rexp = (const int*)(ws + OFF_SMALL + SM_ROUTE); int* rpos = (int*)(ws + OFF_SMALL + SM_ROUTE + 256 * 1024);
    const bf16_t* h2 = (const bf16_t*)(ws + OFF_H); bf16_t* xs = (bf16_t*)(ws + OFF_XS);
    LAS int* pstart = (LAS int*)lds;
    __syncthreads();
    if (tid < 64) { const int cn = (int)ecnt[tid]; const int pad = (cn + 255) / 256 * 256; int s = pad;
        for (int o = 1; o < 64; o <<= 1) { const int u = __shfl_up(s, o); if (tid >= o) s += u; }
        pstart[tid] = s - pad; if (tid == 63) pstart[64] = s;
        if (c == 0) { for (int mt = (s - pad) / 256; mt < s / 256; ++mt) meta[1 + mt] = tid; if (tid == 63) meta[0] = s / 256; } }
    __syncthreads();
    for (int a = (c * 8 + w); a < 2 * T_; a += G * 8) {
        const int t = a >> 1, e = rexp[a]; int pos = 0;
        if (lane == 0) { pos = pstart[e] + (int)atomicAdd(fill + e, 1u); rpos[a] = pos; }
        pos = __shfl(pos, 0);
        const u32x4* src = (const u32x4*)(h2 + (size_t)t * 2048); u32x4* dst = (u32x4*)(xs + (size_t)pos * 2048);
#pragma unroll
        for (int i = 0; i < 4; ++i) dst[i * 64 + lane] = src[i * 64 + lane];
    }
}

__device__ void phase_final(const Params& p) {
    const int G = gridDim.x, c = blockIdx.x, tid = tid_(), w = tid >> 6, lane = tid & 63;
    unsigned char* ws = opq(p.ws); const float* x1 = (const float*)(ws + OFF_X1); const bf16_t* ye = (const bf16_t*)(ws + OFF_YE);
    const float* rwt = (const float*)(ws + OFF_SMALL + SM_ROUTE + 128 * 1024); const int* rpos = (const int*)(ws + OFF_SMALL + SM_ROUTE + 256 * 1024);
    for (int t = c * 8 + w; t < T_; t += G * 8) {
        const float w0 = rwt[t * 2], w1 = rwt[t * 2 + 1]; const bf16_t* y0 = ye + (size_t)rpos[t * 2] * 2048; const bf16_t* y1 = ye + (size_t)rpos[t * 2 + 1] * 2048;
        f32x4 v[8]; float ss = 0.f;
#pragma unroll
        for (int i = 0; i < 8; ++i) { const int k = i * 256 + 4 * lane; v[i] = *(const f32x4*)(x1 + (size_t)t * 2048 + k);
            const u32x2 a = *(const u32x2*)(y0 + k), b = *(const u32x2*)(y1 + k);
            v[i][0] += w0 * bflo(a.x) + w1 * bflo(b.x); v[i][1] += w0 * bfhi(a.x) + w1 * bfhi(b.x); v[i][2] += w0 * bflo(a.y) + w1 * bflo(b.y); v[i][3] += w0 * bfhi(a.y) + w1 * bfhi(b.y);
            ss += v[i][0] * v[i][0] + v[i][1] * v[i][1] + v[i][2] * v[i][2] + v[i][3] * v[i][3]; }
        ss = wave_sum(ss); const float rs = rsqrtf(ss * (1.0f / 2048.0f) + EPS);
#pragma unroll
        for (int i = 0; i < 8; ++i) { const int k = i * 256 + 4 * lane; const f32x4 g = *(const f32x4*)(p.norm_final + k);
            f32x4 o; o[0] = v[i][0] * rs * g[0]; o[1] = v[i][1] * rs * g[1]; o[2] = v[i][2] * rs * g[2]; o[3] = v[i][3] * rs * g[3];
            *(f32x4*)(p.out + (size_t)t * 2048 + k) = o; }
    }
}

__device__ void run_phase(const Params& p, int ph, LAS unsigned char* lds) {
    const int G = gridDim.x, c = blockIdx.x; unsigned char* ws = opq(p.ws);
#ifdef ONLY_PHASE
    ph = ONLY_PHASE;
#endif
    switch (ph) {
    case 0: phase0(p, lds); break;
    case 1: { pg8::DenseOrder S; S.init(ws + OFF_H, ws + OFF_WT_IN, T_, LDP, 2048, G, c); EpiProj E; E.O = (bf16_t*)(ws + OFF_PROJ); pg8::gemm_phase(lds, 2048, S, E); } break;
    case 2: phase_rope(p); for (int item = c; item < NITEM; item += G) dn_prep_item(p, item, (LAS float*)lds); break;
    case 3: phase3(p, lds); break;
    case 4: for (int item = c; item < NITEM; item += G) dn_out_item(p, item, lds); break;
    case 5: { pg8::DenseOrder S; S.init(ws + OFF_Y, ws + OFF_WT_DN, T_, 2048, 1024, G, c); EpiMerge<0> E; E.M = (bf16_t*)(ws + OFF_H); E.proj = (const bf16_t*)(ws + OFF_PROJ); E.bg = p.b_gates; pg8::gemm_phase(lds, 1024, S, E);
              pg8::DenseOrder S2; S2.init(ws + OFF_Y + 32 * MB, ws + OFF_WT_AT, T_, 2048, 1024, G, c); EpiMerge<1> E2; E2.M = E.M; E2.proj = E.proj; E2.bg = p.b_gates; pg8::gemm_phase(lds, 1024, S2, E2); } break;
    case 6: { pg8::DenseOrder S; S.init(ws + OFF_H, ws + OFF_WT_OUT, T_, 2048, 2048, G, c); EpiResid E; E.X1 = (float*)(ws + OFF_X1); E.X = p.x; pg8::gemm_phase(lds, 2048, S, E); } break;
    case 7: phase_router(p, lds); break;
    case 8: phase_slots(p, lds); break;
    case 9: { const int* meta = (const int*)(ws + OFF_SMALL + SM_CTRL) + 256; pg8::GroupedOrder S; S.tile_e = meta + 1; S.n_mt = meta[0]; S.nN = 4; S.G = G; S.c = c; S.K = 2048; S.A = (const char*)(ws + OFF_XS); S.Bt = (const char*)(ws + OFF_WGU); S.bstride = (size_t)1024 * 2048 * 2;
              EpiGateUp E; E.ACT = (bf16_t*)(ws + OFF_ACT); pg8::gemm_phase(lds, 2048, S, E); } break;
    case 10: { const int* meta = (const int*)(ws + OFF_SMALL + SM_CTRL) + 256; pg8::GroupedOrder S; S.tile_e = meta + 1; S.n_mt = meta[0]; S.nN = 8; S.G = G; S.c = c; S.K = 512; S.A = (const char*)(ws + OFF_ACT); S.Bt = (const char*)(ws + OFF_WDT); S.bstride = (size_t)2048 * 512 * 2;
              EpiDown E; E.O = (bf16_t*)(ws + OFF_YE); pg8::gemm_phase(lds, 512, S, E); } break;
    case 11: phase_final(p); break;
    default: break;
    }
}

__global__ void __launch_bounds__(512, 2) mega_kernel(Params p) {
    extern __shared__ __attribute__((aligned(16))) unsigned char shm[];
    LAS unsigned char* lds = (LAS unsigned char*)shm;
    cg::grid_group grid = cg::this_grid();
    for (int ph = p.ph_lo; ph < p.ph_hi; ++ph) {
        run_phase(p, ph, lds);
        if (ph + 1 < p.ph_hi) grid.sync();
    }
}

extern "C" void kernel_launch(void* const* d_in, const int* in_sizes, int n_in, void* d_out, int out_size, void* d_ws, size_t ws_size, hipStream_t stream) {
    (void)in_sizes; (void)n_in; (void)out_size;
    static int grid_blocks = 0;
    if (!grid_blocks) {
        int dev = 0, cus = 0, per_cu = 0;
        hipGetDevice(&dev);
        hipDeviceGetAttribute(&cus, hipDeviceAttributeMultiprocessorCount, dev);
        hipFuncSetAttribute((const void*)mega_kernel, hipFuncAttributeMaxDynamicSharedMemorySize, LDS_BYTES);
        hipOccupancyMaxActiveBlocksPerMultiprocessor(&per_cu, mega_kernel, 512, LDS_BYTES);
        if (per_cu > 1) per_cu = 1;
        grid_blocks = cus * per_cu;
        if (grid_blocks <= 0) { fprintf(stderr, "occupancy query failed\n"); grid_blocks = 0; return; }
    }
    if (ws_size < WS_NEED) { fprintf(stderr, "workspace too small: %zu < %zu\n", ws_size, (size_t)WS_NEED); return; }
    Params p{};
    p.x = (const float*)d_in[0]; p.positions = (const int*)d_in[1]; p.norm_mix = (const float*)d_in[2]; p.w_in = (const float*)d_in[3]; p.b_gates = (const float*)d_in[4];
    p.conv_w = (const float*)d_in[5]; p.a_log = (const float*)d_in[6]; p.dt_bias = (const float*)d_in[7]; p.dn_norm_w = (const float*)d_in[8]; p.idx_k_norm = (const float*)d_in[9];
    p.w_proj_dn = (const float*)d_in[10]; p.w_proj_att = (const float*)d_in[11]; p.w_out = (const float*)d_in[12]; p.norm_ffn = (const float*)d_in[13]; p.w_group = (const float*)d_in[14];
    p.b_group = (const float*)d_in[15]; p.w_router = (const float*)d_in[16]; p.b_router = (const float*)d_in[17]; p.w_exp_gate = (const float*)d_in[18]; p.w_exp_up = (const float*)d_in[19];
    p.w_exp_down = (const float*)d_in[20]; p.norm_final = (const float*)d_in[21]; p.out = (float*)d_out; p.ws = (unsigned char*)d_ws;
#if SINGLE_LAUNCH
    p.ph_lo = 0; p.ph_hi = NPHASE;
    void* args[] = {&p};
    hipError_t e = hipLaunchCooperativeKernel((const void*)mega_kernel, dim3(grid_blocks), dim3(512), args, LDS_BYTES, stream);
    if (e != hipSuccess) fprintf(stderr, "cooperative launch failed: %s (grid %d)\n", hipGetErrorString(e), grid_blocks);
#else
    for (int ph = 0; ph < NPHASE; ++ph) { p.ph_lo = ph; p.ph_hi = ph + 1; hipLaunchKernelGGL(mega_kernel, dim3(grid_blocks), dim3(512), LDS_BYTES, stream, p); }
#endif
}
```

```cpp
#include <hip/hip_runtime.h>
#include <hip/hip_cooperative_groups.h>
#include <cstdio>
namespace cg = cooperative_groups;

#define LAS __attribute__((address_space(3)))
typedef unsigned short bf16_t;
typedef short bf16x8 __attribute__((ext_vector_type(8)));
typedef float f32x4 __attribute__((ext_vector_type(4)));
typedef float f32x2 __attribute__((ext_vector_type(2)));
typedef unsigned u32x4 __attribute__((ext_vector_type(4)));
typedef unsigned u32x2 __attribute__((ext_vector_type(2)));

#ifndef SINGLE_LAUNCH
#define SINGLE_LAUNCH 1
#endif

constexpr int T_ = 16384, D_ = 2048, IN_COLS = 11864, LDP = 12032;
constexpr int C_DNQ = 0, C_DNK = 1024, C_DNV = 2048, C_Z = 3072, C_AQ = 4096, C_AK = 5120, C_AV = 6144, C_IQ = 7168,
              C_G0 = 7680, C_G1 = 9728, C_IK = 11776, C_B = 11840, C_A = 11848, C_IW = 11856;
constexpr int NITEM = 2048;
constexpr int PMAX = 49152;
constexpr float EPS = 1e-6f;
constexpr int LDS_BYTES = 140 * 1024;
constexpr int NPHASE = 12;

constexpr size_t MB = 1ull << 20;
constexpr size_t OFF_WT_IN  = 0;
constexpr size_t OFF_WT_DN  = 50 * MB;
constexpr size_t OFF_WT_AT  = 55 * MB;
constexpr size_t OFF_WT_OUT = 60 * MB;
constexpr size_t OFF_SMALL  = 69 * MB;
constexpr size_t OFF_H      = 72 * MB;
constexpr size_t OFF_PROJ   = 136 * MB;
constexpr size_t OFF_DNP    = 512 * MB;
constexpr size_t OFF_SCAN   = 656 * MB;
constexpr size_t OFF_Y      = 752 * MB;
constexpr size_t OFF_X1     = 816 * MB;
constexpr size_t WS_NEED    = 944 * MB;
constexpr size_t OFF_WGU    = 136 * MB;
constexpr size_t OFF_WDT    = 392 * MB;
constexpr size_t OFF_XS     = 520 * MB;
constexpr size_t OFF_ACT    = 712 * MB;
constexpr size_t OFF_YE     = 520 * MB;
constexpr size_t SM_KIDX   = 0;
constexpr size_t SM_WQ     = 2 * MB;
constexpr size_t SM_ROUTE  = 2 * MB + 512 * 1024;
constexpr size_t SM_GLAST  = 2 * MB + 960 * 1024;
constexpr size_t SM_CTRL   = 2 * MB + 1000 * 1024;
constexpr size_t DNP_W = 0, DNP_UT = 32 * MB, DNP_QD = 64 * MB, DNP_KDT = 96 * MB, DNP_ATT = 128 * MB;

struct Params {
    const float* x; const int* positions; const float* norm_mix; const float* w_in; const float* b_gates; const float* conv_w;
    const float* a_log; const float* dt_bias; const float* dn_norm_w; const float* idx_k_norm; const float* w_proj_dn;
    const float* w_proj_att; const float* w_out; const float* norm_ffn; const float* w_group; const float* b_group;
    const float* w_router; const float* b_router; const float* w_exp_gate; const float* w_exp_up; const float* w_exp_down;
    const float* norm_final; float* out; unsigned char* ws; int ph_lo, ph_hi;
};

__device__ __forceinline__ int tid_() { int t = threadIdx.x; asm volatile("" : "+v"(t)); return t; }
__device__ __forceinline__ unsigned char* opq(unsigned char* q) { asm volatile("" : "+s"(q)); return q; }
__device__ __forceinline__ bf16_t f2bf(float f) { unsigned u = __float_as_uint(f); u += 0x7fffu + ((u >> 16) & 1u); return (bf16_t)(u >> 16); }
__device__ __forceinline__ float bf2f(bf16_t b) { return __uint_as_float(((unsigned)b) << 16); }
__device__ __forceinline__ unsigned pack2(float lo, float hi) { return (unsigned)f2bf(lo) | ((unsigned)f2bf(hi) << 16); }
__device__ __forceinline__ float bflo(unsigned w) { return __uint_as_float(w << 16); }
__device__ __forceinline__ float bfhi(unsigned w) { return __uint_as_float(w & 0xffff0000u); }
__device__ __forceinline__ float sigmoidf_(float x) { return 1.0f / (1.0f + __expf(-x)); }
__device__ __forceinline__ float siluf_(float x) { return x / (1.0f + __expf(-x)); }
template <int CTRL> __device__ __forceinline__ float dpp_f(float v) { return __int_as_float(__builtin_amdgcn_update_dpp(0, __float_as_int(v), CTRL, 0xf, 0xf, true)); }
__device__ __forceinline__ float sum16(float v) {
    v += dpp_f<0xB1>(v); v += dpp_f<0x4E>(v); v += dpp_f<0x141>(v); v += dpp_f<0x140>(v); return v;
}
__device__ __forceinline__ float wave_sum(float v) { for (int o = 32; o >= 1; o >>= 1) v += __shfl_xor(v, o); return v; }

namespace pg8 {
constexpr int BM = 256, BK = 64, HALF = 128, HTB = HALF * BK * 2, STAGE_BYTES = 8 * HTB, NXCD = 8, WGM = 8;
__device__ __forceinline__ int lds_byte(int r, int c) { const int st = (r >> 4) * 2 + (c >> 5), rr = r & 15, cc = c & 31, ob = rr * 64 + cc * 2; return st * 1024 + (ob ^ (((ob >> 9) & 1) << 5)); }
__device__ __forceinline__ void stage_rc(int b, int& R, int& C) { const int st = b / 1024, sb = b % 1024, swz = sb ^ (((sb >> 9) & 1) << 5); R = (st >> 1) * 16 + swz / 64; C = (st & 1) * 32 + (swz % 64) / 2; }
__device__ __forceinline__ int perm32(int rho) { const int n = rho >> 4, i = rho & 15; return 8 * (i >> 2) + 4 * n + (i & 3); }

struct Unit { int pm, pn; const char* A; const char* B; };

struct DenseOrder {
    int nM, nN, nwg, G, c, K; const char* A; const char* Bt;
    __device__ void init(const void* A_, const void* Bt_, int M, int N, int K_, int G_, int c_) { A = (const char*)A_; Bt = (const char*)Bt_; nM = M / BM; nN = N / BM; nwg = nM * nN; G = G_; c = c_; K = K_; }
    __device__ bool next(int i, Unit& u) const {
        const long L = (long)i * G + c; if (L >= nwg) return false;
        int wgid = (int)L; { const int q = nwg / NXCD, r = nwg % NXCD, xcd = wgid % NXCD, off = wgid / NXCD; wgid = (xcd < r ? xcd * (q + 1) : r * (q + 1) + (xcd - r) * q) + off; }
        const int nig = WGM * nN, gid = wgid / nig, fm = gid * WGM, gsz = (nM - fm) < WGM ? (nM - fm) : WGM;
        u.pm = fm + ((wgid % nig) % gsz); u.pn = (wgid % nig) / gsz;
        u.A = A + (size_t)u.pm * 256 * K * 2; u.B = Bt + (size_t)u.pn * 256 * K * 2; return true;
    }
};
struct GroupedOrder {
    const int* tile_e; int n_mt, nN, G, c, K; const char* A; const char* Bt; size_t bstride;
    __device__ bool next(int i, Unit& u) const {
        const long L = (long)i * G + c; if (L >= (long)n_mt * nN) return false;
        u.pn = (int)(L / n_mt); u.pm = (int)(L % n_mt);
        const int e = tile_e[u.pm];
        u.A = A + (size_t)u.pm * 256 * K * 2; u.B = Bt + (size_t)e * bstride + (size_t)u.pn * 256 * K * 2; return true;
    }
};

template <class Epi, class Sched>
__device__ __forceinline__ void gemm_phase(LAS unsigned char* lds, const int K, const Sched& S, const Epi& E) {
    const int tid = tid_(), wid = __builtin_amdgcn_readfirstlane(tid >> 6), lane = tid & 63, wr = wid >> 2, wc = wid & 3, fr = lane & 15, fq = lane >> 4;
    const int nt = K / BK;
    unsigned voffA[2], voffB[2];
#pragma unroll
    for (int i = 0; i < 2; ++i) { int R, C; stage_rc(tid * 16 + i * 8192, R, C); const int Rb = Epi::PERM ? ((R & ~31) + perm32(R & 31)) : R;
        voffA[i] = (unsigned)(R * K + C) * 2u; voffB[i] = (unsigned)(Rb * K + C) * 2u; }
    const size_t kstep = (size_t)(BK * 2);
    const size_t hstep = (size_t)HALF * K * 2;
    const unsigned ldsw = (unsigned)wid * 1024u;
    const int aoff = lds_byte(wr * 64 + fr, fq * 8), boff = lds_byte(wc * 32 + fr, fq * 8);
#define PG8_SA(b, h) (((b) * 2 + (h)) * HTB)
#define PG8_SB(b, h) ((4 + (b) * 2 + (h)) * HTB)
#define PG8_STAGE(bufoff, gbase, voff) do { _Pragma("unroll") for (int _i = 0; _i < 2; ++_i) \
        __builtin_amdgcn_global_load_lds((const unsigned*)((const char*)(gbase) + (voff)[_i]), (LAS unsigned*)(lds + (bufoff) + ldsw + _i * 8192), 16, 0, 0); } while (0)
#define PG8_LDA(dst, b, h) do { _Pragma("unroll") for (int m = 0; m < 4; ++m) _Pragma("unroll") for (int k = 0; k < 2; ++k) dst[m][k] = *(const LAS bf16x8*)(lds + PG8_SA(b, h) + aoff + m * 2048 + k * 1024); } while (0)
#define PG8_LDB(dst, b, h) do { _Pragma("unroll") for (int n = 0; n < 2; ++n) _Pragma("unroll") for (int k = 0; k < 2; ++k) dst[n][k] = *(const LAS bf16x8*)(lds + PG8_SB(b, h) + boff + n * 2048 + k * 1024); } while (0)
#define PG8_MMA(ai, bj, At, Bt) do { __builtin_amdgcn_s_setprio(1); _Pragma("unroll") for (int m = 0; m < 4; ++m) _Pragma("unroll") for (int n = 0; n < 2; ++n) _Pragma("unroll") for (int k = 0; k < 2; ++k) \
        acc[ai][bj][m][n] = __builtin_amdgcn_mfma_f32_16x16x32_bf16(Bt[n][k], At[m][k], acc[ai][bj][m][n], 0, 0, 0); __builtin_amdgcn_s_setprio(0); } while (0)
#define PG8_WAIT_V(n) asm volatile("s_waitcnt vmcnt(" #n ")" ::: "memory")
#define PG8_WAIT_L(n) asm volatile("s_waitcnt lgkmcnt(" #n ")" ::: "memory")
#define PG8_BAR __builtin_amdgcn_s_barrier()
#define PG8_SCHED __builtin_amdgcn_sched_barrier(0)
    Unit cur, nxt; int ui = 0;
    if (!S.next(0, cur)) return;
    f32x4 acc[2][2][4][2];
#pragma unroll
    for (int a = 0; a < 2; ++a)
#pragma unroll
        for (int b = 0; b < 2; ++b)
#pragma unroll
            for (int m = 0; m < 4; ++m)
#pragma unroll
                for (int n = 0; n < 2; ++n) acc[a][b][m][n] = (f32x4){0.f, 0.f, 0.f, 0.f};
    bf16x8 At[4][2], B0[2][2], B1[2][2];
    const char* cA = cur.A; const char* cB = cur.B;
    PG8_STAGE(PG8_SB(0, 0), cB, voffB); PG8_STAGE(PG8_SA(0, 0), cA, voffA); PG8_STAGE(PG8_SB(0, 1), cB + hstep, voffB); PG8_STAGE(PG8_SA(0, 1), cA + hstep, voffA);
    if (wr == 1) PG8_BAR;
    PG8_WAIT_V(4); PG8_BAR;
    PG8_STAGE(PG8_SB(1, 0), cB + kstep, voffB); PG8_STAGE(PG8_SA(1, 0), cA + kstep, voffA); PG8_STAGE(PG8_SB(1, 1), cB + hstep + kstep, voffB);
    PG8_WAIT_V(6); PG8_BAR;
    for (;;) {
        const bool has_next = S.next(ui + 1, nxt);
        const char* nA = has_next ? nxt.A : cA; const char* nB = has_next ? nxt.B : cB;
        for (int t = 0; t < nt; t += 2) {
            const bool last = (t == nt - 2);
            const char* a1 = cA + (size_t)(t + 1) * kstep;
            const char* a2 = last ? nA : cA + (size_t)(t + 2) * kstep; const char* b2 = last ? nB : cB + (size_t)(t + 2) * kstep;
            const char* a3 = a2 + kstep; const char* b3 = b2 + kstep;
            PG8_LDB(B0, 0, 0); PG8_SCHED; PG8_LDA(At, 0, 0); PG8_STAGE(PG8_SA(1, 1), a1 + hstep, voffA);
            PG8_WAIT_L(8); PG8_BAR; PG8_WAIT_L(0); PG8_MMA(0, 0, At, B0); PG8_BAR; PG8_SCHED;
            PG8_LDB(B1, 0, 1); PG8_STAGE(PG8_SB(0, 0), b2, voffB);
            PG8_BAR; PG8_WAIT_L(0); PG8_MMA(0, 1, At, B1); PG8_BAR;
            PG8_LDA(At, 0, 1); PG8_STAGE(PG8_SA(0, 0), a2, voffA);
            PG8_BAR; PG8_WAIT_L(0); PG8_MMA(1, 0, At, B0); PG8_BAR; PG8_SCHED;
            PG8_STAGE(PG8_SB(0, 1), b2 + hstep, voffB);
            PG8_WAIT_V(6); PG8_BAR; PG8_MMA(1, 1, At, B1); PG8_BAR;
            PG8_LDB(B0, 1, 0); PG8_SCHED; PG8_LDA(At, 1, 0); PG8_STAGE(PG8_SA(0, 1), a2 + hstep, voffA);
            PG8_WAIT_L(8); PG8_BAR; PG8_WAIT_L(0); PG8_MMA(0, 0, At, B0); PG8_BAR; PG8_SCHED;
            PG8_LDB(B1, 1, 1); PG8_STAGE(PG8_SB(1, 0), b3, voffB);
            PG8_BAR; PG8_WAIT_L(0); PG8_MMA(0, 1, At, B1); PG8_BAR;
            PG8_LDA(At, 1, 1); PG8_STAGE(PG8_SA(1, 0), a3, voffA);
            PG8_BAR; PG8_WAIT_L(0); PG8_MMA(1, 0, At, B0); PG8_BAR; PG8_SCHED;
            PG8_STAGE(PG8_SB(1, 1), b3 + hstep, voffB);
            PG8_WAIT_V(6); PG8_BAR; PG8_MMA(1, 1, At, B1); PG8_BAR;
        }
        E(acc, cur, wr, wc, fr, fq);
        if (!has_next) break;
#pragma unroll
        for (int a = 0; a < 2; ++a)
#pragma unroll
            for (int b = 0; b < 2; ++b)
#pragma unroll
                for (int m = 0; m < 4; ++m)
#pragma unroll
                    for (int n = 0; n < 2; ++n) acc[a][b][m][n] = (f32x4){0.f, 0.f, 0.f, 0.f};
        cur = nxt; cA = nA; cB = nB; ++ui;
    }
    PG8_WAIT_V(0);
    if (wr == 0) PG8_BAR;
    PG8_BAR;
#undef PG8_SA
#undef PG8_SB
#undef PG8_STAGE
#undef PG8_LDA
#undef PG8_LDB
#undef PG8_MMA
#undef PG8_WAIT_V
#undef PG8_WAIT_L
#undef PG8_BAR
#undef PG8_SCHED
}
}
using pg8::Unit;

struct EpiProj {
    static constexpr bool PERM = true; bf16_t* O;
    __device__ __forceinline__ void operator()(const f32x4 (&acc)[2][2][4][2], const Unit& u, int wr, int wc, int fr, int fq) const {
        const int row0 = u.pm * 256 + wr * 64 + fr, col0 = u.pn * 256 + wc * 32 + 8 * fq;
#pragma unroll
        for (int ai = 0; ai < 2; ++ai)
#pragma unroll
            for (int m = 0; m < 4; ++m) { bf16_t* rowp = O + (size_t)(row0 + ai * 128 + m * 16) * LDP + col0;
#pragma unroll
                for (int bj = 0; bj < 2; ++bj) { const f32x4 v0 = acc[ai][bj][m][0], v1 = acc[ai][bj][m][1];
                    u32x4 w; w.x = pack2(v0[0], v0[1]); w.y = pack2(v0[2], v0[3]); w.z = pack2(v1[0], v1[1]); w.w = pack2(v1[2], v1[3]);
                    *(u32x4*)(rowp + bj * 128) = w; } }
    }
};
template <int PASS> struct EpiMerge {
    static constexpr bool PERM = true; bf16_t* M; const bf16_t* proj; const float* bg;
    __device__ __forceinline__ void operator()(const f32x4 (&acc)[2][2][4][2], const Unit& u, int wr, int wc, int fr, int fq) const {
        const int row0 = u.pm * 256 + wr * 64 + fr, col0 = u.pn * 256 + wc * 32 + 8 * fq;
#pragma unroll
        for (int ai = 0; ai < 2; ++ai)
#pragma unroll
            for (int m = 0; m < 4; ++m) { const int row = row0 + ai * 128 + m * 16;
#pragma unroll
                for (int bj = 0; bj < 2; ++bj)
#pragma unroll
                    for (int n = 0; n < 2; ++n) { const int col = col0 + bj * 128 + 4 * n;
                        const u32x2 gw = *(const u32x2*)(proj + (size_t)row * LDP + (PASS ? C_G1 : C_G0) + col);
                        const f32x4 b0 = *(const f32x4*)(bg + PASS * 2048 + col);
                        bf16_t* dst = M + (size_t)row * 2048 + col;
                        u32x2 old = {0u, 0u}; if (PASS) old = *(const u32x2*)dst;
                        const f32x4 v = acc[ai][bj][m][n];
                        const float r0 = bflo(old.x) + sigmoidf_(bflo(gw.x) + b0[0]) * v[0], r1 = bfhi(old.x) + sigmoidf_(bfhi(gw.x) + b0[1]) * v[1];
                        const float r2 = bflo(old.y) + sigmoidf_(bflo(gw.y) + b0[2]) * v[2], r3 = bfhi(old.y) + sigmoidf_(bfhi(gw.y) + b0[3]) * v[3];
                        u32x2 w; w.x = pack2(r0, r1); w.y = pack2(r2, r3);
                        *(u32x2*)dst = w; }
                asm volatile("" ::: "memory"); }
    }
};
struct EpiResid {
    static constexpr bool PERM = false; float* X1; const float* X;
    __device__ __forceinline__ void operator()(const f32x4 (&acc)[2][2][4][2], const Unit& u, int wr, int wc, int fr, int fq) const {
        const int row0 = u.pm * 256 + wr * 64 + fr, col0 = u.pn * 256 + wc * 32 + 4 * fq;
#pragma unroll
        for (int ai = 0; ai < 2; ++ai)
#pragma unroll
            for (int m = 0; m < 4; ++m) { const size_t ro = (size_t)(row0 + ai * 128 + m * 16) * 2048 + col0;
#pragma unroll
                for (int bj = 0; bj < 2; ++bj)
#pragma unroll
                    for (int n = 0; n < 2; ++n) { const size_t o = ro + bj * 128 + n * 16; *(f32x4*)(X1 + o) = *(const f32x4*)(X + o) + acc[ai][bj][m][n]; } }
    }
};
struct EpiGateUp {
    static constexpr bool PERM = false; bf16_t* ACT;
    __device__ __forceinline__ void operator()(const f32x4 (&acc)[2][2][4][2], const Unit& u, int wr, int wc, int fr, int fq) const {
        const int row0 = u.pm * 256 + wr * 64 + fr, hid0 = u.pn * 128 + wc * 16 + 4 * fq;
#pragma unroll
        for (int ai = 0; ai < 2; ++ai)
#pragma unroll
            for (int m = 0; m < 4; ++m) { bf16_t* rowp = ACT + (size_t)(row0 + ai * 128 + m * 16) * 512 + hid0;
#pragma unroll
                for (int bj = 0; bj < 2; ++bj) { const f32x4 g = acc[ai][bj][m][0], up = acc[ai][bj][m][1];
                    u32x2 w; w.x = pack2(siluf_(g[0]) * up[0], siluf_(g[1]) * up[1]); w.y = pack2(siluf_(g[2]) * up[2], siluf_(g[3]) * up[3]);
                    *(u32x2*)(rowp + bj * 64) = w; } }
    }
};
struct EpiDown {
    static constexpr bool PERM = true; bf16_t* O;
    __device__ __forceinline__ void operator()(const f32x4 (&acc)[2][2][4][2], const Unit& u, int wr, int wc, int fr, int fq) const {
        const int row0 = u.pm * 256 + wr * 64 + fr, col0 = u.pn * 256 + wc * 32 + 8 * fq;
#pragma unroll
        for (int ai = 0; ai < 2; ++ai)
#pragma unroll
            for (int m = 0; m < 4; ++m) { bf16_t* rowp = O + (size_t)(row0 + ai * 128 + m * 16) * 2048 + col0;
#pragma unroll
                for (int bj = 0; bj < 2; ++bj) { const f32x4 v0 = acc[ai][bj][m][0], v1 = acc[ai][bj][m][1];
                    u32x4 w; w.x = pack2(v0[0], v0[1]); w.y = pack2(v0[2], v0[3]); w.z = pack2(v1[0], v1[1]); w.w = pack2(v1[2], v1[3]);
                    *(u32x4*)(rowp + bj * 128) = w; } }
    }
};

template <class ColSrc, class DstRow>
__device__ void transpose_tiles(LAS float* tile  , bf16_t* dst, int K, int Npad, int lds_src, ColSrc colsrc, DstRow dstrow, int first, int stride, int& tile_counter) {
    const int tid = tid_(), nk = K / 64, nn = Npad / 64, total = nk * nn;
    for (int tt = 0; tt < total; ++tt) {
        const int gidx = tile_counter + tt;
        if ((gidx % stride) != first) continue;
        const int kt = tt % nk, ntile = tt / nk, k0 = kt * 64, n0 = ntile * 64;
        __syncthreads();
        { const int nl = tid & 63, kk0 = tid >> 6; const float* cp = colsrc(n0 + nl);
#pragma unroll
          for (int i = 0; i < 8; ++i) { const int kk = kk0 + 8 * i; tile[kk * 65 + nl] = cp ? cp[(size_t)(k0 + kk) * lds_src] : 0.f; } }
        __syncthreads();
        { const int nl = tid >> 3, kc = tid & 7; float v[8];
#pragma unroll
          for (int j = 0; j < 8; ++j) v[j] = tile[(kc * 8 + j) * 65 + nl];
          u32x4 w; w.x = pack2(v[0], v[1]); w.y = pack2(v[2], v[3]); w.z = pack2(v[4], v[5]); w.w = pack2(v[6], v[7]);
          *(u32x4*)(dst + (size_t)dstrow(n0 + nl) * K + k0 + kc * 8) = w; }
    }
    tile_counter += total;
}

__device__ __forceinline__ int in_col_map(int n) {
    if (n < 4096) return n;
    if (n < 7680) return n + 16;
    if (n < 11776) return n + 88;
    if (n < 11840) return 7696 + (n - 11776);
    if (n < 11848) return 4096 + (n - 11840);
    if (n < 11856) return 4104 + (n - 11848);
    if (n < 11864) return 7760 + (n - 11856);
    return -1;
}

__device__ void phase0(const Params& p, LAS unsigned char* lds) {
    const int G = gridDim.x, c = blockIdx.x, tid = tid_();
    unsigned char* ws = opq(p.ws);
    if (c == 0 && tid < 256) ((unsigned*)(ws + OFF_SMALL + SM_CTRL))[tid] = 0u;
    int counter = 0;
    { const float* w = p.w_in; transpose_tiles((LAS float*)lds, (bf16_t*)(ws + OFF_WT_IN), 2048, LDP, IN_COLS, [w](int n) -> const float* { const int o = in_col_map(n); return o < 0 ? nullptr : w + o; }, [](int n) { return n; }, c, G, counter); }
    { const float* w = p.w_proj_dn; transpose_tiles((LAS float*)lds, (bf16_t*)(ws + OFF_WT_DN), 1024, 2048, 2048, [w](int n) -> const float* { return w + n; }, [](int n) { return n; }, c, G, counter); }
    { const float* w = p.w_proj_att; transpose_tiles((LAS float*)lds, (bf16_t*)(ws + OFF_WT_AT), 1024, 2048, 2048, [w](int n) -> const float* { return w + n; }, [](int n) { return n; }, c, G, counter); }
    { const float* w = p.w_out; transpose_tiles((LAS float*)lds, (bf16_t*)(ws + OFF_WT_OUT), 2048, 2048, 2048, [w](int n) -> const float* { return w + n; }, [](int n) { return n; }, c, G, counter); }
    const int wid = tid >> 6, lane = tid & 63; bf16_t* h = (bf16_t*)(ws + OFF_H);
    for (int row = c * 8 + wid; row < T_; row += G * 8) {
        const float* xr = p.x + (size_t)row * 2048; f32x4 v[8]; float ss = 0.f;
#pragma unroll
        for (int i = 0; i < 8; ++i) { v[i] = *(const f32x4*)(xr + i * 256 + 4 * lane); ss += v[i][0] * v[i][0] + v[i][1] * v[i][1] + v[i][2] * v[i][2] + v[i][3] * v[i][3]; }
        ss = wave_sum(ss); const float rs = rsqrtf(ss * (1.0f / 2048.0f) + EPS);
#pragma unroll
        for (int i = 0; i < 8; ++i) { const f32x4 g = *(const f32x4*)(p.norm_mix + i * 256 + 4 * lane);
            u32x2 w; w.x = pack2(v[i][0] * rs * g[0], v[i][1] * rs * g[1]); w.y = pack2(v[i][2] * rs * g[2], v[i][3] * rs * g[3]);
            *(u32x2*)(h + (size_t)row * 2048 + i * 256 + 4 * lane) = w; }
    }
}

__device__ void phase_rope(const Params& p) {
    const int G = gridDim.x, c = blockIdx.x, tid = tid_(), wid = tid >> 6, lane = tid & 63;
    unsigned char* ws = opq(p.ws); bf16_t* proj = (bf16_t*)(ws + OFF_PROJ); bf16_t* kidx = (bf16_t*)(ws + OFF_SMALL + SM_KIDX); float* wq = (float*)(ws + OFF_SMALL + SM_WQ);
    const float invf = exp2f(-(float)(lane & 15) * 1.1832230355827609f);
    for (int t = c * 8 + wid; t < T_; t += G * 8) {
        const float pos = (float)p.positions[t];
        const float ang = pos * invf;
        double r = (double)ang * 0.15915494309189535; r -= floor(r);
        const float cs = __builtin_amdgcn_cosf((float)r), sn = __builtin_amdgcn_sinf((float)r);
        bf16_t* row = proj + (size_t)t * LDP;
#pragma unroll
        for (int tsel = 0; tsel < 2; ++tsel)
#pragma unroll
            for (int rep = 0; rep < 2; ++rep) { const int pr = lane + 64 * rep, hh = pr >> 4, i = pr & 15;
                const float cc = __shfl(cs, i), ss = __shfl(sn, i);
                bf16_t* q = row + (tsel ? C_AK : C_AQ) + hh * 128 + i; const float x1 = bf2f(q[0]), x2 = bf2f(q[16]);
                q[0] = f2bf(x1 * cc - x2 * ss); q[16] = f2bf(x2 * cc + x1 * ss); }
        { const int hh = lane >> 3, i = lane & 7; const float cc = __shfl(cs, 2 * i), ss = __shfl(sn, 2 * i);
          bf16_t* q = row + C_IQ + hh * 64 + i; const float x1 = bf2f(q[0]), x2 = bf2f(q[8]);
          q[0] = f2bf(x1 * cc - x2 * ss); q[8] = f2bf(x2 * cc + x1 * ss); }
        { float v = bf2f(row[C_IK + lane]); const float ss2 = wave_sum(v * v); v = v * rsqrtf(ss2 * (1.0f / 64.0f) + EPS) * p.idx_k_norm[lane];
          const float oth = __shfl_xor(v, 8); const int i = lane & 7; const float cc = __shfl(cs, 2 * i), ss = __shfl(sn, 2 * i);
          float o = v; if (lane < 8) o = v * cc - oth * ss; else if (lane < 16) o = v * cc + oth * ss;
          kidx[(size_t)t * 64 + lane] = f2bf(o); }
        if (lane < 8) wq[(size_t)t * 8 + lane] = bf2f(row[C_IW + lane]) * 0.044194173824159216f;
    }
}

__device__ void dn_prep_item(const Params& p, int item, LAS float* L) {
    const int tid = tid_(), n = item >> 3, h = item & 7, t0 = n * 64;
    unsigned char* ws = opq(p.ws); const bf16_t* proj = (const bf16_t*)(ws + OFF_PROJ);
    LAS float* qs = L; LAS float* ks = qs + 64 * 129; LAS float* vs = ks + 64 * 129; LAS float* Am = vs + 64 * 129; LAS float* Gs = Am + 64 * 65; LAS float* bs = Gs + 64; LAS float* eg = bs + 64;
    __syncthreads();
    { const int d = tid & 127, grp = tid >> 7;
#pragma unroll
      for (int sel = 0; sel < 3; ++sel) { const int col = sel * 1024 + h * 128 + d; LAS float* dst = sel == 0 ? qs : (sel == 1 ? ks : vs);
          const float w0 = p.conv_w[col], w1 = p.conv_w[3072 + col], w2 = p.conv_w[6144 + col], w3 = p.conv_w[9216 + col];
          const int tb = t0 + grp * 16; float xm3 = tb >= 3 ? bf2f(proj[(size_t)(tb - 3) * LDP + col]) : 0.f, xm2 = tb >= 2 ? bf2f(proj[(size_t)(tb - 2) * LDP + col]) : 0.f, xm1 = tb >= 1 ? bf2f(proj[(size_t)(tb - 1) * LDP + col]) : 0.f;
          for (int i = 0; i < 16; ++i) { const float xt = bf2f(proj[(size_t)(tb + i) * LDP + col]); const float y = w0 * xm3 + w1 * xm2 + w2 * xm1 + w3 * xt;
              dst[(grp * 16 + i) * 129 + d] = siluf_(y); xm3 = xm2; xm2 = xm1; xm1 = xt; } } }
    if (tid < 64) { const int t = t0 + tid; const float bl = bf2f(proj[(size_t)t * LDP + C_B + h]), al = bf2f(proj[(size_t)t * LDP + C_A + h]) + p.dt_bias[h];
        const float sp = fmaxf(al, 0.f) + log1pf(__expf(-fabsf(al))); float g = -__expf(p.a_log[h]) * sp;
        for (int o = 1; o < 64; o <<= 1) { const float u = __shfl_up(g, o); if (tid >= o) g += u; }
        Gs[tid] = g; bs[tid] = sigmoidf_(bl); eg[tid] = __expf(g); }
    __syncthreads();
    { const int i = tid >> 3, part = tid & 7; float sq = 0.f, sk = 0.f;
#pragma unroll
      for (int dd = 0; dd < 16; ++dd) { const float a = qs[i * 129 + part * 16 + dd], b = ks[i * 129 + part * 16 + dd]; sq += a * a; sk += b * b; }
      sq += __shfl_xor(sq, 1); sq += __shfl_xor(sq, 2); sq += __shfl_xor(sq, 4); sk += __shfl_xor(sk, 1); sk += __shfl_xor(sk, 2); sk += __shfl_xor(sk, 4);
      const float rq = rsqrtf(sq + EPS) * 0.08838834764831845f, rk = rsqrtf(sk + EPS);
#pragma unroll
      for (int dd = 0; dd < 16; ++dd) { qs[i * 129 + part * 16 + dd] *= rq; ks[i * 129 + part * 16 + dd] *= rk; } }
    __syncthreads();
    { const int i = tid >> 3, jb = tid & 7; float akk[8], aqk[8];
#pragma unroll
      for (int jj = 0; jj < 8; ++jj) { akk[jj] = 0.f; aqk[jj] = 0.f; }
      for (int d = 0; d < 128; ++d) { const float ki = ks[i * 129 + d], qi = qs[i * 129 + d];
#pragma unroll
          for (int jj = 0; jj < 8; ++jj) { const float kj = ks[(jb * 8 + jj) * 129 + d]; akk[jj] += ki * kj; aqk[jj] += qi * kj; } }
      bf16_t* attn = (bf16_t*)(ws + OFF_DNP + DNP_ATT) + (size_t)item * 4096; const float Gi = Gs[i], bi = bs[i];
#pragma unroll
      for (int jj = 0; jj < 8; ++jj) { const int j = jb * 8 + jj; const float dec = j <= i ? __expf(Gi - Gs[j]) : 0.f;
          Am[i * 65 + j] = j < i ? bi * akk[jj] * dec : 0.f; attn[i * 64 + j] = f2bf(aqk[jj] * dec); } }
    { bf16_t* qd = (bf16_t*)(ws + OFF_DNP + DNP_QD) + (size_t)item * 8192; const int d = tid & 127, grp = tid >> 7;
      for (int i = grp * 16; i < grp * 16 + 16; ++i) qd[i * 128 + d] = f2bf(qs[i * 129 + d] * eg[i]);
      bf16_t* kdT = (bf16_t*)(ws + OFF_DNP + DNP_KDT) + (size_t)item * 8192; const int i2 = tid & 63, dg = tid >> 6; const float f = __expf(Gs[63] - Gs[i2]);
      for (int dk = dg * 16; dk < dg * 16 + 16; ++dk) kdT[dk * 64 + i2] = f2bf(ks[i2 * 129 + dk] * f);
      if (tid == 0) ((float*)(ws + OFF_SMALL + SM_GLAST))[item] = eg[63]; }
    __syncthreads();
    { const int d = tid & 127, grp = tid >> 7;
      for (int i = grp * 16; i < grp * 16 + 16; ++i) { const float b = bs[i]; ks[i * 129 + d] *= b * eg[i]; vs[i * 129 + d] *= b; } }
    __syncthreads();
    if (tid < 256) { LAS float* buf = tid < 128 ? ks : vs; const int cc = tid & 127;
        for (int i = 1; i < 64; ++i) { float a0 = 0.f, a1 = 0.f, a2 = 0.f, a3 = 0.f; int j = 0;
            for (; j + 4 <= i; j += 4) { a0 += Am[i * 65 + j] * buf[j * 129 + cc]; a1 += Am[i * 65 + j + 1] * buf[(j + 1) * 129 + cc]; a2 += Am[i * 65 + j + 2] * buf[(j + 2) * 129 + cc]; a3 += Am[i * 65 + j + 3] * buf[(j + 3) * 129 + cc]; }
            for (; j < i; ++j) a0 += Am[i * 65 + j] * buf[j * 129 + cc];
            buf[i * 129 + cc] -= (a0 + a1) + (a2 + a3); } }
    __syncthreads();
    { bf16_t* wb = (bf16_t*)(ws + OFF_DNP + DNP_W) + (size_t)item * 8192; const int d = tid & 127, grp = tid >> 7;
      for (int i = grp * 16; i < grp * 16 + 16; ++i) wb[i * 128 + d] = f2bf(ks[i * 129 + d]);
      bf16_t* uT = (bf16_t*)(ws + OFF_DNP + DNP_UT) + (size_t)item * 8192; const int i2 = tid & 63, dg = tid >> 6;
      for (int dv = dg * 16; dv < dg * 16 + 16; ++dv) uT[dv * 64 + i2] = f2bf(vs[i2 * 129 + dv]); }
}

__device__ void dn_scan(const Params& p, int b, LAS unsigned char* lds) {
    const int tid = tid_(), w = tid >> 6, lane = tid & 63, fr = lane & 15, fq = lane >> 4, h = b >> 3, e0 = (b & 7) * 16;
    unsigned char* ws = opq(p.ws);
    const bf16_t* wbuf = (const bf16_t*)(ws + OFF_DNP + DNP_W); const bf16_t* uT = (const bf16_t*)(ws + OFF_DNP + DNP_UT); const bf16_t* kdT = (const bf16_t*)(ws + OFF_DNP + DNP_KDT);
    const float* glast = (const float*)(ws + OFF_SMALL + SM_GLAST);
    bf16_t* Sold = (bf16_t*)(ws + OFF_SCAN); bf16_t* vnT = (bf16_t*)(ws + OFF_SCAN + 64 * MB);
    LAS bf16_t* Sb = (LAS bf16_t*)lds;
    LAS bf16_t* Vn = (LAS bf16_t*)(lds + 16 * 136 * 2);
    f32x4 S = {0.f, 0.f, 0.f, 0.f};
    __syncthreads();
    for (int n = 0; n < 256; ++n) {
        const int item = n * 8 + h;
        bf16x8 kd[2], wf[4]; u32x2 u4 = {0u, 0u};
#pragma unroll
        for (int kk = 0; kk < 2; ++kk) kd[kk] = *(const bf16x8*)(kdT + (size_t)item * 8192 + (16 * w + fr) * 64 + kk * 32 + 8 * fq);
        if (w < 4) {
#pragma unroll
            for (int kk = 0; kk < 4; ++kk) wf[kk] = *(const bf16x8*)(wbuf + (size_t)item * 8192 + (16 * w + fr) * 128 + kk * 32 + 8 * fq);
            u4 = *(const u32x2*)(uT + (size_t)item * 8192 + (e0 + fr) * 64 + 16 * w + 4 * fq); }
        const float gl = glast[item];
        { u32x2 sw; sw.x = pack2(S[0], S[1]); sw.y = pack2(S[2], S[3]);
          *(LAS u32x2*)(Sb + fr * 136 + 16 * w + 4 * fq) = sw;
          *(u32x2*)(Sold + (size_t)item * 16384 + (e0 + fr) * 128 + 16 * w + 4 * fq) = sw; }
        __syncthreads();
        if (w < 4) { f32x4 va = {0.f, 0.f, 0.f, 0.f};
#pragma unroll
            for (int kk = 0; kk < 4; ++kk) { const bf16x8 bb = *(const LAS bf16x8*)(Sb + fr * 136 + kk * 32 + 8 * fq); va = __builtin_amdgcn_mfma_f32_16x16x32_bf16(wf[kk], bb, va, 0, 0, 0); }
            u32x2 vw; vw.x = pack2(bflo(u4.x) - va[0], bfhi(u4.x) - va[1]); vw.y = pack2(bflo(u4.y) - va[2], bfhi(u4.y) - va[3]);
            *(LAS u32x2*)(Vn + fr * 72 + 16 * w + 4 * fq) = vw;
            *(u32x2*)(vnT + (size_t)item * 8192 + (e0 + fr) * 64 + 16 * w + 4 * fq) = vw; }
        __syncthreads();
        S = S * gl;
#pragma unroll
        for (int kk = 0; kk < 2; ++kk) { const bf16x8 bb = *(const LAS bf16x8*)(Vn + fr * 72 + kk * 32 + 8 * fq); S = __builtin_amdgcn_mfma_f32_16x16x32_bf16(kd[kk], bb, S, 0, 0, 0); }
    }
}

__device__ __forceinline__ unsigned sortable(float f) { const unsigned u = __float_as_uint(f); return (u & 0x80000000u) ? ~u : (u | 0x80000000u); }

__device__ void compact_query(LAS unsigned* ckey, LAS unsigned* cidx, LAS unsigned* cnt, LAS unsigned* tau, int q, int lane) {
    const int n = (int)cnt[q]; LAS unsigned* kq = ckey + q * 512; LAS unsigned* iq = cidx + q * 512;
    unsigned key[8], idx[8]; bool val[8];
#pragma unroll
    for (int i = 0; i < 8; ++i) { const int e = lane + 64 * i; val[i] = e < n; key[i] = val[i] ? kq[e] : 0u; idx[i] = val[i] ? iq[e] : 0xffffffffu; }
    unsigned th = 0u;
    for (int b = 31; b >= 0; --b) { const unsigned cand = th | (1u << b); int c = 0;
#pragma unroll
        for (int i = 0; i < 8; ++i) c += __popcll(__ballot(val[i] && key[i] >= cand));
        if (c >= 256) th = cand; }
    int cgt = 0, ceq = 0;
#pragma unroll
    for (int i = 0; i < 8; ++i) { cgt += __popcll(__ballot(val[i] && key[i] > th)); ceq += __popcll(__ballot(val[i] && key[i] == th)); }
    const int need = 256 - cgt; unsigned beta = 0xffffffffu;
    if (ceq > need) { beta = 0u;
        for (int b = 14; b >= 0; --b) { const unsigned cand = beta | (1u << b); int c = 0;
#pragma unroll
            for (int i = 0; i < 8; ++i) c += __popcll(__ballot(val[i] && key[i] == th && idx[i] < cand));
            if (c < need) beta = cand; } }
    int base = 0;
#pragma unroll
    for (int i = 0; i < 8; ++i) { const bool keep = val[i] && (key[i] > th || (key[i] == th && idx[i] <= beta)); const unsigned long long m = __ballot(keep);
        const int pos = base + __popcll(m & ((1ull << lane) - 1ull)); if (keep) { kq[pos] = key[i]; iq[pos] = idx[i]; } base += __popcll(m); }
    if (lane == 0) { cnt[q] = 256u; tau[q] = th; }
}

__device__ void dsa_block(const Params& p, int qb, LAS unsigned char* lds) {
    const int tid = tid_(), w = tid >> 6, lane = tid & 63, fr = lane & 15, fq = lane >> 4, t0 = qb * 16;
    unsigned char* ws = opq(p.ws); const bf16_t* proj = (const bf16_t*)(ws + OFF_PROJ); const bf16_t* kidx = (const bf16_t*)(ws + OFF_SMALL + SM_KIDX); const float* wq = (const float*)(ws + OFF_SMALL + SM_WQ);
    bf16_t* yat = (bf16_t*)(ws + OFF_Y + 32 * MB);
    LAS unsigned* ckey = (LAS unsigned*)lds;
    LAS unsigned* cidx = (LAS unsigned*)(lds + 32768);
    LAS float* lg = (LAS float*)(lds + 65536);
    LAS unsigned* cnt = (LAS unsigned*)(lds + 131072);
    LAS unsigned* tau = cnt + 16;
    __syncthreads();
    if (tid < 16) { cnt[tid] = 0u; tau[tid] = 0u; }
    bf16x8 af[8][2]; f32x4 wr4[8];
#pragma unroll
    for (int m = 0; m < 8; ++m) {
#pragma unroll
        for (int kk = 0; kk < 2; ++kk) af[m][kk] = *(const bf16x8*)(proj + (size_t)(t0 + 2 * m + (fr >> 3)) * LDP + C_IQ + (fr & 7) * 64 + kk * 32 + 8 * fq);
        wr4[m] = *(const f32x4*)(wq + (size_t)(t0 + 2 * m + (fq >> 1)) * 8 + 4 * (fq & 1)); }
    __syncthreads();
    const int ntile = (t0 + 15) / 128 + 1; const int mb = 4 * (fq & 1), qh = fq >> 1;
#pragma unroll 1
    for (int kt = 0; kt < ntile; ++kt) {
        const int s = kt * 128 + 16 * w + fr;
        bf16x8 bfr[2];
#pragma unroll
        for (int kk = 0; kk < 2; ++kk) bfr[kk] = *(const bf16x8*)(kidx + (size_t)s * 64 + kk * 32 + 8 * fq);
        float pt[8];
#pragma unroll
        for (int m = 0; m < 8; ++m) { f32x4 a = {0.f, 0.f, 0.f, 0.f};
            a = __builtin_amdgcn_mfma_f32_16x16x32_bf16(af[m][0], bfr[0], a, 0, 0, 0); a = __builtin_amdgcn_mfma_f32_16x16x32_bf16(af[m][1], bfr[1], a, 0, 0, 0);
            pt[m] = wr4[m][0] * fmaxf(a[0], 0.f) + wr4[m][1] * fmaxf(a[1], 0.f) + wr4[m][2] * fmaxf(a[2], 0.f) + wr4[m][3] * fmaxf(a[3], 0.f); }
        const unsigned msk = (fq & 1) ? 0xffffffffu : 0u;
#pragma unroll
        for (int i = 0; i < 4; ++i) { const unsigned lo = __float_as_uint(pt[i]), hi = __float_as_uint(pt[4 + i]);
            const float keep = __uint_as_float((lo & ~msk) | (hi & msk)), send = __uint_as_float((hi & ~msk) | (lo & msk));
            const float v = keep + __shfl_xor(send, 16); const int qq = 2 * (mb + i) + qh;
            const unsigned sk = sortable(v);
            if (s <= t0 + qq && sk > tau[qq]) { const unsigned pos = __hip_atomic_fetch_add(cnt + qq, 1u, __ATOMIC_RELAXED, __HIP_MEMORY_SCOPE_WORKGROUP); ckey[qq * 512 + pos] = sk; cidx[qq * 512 + pos] = (unsigned)s; } }
        __syncthreads();
        const bool lastt = kt == ntile - 1;
#pragma unroll
        for (int rep = 0; rep < 2; ++rep) { const int q = w + 8 * rep; const unsigned cq = cnt[q]; if (cq > (lastt ? 256u : 384u)) compact_query(ckey, cidx, cnt, tau, q, lane); }
        __syncthreads();
    }
    LAS float* lgw = lg + w * 2048;
#pragma unroll 1
    for (int rep = 0; rep < 2; ++rep) {
        const int q = w + 8 * rep, t = t0 + q; const int n = min((int)cnt[q], 256); const LAS unsigned* iq = cidx + q * 512;
        const bf16_t* qrow = proj + (size_t)t * LDP + C_AQ + 8 * lane;
        const u32x4 qa = *(const u32x4*)qrow, qb2 = *(const u32x4*)(qrow + 512);
        const float sc = 0.08838834764831845f * 1.4426950408889634f;
        float q0[8] = {bflo(qa.x) * sc, bfhi(qa.x) * sc, bflo(qa.y) * sc, bfhi(qa.y) * sc, bflo(qa.z) * sc, bfhi(qa.z) * sc, bflo(qa.w) * sc, bfhi(qa.w) * sc};
        float q1[8] = {bflo(qb2.x) * sc, bfhi(qb2.x) * sc, bflo(qb2.y) * sc, bfhi(qb2.y) * sc, bflo(qb2.z) * sc, bfhi(qb2.z) * sc, bflo(qb2.w) * sc, bfhi(qb2.w) * sc};
#pragma unroll 1
        for (int j0 = 0; j0 < n; j0 += 4) {
            u32x4 ka[4], kb[4];
#pragma unroll
            for (int u = 0; u < 4; ++u) { const int j = min(j0 + u, n - 1); const int s = __builtin_amdgcn_readfirstlane((int)iq[j]);
                const bf16_t* kr = proj + (size_t)s * LDP + C_AK + 8 * lane; ka[u] = *(const u32x4*)kr; kb[u] = *(const u32x4*)(kr + 512); }
#pragma unroll
            for (int u = 0; u < 4; ++u) {
                float d0 = q0[0] * bflo(ka[u].x) + q0[1] * bfhi(ka[u].x) + q0[2] * bflo(ka[u].y) + q0[3] * bfhi(ka[u].y) + q0[4] * bflo(ka[u].z) + q0[5] * bfhi(ka[u].z) + q0[6] * bflo(ka[u].w) + q0[7] * bfhi(ka[u].w);
                float d1 = q1[0] * bflo(kb[u].x) + q1[1] * bfhi(kb[u].x) + q1[2] * bflo(kb[u].y) + q1[3] * bfhi(kb[u].y) + q1[4] * bflo(kb[u].z) + q1[5] * bfhi(kb[u].z) + q1[6] * bflo(kb[u].w) + q1[7] * bfhi(kb[u].w);
                d0 = sum16(d0); d1 = sum16(d1);
                if (fr == 0 && j0 + u < n) { lgw[(j0 + u) * 8 + fq] = d0; lgw[(j0 + u) * 8 + 4 + fq] = d1; } }
        }
        float inv0, inv1;
        { const int hh = lane & 7, c = lane >> 3; float mx = -3.0e38f;
          for (int i = 0; i < 32; ++i) { const int j = i * 8 + c; if (j < n) mx = fmaxf(mx, lgw[j * 8 + hh]); }
          mx = fmaxf(mx, __shfl_xor(mx, 8)); mx = fmaxf(mx, __shfl_xor(mx, 16)); mx = fmaxf(mx, __shfl_xor(mx, 32));
          float sm = 0.f;
          for (int i = 0; i < 32; ++i) { const int j = i * 8 + c; if (j < n) { const float e = exp2f(lgw[j * 8 + hh] - mx); lgw[j * 8 + hh] = e; sm += e; } }
          sm += __shfl_xor(sm, 8); sm += __shfl_xor(sm, 16); sm += __shfl_xor(sm, 32);
          const float inv = 1.0f / sm; inv0 = __shfl(inv, fq); inv1 = __shfl(inv, fq + 4); }
        float o0[8], o1[8];
#pragma unroll
        for (int d = 0; d < 8; ++d) { o0[d] = 0.f; o1[d] = 0.f; }
#pragma unroll 1
        for (int j0 = 0; j0 < n; j0 += 4) {
            u32x4 va[4], vb[4]; float p0[4], p1[4];
#pragma unroll
            for (int u = 0; u < 4; ++u) { const int j = min(j0 + u, n - 1); const int s = __builtin_amdgcn_readfirstlane((int)iq[j]);
                const bf16_t* vr = proj + (size_t)s * LDP + C_AV + 8 * lane; va[u] = *(const u32x4*)vr; vb[u] = *(const u32x4*)(vr + 512);
                const bool ok = j0 + u < n; p0[u] = ok ? lgw[j * 8 + fq] : 0.f; p1[u] = ok ? lgw[j * 8 + 4 + fq] : 0.f; }
#pragma unroll
            for (int u = 0; u < 4; ++u) {
                o0[0] += p0[u] * bflo(va[u].x); o0[1] += p0[u] * bfhi(va[u].x); o0[2] += p0[u] * bflo(va[u].y); o0[3] += p0[u] * bfhi(va[u].y);
                o0[4] += p0[u] * bflo(va[u].z); o0[5] += p0[u] * bfhi(va[u].z); o0[6] += p0[u] * bflo(va[u].w); o0[7] += p0[u] * bfhi(va[u].w);
                o1[0] += p1[u] * bflo(vb[u].x); o1[1] += p1[u] * bfhi(vb[u].x); o1[2] += p1[u] * bflo(vb[u].y); o1[3] += p1[u] * bfhi(vb[u].y);
                o1[4] += p1[u] * bflo(vb[u].z); o1[5] += p1[u] * bfhi(vb[u].z); o1[6] += p1[u] * bflo(vb[u].w); o1[7] += p1[u] * bfhi(vb[u].w); }
        }
        u32x4 w0, w1;
        w0.x = pack2(o0[0] * inv0, o0[1] * inv0); w0.y = pack2(o0[2] * inv0, o0[3] * inv0); w0.z = pack2(o0[4] * inv0, o0[5] * inv0); w0.w = pack2(o0[6] * inv0, o0[7] * inv0);
        w1.x = pack2(o1[0] * inv1, o1[1] * inv1); w1.y = pack2(o1[2] * inv1, o1[3] * inv1); w1.z = pack2(o1[4] * inv1, o1[5] * inv1); w1.w = pack2(o1[6] * inv1, o1[7] * inv1);
        *(u32x4*)(yat + (size_t)t * 1024 + 8 * lane) = w0; *(u32x4*)(yat + (size_t)t * 1024 + 512 + 8 * lane) = w1;
    }
}

__device__ void phase3(const Params& p, LAS unsigned char* lds) {
    const int c = blockIdx.x, tid = tid_();
    if (c < 64) dn_scan(p, c, lds);
    unsigned* queue = (unsigned*)(opq(p.ws) + OFF_SMALL + SM_CTRL) + 200;
    LAS int* tk = (LAS int*)(lds + 131072 + 256);
    for (;;) {
        __syncthreads();
        if (tid == 0) *tk = (int)atomicAdd(queue, 1u);
        __syncthreads();
        const int ticket = *tk;
        if (ticket >= 1024) break;
        dsa_block(p, 1023 - ticket, lds);
    }
}

__device__ void dn_out_item(const Params& p, int item, LAS unsigned char* lds) {
    const int tid = tid_(), w = tid >> 6, lane = tid & 63, fr = lane & 15, fq = lane >> 4, m = w & 3, nh = w >> 2, n = item >> 3, h = item & 7;
    unsigned char* ws = opq(p.ws); const bf16_t* proj = (const bf16_t*)(ws + OFF_PROJ);
    const bf16_t* qd = (const bf16_t*)(ws + OFF_DNP + DNP_QD) + (size_t)item * 8192; const bf16_t* attn = (const bf16_t*)(ws + OFF_DNP + DNP_ATT) + (size_t)item * 4096;
    const bf16_t* Sold = (const bf16_t*)(ws + OFF_SCAN) + (size_t)item * 16384; const bf16_t* vnT = (const bf16_t*)(ws + OFF_SCAN + 64 * MB) + (size_t)item * 8192;
    bf16_t* ydn = (bf16_t*)(ws + OFF_Y);
    LAS float* red = (LAS float*)lds;
    f32x4 acc[4];
#pragma unroll
    for (int nt = 0; nt < 4; ++nt) acc[nt] = (f32x4){0.f, 0.f, 0.f, 0.f};
#pragma unroll
    for (int kk = 0; kk < 4; ++kk) { const bf16x8 a = *(const bf16x8*)(qd + (16 * m + fr) * 128 + kk * 32 + 8 * fq);
#pragma unroll
        for (int nt = 0; nt < 4; ++nt) { const bf16x8 b = *(const bf16x8*)(Sold + (size_t)(16 * (4 * nh + nt) + fr) * 128 + kk * 32 + 8 * fq); acc[nt] = __builtin_amdgcn_mfma_f32_16x16x32_bf16(a, b, acc[nt], 0, 0, 0); } }
#pragma unroll
    for (int kk = 0; kk < 2; ++kk) { const bf16x8 a = *(const bf16x8*)(attn + (16 * m + fr) * 64 + kk * 32 + 8 * fq);
#pragma unroll
        for (int nt = 0; nt < 4; ++nt) { const bf16x8 b = *(const bf16x8*)(vnT + (size_t)(16 * (4 * nh + nt) + fr) * 64 + kk * 32 + 8 * fq); acc[nt] = __builtin_amdgcn_mfma_f32_16x16x32_bf16(a, b, acc[nt], 0, 0, 0); } }
    float ssq[4];
#pragma unroll
    for (int j = 0; j < 4; ++j) { float s = 0.f;
#pragma unroll
        for (int nt = 0; nt < 4; ++nt) s += acc[nt][j] * acc[nt][j];
        ssq[j] = sum16(s); }
    __syncthreads();
    if (fr == 0) {
#pragma unroll
        for (int j = 0; j < 4; ++j) red[(16 * m + 4 * fq + j) * 2 + nh] = ssq[j]; }
    __syncthreads();
#pragma unroll
    for (int j = 0; j < 4; ++j) { const int i = 16 * m + 4 * fq + j, t = n * 64 + i; const float rs = rsqrtf((red[i * 2] + red[i * 2 + 1]) * (1.0f / 128.0f) + EPS);
#pragma unroll
        for (int nt = 0; nt < 4; ++nt) { const int dv = 16 * (4 * nh + nt) + fr; const float z = bf2f(proj[(size_t)t * LDP + C_Z + h * 128 + dv]);
            ydn[(size_t)t * 1024 + h * 128 + dv] = f2bf(acc[nt][j] * rs * p.dn_norm_w[dv] * siluf_(z)); } }
}

__device__ void phase_router(const Params& p, LAS unsigned char* lds) {
    const int G = gridDim.x, c = blockIdx.x, tid = tid_(), w = tid >> 6, lane = tid & 63;
    unsigned char* ws = opq(p.ws); const float* x1 = (const float*)(ws + OFF_X1); bf16_t* h2 = (bf16_t*)(ws + OFF_H);
    int* rexp = (int*)(ws + OFF_SMALL + SM_ROUTE); float* rwt = (float*)(ws + OFF_SMALL + SM_ROUTE + 128 * 1024);
    unsigned* ecnt = (unsigned*)(ws + OFF_SMALL + SM_CTRL);
    LAS float* hs = (LAS float*)lds;
    LAS float* red = hs + 2048 * 8;
    LAS float* lgt = red + 8 * 8 * 72;
    for (int it = c; it < T_ / 8; it += G) {
        const int tb = it * 8;
        __syncthreads();
        { const int t = tb + w; const float* xr = x1 + (size_t)t * 2048; f32x4 v[8]; float ss = 0.f;
#pragma unroll
          for (int i = 0; i < 8; ++i) { v[i] = *(const f32x4*)(xr + i * 256 + 4 * lane); ss += v[i][0] * v[i][0] + v[i][1] * v[i][1] + v[i][2] * v[i][2] + v[i][3] * v[i][3]; }
          ss = wave_sum(ss); const float rs = rsqrtf(ss * (1.0f / 2048.0f) + EPS);
#pragma unroll
          for (int i = 0; i < 8; ++i) { const f32x4 g = *(const f32x4*)(p.norm_ffn + i * 256 + 4 * lane); const int k = i * 256 + 4 * lane;
              const float a0 = v[i][0] * rs * g[0], a1 = v[i][1] * rs * g[1], a2 = v[i][2] * rs * g[2], a3 = v[i][3] * rs * g[3];
              u32x2 pk; pk.x = pack2(a0, a1); pk.y = pack2(a2, a3); *(u32x2*)(h2 + (size_t)t * 2048 + k) = pk;
              hs[(k + 0) * 8 + w] = a0; hs[(k + 1) * 8 + w] = a1; hs[(k + 2) * 8 + w] = a2; hs[(k + 3) * 8 + w] = a3; } }
        __syncthreads();
        { float ar[8]; float ag = 0.f;
#pragma unroll
          for (int tt = 0; tt < 8; ++tt) ar[tt] = 0.f;
          const int tg = lane >> 3, gg = lane & 7;
          for (int k = w * 256; k < w * 256 + 256; ++k) { const float wv = p.w_router[(size_t)k * 64 + lane]; const f32x4 ha = *(const LAS f32x4*)(hs + k * 8), hb = *(const LAS f32x4*)(hs + k * 8 + 4);
              ar[0] += ha[0] * wv; ar[1] += ha[1] * wv; ar[2] += ha[2] * wv; ar[3] += ha[3] * wv; ar[4] += hb[0] * wv; ar[5] += hb[1] * wv; ar[6] += hb[2] * wv; ar[7] += hb[3] * wv;
              ag += hs[k * 8 + tg] * p.w_group[(size_t)k * 8 + gg]; }
#pragma unroll
          for (int tt = 0; tt < 8; ++tt) red[(w * 8 + tt) * 72 + lane] = ar[tt];
          red[(w * 8 + tg) * 72 + 64 + gg] = ag; }
        __syncthreads();
        for (int o = tid; o < 8 * 72; o += 512) { const int tt = o / 72, e = o % 72; float s = 0.f;
#pragma unroll
            for (int ww = 0; ww < 8; ++ww) s += red[(ww * 8 + tt) * 72 + e];
            lgt[tt * 72 + e] = s; }
        __syncthreads();
        if (tid < 8) { const int t = tb + tid; LAS float* l = lgt + tid * 72;
            float gmax = -3.0e38f; int gs = 0; float gl[8];
#pragma unroll
            for (int g = 0; g < 8; ++g) { gl[g] = l[64 + g] + p.b_group[g]; if (gl[g] > gmax) { gmax = gl[g]; gs = g; } }
            float gsum = 0.f;
#pragma unroll
            for (int g = 0; g < 8; ++g) gsum += __expf(gl[g] - gmax);
            const float pg = 1.0f / gsum;
            float el[8]; float m1 = -3.0e38f, m2 = -3.0e38f; int i1 = 0, i2 = 0;
#pragma unroll
            for (int e = 0; e < 8; ++e) { el[e] = l[gs * 8 + e] + p.b_router[gs * 8 + e]; }
#pragma unroll
            for (int e = 0; e < 8; ++e) if (el[e] > m1) { m1 = el[e]; i1 = e; }
#pragma unroll
            for (int e = 0; e < 8; ++e) if (e != i1 && el[e] > m2) { m2 = el[e]; i2 = e; }
            const float e2 = __expf(m2 - m1); const float w1 = pg / (1.0f + e2), w2 = pg * e2 / (1.0f + e2);
            const int ex1 = gs * 8 + i1, ex2 = gs * 8 + i2;
            rexp[t * 2] = ex1; rexp[t * 2 + 1] = ex2; rwt[t * 2] = w1; rwt[t * 2 + 1] = w2;
            atomicAdd(ecnt + ex1, 1u); atomicAdd(ecnt + ex2, 1u); }
    }
    int counter = 0;
    for (int e = 0; e < 64; ++e) {
        const float* wg = p.w_exp_gate + (size_t)e * 2048 * 512; const float* wu = p.w_exp_up + (size_t)e * 2048 * 512;
        transpose_tiles((LAS float*)lds, (bf16_t*)(ws + OFF_WGU) + (size_t)e * 1024 * 2048, 2048, 512, 512, [wg](int n) -> const float* { return wg + n; }, [](int n) { return (n >> 4) * 32 + (n & 15); }, c, G, counter);
        transpose_tiles((LAS float*)lds, (bf16_t*)(ws + OFF_WGU) + (size_t)e * 1024 * 2048, 2048, 512, 512, [wu](int n) -> const float* { return wu + n; }, [](int n) { return (n >> 4) * 32 + 16 + (n & 15); }, c, G, counter);
        const float* wd = p.w_exp_down + (size_t)e * 512 * 2048;
        transpose_tiles((LAS float*)lds, (bf16_t*)(ws + OFF_WDT) + (size_t)e * 2048 * 512, 512, 2048, 2048, [wd](int n) -> const float* { return wd + n; }, [](int n) { return n; }, c, G, counter);
    }
}

__device__ void phase_slots(const Params& p, LAS unsigned char* lds) {
    const int G = gridDim.x, c = blockIdx.x, tid = tid_(), w = tid >> 6, lane = tid & 63;
    unsigned char* ws = opq(p.ws); const unsigned* ecnt = (const unsigned*)(ws + OFF_SMALL + SM_CTRL); unsigned* fill = (unsigned*)(ws + OFF_SMALL + SM_CTRL) + 64;
    int* meta = (int*)(ws + OFF_SMALL + SM_CTRL) + 256;
    const int* rexp = (const int*)(ws + OFF_SMALL + SM_ROUTE); int* rpos = (int*)(ws + OFF_SMALL + SM_ROUTE + 256 * 1024);
    const bf16_t* h2 = (const bf16_t*)(ws + OFF_H); bf16_t* xs = (bf16_t*)(ws + OFF_XS);
    LAS int* pstart = (LAS int*)lds;
    __syncthreads();
    if (tid < 64) { const int cn = (int)ecnt[tid]; const int pad = (cn + 255) / 256 * 256; int s = pad;
        for (int o = 1; o < 64; o <<= 1) { const int u = __shfl_up(s, o); if (tid >= o) s += u; }
        pstart[tid] = s - pad; if (tid == 63) pstart[64] = s;
        if (c == 0) { for (int mt = (s - pad) / 256; mt < s / 256; ++mt) meta[1 + mt] = tid; if (tid == 63) meta[0] = s / 256; } }
    __syncthreads();
    for (int a = (c * 8 + w); a < 2 * T_; a += G * 8) {
        const int t = a >> 1, e = rexp[a]; int pos = 0;
        if (lane == 0) { pos = pstart[e] + (int)atomicAdd(fill + e, 1u); rpos[a] = pos; }
        pos = __shfl(pos, 0);
        const u32x4* src = (const u32x4*)(h2 + (size_t)t * 2048); u32x4* dst = (u32x4*)(xs + (size_t)pos * 2048);
#pragma unroll
        for (int i = 0; i < 4; ++i) dst[i * 64 + lane] = src[i * 64 + lane];
    }
}

__device__ void phase_final(const Params& p) {
    const int G = gridDim.x, c = blockIdx.x, tid = tid_(), w = tid >> 6, lane = tid & 63;
    unsigned char* ws = opq(p.ws); const float* x1 = (const float*)(ws + OFF_X1); const bf16_t* ye = (const bf16_t*)(ws + OFF_YE);
    const float* rwt = (const float*)(ws + OFF_SMALL + SM_ROUTE + 128 * 1024); const int* rpos = (const int*)(ws + OFF_SMALL + SM_ROUTE + 256 * 1024);
    for (int t = c * 8 + w; t < T_; t += G * 8) {
        const float w0 = rwt[t * 2], w1 = rwt[t * 2 + 1]; const bf16_t* y0 = ye + (size_t)rpos[t * 2] * 2048; const bf16_t* y1 = ye + (size_t)rpos[t * 2 + 1] * 2048;
        f32x4 v[8]; float ss = 0.f;
#pragma unroll
        for (int i = 0; i < 8; ++i) { const int k = i * 256 + 4 * lane; v[i] = *(const f32x4*)(x1 + (size_t)t * 2048 + k);
            const u32x2 a = *(const u32x2*)(y0 + k), b = *(const u32x2*)(y1 + k);
            v[i][0] += w0 * bflo(a.x) + w1 * bflo(b.x); v[i][1] += w0 * bfhi(a.x) + w1 * bfhi(b.x); v[i][2] += w0 * bflo(a.y) + w1 * bflo(b.y); v[i][3] += w0 * bfhi(a.y) + w1 * bfhi(b.y);
            ss += v[i][0] * v[i][0] + v[i][1] * v[i][1] + v[i][2] * v[i][2] + v[i][3] * v[i][3]; }
        ss = wave_sum(ss); const float rs = rsqrtf(ss * (1.0f / 2048.0f) + EPS);
#pragma unroll
        for (int i = 0; i < 8; ++i) { const int k = i * 256 + 4 * lane; const f32x4 g = *(const f32x4*)(p.norm_final + k);
            f32x4 o; o[0] = v[i][0] * rs * g[0]; o[1] = v[i][1] * rs * g[1]; o[2] = v[i][2] * rs * g[2]; o[3] = v[i][3] * rs * g[3];
            *(f32x4*)(p.out + (size_t)t * 2048 + k) = o; }
    }
}

__device__ void run_phase(const Params& p, int ph, LAS unsigned char* lds) {
    const int G = gridDim.x, c = blockIdx.x; unsigned char* ws = opq(p.ws);
#ifdef ONLY_PHASE
    ph = ONLY_PHASE;
#endif
    switch (ph) {
    case 0: phase0(p, lds); break;
    case 1: { pg8::DenseOrder S; S.init(ws + OFF_H, ws + OFF_WT_IN, T_, LDP, 2048, G, c); EpiProj E; E.O = (bf16_t*)(ws + OFF_PROJ); pg8::gemm_phase(lds, 2048, S, E); } break;
    case 2: phase_rope(p); for (int item = c; item < NITEM; item += G) dn_prep_item(p, item, (LAS float*)lds); break;
    case 3: phase3(p, lds); break;
    case 4: for (int item = c; item < NITEM; item += G) dn_out_item(p, item, lds); break;
    case 5: { pg8::DenseOrder S; S.init(ws + OFF_Y, ws + OFF_WT_DN, T_, 2048, 1024, G, c); EpiMerge<0> E; E.M = (bf16_t*)(ws + OFF_H); E.proj = (const bf16_t*)(ws + OFF_PROJ); E.bg = p.b_gates; pg8::gemm_phase(lds, 1024, S, E);
              pg8::DenseOrder S2; S2.init(ws + OFF_Y + 32 * MB, ws + OFF_WT_AT, T_, 2048, 1024, G, c); EpiMerge<1> E2; E2.M = E.M; E2.proj = E.proj; E2.bg = p.b_gates; pg8::gemm_phase(lds, 1024, S2, E2); } break;
    case 6: { pg8::DenseOrder S; S.init(ws + OFF_H, ws + OFF_WT_OUT, T_, 2048, 2048, G, c); EpiResid E; E.X1 = (float*)(ws + OFF_X1); E.X = p.x; pg8::gemm_phase(lds, 2048, S, E); } break;
    case 7: phase_router(p, lds); break;
    case 8: phase_slots(p, lds); break;
    case 9: { const int* meta = (const int*)(ws + OFF_SMALL + SM_CTRL) + 256; pg8::GroupedOrder S; S.tile_e = meta + 1; S.n_mt = meta[0]; S.nN = 4; S.G = G; S.c = c; S.K = 2048; S.A = (const char*)(ws + OFF_XS); S.Bt = (const char*)(ws + OFF_WGU); S.bstride = (size_t)1024 * 2048 * 2;
              EpiGateUp E; E.ACT = (bf16_t*)(ws + OFF_ACT); pg8::gemm_phase(lds, 2048, S, E); } break;
    case 10: { const int* meta = (const int*)(ws + OFF_SMALL + SM_CTRL) + 256; pg8::GroupedOrder S; S.tile_e = meta + 1; S.n_mt = meta[0]; S.nN = 8; S.G = G; S.c = c; S.K = 512; S.A = (const char*)(ws + OFF_ACT); S.Bt = (const char*)(ws + OFF_WDT); S.bstride = (size_t)2048 * 512 * 2;
              EpiDown E; E.O = (bf16_t*)(ws + OFF_YE); pg8::gemm_phase(lds, 512, S, E); } break;
    case 11: phase_final(p); break;
    default: break;
    }
}

__global__ void __launch_bounds__(512, 2) mega_kernel(Params p) {
    extern __shared__ __attribute__((aligned(16))) unsigned char shm[];
    LAS unsigned char* lds = (LAS unsigned char*)shm;
    cg::grid_group grid = cg::this_grid();
    for (int ph = p.ph_lo; ph < p.ph_hi; ++ph) {
        run_phase(p, ph, lds);
        if (ph + 1 < p.ph_hi) grid.sync();
    }
}

extern "C" void kernel_launch(void* const* d_in, const int* in_sizes, int n_in, void* d_out, int out_size, void* d_ws, size_t ws_size, hipStream_t stream) {
    (void)in_sizes; (void)n_in; (void)out_size;
    static int grid_blocks = 0;
    if (!grid_blocks) {
        int dev = 0, cus = 0, per_cu = 0;
        hipGetDevice(&dev);
        hipDeviceGetAttribute(&cus, hipDeviceAttributeMultiprocessorCount, dev);
        hipFuncSetAttribute((const void*)mega_kernel, hipFuncAttributeMaxDynamicSharedMemorySize, LDS_BYTES);
        hipOccupancyMaxActiveBlocksPerMultiprocessor(&per_cu, mega_kernel, 512, LDS_BYTES);
        if (per_cu > 1) per_cu = 1;
        grid_blocks = cus * per_cu;
        if (grid_blocks <= 0) { fprintf(stderr, "occupancy query failed\n"); grid_blocks = 0; return; }
    }
    if (ws_size < WS_NEED) { fprintf(stderr, "workspace too small: %zu < %zu\n", ws_size, (size_t)WS_NEED); return; }
    Params p{};
    p.x = (const float*)d_in[0]; p.positions = (const int*)d_in[1]; p.norm_mix = (const float*)d_in[2]; p.w_in = (const float*)d_in[3]; p.b_gates = (const float*)d_in[4];
    p.conv_w = (const float*)d_in[5]; p.a_log = (const float*)d_in[6]; p.dt_bias = (const float*)d_in[7]; p.dn_norm_w = (const float*)d_in[8]; p.idx_k_norm = (const float*)d_in[9];
    p.w_proj_dn = (const float*)d_in[10]; p.w_proj_att = (const float*)d_in[11]; p.w_out = (const float*)d_in[12]; p.norm_ffn = (const float*)d_in[13]; p.w_group = (const float*)d_in[14];
    p.b_group = (const float*)d_in[15]; p.w_router = (const float*)d_in[16]; p.b_router = (const float*)d_in[17]; p.w_exp_gate = (const float*)d_in[18]; p.w_exp_up = (const float*)d_in[19];
    p.w_exp_down = (const float*)d_in[20]; p.norm_final = (const float*)d_in[21]; p.out = (float*)d_out; p.ws = (unsigned char*)d_ws;
#if SINGLE_LAUNCH
    p.ph_lo = 0; p.ph_hi = NPHASE;
    void* args[] = {&p};
    hipError_t e = hipLaunchCooperativeKernel((const void*)mega_kernel, dim3(grid_blocks), dim3(512), args, LDS_BYTES, stream);
    if (e != hipSuccess) fprintf(stderr, "cooperative launch failed: %s (grid %d)\n", hipGetErrorString(e), grid_blocks);
#else
    for (int ph = 0; ph < NPHASE; ++ph) { p.ph_lo = ph; p.ph_hi = ph + 1; hipLaunchKernelGGL(mega_kernel, dim3(grid_blocks), dim3(512), LDS_BYTES, stream, p); }
#endif
}
```

```cpp
#include <hip/hip_runtime.h>
#include <hip/hip_cooperative_groups.h>
#include <cstdio>
#include <cstdint>
namespace cg = cooperative_groups;

#define LAS __attribute__((address_space(3)))
typedef unsigned short bf16_t;
typedef short bf16x8 __attribute__((ext_vector_type(8)));
typedef float f32x4 __attribute__((ext_vector_type(4)));
typedef float f32x2 __attribute__((ext_vector_type(2)));
typedef unsigned u32x4 __attribute__((ext_vector_type(4)));
typedef unsigned u32x2 __attribute__((ext_vector_type(2)));

#ifndef PROBE_PHASE
#define PROBE_PHASE -1
#endif
#define PROBE_MULT 8
#ifndef SINGLE_LAUNCH
#define SINGLE_LAUNCH 1
#endif

constexpr int T_ = 16384, D_ = 2048, IN_COLS = 11864, LDP = 12032;
constexpr int C_DNQ = 0, C_DNK = 1024, C_DNV = 2048, C_Z = 3072, C_AQ = 4096, C_AK = 5120, C_AV = 6144, C_IQ = 7168,
              C_G0 = 7680, C_G1 = 9728, C_IK = 11776, C_B = 11840, C_A = 11848, C_IW = 11856;
constexpr int NITEM = 2048;
constexpr int PMAX = 40960;
constexpr float EPS = 1e-6f;
constexpr int LDS_BYTES = 156 * 1024;
constexpr int NPHASE = 12;

constexpr size_t MB = 1ull << 20;
constexpr size_t OFF_WT_IN  = 0;
constexpr size_t OFF_WT_DN  = 50 * MB;
constexpr size_t OFF_WT_AT  = 55 * MB;
constexpr size_t OFF_WT_OUT = 60 * MB;
constexpr size_t OFF_COS    = 54 * MB;
constexpr size_t OFF_SIN    = 59 * MB;
constexpr size_t OFF_WR     = 68 * MB;
constexpr size_t OFF_SMALL  = 69 * MB;
constexpr size_t OFF_H      = 72 * MB;
constexpr size_t OFF_PROJ   = 136 * MB;
constexpr size_t OFF_DNP    = 512 * MB;
constexpr size_t OFF_SCAN   = 656 * MB;
constexpr size_t OFF_Y      = 752 * MB;
constexpr size_t OFF_X1     = 816 * MB;
constexpr size_t WS_NEED    = 944 * MB;
constexpr size_t OFF_MASK   = 816 * MB;
constexpr size_t OFF_ROWTOK = 520 * MB;
constexpr size_t OFF_YE     = 528 * MB;
constexpr size_t OFF_ACT    = 712 * MB;
constexpr size_t SM_KIDX   = 0;
constexpr size_t SM_WQ     = 2 * MB;
constexpr size_t SM_ROUTE  = 2 * MB + 512 * 1024;
constexpr size_t SM_GLAST  = 2 * MB + 960 * 1024;
constexpr size_t SM_CTRL   = 2 * MB + 1000 * 1024;
constexpr size_t SM_BAR    = 2 * MB + 1008 * 1024;
constexpr size_t DNP_W = 0, DNP_UT = 32 * MB, DNP_QD = 64 * MB, DNP_KDT = 96 * MB, DNP_ATT = 128 * MB;

struct Params {
    const float* x; const int* positions; const float* norm_mix; const float* w_in; const float* b_gates; const float* conv_w;
    const float* a_log; const float* dt_bias; const float* dn_norm_w; const float* idx_k_norm; const float* w_proj_dn;
    const float* w_proj_att; const float* w_out; const float* norm_ffn; const float* w_group; const float* b_group;
    const float* w_router; const float* b_router; const float* w_exp_gate; const float* w_exp_up; const float* w_exp_down;
    const float* norm_final; float* out; unsigned char* ws;
};

__device__ __forceinline__ int tid_() { int t = threadIdx.x; asm volatile("" : "+v"(t)); return t; }
__device__ __forceinline__ unsigned char* opq(unsigned char* q) { unsigned long long z = 0ull; asm volatile("" : "+s"(z)); return q + z; }
__device__ __forceinline__ bf16_t f2bf(float f) { unsigned u = __float_as_uint(f); u += 0x7fffu + ((u >> 16) & 1u); return (bf16_t)(u >> 16); }
__device__ __forceinline__ float bf2f(bf16_t b) { return __uint_as_float(((unsigned)b) << 16); }
__device__ __forceinline__ unsigned pack2(float lo, float hi) { return (unsigned)f2bf(lo) | ((unsigned)f2bf(hi) << 16); }
__device__ __forceinline__ float bflo(unsigned w) { return __uint_as_float(w << 16); }
__device__ __forceinline__ float bfhi(unsigned w) { return __uint_as_float(w & 0xffff0000u); }
__device__ __forceinline__ float sigmoidf_(float x) { return 1.0f / (1.0f + __expf(-x)); }
__device__ __forceinline__ float siluf_(float x) { return x / (1.0f + __expf(-x)); }
template <int CTRL> __device__ __forceinline__ float dpp_f(float v) { return __int_as_float(__builtin_amdgcn_update_dpp(0, __float_as_int(v), CTRL, 0xf, 0xf, true)); }
__device__ __forceinline__ float sum16(float v) {
    v += dpp_f<0xB1>(v); v += dpp_f<0x4E>(v); v += dpp_f<0x141>(v); v += dpp_f<0x140>(v); return v;
}
__device__ __forceinline__ int lane_() { return tid_() & 63; }
__device__ __forceinline__ int bperm_i(int srclane, int v) { return __builtin_amdgcn_ds_bpermute(srclane << 2, v); }
__device__ __forceinline__ float shfl_xor_(float v, int o) { return __int_as_float(bperm_i(lane_() ^ o, __float_as_int(v))); }
__device__ __forceinline__ int shfl_xor_(int v, int o) { return bperm_i(lane_() ^ o, v); }
__device__ __forceinline__ float shfl_(float v, int src) { return __int_as_float(bperm_i(src, __float_as_int(v))); }
__device__ __forceinline__ int shfl_(int v, int src) { return bperm_i(src, v); }
__device__ __forceinline__ float shfl_up_(float v, int o) { return __int_as_float(bperm_i((lane_() - o) & 63, __float_as_int(v))); }
__device__ __forceinline__ int shfl_up_(int v, int o) { return bperm_i((lane_() - o) & 63, v); }
__device__ __forceinline__ float wave_sum(float v) { for (int o = 32; o >= 1; o >>= 1) v += shfl_xor_(v, o); return v; }

#define XB_TMO      128
#define XB_XCNT(j)  (256  + 64 * (j))
#define XB_XSUB(j)  (1280 + 64 * (j))
#define XB_XGEN(j)  (2304 + 64 * (j))
#define XB_TOP      3328
#define XB_TOPGEN   3392
#define XCD_BAR_WORDS 3456
#define XB_SPIN_CAP (1u << 18)

__device__ __forceinline__ unsigned xb_ld(unsigned* p)              { return __hip_atomic_load(p, __ATOMIC_RELAXED, __HIP_MEMORY_SCOPE_AGENT); }
__device__ __forceinline__ unsigned xb_add(unsigned* p, unsigned v) { return __hip_atomic_fetch_add(p, v, __ATOMIC_RELAXED, __HIP_MEMORY_SCOPE_AGENT); }
__device__ __forceinline__ unsigned xb_xcc_id() { return (unsigned)__builtin_amdgcn_s_getreg((3 << 11) | 20) & 0xFu; }
#define XB_SPIN(cond, bar) do { unsigned _sp = 0; while (cond) { __builtin_amdgcn_s_sleep(1); \
    if ((++_sp & 255u) == 0u) { if (xb_ld(&(bar)[XB_TMO])) break; if (_sp > XB_SPIN_CAP) { atomicAdd(&(bar)[XB_TMO], 1u); break; } } } } while (0)

struct XcdBarrier {
    unsigned* bar; unsigned x;
    volatile LAS unsigned* st;
};

__device__ __forceinline__ XcdBarrier xcd_barrier_post(unsigned* bar, volatile LAS unsigned* st) {
    XcdBarrier b; b.bar = bar; b.x = xb_xcc_id(); b.st = st;
    if (threadIdx.x == 0) (void)xb_add(&bar[XB_XCNT(b.x)], 1u);
    return b;
}
__device__ __forceinline__ void xcd_barrier_complete(unsigned* bar, unsigned x, unsigned& nloc, unsigned& nx) {
    const unsigned G = gridDim.x * gridDim.y * gridDim.z;
    unsigned sum, cnt, mine, sp = 0u;
    for (;;) {
        sum = 0u; cnt = 0u; mine = 0u;
#pragma unroll
        for (unsigned j = 0; j < 16; ++j) { const unsigned c = xb_ld(&bar[XB_XCNT(j)]); sum += c; cnt += (c > 0u) ? 1u : 0u; mine = (j == x) ? c : mine; }
        if (sum == G) break;
        __builtin_amdgcn_s_sleep(1);
        if ((++sp & 255u) == 0u) { if (xb_ld(&bar[XB_TMO])) break; if (sp > XB_SPIN_CAP) { atomicAdd(&bar[XB_TMO], 1u); break; } }
    }
    nloc = mine > 0u ? mine : 1u; nx = cnt > 0u ? cnt : 1u;
}

__device__ __forceinline__ void xcd_barrier(const XcdBarrier& b) {
    asm volatile("s_waitcnt vmcnt(0)" ::: "memory");
    __syncthreads();
    if (threadIdx.x == 0) {
        unsigned* bar = b.bar;
        __builtin_amdgcn_s_waitcnt(0);
        unsigned nloc = b.st[0], nx = b.st[1];
        if (nloc == 0u) { xcd_barrier_complete(bar, b.x, nloc, nx); b.st[0] = nloc; b.st[1] = nx; }
        const unsigned old = xb_add(&bar[XB_XSUB(b.x)], 1u);
        const unsigned gen = old / nloc;
        if (old + 1u == (gen + 1u) * nloc) {
            __builtin_amdgcn_fence(__ATOMIC_RELEASE, "agent");
            asm volatile("s_waitcnt vmcnt(0)" ::: "memory");
            const unsigned og = xb_add(&bar[XB_TOP], 1u);
            const unsigned tg = og / nx;
            if (og + 1u == (tg + 1u) * nx) xb_add(&bar[XB_TOPGEN], 1u);
            else XB_SPIN(xb_ld(&bar[XB_TOPGEN]) == tg, bar);
            __builtin_amdgcn_fence(__ATOMIC_ACQUIRE, "agent");
            xb_add(&bar[XB_XGEN(b.x)], 1u);
            asm volatile("s_waitcnt vmcnt(0)" ::: "memory");
        } else {
            XB_SPIN(xb_ld(&bar[XB_XGEN(b.x)]) == gen, bar);
            __builtin_amdgcn_fence(__ATOMIC_ACQUIRE, "agent");
            asm volatile("s_waitcnt vmcnt(0)" ::: "memory");
        }
    }
    __syncthreads();
}

namespace pg8 {
constexpr int BM = 256, BK = 64, HALF = 128, HTB = HALF * BK * 2, STAGE_BYTES = 8 * HTB, NXCD = 8, WGM = 8;
__device__ __forceinline__ int lds_byte(int r, int c) { const int st = (r >> 4) * 2 + (c >> 5), rr = r & 15, cc = c & 31, ob = rr * 64 + cc * 2; return st * 1024 + (ob ^ (((ob >> 9) & 1) << 5)); }
__device__ __forceinline__ void stage_rc(int b, int& R, int& C) { const int st = b / 1024, sb = b % 1024, swz = sb ^ (((sb >> 9) & 1) << 5); R = (st >> 1) * 16 + swz / 64; C = (st & 1) * 32 + (swz % 64) / 2; }
__device__ __forceinline__ int perm32(int rho) { const int n = rho >> 4, i = rho & 15; return 8 * (i >> 2) + 4 * n + (i & 3); }

struct Unit { int pm, pn; const char* A; const char* B; };

struct DenseOrder {
    int nM, nN, nwg, G, c, K; const char* A; const char* Bt;
    __device__ void init(const void* A_, const void* Bt_, int M, int N, int K_, int G_, int c_) { A = (const char*)A_; Bt = (const char*)Bt_; nM = M / BM; nN = N / BM; nwg = nM * nN; G = G_; c = c_; K = K_; }
    __device__ bool next(int i, Unit& u) const {
        const long L = (long)i * G + c; if (L >= nwg) return false;
        int wgid = (int)L; { const int q = nwg / NXCD, r = nwg % NXCD, xcd = wgid % NXCD, off = wgid / NXCD; wgid = (xcd < r ? xcd * (q + 1) : r * (q + 1) + (xcd - r) * q) + off; }
        const int nig = WGM * nN, gid = wgid / nig, fm = gid * WGM, gsz = (nM - fm) < WGM ? (nM - fm) : WGM;
        u.pm = fm + ((wgid % nig) % gsz); u.pn = (wgid % nig) / gsz;
        u.A = A + (size_t)u.pm * 256 * K * 2; u.B = Bt + (size_t)u.pn * 256 * K * 2; return true;
    }
};
struct GroupedOrder {
    const int* tile_e; int n_mt, nN, G, c, K; const char* A; const char* Bt; size_t bstride;
    __device__ bool next(int i, Unit& u) const {
        const long L = (long)i * G + c; if (L >= (long)n_mt * nN) return false;
        u.pn = (int)(L / n_mt); u.pm = (int)(L % n_mt);
        const int e = tile_e[u.pm];
        u.A = A + (size_t)u.pm * 256 * K * 2; u.B = Bt + (size_t)e * bstride + (size_t)u.pn * 256 * K * 2; return true;
    }
};

template <class Epi, class Sched>
__device__ __forceinline__ void gemm_phase(LAS unsigned char* lds, const int K, const Sched& S, const Epi& E) {
    const int tid = tid_(), wid = __builtin_amdgcn_readfirstlane(tid >> 6), lane = tid & 63, wr = wid >> 2, wc = wid & 3, fr = lane & 15, fq = lane >> 4;
    const int nt = K / BK;
    unsigned voffA[2], voffB[2];
#pragma unroll
    for (int i = 0; i < 2; ++i) { int R, C; stage_rc(tid * 16 + i * 8192, R, C); const int Rb = Epi::PERM ? ((R & ~31) + perm32(R & 31)) : R;
        voffA[i] = (unsigned)(R * K + C) * 2u; voffB[i] = (unsigned)(Rb * K + C) * 2u; }
    const size_t kstep = (size_t)(BK * 2);
    const size_t hstep = (size_t)HALF * K * 2;
    const unsigned ldsw = (unsigned)wid * 1024u;
    const int aoff = lds_byte(wr * 64 + fr, fq * 8), boff = lds_byte(wc * 32 + fr, fq * 8);
#define PG8_SA(b, h) (((b) * 2 + (h)) * HTB)
#define PG8_SB(b, h) ((4 + (b) * 2 + (h)) * HTB)
#define PG8_STAGE(bufoff, gbase, voff) do { _Pragma("unroll") for (int _i = 0; _i < 2; ++_i) \
        __builtin_amdgcn_global_load_lds((const unsigned*)((const char*)(gbase) + (voff)[_i]), (LAS unsigned*)(lds + (bufoff) + ldsw + _i * 8192), 16, 0, 0); } while (0)
#define PG8_LDA(dst, b, h) do { _Pragma("unroll") for (int m = 0; m < 4; ++m) _Pragma("unroll") for (int k = 0; k < 2; ++k) dst[m][k] = *(const LAS bf16x8*)(lds + PG8_SA(b, h) + aoff + m * 2048 + k * 1024); } while (0)
#define PG8_LDB(dst, b, h) do { _Pragma("unroll") for (int n = 0; n < 2; ++n) _Pragma("unroll") for (int k = 0; k < 2; ++k) dst[n][k] = *(const LAS bf16x8*)(lds + PG8_SB(b, h) + boff + n * 2048 + k * 1024); } while (0)
#define PG8_MMA(ai, bj, At, Bt) do { __builtin_amdgcn_s_setprio(1); _Pragma("unroll") for (int m = 0; m < 4; ++m) _Pragma("unroll") for (int n = 0; n < 2; ++n) _Pragma("unroll") for (int k = 0; k < 2; ++k) \
        acc[ai][bj][m][n] = __builtin_amdgcn_mfma_f32_16x16x32_bf16(Bt[n][k], At[m][k], acc[ai][bj][m][n], 0, 0, 0); __builtin_amdgcn_s_setprio(0); } while (0)
#define PG8_WAIT_V(n) asm volatile("s_waitcnt vmcnt(" #n ")" ::: "memory")
#define PG8_WAIT_L(n) asm volatile("s_waitcnt lgkmcnt(" #n ")" ::: "memory")
#define PG8_BAR __builtin_amdgcn_s_barrier()
#define PG8_SCHED __builtin_amdgcn_sched_barrier(0)
    Unit cur, nxt; int ui = 0;
    if (!S.next(0, cur)) return;
    f32x4 acc[2][2][4][2];
#pragma unroll
    for (int a = 0; a < 2; ++a)
#pragma unroll
        for (int b = 0; b < 2; ++b)
#pragma unroll
            for (int m = 0; m < 4; ++m)
#pragma unroll
                for (int n = 0; n < 2; ++n) acc[a][b][m][n] = (f32x4){0.f, 0.f, 0.f, 0.f};
    bf16x8 At[4][2], B0[2][2], B1[2][2];
    const char* cA = cur.A; const char* cB = cur.B;
    PG8_STAGE(PG8_SB(0, 0), cB, voffB); PG8_STAGE(PG8_SA(0, 0), cA, voffA); PG8_STAGE(PG8_SB(0, 1), cB + hstep, voffB); PG8_STAGE(PG8_SA(0, 1), cA + hstep, voffA);
    if (wr == 1) PG8_BAR;
    PG8_WAIT_V(4); PG8_BAR;
    PG8_STAGE(PG8_SB(1, 0), cB + kstep, voffB); PG8_STAGE(PG8_SA(1, 0), cA + kstep, voffA); PG8_STAGE(PG8_SB(1, 1), cB + hstep + kstep, voffB);
    PG8_WAIT_V(6); PG8_BAR;
    for (;;) {
        const bool has_next = S.next(ui + 1, nxt);
        const char* nA = has_next ? nxt.A : cA; const char* nB = has_next ? nxt.B : cB;
        for (int t = 0; t < nt; t += 2) {
            const bool last = (t == nt - 2);
            const char* a1 = cA + (size_t)(t + 1) * kstep;
            const char* a2 = last ? nA : cA + (size_t)(t + 2) * kstep; const char* b2 = last ? nB : cB + (size_t)(t + 2) * kstep;
            const char* a3 = a2 + kstep; const char* b3 = b2 + kstep;
            PG8_LDB(B0, 0, 0); PG8_SCHED; PG8_LDA(At, 0, 0); PG8_STAGE(PG8_SA(1, 1), a1 + hstep, voffA);
            PG8_WAIT_L(8); PG8_BAR; PG8_WAIT_L(0); PG8_MMA(0, 0, At, B0); PG8_BAR; PG8_SCHED;
            PG8_LDB(B1, 0, 1); PG8_STAGE(PG8_SB(0, 0), b2, voffB);
            PG8_BAR; PG8_WAIT_L(0); PG8_MMA(0, 1, At, B1); PG8_BAR;
            PG8_LDA(At, 0, 1); PG8_STAGE(PG8_SA(0, 0), a2, voffA);
            PG8_BAR; PG8_WAIT_L(0); PG8_MMA(1, 0, At, B0); PG8_BAR; PG8_SCHED;
            PG8_STAGE(PG8_SB(0, 1), b2 + hstep, voffB);
            PG8_WAIT_V(6); PG8_BAR; PG8_MMA(1, 1, At, B1); PG8_BAR;
            PG8_LDB(B0, 1, 0); PG8_SCHED; PG8_LDA(At, 1, 0); PG8_STAGE(PG8_SA(0, 1), a2 + hstep, voffA);
            PG8_WAIT_L(8); PG8_BAR; PG8_WAIT_L(0); PG8_MMA(0, 0, At, B0); PG8_BAR; PG8_SCHED;
            PG8_LDB(B1, 1, 1); PG8_STAGE(PG8_SB(1, 0), b3, voffB);
            PG8_BAR; PG8_WAIT_L(0); PG8_MMA(0, 1, At, B1); PG8_BAR;
            PG8_LDA(At, 1, 1); PG8_STAGE(PG8_SA(1, 0), a3, voffA);
            PG8_BAR; PG8_WAIT_L(0); PG8_MMA(1, 0, At, B0); PG8_BAR; PG8_SCHED;
            PG8_STAGE(PG8_SB(1, 1), b3 + hstep, voffB);
            PG8_WAIT_V(6); PG8_BAR; PG8_MMA(1, 1, At, B1); PG8_BAR;
        }
        E(acc, cur, wr, wc, fr, fq);
        if (!has_next) break;
#pragma unroll
        for (int a = 0; a < 2; ++a)
#pragma unroll
            for (int b = 0; b < 2; ++b)
#pragma unroll
                for (int m = 0; m < 4; ++m)
#pragma unroll
                    for (int n = 0; n < 2; ++n) acc[a][b][m][n] = (f32x4){0.f, 0.f, 0.f, 0.f};
        cur = nxt; cA = nA; cB = nB; ++ui;
    }
    PG8_WAIT_V(0);
    if (wr == 0) PG8_BAR;
    PG8_BAR;
#undef PG8_SA
#undef PG8_SB
#undef PG8_STAGE
#undef PG8_LDA
#undef PG8_LDB
#undef PG8_MMA
#undef PG8_WAIT_V
#undef PG8_WAIT_L
#undef PG8_BAR
#undef PG8_SCHED
}
}
using pg8::Unit;

struct EpiProj {
    static constexpr bool PERM = true; bf16_t* O;
    __device__ __forceinline__ void operator()(const f32x4 (&acc)[2][2][4][2], const Unit& u, int wr, int wc, int fr, int fq) const {
        const int row0 = u.pm * 256 + wr * 64 + fr, col0 = u.pn * 256 + wc * 32 + 8 * fq;
#pragma unroll
        for (int ai = 0; ai < 2; ++ai)
#pragma unroll
            for (int m = 0; m < 4; ++m) { bf16_t* rowp = O + (size_t)(row0 + ai * 128 + m * 16) * LDP + col0;
#pragma unroll
                for (int bj = 0; bj < 2; ++bj) { const f32x4 v0 = acc[ai][bj][m][0], v1 = acc[ai][bj][m][1];
                    u32x4 w; w.x = pack2(v0[0], v0[1]); w.y = pack2(v0[2], v0[3]); w.z = pack2(v1[0], v1[1]); w.w = pack2(v1[2], v1[3]);
                    *(u32x4*)(rowp + bj * 128) = w; } }
    }
};
template <int PASS> struct EpiMerge {
    static constexpr bool PERM = true; bf16_t* M; const bf16_t* proj; const float* bg;
    __device__ __forceinline__ void operator()(const f32x4 (&acc)[2][2][4][2], const Unit& u, int wr, int wc, int fr, int fq) const {
        const int row0 = u.pm * 256 + wr * 64 + fr, col0 = u.pn * 256 + wc * 32 + 8 * fq;
#pragma unroll
        for (int ai = 0; ai < 2; ++ai)
#pragma unroll
            for (int m = 0; m < 4; ++m) { const int row = row0 + ai * 128 + m * 16;
#pragma unroll
                for (int bj = 0; bj < 2; ++bj)
#pragma unroll
                    for (int n = 0; n < 2; ++n) { const int col = col0 + bj * 128 + 4 * n;
                        const u32x2 gw = *(const u32x2*)(proj + (size_t)row * LDP + (PASS ? C_G1 : C_G0) + col);
                        const f32x4 b0 = *(const f32x4*)(bg + PASS * 2048 + col);
                        bf16_t* dst = M + (size_t)row * 2048 + col;
                        u32x2 old = {0u, 0u}; if (PASS) old = *(const u32x2*)dst;
                        const f32x4 v = acc[ai][bj][m][n];
                        const float r0 = bflo(old.x) + sigmoidf_(bflo(gw.x) + b0[0]) * v[0], r1 = bfhi(old.x) + sigmoidf_(bfhi(gw.x) + b0[1]) * v[1];
                        const float r2 = bflo(old.y) + sigmoidf_(bflo(gw.y) + b0[2]) * v[2], r3 = bfhi(old.y) + sigmoidf_(bfhi(gw.y) + b0[3]) * v[3];
                        u32x2 w; w.x = pack2(r0, r1); w.y = pack2(r2, r3);
                        *(u32x2*)dst = w; }
                asm volatile("" ::: "memory"); }
    }
};
struct EpiResid {
    static constexpr bool PERM = false; float* X1; const float* X;
    __device__ __forceinline__ void operator()(const f32x4 (&acc)[2][2][4][2], const Unit& u, int wr, int wc, int fr, int fq) const {
        const int row0 = u.pm * 256 + wr * 64 + fr, col0 = u.pn * 256 + wc * 32 + 4 * fq;
#pragma unroll
        for (int ai = 0; ai < 2; ++ai)
#pragma unroll
            for (int m = 0; m < 4; ++m) { const size_t ro = (size_t)(row0 + ai * 128 + m * 16) * 2048 + col0;
#pragma unroll
                for (int bj = 0; bj < 2; ++bj)
#pragma unroll
                    for (int n = 0; n < 2; ++n) { const size_t o = ro + bj * 128 + n * 16; *(f32x4*)(X1 + o) = *(const f32x4*)(X + o) + acc[ai][bj][m][n]; } }
    }
};
struct EpiGateUp {
    static constexpr bool PERM = false; bf16_t* ACT;
    __device__ __forceinline__ void operator()(const f32x4 (&acc)[2][2][4][2], const Unit& u, int wr, int wc, int fr, int fq) const {
        const int row0 = u.pm * 256 + wr * 64 + fr, hid0 = u.pn * 128 + wc * 16 + 4 * fq;
#pragma unroll
        for (int ai = 0; ai < 2; ++ai)
#pragma unroll
            for (int m = 0; m < 4; ++m) { bf16_t* rowp = ACT + (size_t)(row0 + ai * 128 + m * 16) * 512 + hid0;
#pragma unroll
                for (int bj = 0; bj < 2; ++bj) { const f32x4 g = acc[ai][bj][m][0], up = acc[ai][bj][m][1];
                    u32x2 w; w.x = pack2(siluf_(g[0]) * up[0], siluf_(g[1]) * up[1]); w.y = pack2(siluf_(g[2]) * up[2], siluf_(g[3]) * up[3]);
                    *(u32x2*)(rowp + bj * 64) = w; } }
    }
};
struct EpiDown {
    static constexpr bool PERM = true; bf16_t* O;
    __device__ __forceinline__ void operator()(const f32x4 (&acc)[2][2][4][2], const Unit& u, int wr, int wc, int fr, int fq) const {
        const int row0 = u.pm * 256 + wr * 64 + fr, col0 = u.pn * 256 + wc * 32 + 8 * fq;
#pragma unroll
        for (int ai = 0; ai < 2; ++ai)
#pragma unroll
            for (int m = 0; m < 4; ++m) { bf16_t* rowp = O + (size_t)(row0 + ai * 128 + m * 16) * 2048 + col0;
#pragma unroll
                for (int bj = 0; bj < 2; ++bj) { const f32x4 v0 = acc[ai][bj][m][0], v1 = acc[ai][bj][m][1];
                    u32x4 w; w.x = pack2(v0[0], v0[1]); w.y = pack2(v0[2], v0[3]); w.z = pack2(v1[0], v1[1]); w.w = pack2(v1[2], v1[3]);
                    *(u32x4*)(rowp + bj * 128) = w; } }
    }
};

namespace att {
constexpr int D = 128, ASTR = LDP, OSTR = 1024, MSTR = T_;
constexpr float SCALE = 0.08838834764831845f, THR = 8.f;
constexpr bool WSKIP = false;
constexpr int NW = 8, QBLK = 32, KVBLK = 64, QB = NW * QBLK;
constexpr int SHM_V = KVBLK * D * 2, SHM_K = KVBLK * D * 2;
constexpr int ATT_LDS = 2 * SHM_V + 2 * SHM_K + NW * 64 * 4;
typedef short s16x4 __attribute__((ext_vector_type(4)));
typedef float f32x16 __attribute__((ext_vector_type(16)));
template <class A, class Bt> struct same_t { static constexpr bool v = false; };
template <class A> struct same_t<A, A> { static constexpr bool v = true; };
#define KSWZ(row, colB) ((row) * 256 + ((colB) ^ (((row) & 7) << 4)))
#define SBAR() __builtin_amdgcn_sched_barrier(0)
__device__ __forceinline__ int v_st(int k, int c) { const int kk = (k & ~0xC) | ((k & 4) << 1) | ((k & 8) >> 1); return ((kk >> 3) * 4 + (c >> 5)) * 512 + ((kk & 7) * 32 + (c & 31)) * 2; }
__device__ __forceinline__ int v_rd_base(int lane) { return ((lane & 3) << 3) | (((lane >> 2) & 3) << 6) | (((lane >> 4) & 1) << 5) | (((lane >> 5) & 1) << 8); }
constexpr int v_rd_off(int d0, int ks, int half) { return d0 * 512 + ks * 4096 + half * 2048; }
__device__ __forceinline__ int crow(int r, int hi) { return (r & 3) + 8 * (r >> 2) + 4 * hi; }
__device__ __forceinline__ unsigned cvtpk(float lo, float hi) {
    unsigned r; asm volatile("v_cvt_pk_bf16_f32 %0, %1, %2" : "=v"(r) : "v"(lo), "v"(hi)); return r;
}
__device__ __forceinline__ bf16x8 pack8(f32x4 a, f32x4 b) {
    u32x4 w = {cvtpk(a[0], a[1]), cvtpk(a[2], a[3]), cvtpk(b[0], b[1]), cvtpk(b[2], b[3])};
    return *reinterpret_cast<bf16x8*>(&w);
}
template <class T> __device__ __forceinline__ bf16x8 load8(const T* p) {
    if constexpr (same_t<T, float>::v) { return pack8(*(const f32x4*)p, *(const f32x4*)(p + 4)); }
    else { return *reinterpret_cast<const bf16x8*>(p); }
}
__device__ __forceinline__ void mask_tile(f32x16& p0, f32x16& p1, int dq, unsigned W) {
    const float NEG = -__builtin_inff();
#pragma unroll
    for (int r = 0; r < 16; ++r) {
        const int c = (r & 3) + 8 * (r >> 2);
        if ((unsigned)(dq - c) >= W) p0[r] = NEG;
        if ((unsigned)(dq - c - 32) >= W) p1[r] = NEG;
    }
}
__device__ __forceinline__ void mask_bits(f32x16& p0, f32x16& p1, unsigned long long mw, int hi) {
    const float NEG = -__builtin_inff(); const unsigned lo = (unsigned)mw >> (4 * hi), hw = (unsigned)(mw >> 32) >> (4 * hi);
#pragma unroll
    for (int r = 0; r < 16; ++r) { const int c = (r & 3) + 8 * (r >> 2);
        if (!((lo >> c) & 1u)) p0[r] = NEG;
        if (!((hw >> c) & 1u)) p1[r] = NEG; }
}
__device__ __forceinline__ void partialSM(f32x16& p0, f32x16& p1, float& m_reg, float& mn, float& alpha) {
    float pmax = p0[0]; for (int r = 1; r < 16; ++r) pmax = fmaxf(pmax, p0[r]); for (int r = 0; r < 16; ++r) pmax = fmaxf(pmax, p1[r]);
    { auto rr = __builtin_amdgcn_permlane32_swap(__float_as_uint(pmax), __float_as_uint(pmax), false, false);
      pmax = fmaxf(__uint_as_float(rr[0]), __uint_as_float(rr[1])); }
    constexpr float C2 = 1.4426950408889634f * SCALE;
    if (__builtin_expect(__all((pmax - m_reg) * SCALE <= THR), 1)) { mn = m_reg; alpha = 1.f; }
    else { mn = fmaxf(m_reg, pmax); alpha = __builtin_amdgcn_exp2f((m_reg - mn) * C2); m_reg = mn; }
    const float mnL = -mn * C2;
    for (int r = 0; r < 16; ++r) p0[r] = fmaf(p0[r], C2, mnL); for (int r = 0; r < 16; ++r) p1[r] = fmaf(p1[r], C2, mnL);
    for (int r = 0; r < 16; ++r) p0[r] = __builtin_amdgcn_exp2f(p0[r]);
}
__device__ __forceinline__ void finishSM(f32x16& p0, f32x16& p1, float alpha, float& l_reg, bf16x8& pa0, bf16x8& pa1, bf16x8& pa2, bf16x8& pa3) {
    for (int r = 0; r < 16; ++r) p1[r] = __builtin_amdgcn_exp2f(p1[r]);
    float ps = 0; for (int r = 0; r < 16; ++r) ps += p0[r]; for (int r = 0; r < 16; ++r) ps += p1[r];
    { auto rr = __builtin_amdgcn_permlane32_swap(__float_as_uint(ps), __float_as_uint(ps), false, false);
      ps = __uint_as_float(rr[0]) + __uint_as_float(rr[1]); }
    l_reg = l_reg * alpha + ps;
#define PK4(P, B_, OUT) do { unsigned a0 = cvtpk(P[B_+0], P[B_+1]), a1 = cvtpk(P[B_+2], P[B_+3]);                          \
        unsigned b0 = cvtpk(P[B_+4], P[B_+5]), b1 = cvtpk(P[B_+6], P[B_+7]);                                             \
        auto r0 = __builtin_amdgcn_permlane32_swap(a0, b0, false, false); auto r1 = __builtin_amdgcn_permlane32_swap(a1, b1, false, false); \
        u32x4 w = {r0[0], r1[0], r0[1], r1[1]}; OUT = *reinterpret_cast<bf16x8*>(&w); } while (0)
    PK4(p0, 0, pa0); PK4(p0, 8, pa1); PK4(p1, 0, pa2); PK4(p1, 8, pa3);
#undef PK4
}
template <int KB, bool SK>
__device__ __forceinline__ void qkt(f32x16& p0, f32x16& p1, const char* K_lds, int r32, int hi, const bf16x8* qr, bool act) {
    if (SK && !act) { const float NEG = -__builtin_inff();
#pragma unroll
        for (int r = 0; r < 16; ++r) { p0[r] = NEG; p1[r] = NEG; } return; }
    p0 = f32x16{}; p1 = f32x16{};
    const char* kb[4];
#pragma unroll
    for (int dd = 0; dd < 4; ++dd) kb[dd] = K_lds + KB * SHM_K + KSWZ(r32, (dd * 16 + hi * 8) * 2);
#pragma unroll
    for (int d0 = 0; d0 < 8; ++d0) { const char* a = kb[d0 & 3] + (d0 >> 2) * 128;
        bf16x8 b0 = *reinterpret_cast<const bf16x8*>(a);
        bf16x8 b1 = *reinterpret_cast<const bf16x8*>(a + 32 * 256);
        p0 = __builtin_amdgcn_mfma_f32_32x32x16_bf16(b0, qr[d0], p0, 0, 0, 0);
        p1 = __builtin_amdgcn_mfma_f32_32x32x16_bf16(b1, qr[d0], p1, 0, 0, 0); }
}
template <int VB, bool SK>
__device__ __forceinline__ void pv_tile(f32x16* o, int vb0, bf16x8 pa0, bf16x8 pa1, bf16x8 pa2, bf16x8 pa3, bool act) {
    if (SK && !act) return;
#define TRRD(dst, off) asm volatile("ds_read_b64_tr_b16 %0, %1 offset:%2" : "=&v"(dst) : "v"(vb0), "i"(off) : "memory")
#define PV_D0(d0) do { s16x4 l0, l1, l2, l3, h0, h1, h2, h3; constexpr int b_ = VB * SHM_V + v_rd_off(d0, 0, 0);     \
        TRRD(l0, b_); TRRD(h0, b_ + 2048); TRRD(l1, b_ + 4096); TRRD(h1, b_ + 6144); TRRD(l2, b_ + 8192); TRRD(h2, b_ + 10240); TRRD(l3, b_ + 12288); TRRD(h3, b_ + 14336); \
        asm volatile("s_waitcnt lgkmcnt(0)" ::: "memory"); SBAR();                 \
        o[d0] = __builtin_amdgcn_mfma_f32_32x32x16_bf16(pa0, (bf16x8){l0[0], l0[1], l0[2], l0[3], h0[0], h0[1], h0[2], h0[3]}, o[d0], 0, 0, 0);   \
        o[d0] = __builtin_amdgcn_mfma_f32_32x32x16_bf16(pa1, (bf16x8){l1[0], l1[1], l1[2], l1[3], h1[0], h1[1], h1[2], h1[3]}, o[d0], 0, 0, 0);   \
        o[d0] = __builtin_amdgcn_mfma_f32_32x32x16_bf16(pa2, (bf16x8){l2[0], l2[1], l2[2], l2[3], h2[0], h2[1], h2[2], h2[3]}, o[d0], 0, 0, 0);   \
        o[d0] = __builtin_amdgcn_mfma_f32_32x32x16_bf16(pa3, (bf16x8){l3[0], l3[1], l3[2], l3[3], h3[0], h3[1], h3[2], h3[3]}, o[d0], 0, 0, 0); } while (0)
    PV_D0(0); PV_D0(1); PV_D0(2); PV_D0(3);
#undef PV_D0
#undef TRRD
}

template <class TIn, class TOut> struct BlockRef { const TIn* Q; const TIn* K; const TIn* V; TOut* O; int P0; const unsigned long long* MK; };
template <class TIn> struct Seam {
    bf16x8 qr[8];
    bf16x8 st_v0, st_v1, st_k0, st_k1; f32x4 sf0, sf1, sf2, sf3;
    f32x4 tq[16];
};
__device__ __forceinline__ int swa_jlo(int P0, int W) { const int lowk = P0 - W + 1; return lowk > 0 ? lowk / KVBLK : 0; }
#define ROW(p, k0, rr) ((p) + (size_t)((k0) + (rr)) * ASTR + sc)
#define VMW() asm volatile("s_waitcnt vmcnt(0)" ::: "memory")
#define VMWN(n) asm volatile("s_waitcnt vmcnt(%0)" :: "i"(n) : "memory")
#define SLOAD_H(Kp, Vp, k0) do { S.st_v0 = load8<TIn>(ROW(Vp, k0, sr)); S.st_v1 = load8<TIn>(ROW(Vp, k0, 32 + sr));              \
                         S.st_k0 = load8<TIn>(ROW(Kp, k0, sr)); S.st_k1 = load8<TIn>(ROW(Kp, k0, 32 + sr)); } while (0)
#define SWRITE_HK(bf) do { *(bf16x8*)(K_lds + (bf) * SHM_K + kws) = S.st_k0; *(bf16x8*)(K_lds + (bf) * SHM_K + kws + 32 * 256) = S.st_k1; } while (0)
#define SWRITE_HV(bf) do { *(bf16x8*)(V_lds + (bf) * SHM_V + vst0) = S.st_v0; *(bf16x8*)(V_lds + (bf) * SHM_V + vst1) = S.st_v1; } while (0)
#define SWRITE_H(bf) do { SWRITE_HV(bf); SWRITE_HK(bf); } while (0)
#define SLOAD_F(p, k0) do { S.sf0 = *(const f32x4*)ROW(p, k0, sr); S.sf1 = *(const f32x4*)(ROW(p, k0, sr) + 4);                \
                            S.sf2 = *(const f32x4*)ROW(p, k0, 32 + sr); S.sf3 = *(const f32x4*)(ROW(p, k0, 32 + sr) + 4); } while (0)
#define SWRITE_KF(bf) do { *(bf16x8*)(K_lds + (bf) * SHM_K + kws) = pack8(S.sf0, S.sf1); *(bf16x8*)(K_lds + (bf) * SHM_K + kws + 32 * 256) = pack8(S.sf2, S.sf3); } while (0)
#define SWRITE_VF(bf) do { *(bf16x8*)(V_lds + (bf) * SHM_V + vst0) = pack8(S.sf0, S.sf1); *(bf16x8*)(V_lds + (bf) * SHM_V + vst1) = pack8(S.sf2, S.sf3); } while (0)
template <class TIn, class TOut>
__device__ __forceinline__ void causal_swa_prime(const BlockRef<TIn, TOut>& cur, int W, char* lds, Seam<TIn>& S) {
    constexpr bool F32 = same_t<TIn, float>::v;
    const int tid = tid_(), wid = __builtin_amdgcn_readfirstlane(tid >> 6), lane = tid & 63, r32 = lane & 31, hi = lane >> 5;
    const int sr = tid >> 4, sc = (tid & 15) * 8, kws = KSWZ(sr, sc * 2); char* K_lds = lds + 2 * SHM_V;
    const int kb0 = swa_jlo(cur.P0, W) * KVBLK;
    for (int d0 = 0; d0 < 8; ++d0) S.qr[d0] = load8<TIn>(cur.Q + (size_t)(wid * QBLK + r32) * ASTR + d0 * 16 + hi * 8);
    if constexpr (F32) { SLOAD_F((const float*)cur.K, kb0); VMW(); SWRITE_KF(0); SBAR(); SLOAD_F((const float*)cur.V, kb0); }
    else { SLOAD_H(cur.K, cur.V, kb0); VMW(); SWRITE_HK(0); }
    __syncthreads();
}
template <class TIn, class TOut>
__device__ __forceinline__ void causal_swa_block(const BlockRef<TIn, TOut>& cur, const BlockRef<TIn, TOut>& nxt, int skv, int W, char* lds, Seam<TIn>& S) {
    constexpr bool F32 = same_t<TIn, float>::v;
    const int tid = tid_(), wid = __builtin_amdgcn_readfirstlane(tid >> 6), lane = tid & 63, r32 = lane & 31, hi = lane >> 5;
    const int j_lo = swa_jlo(cur.P0, W);
    int j_hi = (cur.P0 + QB - 1) / KVBLK + 1; if (j_hi > skv / KVBLK) j_hi = skv / KVBLK;
    const int NT = j_hi - j_lo;
    const int kbn = swa_jlo(nxt.P0, W) * KVBLK;
    const int qlo = cur.P0 + wid * QBLK, qm = qlo + r32 - 4 * hi;
    char* V_lds = lds; char* K_lds = lds + 2 * SHM_V;
    float* ws = (float*)(lds + 2 * SHM_V + 2 * SHM_K) + wid * 64; float* li_l = ws, * al_l = ws + 32;
    float m_reg = -1e30f, l_reg = 0; f32x16 o[4] = {};
    const int sr = tid >> 4, sc = (tid & 15) * 8, vst0 = v_st(sr, sc), vst1 = v_st(32 + sr, sc), kws = KSWZ(sr, sc * 2);
    const int vb0 = (int)(uintptr_t)V_lds + v_rd_base(lane);
    const TIn* Kh = cur.K; const TIn* Vh = cur.V;
#define RESC(a) do { if (__any((a) < 1.f)) { if (hi == 0) al_l[r32] = (a); asm volatile("s_waitcnt lgkmcnt(0)" ::: "memory");              \
                     for (int d_ = 0; d_ < 4; ++d_) for (int r = 0; r < 16; ++r) o[d_][r] *= al_l[crow(r, hi)]; } } while (0)
#define KBASE(t) ((j_lo + (t)) * KVBLK)
#define ACT(t) (KBASE(t) <= qlo + QBLK - 1 && KBASE(t) + KVBLK - 1 >= qlo - W + 1)
#define MASKT(P0_, P1_, t) do { mask_bits(P0_, P1_, mw, hi); } while (0)
#define MLOAD(t) do { mw = cur.MK[(size_t)(j_lo + (t)) * MSTR + wid * QBLK + r32]; } while (0)
    constexpr int NQL = F32 ? 16 : 8;
    constexpr bool SK = WSKIP && !F32;
#define SEAM_K0() do { VMWN(NQL); if constexpr (F32) { SWRITE_KF(0); SBAR(); SLOAD_F((const float*)nxt.V, kbn); } else { SWRITE_HK(0); } SBAR(); } while (0)
    f32x16 pA0, pA1, pB0, pB1; float mnA, mnB, alA, alB; bf16x8 pa0, pa1, pa2, pa3; unsigned long long mw = 0ull;
    if constexpr (F32) { VMW(); SWRITE_VF(0); SBAR(); } else { SWRITE_HV(0); SBAR(); }
    if (NT > 1) { if constexpr (F32) SLOAD_F((const float*)Kh, KBASE(1)); else SLOAD_H(Kh, Vh, KBASE(1)); }
    MLOAD(0); SBAR(); qkt<0, SK>(pA0, pA1, K_lds, r32, hi, S.qr, ACT(0));
    if constexpr (F32) { if (NT > 1) { VMW(); SWRITE_KF(1); SBAR(); SLOAD_F((const float*)Vh, KBASE(1)); } }
    MASKT(pA0, pA1, 0); partialSM(pA0, pA1, m_reg, mnA, alA);
    if (NT > 1) { VMW(); if constexpr (F32) { SWRITE_VF(1); SBAR(); if (NT > 2) SLOAD_F((const float*)Kh, KBASE(2)); } else SWRITE_H(1); }
    __syncthreads();
#define HALF_STEP(PX0, PX1, mnX, alX, PY0, PY1, alY, t, KB, VB, SB) do {                                                      \
        MLOAD(t); SBAR(); qkt<KB, SK>(PX0, PX1, K_lds, r32, hi, S.qr, ACT(t));                                             \
        finishSM(PY0, PY1, alY, l_reg, pa0, pa1, pa2, pa3); SBAR();                                                           \
        if ((t) + 1 < NT) { if constexpr (F32) { VMW(); SWRITE_KF(SB); SBAR(); SLOAD_F((const float*)Vh, KBASE((t) + 1)); }  \
                            else { SLOAD_H(Kh, Vh, KBASE((t) + 1)); } SBAR(); }                                               \
        pv_tile<VB, SK>(o, vb0, pa0, pa1, pa2, pa3, ACT((t) - 1)); MASKT(PX0, PX1, (t)); partialSM(PX0, PX1, m_reg, mnX, alX);                                        \
        __syncthreads();                                                                                                      \
        if ((t) + 1 < NT) { VMW(); if constexpr (F32) { SWRITE_VF(SB); SBAR(); if ((t) + 2 < NT) SLOAD_F((const float*)Kh, KBASE((t) + 2)); } \
                            else { SWRITE_H(SB); } }                                                                          \
        RESC(alX); __syncthreads(); } while (0)
    for (int t = 1; t + 1 < NT; t += 2) {
        HALF_STEP(pB0, pB1, mnB, alB, pA0, pA1, alA, t, 1, 0, 0);
        HALF_STEP(pA0, pA1, mnA, alA, pB0, pB1, alB, t + 1, 0, 1, 1);
    }
    const bool even = (NT & 1) == 0;
    if (even) { MLOAD(NT - 1); SBAR(); qkt<1, SK>(pB0, pB1, K_lds, r32, hi, S.qr, ACT(NT - 1)); SBAR(); }
#define QROW(e) (nxt.Q + (size_t)(wid * QBLK + r32) * ASTR + ((e) >> 1) * 16 + hi * 8 + ((e) & 1) * 4)
    if constexpr (F32) { SLOAD_F((const float*)nxt.K, kbn); SBAR();
#pragma unroll
        for (int e = 0; e < 8; ++e) S.tq[e] = *(const f32x4*)QROW(e); }
    else { SLOAD_H(nxt.K, nxt.V, kbn); SBAR();
#pragma unroll
        for (int d0 = 0; d0 < 8; ++d0) S.qr[d0] = load8<TIn>(nxt.Q + (size_t)(wid * QBLK + r32) * ASTR + d0 * 16 + hi * 8); }
    SBAR();
    finishSM(pA0, pA1, alA, l_reg, pa0, pa1, pa2, pa3); SBAR();
    if constexpr (F32) {
#pragma unroll
        for (int e = 8; e < 16; ++e) S.tq[e] = *(const f32x4*)QROW(e); SBAR(); }
#undef QROW
    pv_tile<0, SK>(o, vb0, pa0, pa1, pa2, pa3, ACT(even ? NT - 2 : NT - 1));
    if (even) { MASKT(pB0, pB1, NT - 1); partialSM(pB0, pB1, m_reg, mnB, alB); __syncthreads(); RESC(alB);
        finishSM(pB0, pB1, alB, l_reg, pa0, pa1, pa2, pa3); SBAR(); pv_tile<1, SK>(o, vb0, pa0, pa1, pa2, pa3, ACT(NT - 1)); }
    SBAR(); SEAM_K0();
    if (hi == 0) li_l[r32] = l_reg; asm volatile("s_waitcnt lgkmcnt(0)" ::: "memory");
    float rli[16];
#pragma unroll
    for (int r = 0; r < 16; ++r) rli[r] = __builtin_amdgcn_rcpf(li_l[crow(r, hi)]);
    TOut* Ow = cur.O + (size_t)(wid * QBLK) * OSTR;
#pragma unroll
    for (int r = 0; r < 16; ++r) { const int orow = crow(r, hi);
#pragma unroll
        for (int d0 = 0; d0 < 4; ++d0) { const float v = o[d0][r] * rli[r];
            if constexpr (same_t<TOut, float>::v) { Ow[(size_t)orow * OSTR + d0 * 32 + r32] = v; }
            else { const float vn = dpp_f<0xB1>(v);
                   if ((r32 & 1) == 0) *(unsigned*)(Ow + (size_t)orow * OSTR + d0 * 32 + r32) = cvtpk(v, vn); } } }
    if constexpr (F32) {
#pragma unroll
        for (int d0 = 0; d0 < 8; ++d0) S.qr[d0] = pack8(S.tq[2 * d0], S.tq[2 * d0 + 1]); }
    __syncthreads();
#undef RESC
#undef KBASE
#undef ACT
#undef MASKT
#undef MLOAD
#undef SEAM_K0
#undef HALF_STEP
}
#undef ROW
#undef VMW
#undef VMWN
#undef SLOAD_H
#undef SWRITE_HK
#undef SWRITE_HV
#undef SWRITE_H
#undef SLOAD_F
#undef SWRITE_KF
#undef SWRITE_VF
}

template <class Load4, class DstRow>
__device__ __forceinline__ void convert_tiles(LAS float* tile  , bf16_t* dst, int K, int N, Load4 load4, DstRow dstrow, int c, int G, int& tile_counter) {
    const int tid = tid_(), nk = K / 64, total = nk * (N / 256);
    const int kr = tid >> 6, n4 = (tid & 63) * 4;
    int tt = (c - tile_counter % G + G) % G;
    tile_counter += total;
    f32x4 r[8];
    if (tt < total) { const int k0 = (tt % nk) * 64, n0 = (tt / nk) * 256;
#pragma unroll
        for (int i = 0; i < 8; ++i) r[i] = load4(k0 + kr + 8 * i, n0 + n4); }
    while (tt < total) {
        const int k0 = (tt % nk) * 64, n0 = (tt / nk) * 256;
        __syncthreads();
#pragma unroll
        for (int i = 0; i < 8; ++i) { LAS float* q = tile + (kr + 8 * i) * 257 + n4; q[0] = r[i][0]; q[1] = r[i][1]; q[2] = r[i][2]; q[3] = r[i][3]; }
        const int nx = tt + G;
        if (nx < total) { const int k1 = (nx % nk) * 64, n1 = (nx / nk) * 256;
#pragma unroll
            for (int i = 0; i < 8; ++i) r[i] = load4(k1 + kr + 8 * i, n1 + n4); }
        __syncthreads();
        const int kc = tid & 7;
#pragma unroll
        for (int i = 0; i < 4; ++i) { const int nl = (tid >> 3) + 64 * i; float v[8];
#pragma unroll
            for (int j = 0; j < 8; ++j) v[j] = tile[(kc * 8 + j) * 257 + nl];
            u32x4 w; w.x = pack2(v[0], v[1]); w.y = pack2(v[2], v[3]); w.z = pack2(v[4], v[5]); w.w = pack2(v[6], v[7]);
            *(u32x4*)(dst + (size_t)dstrow(n0 + nl) * K + k0 + kc * 8) = w; }
        tt = nx;
    }
}

__device__ __forceinline__ int in_col_map(int n) {
    if (n < 4096) return n;
    if (n < 7680) return n + 16;
    if (n < 11776) return n + 88;
    if (n < 11840) return 7696 + (n - 11776);
    if (n < 11848) return 4096 + (n - 11840);
    if (n < 11856) return 4104 + (n - 11848);
    if (n < 11864) return 7760 + (n - 11856);
    return -1;
}

__device__ __forceinline__ void phase0(const Params& p, LAS unsigned char* lds) {
    const int G = gridDim.x, c = blockIdx.x, tid = tid_();
    unsigned char* ws = opq(p.ws);
    if (c == 0 && tid < 256) ((unsigned*)(ws + OFF_SMALL + SM_CTRL))[tid] = 0u;
    int counter = 0;
    { const float* w = p.w_in;
      convert_tiles((LAS float*)lds, (bf16_t*)(ws + OFF_WT_IN), 2048, LDP, [w](int k, int n) -> f32x4 {
          const float* row = w + (size_t)k * IN_COLS;
          if (n < 11776) { const int o = n < 4096 ? n : (n < 7680 ? n + 16 : n + 88); return *(const f32x4*)(row + o); }
          f32x4 v;
#pragma unroll
          for (int j = 0; j < 4; ++j) { const int o = in_col_map(n + j); v[j] = o < 0 ? 0.f : row[o]; }
          return v; }, [](int n) { return n; }, c, G, counter); }
    { const float* w = p.w_proj_dn; convert_tiles((LAS float*)lds, (bf16_t*)(ws + OFF_WT_DN), 1024, 2048, [w](int k, int n) -> f32x4 { return *(const f32x4*)(w + (size_t)k * 2048 + n); }, [](int n) { return n; }, c, G, counter); }
    { const float* w = p.w_proj_att; convert_tiles((LAS float*)lds, (bf16_t*)(ws + OFF_WT_AT), 1024, 2048, [w](int k, int n) -> f32x4 { return *(const f32x4*)(w + (size_t)k * 2048 + n); }, [](int n) { return n; }, c, G, counter); }
    { const float* w = p.w_out; convert_tiles((LAS float*)lds, (bf16_t*)(ws + OFF_WT_OUT), 2048, 2048, [w](int k, int n) -> f32x4 { return *(const f32x4*)(w + (size_t)k * 2048 + n); }, [](int n) { return n; }, c, G, counter); }
    { bf16_t* wh = (bf16_t*)(ws + OFF_WR); bf16_t* wl = (bf16_t*)(ws + OFF_WR + 512 * 1024);
      for (int i = c * 512 + tid; i < 5 * 64 * 64 * 8; i += G * 512) { const int e = i & 7, ln = (i >> 3) & 63, kk = (i >> 9) & 63, j = i >> 15;
          const int k = 32 * kk + 8 * (ln >> 4) + e, col = 16 * j + (ln & 15);
          const float v = col < 64 ? p.w_router[(size_t)k * 64 + col] : (col < 72 ? p.w_group[(size_t)k * 8 + col - 64] : 0.f);
          const bf16_t hi = f2bf(v); wh[i] = hi; wl[i] = f2bf(v - bf2f(hi)); } }
    { float* ct = (float*)(ws + OFF_COS); float* st = (float*)(ws + OFF_SIN);
      for (int i = c * 512 + tid; i < T_ * 16; i += G * 512) { const int t = i >> 4;
          const float invf = exp2f(-(float)(i & 15) * 1.1832230355827609f);
          const float ang = (float)p.positions[t] * invf;
          double r = (double)ang * 0.15915494309189535; r -= floor(r);
          ct[i] = __builtin_amdgcn_cosf((float)r); st[i] = __builtin_amdgcn_sinf((float)r); } }
    const int wid = tid >> 6, lane = tid & 63; bf16_t* h = (bf16_t*)(ws + OFF_H);
    for (int row = c * 8 + wid; row < T_; row += G * 8) {
        const float* xr = p.x + (size_t)row * 2048; f32x4 v[8]; float ss = 0.f;
#pragma unroll
        for (int i = 0; i < 8; ++i) { v[i] = *(const f32x4*)(xr + i * 256 + 4 * lane); ss += v[i][0] * v[i][0] + v[i][1] * v[i][1] + v[i][2] * v[i][2] + v[i][3] * v[i][3]; }
        ss = wave_sum(ss); const float rs = rsqrtf(ss * (1.0f / 2048.0f) + EPS);
#pragma unroll
        for (int i = 0; i < 8; ++i) { const f32x4 g = *(const f32x4*)(p.norm_mix + i * 256 + 4 * lane);
            u32x2 w; w.x = pack2(v[i][0] * rs * g[0], v[i][1] * rs * g[1]); w.y = pack2(v[i][2] * rs * g[2], v[i][3] * rs * g[3]);
            *(u32x2*)(h + (size_t)row * 2048 + i * 256 + 4 * lane) = w; }
    }
}

__device__ __forceinline__ void phase_rope(const Params& p) {
    const int G = gridDim.x, c = blockIdx.x, tid = tid_();
    unsigned char* ws = opq(p.ws); bf16_t* proj = (bf16_t*)(ws + OFF_PROJ); bf16_t* kidx = (bf16_t*)(ws + OFF_SMALL + SM_KIDX); float* wq = (float*)(ws + OFF_SMALL + SM_WQ);
    const float* ct = (const float*)(ws + OFF_COS); const float* st = (const float*)(ws + OFF_SIN);
    const int gtid = c * 512 + tid, gsz = G * 512;
    for (int id = gtid; id < 2 * T_ * 8; id += gsz) { const int tsel = id >= T_ * 8, rem = id - tsel * T_ * 8, t = rem >> 3, hh = rem & 7;
        bf16_t* q = proj + (size_t)t * LDP + (tsel ? C_AK : C_AQ) + hh * 128;
        u32x4 d[4]; f32x4 cv[4], sv[4];
#pragma unroll
        for (int i = 0; i < 4; ++i) { d[i] = *(const u32x4*)(q + 8 * i); cv[i] = *(const f32x4*)(ct + (size_t)t * 16 + 4 * i); sv[i] = *(const f32x4*)(st + (size_t)t * 16 + 4 * i); }
#pragma unroll
        for (int hf = 0; hf < 2; ++hf) { u32x4& a = d[hf]; u32x4& bq = d[hf + 2];
#pragma unroll
            for (int j = 0; j < 4; ++j) { const unsigned wa = a[j], wb = bq[j]; const int i0 = 8 * hf + 2 * j;
                const float c0 = cv[i0 >> 2][i0 & 3], s0 = sv[i0 >> 2][i0 & 3], c1 = cv[(i0 + 1) >> 2][(i0 + 1) & 3], s1 = sv[(i0 + 1) >> 2][(i0 + 1) & 3];
                const float x10 = bflo(wa), x11 = bfhi(wa), x20 = bflo(wb), x21 = bfhi(wb);
                a[j] = pack2(x10 * c0 - x20 * s0, x11 * c1 - x21 * s1); bq[j] = pack2(x20 * c0 + x10 * s0, x21 * c1 + x11 * s1); } }
#pragma unroll
        for (int i = 0; i < 4; ++i) *(u32x4*)(q + 8 * i) = d[i]; }
    for (int id = gtid; id < T_ * 8; id += gsz) { const int t = id >> 3, hh = id & 7;
        bf16_t* q = proj + (size_t)t * LDP + C_IQ + hh * 64;
        u32x4 a = *(const u32x4*)q, bq = *(const u32x4*)(q + 8); f32x4 cv[4], sv[4];
#pragma unroll
        for (int i = 0; i < 4; ++i) { cv[i] = *(const f32x4*)(ct + (size_t)t * 16 + 4 * i); sv[i] = *(const f32x4*)(st + (size_t)t * 16 + 4 * i); }
#pragma unroll
        for (int j = 0; j < 4; ++j) { const unsigned wa = a[j], wb = bq[j];
            const float c0 = cv[j][0], s0 = sv[j][0], c1 = cv[j][2], s1 = sv[j][2];
            const float x10 = bflo(wa), x11 = bfhi(wa), x20 = bflo(wb), x21 = bfhi(wb);
            a[j] = pack2(x10 * c0 - x20 * s0, x11 * c1 - x21 * s1); bq[j] = pack2(x20 * c0 + x10 * s0, x21 * c1 + x11 * s1); }
        *(u32x4*)q = a; *(u32x4*)(q + 8) = bq; }
    for (int t = gtid; t < T_; t += gsz) { const bf16_t* row = proj + (size_t)t * LDP;
        float v[64]; float ss = 0.f;
#pragma unroll
        for (int i = 0; i < 8; ++i) { const u32x4 dd = *(const u32x4*)(row + C_IK + 8 * i);
#pragma unroll
            for (int j = 0; j < 4; ++j) { v[8 * i + 2 * j] = bflo(dd[j]); v[8 * i + 2 * j + 1] = bfhi(dd[j]); ss += v[8 * i + 2 * j] * v[8 * i + 2 * j] + v[8 * i + 2 * j + 1] * v[8 * i + 2 * j + 1]; } }
        const float rs = rsqrtf(ss * (1.0f / 64.0f) + EPS);
#pragma unroll
        for (int d = 0; d < 64; ++d) v[d] = v[d] * rs * p.idx_k_norm[d];
#pragma unroll
        for (int i = 0; i < 8; ++i) { const float cc = ct[(size_t)t * 16 + 2 * i], sn = st[(size_t)t * 16 + 2 * i]; const float x1 = v[i], x2 = v[8 + i]; v[i] = x1 * cc - x2 * sn; v[8 + i] = x2 * cc + x1 * sn; }
#pragma unroll
        for (int ch = 0; ch < 8; ++ch) { const int kk = ch >> 2, fq2 = ch & 3; u32x4 w; w.x = pack2(v[8 * ch], v[8 * ch + 1]); w.y = pack2(v[8 * ch + 2], v[8 * ch + 3]); w.z = pack2(v[8 * ch + 4], v[8 * ch + 5]); w.w = pack2(v[8 * ch + 6], v[8 * ch + 7]);
            *(u32x4*)(kidx + ((size_t)((t >> 4) * 2 + kk) * 64 + fq2 * 16 + (t & 15)) * 8) = w; }
        const u32x4 ww = *(const u32x4*)(row + C_IW); const float sc = 0.044194173824159216f;
        f32x4 w0 = {bflo(ww.x) * sc, bfhi(ww.x) * sc, bflo(ww.y) * sc, bfhi(ww.y) * sc}, w1 = {bflo(ww.z) * sc, bfhi(ww.z) * sc, bflo(ww.w) * sc, bfhi(ww.w) * sc};
        *(f32x4*)(wq + (size_t)t * 8) = w0; *(f32x4*)(wq + (size_t)t * 8 + 4) = w1; }
}

__device__ __forceinline__ bf16x8 ldfrag(const LAS bf16_t* X, int stride, int rt, int ks, int fr, int fq) { return *(const LAS bf16x8*)(X + (16 * rt + fr) * stride + 32 * ks + 8 * fq); }
__device__ __forceinline__ void dn_prep_load(const Params& p, int item, u32x4 (&xr)[3][2][4], float (&ba)[2]) {
    const int tid = tid_(), n = item >> 3, h = item & 7, t0 = n * 64, c = tid & 15, i0 = tid >> 4;
    const bf16_t* proj = (const bf16_t*)(opq(p.ws) + OFF_PROJ);
#pragma unroll
    for (int sel = 0; sel < 3; ++sel) { const int col = sel * 1024 + h * 128 + 8 * c;
#pragma unroll
        for (int rr = 0; rr < 2; ++rr)
#pragma unroll
            for (int j = 0; j < 4; ++j) { const int tt = t0 + i0 + 32 * rr - 3 + j; xr[sel][rr][j] = (u32x4){0u, 0u, 0u, 0u}; if (tt >= 0) xr[sel][rr][j] = *(const u32x4*)(proj + (size_t)tt * LDP + col); } }
    ba[0] = 0.f; ba[1] = 0.f;
    if (tid < 64) { const int t = t0 + tid; ba[0] = bf2f(proj[(size_t)t * LDP + C_B + h]); ba[1] = bf2f(proj[(size_t)t * LDP + C_A + h]); }
}
__device__ __forceinline__ void dn_prep_item(const Params& p, int item, int next_item, LAS unsigned char* lds, u32x4 (&xr)[3][2][4], float (&ba)[2]) {
    const int tid = tid_(), w = tid >> 6, lane = tid & 63, fr = lane & 15, fq = lane >> 4, n = item >> 3, h = item & 7, t0 = n * 64;
    unsigned char* ws = opq(p.ws); const bf16_t* proj = (const bf16_t*)(ws + OFF_PROJ);
    LAS bf16_t* Kr = (LAS bf16_t*)lds; LAS bf16_t* Qr = Kr + 64 * 136; LAS bf16_t* KTs = Qr + 64 * 136; LAS bf16_t* VTs = KTs + 128 * 72;
    LAS bf16_t* Pb = VTs + 128 * 72;
    LAS float* Gs = (LAS float*)(Pb + 6 * 64 * 72); LAS float* bs = Gs + 64; LAS float* eg = bs + 64;
    bf16_t* wb = (bf16_t*)(ws + OFF_DNP + DNP_W) + (size_t)item * 8192; bf16_t* uT = (bf16_t*)(ws + OFF_DNP + DNP_UT) + (size_t)item * 8192;
    bf16_t* qd = (bf16_t*)(ws + OFF_DNP + DNP_QD) + (size_t)item * 8192; bf16_t* kdT = (bf16_t*)(ws + OFF_DNP + DNP_KDT) + (size_t)item * 8192;
    bf16_t* attn = (bf16_t*)(ws + OFF_DNP + DNP_ATT) + (size_t)item * 4096;
    __syncthreads();
    if (tid < 64) { const float bl = ba[0], al = ba[1] + p.dt_bias[h];
        const float sp = fmaxf(al, 0.f) + log1pf(__expf(-fabsf(al))); float g = -__expf(p.a_log[h]) * sp;
        for (int o = 1; o < 64; o <<= 1) { const float u = shfl_up_(g, o); if (tid >= o) g += u; }
        Gs[tid] = g; bs[tid] = sigmoidf_(bl); eg[tid] = __expf(g);
        if (tid == 63) ((float*)(ws + OFF_SMALL + SM_GLAST))[item] = __expf(g); }
    __syncthreads();
    { const int c = tid & 15, i0 = tid >> 4;
#pragma unroll
      for (int sel = 0; sel < 3; ++sel) { const int col = sel * 1024 + h * 128 + 8 * c;
          f32x4 wv[4][2];
#pragma unroll
          for (int j = 0; j < 4; ++j) { wv[j][0] = *(const f32x4*)(p.conv_w + j * 3072 + col); wv[j][1] = *(const f32x4*)(p.conv_w + j * 3072 + col + 4); }
#pragma unroll
          for (int rr = 0; rr < 2; ++rr) { const int i = i0 + 32 * rr; float y[8];
#pragma unroll
              for (int e = 0; e < 8; ++e) y[e] = 0.f;
#pragma unroll
              for (int j = 0; j < 4; ++j) { const u32x4 xv = xr[sel][rr][j];
                  y[0] += wv[j][0][0] * bflo(xv.x); y[1] += wv[j][0][1] * bfhi(xv.x); y[2] += wv[j][0][2] * bflo(xv.y); y[3] += wv[j][0][3] * bfhi(xv.y);
                  y[4] += wv[j][1][0] * bflo(xv.z); y[5] += wv[j][1][1] * bfhi(xv.z); y[6] += wv[j][1][2] * bflo(xv.w); y[7] += wv[j][1][3] * bfhi(xv.w); }
              float ss = 0.f;
#pragma unroll
              for (int e = 0; e < 8; ++e) { y[e] = siluf_(y[e]); ss += y[e] * y[e]; }
              const float bi = bs[i], ei = eg[i];
              if (sel < 2) { ss = sum16(ss); const float rn = rsqrtf(ss + EPS) * (sel == 0 ? 0.08838834764831845f : 1.0f);
#pragma unroll
                  for (int e = 0; e < 8; ++e) y[e] *= rn; }
              if (sel == 0) { u32x4 pk; pk.x = pack2(y[0], y[1]); pk.y = pack2(y[2], y[3]); pk.z = pack2(y[4], y[5]); pk.w = pack2(y[6], y[7]);
                  *(LAS u32x4*)(Qr + i * 136 + 8 * c) = pk;
                  u32x4 pd; pd.x = pack2(y[0] * ei, y[1] * ei); pd.y = pack2(y[2] * ei, y[3] * ei); pd.z = pack2(y[4] * ei, y[5] * ei); pd.w = pack2(y[6] * ei, y[7] * ei);
                  *(u32x4*)(qd + i * 128 + 8 * c) = pd; }
              else if (sel == 1) { u32x4 pk; pk.x = pack2(y[0], y[1]); pk.y = pack2(y[2], y[3]); pk.z = pack2(y[4], y[5]); pk.w = pack2(y[6], y[7]);
                  *(LAS u32x4*)(Kr + i * 136 + 8 * c) = pk; const float f = bi * ei;
#pragma unroll
                  for (int e = 0; e < 8; ++e) KTs[(8 * c + e) * 72 + i] = f2bf(y[e] * f); }
              else {
#pragma unroll
                  for (int e = 0; e < 8; ++e) VTs[(8 * c + e) * 72 + i] = f2bf(y[e] * bi); } } } }
    if (next_item >= 0) dn_prep_load(p, next_item, xr, ba);
    __syncthreads();
    { const float g63 = Gs[63];
#pragma unroll
      for (int rr = 0; rr < 2; ++rr) { const int u = tid + 512 * rr, d = u >> 3, ic = u & 7; float v[8];
#pragma unroll
          for (int e = 0; e < 8; ++e) v[e] = bf2f(Kr[(8 * ic + e) * 136 + d]) * __expf(g63 - Gs[8 * ic + e]);
          u32x4 pk; pk.x = pack2(v[0], v[1]); pk.y = pack2(v[2], v[3]); pk.z = pack2(v[4], v[5]); pk.w = pack2(v[6], v[7]);
          *(u32x4*)(kdT + d * 64 + 8 * ic) = pk; } }
    LAS bf16_t* P0 = Pb; LAS bf16_t* P1 = Pb + 64 * 72; LAS bf16_t* PT0 = Pb + 2 * 64 * 72; LAS bf16_t* PT1 = Pb + 3 * 64 * 72; LAS bf16_t* TT0 = Pb + 4 * 64 * 72; LAS bf16_t* TT1 = Pb + 5 * 64 * 72;
#pragma unroll
    for (int pp = 0; pp < 2; ++pp) { const int pr = 2 * w + pp, it = pr >> 2, jt = pr & 3;
        f32x4 akk = {0.f, 0.f, 0.f, 0.f}, aqk = {0.f, 0.f, 0.f, 0.f};
#pragma unroll
        for (int ks = 0; ks < 4; ++ks) { const bf16x8 ki = ldfrag(Kr, 136, it, ks, fr, fq), kj = ldfrag(Kr, 136, jt, ks, fr, fq), qi = ldfrag(Qr, 136, it, ks, fr, fq);
            akk = __builtin_amdgcn_mfma_f32_16x16x32_bf16(ki, kj, akk, 0, 0, 0);
            aqk = __builtin_amdgcn_mfma_f32_16x16x32_bf16(kj, qi, aqk, 0, 0, 0); }
        { const int j = 16 * jt + fr; const float Gj = Gs[j]; float mv[4];
#pragma unroll
          for (int r = 0; r < 4; ++r) { const int i = 16 * it + 4 * fq + r; mv[r] = j < i ? -bs[i] * akk[r] * __expf(Gs[i] - Gj) : 0.f; P0[i * 72 + j] = f2bf(mv[r]); }
          u32x2 pk; pk.x = pack2(mv[0], mv[1]); pk.y = pack2(mv[2], mv[3]); *(LAS u32x2*)(PT0 + j * 72 + 16 * it + 4 * fq) = pk; }
        { const int i = 16 * it + fr; const float Gi = Gs[i]; float av[4];
#pragma unroll
          for (int r = 0; r < 4; ++r) { const int j = 16 * jt + 4 * fq + r; av[r] = j <= i ? aqk[r] * __expf(Gi - Gs[j]) : 0.f; }
          u32x2 pk; pk.x = pack2(av[0], av[1]); pk.y = pack2(av[2], av[3]); *(u32x2*)(attn + i * 64 + 16 * jt + 4 * fq) = pk; } }
    f32x4 tm[2];
#pragma unroll
    for (int pp = 0; pp < 2; ++pp) { const int pr = 2 * w + pp, it = pr >> 2, jt = pr & 3;
#pragma unroll
        for (int r = 0; r < 4; ++r) tm[pp][r] = (16 * it + 4 * fq + r == 16 * jt + fr) ? 1.f : 0.f;
        u32x2 pk; pk.x = pack2(tm[pp][0], tm[pp][1]); pk.y = pack2(tm[pp][2], tm[pp][3]); *(LAS u32x2*)(TT0 + (16 * jt + fr) * 72 + 16 * it + 4 * fq) = pk; }
    __syncthreads();
#pragma unroll
    for (int k = 0; k < 6; ++k) {
        const LAS bf16_t* Pc = (k & 1) ? P1 : P0; const LAS bf16_t* PTc = (k & 1) ? PT1 : PT0; const LAS bf16_t* TTc = (k & 1) ? TT1 : TT0;
        LAS bf16_t* Pn = (k & 1) ? P0 : P1; LAS bf16_t* PTn = (k & 1) ? PT0 : PT1; LAS bf16_t* TTn = (k & 1) ? TT0 : TT1;
#pragma unroll
        for (int pp = 0; pp < 2; ++pp) { const int pr = 2 * w + pp, it = pr >> 2, jt = pr & 3;
            f32x4 x = {0.f, 0.f, 0.f, 0.f}, y = {0.f, 0.f, 0.f, 0.f};
#pragma unroll
            for (int ks = 0; ks < 2; ++ks) { const bf16x8 pa = ldfrag(Pc, 72, it, ks, fr, fq);
                x = __builtin_amdgcn_mfma_f32_16x16x32_bf16(pa, ldfrag(TTc, 72, jt, ks, fr, fq), x, 0, 0, 0);
                if (k < 5) y = __builtin_amdgcn_mfma_f32_16x16x32_bf16(pa, ldfrag(PTc, 72, jt, ks, fr, fq), y, 0, 0, 0); }
            tm[pp] += x;
            if (k < 5) { u32x2 pk; pk.x = pack2(tm[pp][0], tm[pp][1]); pk.y = pack2(tm[pp][2], tm[pp][3]); *(LAS u32x2*)(TTn + (16 * jt + fr) * 72 + 16 * it + 4 * fq) = pk;
#pragma unroll
                for (int r = 0; r < 4; ++r) Pn[(16 * it + 4 * fq + r) * 72 + 16 * jt + fr] = f2bf(y[r]);
                u32x2 pq; pq.x = pack2(y[0], y[1]); pq.y = pack2(y[2], y[3]); *(LAS u32x2*)(PTn + (16 * jt + fr) * 72 + 16 * it + 4 * fq) = pq; }
            else {
#pragma unroll
                for (int r = 0; r < 4; ++r) P0[(16 * it + 4 * fq + r) * 72 + 16 * jt + fr] = f2bf(tm[pp][r]); } }
        __syncthreads();
    }
#pragma unroll
    for (int q4 = 0; q4 < 4; ++q4) { const int tl = 4 * w + q4;
        { const int dt = tl >> 2, it = tl & 3; f32x4 a = {0.f, 0.f, 0.f, 0.f};
#pragma unroll
          for (int ks = 0; ks < 2; ++ks) a = __builtin_amdgcn_mfma_f32_16x16x32_bf16(ldfrag(KTs, 72, dt, ks, fr, fq), ldfrag(P0, 72, it, ks, fr, fq), a, 0, 0, 0);
          u32x2 pk; pk.x = pack2(a[0], a[1]); pk.y = pack2(a[2], a[3]); *(u32x2*)(wb + (16 * it + fr) * 128 + 16 * dt + 4 * fq) = pk; }
        { const int it = tl >> 3, vt = tl & 7; f32x4 a = {0.f, 0.f, 0.f, 0.f};
#pragma unroll
          for (int ks = 0; ks < 2; ++ks) a = __builtin_amdgcn_mfma_f32_16x16x32_bf16(ldfrag(P0, 72, it, ks, fr, fq), ldfrag(VTs, 72, vt, ks, fr, fq), a, 0, 0, 0);
          u32x2 pk; pk.x = pack2(a[0], a[1]); pk.y = pack2(a[2], a[3]); *(u32x2*)(uT + (16 * vt + fr) * 64 + 16 * it + 4 * fq) = pk; } }
}

__device__ __forceinline__ void dn_scan(const Params& p, int b, LAS unsigned char* lds) {
    const int tid = tid_(), w = tid >> 6, lane = tid & 63, fr = lane & 15, fq = lane >> 4, h = b >> 2, e0 = (b & 3) * 32;
    unsigned char* ws = opq(p.ws);
    const bf16_t* wbuf = (const bf16_t*)(ws + OFF_DNP + DNP_W); const bf16_t* uT = (const bf16_t*)(ws + OFF_DNP + DNP_UT); const bf16_t* kdT = (const bf16_t*)(ws + OFF_DNP + DNP_KDT);
    const float* glast = (const float*)(ws + OFF_SMALL + SM_GLAST);
    bf16_t* Sold = (bf16_t*)(ws + OFF_SCAN); bf16_t* vnT = (bf16_t*)(ws + OFF_SCAN + 64 * MB);
    LAS bf16_t* Sb = (LAS bf16_t*)lds;
    LAS bf16_t* Vn = (LAS bf16_t*)(lds + 32 * 136 * 2);
    f32x4 S[2] = {{0.f, 0.f, 0.f, 0.f}, {0.f, 0.f, 0.f, 0.f}};
    __syncthreads();
    bf16x8 kd[2], wf[4], kdn[2], wfn[4]; u32x2 u4[2] = {{0u, 0u}, {0u, 0u}}, u4n[2] = {{0u, 0u}, {0u, 0u}}; float gl, gln;
#define DN_LOAD(KD, WF, U4, GL, n_) do { const int it_ = (n_) * 8 + h;                                                                               \
        _Pragma("unroll") for (int kk = 0; kk < 2; ++kk) KD[kk] = *(const bf16x8*)(kdT + (size_t)it_ * 8192 + (16 * w + fr) * 64 + kk * 32 + 8 * fq); \
        if (w < 4) { _Pragma("unroll") for (int kk = 0; kk < 4; ++kk) WF[kk] = *(const bf16x8*)(wbuf + (size_t)it_ * 8192 + (16 * w + fr) * 128 + kk * 32 + 8 * fq); \
            _Pragma("unroll") for (int sl = 0; sl < 2; ++sl) U4[sl] = *(const u32x2*)(uT + (size_t)it_ * 8192 + (e0 + 16 * sl + fr) * 64 + 16 * w + 4 * fq); } \
        GL = glast[it_]; } while (0)
    DN_LOAD(kd, wf, u4, gl, 0);
#pragma unroll 1
    for (int n = 0; n < 256; ++n) {
        const int item = n * 8 + h;
        if (n + 1 < 256) DN_LOAD(kdn, wfn, u4n, gln, n + 1);
#pragma unroll
        for (int sl = 0; sl < 2; ++sl) { u32x2 sw; sw.x = pack2(S[sl][0], S[sl][1]); sw.y = pack2(S[sl][2], S[sl][3]);
            *(LAS u32x2*)(Sb + (16 * sl + fr) * 136 + 16 * w + 4 * fq) = sw;
            *(u32x2*)(Sold + (size_t)item * 16384 + (e0 + 16 * sl + fr) * 128 + 16 * w + 4 * fq) = sw; }
        __syncthreads();
        if (w < 4) {
#pragma unroll
            for (int sl = 0; sl < 2; ++sl) { f32x4 va = {0.f, 0.f, 0.f, 0.f};
#pragma unroll
                for (int kk = 0; kk < 4; ++kk) { const bf16x8 bb = *(const LAS bf16x8*)(Sb + (16 * sl + fr) * 136 + kk * 32 + 8 * fq); va = __builtin_amdgcn_mfma_f32_16x16x32_bf16(wf[kk], bb, va, 0, 0, 0); }
                u32x2 vw; vw.x = pack2(bflo(u4[sl].x) - va[0], bfhi(u4[sl].x) - va[1]); vw.y = pack2(bflo(u4[sl].y) - va[2], bfhi(u4[sl].y) - va[3]);
                *(LAS u32x2*)(Vn + (16 * sl + fr) * 72 + 16 * w + 4 * fq) = vw;
                *(u32x2*)(vnT + (size_t)item * 8192 + (e0 + 16 * sl + fr) * 64 + 16 * w + 4 * fq) = vw; } }
        __syncthreads();
#pragma unroll
        for (int sl = 0; sl < 2; ++sl) { S[sl] = S[sl] * gl;
#pragma unroll
            for (int kk = 0; kk < 2; ++kk) { const bf16x8 bb = *(const LAS bf16x8*)(Vn + (16 * sl + fr) * 72 + kk * 32 + 8 * fq); S[sl] = __builtin_amdgcn_mfma_f32_16x16x32_bf16(kd[kk], bb, S[sl], 0, 0, 0); } }
#pragma unroll
        for (int kk = 0; kk < 2; ++kk) kd[kk] = kdn[kk];
#pragma unroll
        for (int kk = 0; kk < 4; ++kk) wf[kk] = wfn[kk];
        u4[0] = u4n[0]; u4[1] = u4n[1]; gl = gln;
    }
#undef DN_LOAD
}

__device__ __forceinline__ float relu_(float x) { return __builtin_amdgcn_fmed3f(x, 0.f, __builtin_inff()); }
__device__ __forceinline__ float unsortable(unsigned u) { return __uint_as_float((u & 0x80000000u) ? (u ^ 0x80000000u) : ~u); }
__device__ __forceinline__ unsigned sortable(float f) { const unsigned u = __float_as_uint(f); return (u & 0x80000000u) ? ~u : (u | 0x80000000u); }

template <bool EXACT>
__device__ __forceinline__ unsigned compact_q(LAS unsigned* kq, LAS unsigned* iq, int n, int lane, int& nkeep) {
    unsigned key[8], idx[8]; bool val[8];
#pragma unroll
    for (int i = 0; i < 8; ++i) { const int e = lane + 64 * i; val[i] = e < n; key[i] = val[i] ? kq[e] : 0u; idx[i] = val[i] ? iq[e] : 0xffffffffu; }
    unsigned th = 0u; int cur = n;
#pragma unroll 1
    for (int b = 31; b >= 0; --b) { const unsigned cand = th | (1u << b); int c = 0;
#pragma unroll
        for (int i = 0; i < 8; ++i) c += __popcll(__ballot(val[i] && key[i] >= cand));
        if (c >= 256) { th = cand; cur = c; if (!EXACT && c <= 288) break; } }
    if (!EXACT) { int base = 0;
#pragma unroll
        for (int i = 0; i < 8; ++i) { const bool keep = val[i] && key[i] >= th; const unsigned long long m = __ballot(keep);
            const int pos = base + __popcll(m & ((1ull << lane) - 1ull)); if (keep) { kq[pos] = key[i]; iq[pos] = idx[i]; } base += __popcll(m); }
        nkeep = cur; return th - 1u; }
    int cgt = 0, ceq = 0;
#pragma unroll
    for (int i = 0; i < 8; ++i) { cgt += __popcll(__ballot(val[i] && key[i] > th)); ceq += __popcll(__ballot(val[i] && key[i] == th)); }
    const int need = 256 - cgt; unsigned beta = 0xffffffffu;
    if (ceq > need) { beta = 0u;
#pragma unroll 1
        for (int b = 14; b >= 0; --b) { const unsigned cand = beta | (1u << b); int c = 0;
#pragma unroll
            for (int i = 0; i < 8; ++i) c += __popcll(__ballot(val[i] && key[i] == th && idx[i] < cand));
            if (c < need) beta = cand; } }
    int base = 0;
#pragma unroll
    for (int i = 0; i < 8; ++i) { const bool keep = val[i] && (key[i] > th || (key[i] == th && idx[i] <= beta)); const unsigned long long m = __ballot(keep);
        const int pos = base + __popcll(m & ((1ull << lane) - 1ull)); if (keep) { kq[pos] = key[i]; iq[pos] = idx[i]; } base += __popcll(m); }
    nkeep = 256; return th;
}

__device__ __forceinline__ unsigned compact_hist(LAS unsigned* kq, LAS unsigned* iq, int n, int lane, int& nkeep, LAS unsigned* hist, unsigned lo) {
    unsigned key[8], idx[8]; bool val[8]; unsigned mx = 0u;
#pragma unroll
    for (int i = 0; i < 8; ++i) { const int e = lane + 64 * i; val[i] = e < n; key[i] = val[i] ? kq[e] : 0u; idx[i] = val[i] ? iq[e] : 0xffffffffu; mx = key[i] > mx ? key[i] : mx; }
#pragma unroll
    for (int o = 32; o >= 1; o >>= 1) { const unsigned t = (unsigned)shfl_xor_((int)mx, o); mx = t > mx ? t : mx; }
    const unsigned range = mx - lo; const int nb = 32 - __clz((int)(range | 1u)); const int sh = nb > 8 ? nb - 8 : 0;
#pragma unroll
    for (int i = 0; i < 4; ++i) hist[lane + 64 * i] = 0u;
#pragma unroll
    for (int i = 0; i < 8; ++i) if (val[i]) { unsigned b = (key[i] - lo) >> sh; b = b < 255u ? b : 255u; __hip_atomic_fetch_add(hist + b, 1u, __ATOMIC_RELAXED, __HIP_MEMORY_SCOPE_WORKGROUP); }
    const u32x4 cb = *(const LAS u32x4*)(hist + 4 * lane);
    int S = (int)(cb.x + cb.y + cb.z + cb.w);
#pragma unroll
    for (int o = 1; o < 64; o <<= 1) { const int t = bperm_i((lane + o) & 63, S); if (lane + o < 64) S += t; }
    const unsigned long long ge = __ballot(S >= 256); const int L = 63 - __clzll((long long)ge);
    int above = bperm_i((L + 1) & 63, S); if (L == 63) above = 0;
    const unsigned c3 = (unsigned)bperm_i(L, (int)cb.w), c2 = (unsigned)bperm_i(L, (int)cb.z), c1 = (unsigned)bperm_i(L, (int)cb.y), c0 = (unsigned)bperm_i(L, (int)cb.x);
    int bsel, cur;
    if (above + (int)c3 >= 256) { bsel = 3; cur = above + (int)c3; } else if (above + (int)(c3 + c2) >= 256) { bsel = 2; cur = above + (int)(c3 + c2); }
    else if (above + (int)(c3 + c2 + c1) >= 256) { bsel = 1; cur = above + (int)(c3 + c2 + c1); } else { bsel = 0; cur = above + (int)(c3 + c2 + c1 + c0); }
    if (cur > 352) return compact_q<false>(kq, iq, n, lane, nkeep);
    const unsigned th = lo + ((unsigned)(4 * L + bsel) << sh);
    int base = 0;
#pragma unroll
    for (int i = 0; i < 8; ++i) { const bool keep = val[i] && key[i] >= th; const unsigned long long m = __ballot(keep);
        const int pos = base + __popcll(m & ((1ull << lane) - 1ull)); if (keep) { kq[pos] = key[i]; iq[pos] = idx[i]; } base += __popcll(m); }
    nkeep = cur; return th - 1u;
}

__device__ __forceinline__ void dsa_block(const Params& p, int qb, LAS unsigned char* lds) {
    const int tid = tid_(), w = tid >> 6, lane = tid & 63, fr = lane & 15, fq = lane >> 4, t0 = qb * 32;
    unsigned char* ws = opq(p.ws); const bf16_t* proj = (const bf16_t*)(ws + OFF_PROJ); const bf16_t* kidx = (const bf16_t*)(ws + OFF_SMALL + SM_KIDX); const float* wq = (const float*)(ws + OFF_SMALL + SM_WQ);
    LAS unsigned* ckey = (LAS unsigned*)lds;
    LAS unsigned* cidx = (LAS unsigned*)(lds + 65536);
    LAS unsigned* cnt = (LAS unsigned*)(lds + 131072);
    __syncthreads();
    bf16x8 af[2][2]; f32x4 wr[2]; int tmy[2];
    const int hb = fq & 1, qoff = (fq >> 1) ? w + 8 : w;
#pragma unroll
    for (int m = 0; m < 2; ++m) { const int tqr = t0 + 16 * m + ((fr >> 3) ? w + 8 : w);
#pragma unroll
        for (int kk = 0; kk < 2; ++kk) af[m][kk] = *(const bf16x8*)(proj + (size_t)tqr * LDP + C_IQ + (fr & 7) * 64 + kk * 32 + 8 * fq);
        tmy[m] = t0 + 16 * m + qoff; wr[m] = *(const f32x4*)(wq + (size_t)tmy[m] * 8 + 4 * hb); }
    const unsigned msk = hb ? 0xffffffffu : 0u, lt = (1u << (lane & 31)) - 1u;
    unsigned tauu[2] = {0u, 0u};
    LAS unsigned* hist = (LAS unsigned*)(lds + 132096 + w * 1024);
    float tauf[2] = {-__builtin_inff(), -__builtin_inff()};
    if (tid < 32) cnt[tid] = 0u;
    __syncthreads();
    const int ntile = (t0 + 31) / 128 + 1;
    bf16x8 bfr[8][2], bfn[8][2];
#pragma unroll
    for (int j = 0; j < 8; ++j)
#pragma unroll
        for (int kk = 0; kk < 2; ++kk) bfr[j][kk] = *(const bf16x8*)(kidx + ((size_t)(j * 2 + kk) * 64 + lane) * 8);
#pragma unroll 1
    for (int kt = 0; kt < ntile; ++kt) {
        if (kt + 1 < ntile) {
#pragma unroll
            for (int j = 0; j < 8; ++j)
#pragma unroll
                for (int kk = 0; kk < 2; ++kk) bfn[j][kk] = *(const bf16x8*)(kidx + ((size_t)(((kt + 1) * 8 + j) * 2 + kk) * 64 + lane) * 8); }
        const bool lastt = kt == ntile - 1; const int lim = lastt ? 256 : 384;
#pragma unroll
        for (int m = 0; m < 2; ++m) {
            float pt[8];
#pragma unroll
            for (int j = 0; j < 8; ++j) { f32x4 a = {0.f, 0.f, 0.f, 0.f};
                a = __builtin_amdgcn_mfma_f32_16x16x32_bf16(af[m][0], bfr[j][0], a, 0, 0, 0); a = __builtin_amdgcn_mfma_f32_16x16x32_bf16(af[m][1], bfr[j][1], a, 0, 0, 0);
                pt[j] = wr[m][0] * relu_(a[0]) + wr[m][1] * relu_(a[1]) + wr[m][2] * relu_(a[2]) + wr[m][3] * relu_(a[3]); }
            const int myq = 16 * m + qoff; LAS unsigned* kq = ckey + myq * 512; LAS unsigned* iq = cidx + myq * 512;
#pragma unroll
            for (int i = 0; i < 4; ++i) {
                const auto sw = __builtin_amdgcn_permlane16_swap(__float_as_uint(pt[i]), __float_as_uint(pt[4 + i]), false, false);
                const float v = __uint_as_float(sw[0]) + __uint_as_float(sw[1]);
                const int s = kt * 128 + 16 * (4 * hb + i) + fr;
                if (s <= tmy[m] && v > tauf[m]) {
                    const unsigned pos = __hip_atomic_fetch_add(cnt + myq, 1u, __ATOMIC_RELAXED, __HIP_MEMORY_SCOPE_WORKGROUP);
                    if (pos < 512u) { kq[pos] = sortable(v); iq[pos] = (unsigned)s; } } }
            const int c0 = __builtin_amdgcn_readfirstlane((int)cnt[16 * m + w]), c1 = __builtin_amdgcn_readfirstlane((int)cnt[16 * m + w + 8]);
            if (c0 > lim) { int nk; const int n0 = c0 < 512 ? c0 : 512; const unsigned lo0 = (unsigned)__builtin_amdgcn_readlane((int)tauu[m], 0);
                const unsigned th = lastt ? compact_q<true>(ckey + (16 * m + w) * 512, cidx + (16 * m + w) * 512, n0, lane, nk) : compact_hist(ckey + (16 * m + w) * 512, cidx + (16 * m + w) * 512, n0, lane, nk, hist, lo0);
                if (lane == 0) cnt[16 * m + w] = (unsigned)nk; if (lane < 32) { tauf[m] = unsortable(th); tauu[m] = th; } }
            if (c1 > lim) { int nk; const int n1 = c1 < 512 ? c1 : 512; const unsigned lo1 = (unsigned)__builtin_amdgcn_readlane((int)tauu[m], 32);
                const unsigned th = lastt ? compact_q<true>(ckey + (16 * m + w + 8) * 512, cidx + (16 * m + w + 8) * 512, n1, lane, nk) : compact_hist(ckey + (16 * m + w + 8) * 512, cidx + (16 * m + w + 8) * 512, n1, lane, nk, hist, lo1);
                if (lane == 0) cnt[16 * m + w + 8] = (unsigned)nk; if (lane >= 32) { tauf[m] = unsortable(th); tauu[m] = th; } }
        }
#pragma unroll
        for (int j = 0; j < 8; ++j)
#pragma unroll
            for (int kk = 0; kk < 2; ++kk) bfr[j][kk] = bfn[j][kk];
    }
    __syncthreads();
    LAS unsigned* mk = ckey;
    for (int i = tid; i < 32 * 512; i += 512) mk[i] = 0u;
    __syncthreads();
#pragma unroll 1
    for (int rep = 0; rep < 4; ++rep) { const int q = w + 8 * rep; const int n = min((int)cnt[q], 256);
        for (int e = lane; e < n; e += 64) { const unsigned s = cidx[q * 512 + e]; __hip_atomic_fetch_or(mk + q * 512 + (s >> 5), 1u << (s & 31u), __ATOMIC_RELAXED, __HIP_MEMORY_SCOPE_WORKGROUP); } }
    __syncthreads();
    unsigned long long* mg = (unsigned long long*)(ws + OFF_MASK);
    const int nkt = (((t0 & ~255) + 255) >> 6) + 1;
    for (int i = tid; i < nkt * 32; i += 512) { const int kt = i >> 5, q = i & 31; const unsigned long long lo = mk[q * 512 + 2 * kt], hi2 = mk[q * 512 + 2 * kt + 1];
        mg[(size_t)kt * T_ + t0 + q] = lo | (hi2 << 32); }
}

__device__ __forceinline__ void phase3(const Params& p, LAS unsigned char* lds) {
    const int c = blockIdx.x, tid = tid_();
    if (c < 32) dn_scan(p, c, lds);
    unsigned* queue = (unsigned*)(opq(p.ws) + OFF_SMALL + SM_CTRL) + 200;
    LAS int* tk = (LAS int*)(lds + 131072 + 512);
    for (;;) {
        __syncthreads();
        if (tid == 0) *tk = (int)atomicAdd(queue, 1u);
        __syncthreads();
        const int ticket = *tk;
        if (ticket >= 512) break;
        dsa_block(p, 511 - ticket, lds);
    }
}

__device__ __forceinline__ void dn_out_item(const Params& p, int item, LAS unsigned char* lds) {
    const int tid = tid_(), w = tid >> 6, lane = tid & 63, fr = lane & 15, fq = lane >> 4, m = w & 3, nh = w >> 2, n = item >> 3, h = item & 7;
    unsigned char* ws = opq(p.ws); const bf16_t* proj = (const bf16_t*)(ws + OFF_PROJ);
    const bf16_t* qd = (const bf16_t*)(ws + OFF_DNP + DNP_QD) + (size_t)item * 8192; const bf16_t* attn = (const bf16_t*)(ws + OFF_DNP + DNP_ATT) + (size_t)item * 4096;
    const bf16_t* Sold = (const bf16_t*)(ws + OFF_SCAN) + (size_t)item * 16384; const bf16_t* vnT = (const bf16_t*)(ws + OFF_SCAN + 64 * MB) + (size_t)item * 8192;
    bf16_t* ydn = (bf16_t*)(ws + OFF_Y);
    LAS float* red = (LAS float*)lds;
    f32x4 acc[4];
#pragma unroll
    for (int nt = 0; nt < 4; ++nt) acc[nt] = (f32x4){0.f, 0.f, 0.f, 0.f};
#pragma unroll
    for (int kk = 0; kk < 4; ++kk) { const bf16x8 a = *(const bf16x8*)(qd + (16 * m + fr) * 128 + kk * 32 + 8 * fq);
#pragma unroll
        for (int nt = 0; nt < 4; ++nt) { const bf16x8 b = *(const bf16x8*)(Sold + (size_t)(16 * (4 * nh + nt) + fr) * 128 + kk * 32 + 8 * fq); acc[nt] = __builtin_amdgcn_mfma_f32_16x16x32_bf16(a, b, acc[nt], 0, 0, 0); } }
#pragma unroll
    for (int kk = 0; kk < 2; ++kk) { const bf16x8 a = *(const bf16x8*)(attn + (16 * m + fr) * 64 + kk * 32 + 8 * fq);
#pragma unroll
        for (int nt = 0; nt < 4; ++nt) { const bf16x8 b = *(const bf16x8*)(vnT + (size_t)(16 * (4 * nh + nt) + fr) * 64 + kk * 32 + 8 * fq); acc[nt] = __builtin_amdgcn_mfma_f32_16x16x32_bf16(a, b, acc[nt], 0, 0, 0); } }
    float ssq[4];
#pragma unroll
    for (int j = 0; j < 4; ++j) { float s = 0.f;
#pragma unroll
        for (int nt = 0; nt < 4; ++nt) s += acc[nt][j] * acc[nt][j];
        ssq[j] = sum16(s); }
    __syncthreads();
    if (fr == 0) {
#pragma unroll
        for (int j = 0; j < 4; ++j) red[(16 * m + 4 * fq + j) * 2 + nh] = ssq[j]; }
    __syncthreads();
#pragma unroll
    for (int j = 0; j < 4; ++j) { const int i = 16 * m + 4 * fq + j, t = n * 64 + i; const float rs = rsqrtf((red[i * 2] + red[i * 2 + 1]) * (1.0f / 128.0f) + EPS);
#pragma unroll
        for (int nt = 0; nt < 4; ++nt) { const int dv = 16 * (4 * nh + nt) + fr; const float z = bf2f(proj[(size_t)t * LDP + C_Z + h * 128 + dv]);
            ydn[(size_t)t * 1024 + h * 128 + dv] = f2bf(acc[nt][j] * rs * p.dn_norm_w[dv] * siluf_(z)); } }
}

__device__ __forceinline__ void phase_attn(const Params& p, LAS unsigned char* lds) {
    const int G = gridDim.x, c = blockIdx.x; unsigned char* ws = opq(p.ws);
    const bf16_t* proj = (const bf16_t*)(ws + OFF_PROJ); bf16_t* yat = (bf16_t*)(ws + OFF_Y + 32 * MB); const unsigned long long* mk = (const unsigned long long*)(ws + OFF_MASK);
    typedef att::BlockRef<bf16_t, bf16_t> BR;
    auto mkref = [&](int L, int pass) { const int h = L & 7, x = L >> 3, qb = pass ? 63 - x : x; BR r;
        r.Q = proj + (size_t)qb * 256 * LDP + C_AQ + h * 128; r.K = proj + C_AK + h * 128; r.V = proj + C_AV + h * 128;
        r.O = yat + (size_t)qb * 256 * 1024 + h * 128; r.P0 = qb * 256; r.MK = mk + qb * 256; return r; };
    int L = c;
    if (L < 256) {
        int pass = 0; BR cur = mkref(L, 0); att::Seam<bf16_t> S;
        att::causal_swa_prime<bf16_t, bf16_t>(cur, 1 << 30, (char*)lds, S);
        for (;;) {
            const bool more_pass = pass == 0, more_item = L + G < 256, last = !more_pass && !more_item;
            int passn = pass + 1, Ln = L; if (!more_pass) { passn = 0; Ln = more_item ? L + G : L; }
            const BR nxt = last ? cur : mkref(Ln, passn);
            att::causal_swa_block<bf16_t, bf16_t>(cur, nxt, T_, 1 << 30, (char*)lds, S);
            if (last) break;
            cur = nxt; pass = passn; L = Ln;
        }
    }
    __syncthreads();
    for (int item = c; item < NITEM; item += G) dn_out_item(p, item, lds);
}

__device__ __forceinline__ void phase_router(const Params& p, LAS unsigned char* lds) {
    const int G = gridDim.x, c = blockIdx.x, tid = tid_(), w = tid >> 6, lane = tid & 63, fr = lane & 15, fq = lane >> 4;
    unsigned char* ws = opq(p.ws); const float* x1 = (const float*)(ws + OFF_X1); bf16_t* h2 = (bf16_t*)(ws + OFF_H);
    int* rexp = (int*)(ws + OFF_SMALL + SM_ROUTE); float* rwt = (float*)(ws + OFF_SMALL + SM_ROUTE + 128 * 1024);
    unsigned* ecnt = (unsigned*)(ws + OFF_SMALL + SM_CTRL);
    const bf16_t* wh = (const bf16_t*)(ws + OFF_WR); const bf16_t* wl = (const bf16_t*)(ws + OFF_WR + 512 * 1024);
    constexpr int HS = 2056;
    LAS bf16_t* hiL = (LAS bf16_t*)lds; LAS bf16_t* loL = hiL + 16 * HS;
    LAS float* red = (LAS float*)lds;
    LAS float* lgt = (LAS float*)(lds + 133120);
    for (int tile = c; tile < T_ / 16; tile += G) {
        const int tb = tile * 16;
        __syncthreads();
#pragma unroll 1
        for (int rep = 0; rep < 2; ++rep) { const int tl = 2 * w + rep, t = tb + tl; const float* xr = x1 + (size_t)t * 2048; f32x4 v[8]; float ss = 0.f;
#pragma unroll
            for (int i = 0; i < 8; ++i) { v[i] = *(const f32x4*)(xr + i * 256 + 4 * lane); ss += v[i][0] * v[i][0] + v[i][1] * v[i][1] + v[i][2] * v[i][2] + v[i][3] * v[i][3]; }
            ss = wave_sum(ss); const float rs = rsqrtf(ss * (1.0f / 2048.0f) + EPS);
#pragma unroll
            for (int i = 0; i < 8; ++i) { const int k = i * 256 + 4 * lane; const f32x4 g = *(const f32x4*)(p.norm_ffn + k);
                const float a0 = v[i][0] * rs * g[0], a1 = v[i][1] * rs * g[1], a2 = v[i][2] * rs * g[2], a3 = v[i][3] * rs * g[3];
                u32x2 ph; ph.x = pack2(a0, a1); ph.y = pack2(a2, a3);
                u32x2 pl; pl.x = pack2(a0 - bflo(ph.x), a1 - bfhi(ph.x)); pl.y = pack2(a2 - bflo(ph.y), a3 - bfhi(ph.y));
                *(u32x2*)(h2 + (size_t)t * 2048 + k) = ph;
                *(LAS u32x2*)(hiL + tl * HS + k) = ph; *(LAS u32x2*)(loL + tl * HS + k) = pl; } }
        __syncthreads();
        f32x4 acc[5];
#pragma unroll
        for (int j = 0; j < 5; ++j) acc[j] = (f32x4){0.f, 0.f, 0.f, 0.f};
#pragma unroll 2
        for (int kk = 0; kk < 8; ++kk) { const int ks = 8 * w + kk;
            const bf16x8 ah = *(const LAS bf16x8*)(hiL + fr * HS + 32 * ks + 8 * fq), al = *(const LAS bf16x8*)(loL + fr * HS + 32 * ks + 8 * fq);
#pragma unroll
            for (int j = 0; j < 5; ++j) { const size_t o = ((size_t)(j * 64 + ks) * 64 + lane) * 8; const bf16x8 bh = *(const bf16x8*)(wh + o), bl = *(const bf16x8*)(wl + o);
                acc[j] = __builtin_amdgcn_mfma_f32_16x16x32_bf16(ah, bh, acc[j], 0, 0, 0);
                acc[j] = __builtin_amdgcn_mfma_f32_16x16x32_bf16(ah, bl, acc[j], 0, 0, 0);
                acc[j] = __builtin_amdgcn_mfma_f32_16x16x32_bf16(al, bh, acc[j], 0, 0, 0); } }
        __syncthreads();
#pragma unroll
        for (int j = 0; j < 5; ++j)
#pragma unroll
            for (int r = 0; r < 4; ++r) red[(w * 16 + 4 * fq + r) * 80 + 16 * j + fr] = acc[j][r];
        __syncthreads();
        for (int o = tid; o < 16 * 80; o += 512) { float sacc = 0.f;
#pragma unroll
            for (int ww = 0; ww < 8; ++ww) sacc += red[ww * 1280 + o];
            lgt[o] = sacc; }
        __syncthreads();
        if (tid < 16) { const int t = tb + tid; LAS float* l = lgt + tid * 80;
            float gmax = -3.0e38f; int gs = 0; float gl[8];
#pragma unroll
            for (int g = 0; g < 8; ++g) { gl[g] = l[64 + g] + p.b_group[g]; if (gl[g] > gmax) { gmax = gl[g]; gs = g; } }
            float gsum = 0.f;
#pragma unroll
            for (int g = 0; g < 8; ++g) gsum += __expf(gl[g] - gmax);
            const float pg = 1.0f / gsum;
            float el[8]; float m1 = -3.0e38f, m2 = -3.0e38f; int i1 = 0, i2 = 0;
#pragma unroll
            for (int e = 0; e < 8; ++e) { el[e] = l[gs * 8 + e] + p.b_router[gs * 8 + e]; }
#pragma unroll
            for (int e = 0; e < 8; ++e) if (el[e] > m1) { m1 = el[e]; i1 = e; }
#pragma unroll
            for (int e = 0; e < 8; ++e) if (e != i1 && el[e] > m2) { m2 = el[e]; i2 = e; }
            const float e2 = __expf(m2 - m1); const float w1 = pg / (1.0f + e2), w2 = pg * e2 / (1.0f + e2);
            const int ex1 = gs * 8 + i1, ex2 = gs * 8 + i2;
            rexp[t * 2] = ex1; rexp[t * 2 + 1] = ex2; rwt[t * 2] = w1; rwt[t * 2 + 1] = w2;
            atomicAdd(ecnt + ex1, 1u); atomicAdd(ecnt + ex2, 1u); }
    }
}

__device__ __forceinline__ void expert_starts(const unsigned* ecnt, LAS int* pstart, int tid) {
    if (tid < 64) { const int cn = (int)ecnt[tid]; const int pad = (cn + 127) / 128 * 128; int s = pad;
        for (int o = 1; o < 64; o <<= 1) { const int u = shfl_up_(s, o); if (tid >= o) s += u; }
        pstart[tid] = s - pad; if (tid == 63) pstart[64] = s; }
}
__device__ __forceinline__ void phase_slots(const Params& p, LAS unsigned char* lds) {
    const int G = gridDim.x, c = blockIdx.x, tid = tid_();
    unsigned char* ws = opq(p.ws); const unsigned* ecnt = (const unsigned*)(ws + OFF_SMALL + SM_CTRL); unsigned* fill = (unsigned*)(ws + OFF_SMALL + SM_CTRL) + 64;
    const int* rexp = (const int*)(ws + OFF_SMALL + SM_ROUTE); int* rpos = (int*)(ws + OFF_SMALL + SM_ROUTE + 256 * 1024); int* rowtok = (int*)(ws + OFF_ROWTOK);
    LAS int* pstart = (LAS int*)lds;
    __syncthreads();
    expert_starts(ecnt, pstart, tid);
    __syncthreads();
    for (int a = c * 512 + tid; a < 2 * T_; a += G * 512) { const int e = rexp[a]; const int pos = pstart[e] + (int)atomicAdd(fill + e, 1u); rpos[a] = pos; rowtok[pos] = a >> 1; }
}

#define MOE_BAR() do { asm volatile("s_waitcnt lgkmcnt(0)" ::: "memory"); __builtin_amdgcn_s_barrier(); asm volatile("" ::: "memory"); } while (0)
__device__ __forceinline__ void vm_wait(int n) {
    if (n >= 20) asm volatile("s_waitcnt vmcnt(20)" ::: "memory"); else if (n >= 16) asm volatile("s_waitcnt vmcnt(16)" ::: "memory");
    else if (n >= 14) asm volatile("s_waitcnt vmcnt(14)" ::: "memory"); else if (n >= 12) asm volatile("s_waitcnt vmcnt(12)" ::: "memory");
    else if (n >= 10) asm volatile("s_waitcnt vmcnt(10)" ::: "memory"); else if (n >= 8) asm volatile("s_waitcnt vmcnt(8)" ::: "memory");
    else if (n >= 6) asm volatile("s_waitcnt vmcnt(6)" ::: "memory"); else if (n >= 4) asm volatile("s_waitcnt vmcnt(4)" ::: "memory");
    else if (n >= 2) asm volatile("s_waitcnt vmcnt(2)" ::: "memory"); else asm volatile("s_waitcnt vmcnt(0)" ::: "memory");
}
template <int MODE>
__device__ __forceinline__ void moe_item(const Params& p, LAS unsigned char* lds, int e, int nt, int rs, int cnt) {
    constexpr int K = MODE == 0 ? 2048 : 512, NK = K / 64, WLD = MODE == 0 ? 512 : 2048;
    const int tid = tid_(), w = __builtin_amdgcn_readfirstlane(tid >> 6), lane = tid & 63, fr = lane & 15, fq = lane >> 4;
    const int nmt = (cnt + 127) >> 7, total = NK * nmt;
    unsigned char* ws = opq(p.ws);
    LAS float* Rw = (LAS float*)(lds + w * 4096);
    LAS bf16_t* Wb0 = (LAS bf16_t*)(lds + 32768);
    LAS unsigned char* Ar = lds + 69632 + w * 10240;
    LAS int* tokl = (LAS int*)(lds + 151552);
    const bf16_t* Asrc = (const bf16_t*)(ws + (MODE == 0 ? OFF_H : OFF_ACT));
    const float* W0; const float* W1;
    if (MODE == 0) { W0 = p.w_exp_gate + (size_t)e * 2048 * 512 + nt * 64; W1 = p.w_exp_up + (size_t)e * 2048 * 512 + nt * 64; }
    else { W0 = p.w_exp_down + (size_t)e * 512 * 2048 + nt * 128; W1 = W0 + 64; }
    MOE_BAR();
    if (MODE == 0) { const int* rowtok = (const int*)(ws + OFF_ROWTOK); for (int i = tid; i < 640; i += 512) tokl[i] = rowtok[rs + (i < cnt ? i : 0)]; }
    MOE_BAR();
    auto issueA = [&](int ks, int mt, int slot) {
#pragma unroll
        for (int i = 0; i < 2; ++i) { const int pch = lane + 64 * i, r = pch >> 3, csrc = (pch & 7) ^ (r & 7);
            const size_t row = MODE == 0 ? (size_t)tokl[mt * 128 + 16 * w + r] * 2048 : (size_t)(rs + mt * 128 + 16 * w + r) * 512;
            __builtin_amdgcn_global_load_lds((const unsigned*)(Asrc + row + ks * 64 + csrc * 8), (LAS unsigned*)(Ar + slot * 2048 + pch * 16), 16, 0, 0); } };
    auto issueW = [&](int ks) {
#pragma unroll
        for (int i = 0; i < 4; ++i) { const int pch = lane + 64 * i, r = pch >> 5, cc = pch & 31;
            const float* src = (cc < 16 ? W0 + 4 * cc : W1 + 4 * (cc - 16)) + (size_t)(ks * 64 + 8 * w + r) * WLD;
            __builtin_amdgcn_global_load_lds((const unsigned*)src, (LAS unsigned*)((LAS unsigned char*)Rw + pch * 16), 16, 0, 0); } };
    auto convertW = [&](int buf) {
        LAS bf16_t* Wb = Wb0 + buf * (128 * 72);
#pragma unroll
        for (int c2 = 0; c2 < 2; ++c2) { const int nm = lane + 64 * c2; float v[8];
#pragma unroll
            for (int r = 0; r < 8; ++r) v[r] = Rw[r * 128 + nm];
            const int nrow = MODE == 0 ? (((nm & 63) >> 4) * 2 + (nm >> 6)) * 16 + (nm & 15) : nm;
            u32x4 pk; pk.x = pack2(v[0], v[1]); pk.y = pack2(v[2], v[3]); pk.z = pack2(v[4], v[5]); pk.w = pack2(v[6], v[7]);
            *(LAS u32x4*)(Wb + nrow * 72 + 8 * w) = pk; } };
    f32x4 acc[5][8];
#pragma unroll
    for (int a = 0; a < 5; ++a)
#pragma unroll
        for (int n = 0; n < 8; ++n) acc[a][n] = (f32x4){0.f, 0.f, 0.f, 0.f};
    issueW(0); asm volatile("s_waitcnt vmcnt(0)" ::: "memory"); convertW(0);
    asm volatile("s_waitcnt lgkmcnt(0)" ::: "memory");
    int a_since_w = 0;
    int wy0 = 0, wy1 = 0, wy2 = 0, wy3 = 0;
    { int ks = 0, mt = 0;
#pragma unroll 1
      for (int i = 0; i < 4 && i < total; ++i) { issueA(ks, mt, i); if (++mt == nmt) { mt = 0; ++ks; } } }
    if (NK > 1) { issueW(1); wy3 = 4; }
    int pks = 4 / nmt, pmt = 4 % nmt, q = 0, slot = 0, pslot = 4;
#pragma unroll 1
    for (int ks = 0; ks < NK; ++ks) {
        MOE_BAR();
        const LAS bf16_t* Wb = Wb0 + (ks & 1) * (128 * 72);
        bf16x8 bf[4][2];
#pragma unroll
        for (int n = 0; n < 4; ++n)
#pragma unroll
            for (int k2 = 0; k2 < 2; ++k2) bf[n][k2] = *(const LAS bf16x8*)(Wb + (16 * n + fr) * 72 + 32 * k2 + 8 * fq);
#pragma unroll
        for (int mt = 0; mt < 5; ++mt) {
            if (mt < nmt) {
                if (q + 4 < total) { issueA(pks, pmt, pslot); ++a_since_w; }
                if (++pmt == nmt) { pmt = 0; ++pks; }
                if (++pslot == 5) pslot = 0;
                { const int rem = total - 1 - q; vm_wait(2 * (rem < 4 ? rem : 4) + wy0 + wy1 + wy2 + wy3); }
                if (mt * 128 + 16 * w < cnt) {
                    const LAS unsigned char* as = Ar + slot * 2048;
#pragma unroll
                    for (int k2 = 0; k2 < 2; ++k2) { const bf16x8 af = *(const LAS bf16x8*)(as + (fr * 8 + ((4 * k2 + fq) ^ (fr & 7))) * 16);
#pragma unroll
                        for (int n = 0; n < 4; ++n) acc[mt][n] = __builtin_amdgcn_mfma_f32_16x16x32_bf16(bf[n][k2], af, acc[mt][n], 0, 0, 0);
#pragma unroll
                        for (int n = 4; n < 8; ++n) { const bf16x8 bu = *(const LAS bf16x8*)(Wb + (16 * n + fr) * 72 + 32 * k2 + 8 * fq);
                            acc[mt][n] = __builtin_amdgcn_mfma_f32_16x16x32_bf16(bu, af, acc[mt][n], 0, 0, 0); } } }
                ++q; if (++slot == 5) slot = 0; wy0 = wy1; wy1 = wy2; wy2 = wy3; wy3 = 0;
            }
        }
        if (ks + 1 < NK) {
            vm_wait(2 * a_since_w);
            convertW((ks + 1) & 1);
            asm volatile("s_waitcnt lgkmcnt(0)" ::: "memory");
            if (ks + 2 < NK) { issueW(ks + 2); a_since_w = 0; wy3 = 4; }
        }
    }
#pragma unroll
    for (int mt = 0; mt < 5; ++mt) {
        if (mt < nmt) { const int rl = mt * 128 + 16 * w + fr;
            if (rl < cnt) {
                if (MODE == 0) { bf16_t* dst = (bf16_t*)(ws + OFF_ACT) + (size_t)(rs + rl) * 512 + nt * 64 + 4 * fq;
#pragma unroll
                    for (int g = 0; g < 4; ++g) { const f32x4 gt = acc[mt][2 * g], u = acc[mt][2 * g + 1];
                        u32x2 pk; pk.x = pack2(siluf_(gt[0]) * u[0], siluf_(gt[1]) * u[1]); pk.y = pack2(siluf_(gt[2]) * u[2], siluf_(gt[3]) * u[3]); *(u32x2*)(dst + 16 * g) = pk; } }
                else { bf16_t* dst = (bf16_t*)(ws + OFF_YE) + (size_t)(rs + rl) * 2048 + nt * 128 + 4 * fq;
#pragma unroll
                    for (int n = 0; n < 8; ++n) { const f32x4 v = acc[mt][n]; u32x2 pk; pk.x = pack2(v[0], v[1]); pk.y = pack2(v[2], v[3]); *(u32x2*)(dst + 16 * n) = pk; } } } } }
    asm volatile("s_waitcnt vmcnt(0)" ::: "memory");
}
template <int MODE>
__device__ __forceinline__ void phase_moe(const Params& p, LAS unsigned char* lds) {
    const int G = gridDim.x, c = blockIdx.x, tid = tid_();
    unsigned char* ws = opq(p.ws); const unsigned* ecnt = (const unsigned*)(ws + OFF_SMALL + SM_CTRL);
    LAS int* pstart = (LAS int*)(lds + 154112); LAS int* order = pstart + 80;
    __syncthreads();
    expert_starts(ecnt, pstart, tid);
    if (tid < 64) { const unsigned mine = ecnt[tid]; int rk = 0;
        for (int j = 0; j < 64; ++j) { const unsigned o = ecnt[j]; rk += (o > mine || (o == mine && j < tid)) ? 1 : 0; }
        order[rk] = tid; }
    __syncthreads();
    constexpr int PER = MODE == 0 ? 8 : 16;
    if (G == 256) {
        const int within = c / PER, nt = c % PER; constexpr int EPR = 256 / PER;
        for (int j = 0; j < 64 / EPR; ++j) { const int rnk = EPR * j + ((j & 1) ? EPR - 1 - within : within);
            const int e = order[rnk]; const int cn = (int)ecnt[e], rs = pstart[e];
            for (int seg = 0; seg < cn; seg += 640) moe_item<MODE>(p, lds, e, nt, rs + seg, min(cn - seg, 640)); }
    } else {
        for (int it = c; it < 64 * PER; it += G) { const int e = it / PER, nt = it % PER; const int cn = (int)ecnt[e], rs = pstart[e];
            for (int seg = 0; seg < cn; seg += 640) moe_item<MODE>(p, lds, e, nt, rs + seg, min(cn - seg, 640)); }
    }
    __syncthreads();
}

__device__ __forceinline__ void phase_final(const Params& p) {
    const int G = gridDim.x, c = blockIdx.x, tid = tid_(), w = tid >> 6, lane = tid & 63;
    unsigned char* ws = opq(p.ws); const float* x1 = (const float*)(ws + OFF_X1); const bf16_t* ye = (const bf16_t*)(ws + OFF_YE);
    const float* rwt = (const float*)(ws + OFF_SMALL + SM_ROUTE + 128 * 1024); const int* rpos = (const int*)(ws + OFF_SMALL + SM_ROUTE + 256 * 1024);
    for (int t = c * 8 + w; t < T_; t += G * 8) {
        const float w0 = rwt[t * 2], w1 = rwt[t * 2 + 1]; const bf16_t* y0 = ye + (size_t)rpos[t * 2] * 2048; const bf16_t* y1 = ye + (size_t)rpos[t * 2 + 1] * 2048;
        f32x4 v[8]; float ss = 0.f;
#pragma unroll
        for (int i = 0; i < 8; ++i) { const int k = i * 256 + 4 * lane; v[i] = *(const f32x4*)(x1 + (size_t)t * 2048 + k);
            const u32x2 a = *(const u32x2*)(y0 + k), b = *(const u32x2*)(y1 + k);
            v[i][0] += w0 * bflo(a.x) + w1 * bflo(b.x); v[i][1] += w0 * bfhi(a.x) + w1 * bfhi(b.x); v[i][2] += w0 * bflo(a.y) + w1 * bflo(b.y); v[i][3] += w0 * bfhi(a.y) + w1 * bfhi(b.y);
            ss += v[i][0] * v[i][0] + v[i][1] * v[i][1] + v[i][2] * v[i][2] + v[i][3] * v[i][3]; }
        ss = wave_sum(ss); const float rs = rsqrtf(ss * (1.0f / 2048.0f) + EPS);
#pragma unroll
        for (int i = 0; i < 8; ++i) { const int k = i * 256 + 4 * lane; const f32x4 g = *(const f32x4*)(p.norm_final + k);
            f32x4 o; o[0] = v[i][0] * rs * g[0]; o[1] = v[i][1] * rs * g[1]; o[2] = v[i][2] * rs * g[2]; o[3] = v[i][3] * rs * g[3];
            *(f32x4*)(p.out + (size_t)t * 2048 + k) = o; }
    }
}

template <int PH>
__device__ __forceinline__ void run_phase(const Params& p, LAS unsigned char* lds) {
    const int G = gridDim.x, c = blockIdx.x; unsigned char* ws = opq(p.ws);
    if constexpr (PH == 0) phase0(p, lds);
    if constexpr (PH == 1) { pg8::DenseOrder S; S.init(ws + OFF_H, ws + OFF_WT_IN, T_, LDP, 2048, G, c); EpiProj E; E.O = (bf16_t*)(ws + OFF_PROJ); pg8::gemm_phase(lds, 2048, S, E); }
    if constexpr (PH == 2) { phase_rope(p); u32x4 xr[3][2][4]; float ba[2]; if (c < NITEM) dn_prep_load(p, c, xr, ba);
        for (int item = c; item < NITEM; item += G) dn_prep_item(p, item, item + G < NITEM ? item + G : -1, lds, xr, ba); }
    if constexpr (PH == 3) phase3(p, lds);
    if constexpr (PH == 4) phase_attn(p, lds);
    if constexpr (PH == 5) { pg8::DenseOrder S; S.init(ws + OFF_Y, ws + OFF_WT_DN, T_, 2048, 1024, G, c); EpiMerge<0> E; E.M = (bf16_t*)(ws + OFF_H); E.proj = (const bf16_t*)(ws + OFF_PROJ); E.bg = p.b_gates; pg8::gemm_phase(lds, 1024, S, E);
              pg8::DenseOrder S2; S2.init(ws + OFF_Y + 32 * MB, ws + OFF_WT_AT, T_, 2048, 1024, G, c); EpiMerge<1> E2; E2.M = E.M; E2.proj = E.proj; E2.bg = p.b_gates; pg8::gemm_phase(lds, 1024, S2, E2); }
    if constexpr (PH == 6) { pg8::DenseOrder S; S.init(ws + OFF_H, ws + OFF_WT_OUT, T_, 2048, 2048, G, c); EpiResid E; E.X1 = (float*)(ws + OFF_X1); E.X = p.x; pg8::gemm_phase(lds, 2048, S, E); }
    if constexpr (PH == 7) phase_router(p, lds);
    if constexpr (PH == 8) phase_slots(p, lds);
    if constexpr (PH == 9) phase_moe<0>(p, lds);
    if constexpr (PH == 10) phase_moe<1>(p, lds);
    if constexpr (PH == 11) phase_final(p);
}

template <int PH>
__device__ __forceinline__ void phase_step(const Params& p, LAS unsigned char* lds, cg::grid_group& grid, const XcdBarrier& xb, unsigned long long& tp) {
#ifdef ONLY_PHASE
    if constexpr (PH != ONLY_PHASE) return;
#endif
    unsigned long long t0 = 0;
    if constexpr (PH == PROBE_PHASE) t0 = __builtin_amdgcn_s_memrealtime();
    run_phase<PH>(p, lds);
    if constexpr (PH + 1 < NPHASE) { if constexpr (PH == 0) grid.sync(); else xcd_barrier(xb); }
    if constexpr (PH == PROBE_PHASE) tp = __builtin_amdgcn_s_memrealtime() - t0;
}

__global__ void __launch_bounds__(512, 2) mega_kernel(Params p) {
    extern __shared__ __attribute__((aligned(16))) unsigned char shm[];
    LAS unsigned char* lds = (LAS unsigned char*)shm;
    cg::grid_group grid = cg::this_grid();
    volatile LAS unsigned* xst = (volatile LAS unsigned*)(lds + LDS_BYTES - 16);
    if (threadIdx.x == 0) { xst[0] = 0u; xst[1] = 0u; }
    __syncthreads();
    const XcdBarrier xb = xcd_barrier_post((unsigned*)(p.ws + OFF_SMALL + SM_BAR), xst);
    unsigned long long tp = 0;
    phase_step<0>(p, lds, grid, xb, tp); phase_step<1>(p, lds, grid, xb, tp); phase_step<2>(p, lds, grid, xb, tp); phase_step<3>(p, lds, grid, xb, tp);
    phase_step<4>(p, lds, grid, xb, tp); phase_step<5>(p, lds, grid, xb, tp); phase_step<6>(p, lds, grid, xb, tp); phase_step<7>(p, lds, grid, xb, tp);
    phase_step<8>(p, lds, grid, xb, tp); phase_step<9>(p, lds, grid, xb, tp); phase_step<10>(p, lds, grid, xb, tp); phase_step<11>(p, lds, grid, xb, tp);
#if PROBE_PHASE >= 0
    if (blockIdx.x == 0) { const unsigned long long te = __builtin_amdgcn_s_memrealtime(); while (__builtin_amdgcn_s_memrealtime() - te < (unsigned long long)PROBE_MULT * tp) __builtin_amdgcn_s_sleep(8); }
#endif
}

extern "C" void kernel_launch(void* const* d_in, const int* in_sizes, int n_in, void* d_out, int out_size, void* d_ws, size_t ws_size, hipStream_t stream) {
    (void)in_sizes; (void)n_in; (void)out_size;
    static int grid_blocks = 0;
    if (!grid_blocks) {
        int dev = 0, cus = 0, per_cu = 0;
        hipGetDevice(&dev);
        hipDeviceGetAttribute(&cus, hipDeviceAttributeMultiprocessorCount, dev);
        hipFuncSetAttribute((const void*)mega_kernel, hipFuncAttributeMaxDynamicSharedMemorySize, LDS_BYTES);
        hipOccupancyMaxActiveBlocksPerMultiprocessor(&per_cu, mega_kernel, 512, LDS_BYTES);
        if (per_cu > 1) per_cu = 1;
        grid_blocks = cus * per_cu;
        if (grid_blocks <= 0) { fprintf(stderr, "occupancy query failed\n"); grid_blocks = 0; return; }
    }
    if (ws_size < WS_NEED) { fprintf(stderr, "workspace too small: %zu < %zu\n", ws_size, (size_t)WS_NEED); return; }
    Params p{};
    p.x = (const float*)d_in[0]; p.positions = (const int*)d_in[1]; p.norm_mix = (const float*)d_in[2]; p.w_in = (const float*)d_in[3]; p.b_gates = (const float*)d_in[4];
    p.conv_w = (const float*)d_in[5]; p.a_log = (const float*)d_in[6]; p.dt_bias = (const float*)d_in[7]; p.dn_norm_w = (const float*)d_in[8]; p.idx_k_norm = (const float*)d_in[9];
    p.w_proj_dn = (const float*)d_in[10]; p.w_proj_att = (const float*)d_in[11]; p.w_out = (const float*)d_in[12]; p.norm_ffn = (const float*)d_in[13]; p.w_group = (const float*)d_in[14];
    p.b_group = (const float*)d_in[15]; p.w_router = (const float*)d_in[16]; p.b_router = (const float*)d_in[17]; p.w_exp_gate = (const float*)d_in[18]; p.w_exp_up = (const float*)d_in[19];
    p.w_exp_down = (const float*)d_in[20]; p.norm_final = (const float*)d_in[21]; p.out = (float*)d_out; p.ws = (unsigned char*)d_ws;
    (void)hipMemsetAsync((unsigned char*)d_ws + OFF_SMALL + SM_BAR, 0, XCD_BAR_WORDS * 4, stream);
    void* args[] = {&p};
    hipError_t e = hipLaunchCooperativeKernel((const void*)mega_kernel, dim3(grid_blocks), dim3(512), args, LDS_BYTES, stream);
    if (e != hipSuccess) fprintf(stderr, "cooperative launch failed: %s (grid %d)\n", hipGetErrorString(e), grid_blocks);
}
```

```cpp
#include <hip/hip_runtime.h>
#include <hip/hip_cooperative_groups.h>
#include <cstdio>
#include <cstdint>
namespace cg = cooperative_groups;

#define LAS __attribute__((address_space(3)))
typedef unsigned short bf16_t;
typedef short bf16x8 __attribute__((ext_vector_type(8)));
typedef float f32x4 __attribute__((ext_vector_type(4)));
typedef float f32x2 __attribute__((ext_vector_type(2)));
typedef unsigned u32x4 __attribute__((ext_vector_type(4)));
typedef unsigned u32x2 __attribute__((ext_vector_type(2)));

#ifndef PROBE_PHASE
#define PROBE_PHASE -1
#endif
#define PROBE_MULT 8
#ifndef SINGLE_LAUNCH
#define SINGLE_LAUNCH 1
#endif

constexpr int T_ = 16384, D_ = 2048, IN_COLS = 11864, LDP = 12032;
constexpr int C_DNQ = 0, C_DNK = 1024, C_DNV = 2048, C_Z = 3072, C_AQ = 4096, C_AK = 5120, C_AV = 6144, C_IQ = 7168,
              C_G0 = 7680, C_G1 = 9728, C_IK = 11776, C_B = 11840, C_A = 11848, C_IW = 11856;
constexpr int NITEM = 2048;
constexpr int PMAX = 40960;
constexpr float EPS = 1e-6f;
constexpr int LDS_BYTES = 156 * 1024;
constexpr int NPHASE = 12;

constexpr size_t MB = 1ull << 20;
constexpr size_t OFF_WT_IN  = 0;
constexpr size_t OFF_WT_DN  = 50 * MB;
constexpr size_t OFF_WT_AT  = 55 * MB;
constexpr size_t OFF_WT_OUT = 60 * MB;
constexpr size_t OFF_COS    = 54 * MB;
constexpr size_t OFF_SIN    = 59 * MB;
constexpr size_t OFF_WR     = 68 * MB;
constexpr size_t OFF_SMALL  = 69 * MB;
constexpr size_t OFF_H      = 72 * MB;
constexpr size_t OFF_PROJ   = 136 * MB;
constexpr size_t OFF_DNP    = 512 * MB;
constexpr size_t OFF_SCAN   = 656 * MB;
constexpr size_t OFF_Y      = 752 * MB;
constexpr size_t OFF_X1     = 816 * MB;
constexpr size_t WS_NEED    = 944 * MB;
constexpr size_t OFF_MASK   = 816 * MB;
constexpr size_t OFF_ROWTOK = 520 * MB;
constexpr size_t OFF_YE     = 528 * MB;
constexpr size_t OFF_ACT    = 712 * MB;
constexpr size_t SM_KIDX   = 0;
constexpr size_t SM_WQ     = 2 * MB;
constexpr size_t SM_ROUTE  = 2 * MB + 512 * 1024;
constexpr size_t SM_GLAST  = 2 * MB + 960 * 1024;
constexpr size_t SM_CTRL   = 2 * MB + 1000 * 1024;
constexpr size_t SM_BAR    = 2 * MB + 1008 * 1024;
constexpr size_t DNP_W = 0, DNP_UT = 32 * MB, DNP_QD = 64 * MB, DNP_KDT = 96 * MB, DNP_ATT = 128 * MB;

struct Params {
    const float* x; const int* positions; const float* norm_mix; const float* w_in; const float* b_gates; const float* conv_w;
    const float* a_log; const float* dt_bias; const float* dn_norm_w; const float* idx_k_norm; const float* w_proj_dn;
    const float* w_proj_att; const float* w_out; const float* norm_ffn; const float* w_group; const float* b_group;
    const float* w_router; const float* b_router; const float* w_exp_gate; const float* w_exp_up; const float* w_exp_down;
    const float* norm_final; float* out; unsigned char* ws;
};

__device__ __forceinline__ int tid_() { int t = threadIdx.x; asm volatile("" : "+v"(t)); return t; }
__device__ __forceinline__ unsigned char* opq(unsigned char* q) { unsigned long long z = 0ull; asm volatile("" : "+s"(z)); return q + z; }
__device__ __forceinline__ bf16_t f2bf(float f) { unsigned u = __float_as_uint(f); u += 0x7fffu + ((u >> 16) & 1u); return (bf16_t)(u >> 16); }
__device__ __forceinline__ float bf2f(bf16_t b) { return __uint_as_float(((unsigned)b) << 16); }
__device__ __forceinline__ unsigned pack2(float lo, float hi) { return (unsigned)f2bf(lo) | ((unsigned)f2bf(hi) << 16); }
__device__ __forceinline__ float bflo(unsigned w) { return __uint_as_float(w << 16); }
__device__ __forceinline__ float bfhi(unsigned w) { return __uint_as_float(w & 0xffff0000u); }
__device__ __forceinline__ float sigmoidf_(float x) { return 1.0f / (1.0f + __expf(-x)); }
__device__ __forceinline__ float siluf_(float x) { return x / (1.0f + __expf(-x)); }
template <int CTRL> __device__ __forceinline__ float dpp_f(float v) { return __int_as_float(__builtin_amdgcn_update_dpp(0, __float_as_int(v), CTRL, 0xf, 0xf, true)); }
__device__ __forceinline__ float sum16(float v) {
    v += dpp_f<0xB1>(v); v += dpp_f<0x4E>(v); v += dpp_f<0x141>(v); v += dpp_f<0x140>(v); return v;
}
__device__ __forceinline__ int lane_() { return tid_() & 63; }
__device__ __forceinline__ int bperm_i(int srclane, int v) { return __builtin_amdgcn_ds_bpermute(srclane << 2, v); }
__device__ __forceinline__ float shfl_xor_(float v, int o) { return __int_as_float(bperm_i(lane_() ^ o, __float_as_int(v))); }
__device__ __forceinline__ int shfl_xor_(int v, int o) { return bperm_i(lane_() ^ o, v); }
__device__ __forceinline__ float shfl_(float v, int src) { return __int_as_float(bperm_i(src, __float_as_int(v))); }
__device__ __forceinline__ int shfl_(int v, int src) { return bperm_i(src, v); }
__device__ __forceinline__ float shfl_up_(float v, int o) { return __int_as_float(bperm_i((lane_() - o) & 63, __float_as_int(v))); }
__device__ __forceinline__ int shfl_up_(int v, int o) { return bperm_i((lane_() - o) & 63, v); }
__device__ __forceinline__ float wave_sum(float v) { for (int o = 32; o >= 1; o >>= 1) v += shfl_xor_(v, o); return v; }

#define XB_TMO      128
#define XB_XCNT(j)  (256  + 64 * (j))
#define XB_XSUB(j)  (1280 + 64 * (j))
#define XB_XGEN(j)  (2304 + 64 * (j))
#define XB_TOP      3328
#define XB_TOPGEN   3392
#define XCD_BAR_WORDS 3456
#define XB_SPIN_CAP (1u << 18)

__device__ __forceinline__ unsigned xb_ld(unsigned* p)              { return __hip_atomic_load(p, __ATOMIC_RELAXED, __HIP_MEMORY_SCOPE_AGENT); }
__device__ __forceinline__ unsigned xb_add(unsigned* p, unsigned v) { return __hip_atomic_fetch_add(p, v, __ATOMIC_RELAXED, __HIP_MEMORY_SCOPE_AGENT); }
__device__ __forceinline__ unsigned xb_xcc_id() { return (unsigned)__builtin_amdgcn_s_getreg((3 << 11) | 20) & 0xFu; }
#define XB_SPIN(cond, bar) do { unsigned _sp = 0; while (cond) { __builtin_amdgcn_s_sleep(1); \
    if ((++_sp & 255u) == 0u) { if (xb_ld(&(bar)[XB_TMO])) break; if (_sp > XB_SPIN_CAP) { atomicAdd(&(bar)[XB_TMO], 1u); break; } } } } while (0)

struct XcdBarrier {
    unsigned* bar; unsigned x;
    volatile LAS unsigned* st;
};

__device__ __forceinline__ XcdBarrier xcd_barrier_post(unsigned* bar, volatile LAS unsigned* st) {
    XcdBarrier b; b.bar = bar; b.x = xb_xcc_id(); b.st = st;
    if (threadIdx.x == 0) (void)xb_add(&bar[XB_XCNT(b.x)], 1u);
    return b;
}
__device__ __forceinline__ void xcd_barrier_complete(unsigned* bar, unsigned x, unsigned& nloc, unsigned& nx) {
    const unsigned G = gridDim.x * gridDim.y * gridDim.z;
    unsigned sum, cnt, mine, sp = 0u;
    for (;;) {
        sum = 0u; cnt = 0u; mine = 0u;
#pragma unroll
        for (unsigned j = 0; j < 16; ++j) { const unsigned c = xb_ld(&bar[XB_XCNT(j)]); sum += c; cnt += (c > 0u) ? 1u : 0u; mine = (j == x) ? c : mine; }
        if (sum == G) break;
        __builtin_amdgcn_s_sleep(1);
        if ((++sp & 255u) == 0u) { if (xb_ld(&bar[XB_TMO])) break; if (sp > XB_SPIN_CAP) { atomicAdd(&bar[XB_TMO], 1u); break; } }
    }
    nloc = mine > 0u ? mine : 1u; nx = cnt > 0u ? cnt : 1u;
}

__device__ __forceinline__ void xcd_barrier(const XcdBarrier& b) {
    asm volatile("s_waitcnt vmcnt(0)" ::: "memory");
    __syncthreads();
    if (threadIdx.x == 0) {
        unsigned* bar = b.bar;
        __builtin_amdgcn_s_waitcnt(0);
        unsigned nloc = b.st[0], nx = b.st[1];
        if (nloc == 0u) { xcd_barrier_complete(bar, b.x, nloc, nx); b.st[0] = nloc; b.st[1] = nx; }
        const unsigned old = xb_add(&bar[XB_XSUB(b.x)], 1u);
        const unsigned gen = old / nloc;
        if (old + 1u == (gen + 1u) * nloc) {
            __builtin_amdgcn_fence(__ATOMIC_RELEASE, "agent");
            asm volatile("s_waitcnt vmcnt(0)" ::: "memory");
            const unsigned og = xb_add(&bar[XB_TOP], 1u);
            const unsigned tg = og / nx;
            if (og + 1u == (tg + 1u) * nx) xb_add(&bar[XB_TOPGEN], 1u);
            else XB_SPIN(xb_ld(&bar[XB_TOPGEN]) == tg, bar);
            __builtin_amdgcn_fence(__ATOMIC_ACQUIRE, "agent");
            xb_add(&bar[XB_XGEN(b.x)], 1u);
            asm volatile("s_waitcnt vmcnt(0)" ::: "memory");
        } else {
            XB_SPIN(xb_ld(&bar[XB_XGEN(b.x)]) == gen, bar);
            __builtin_amdgcn_fence(__ATOMIC_ACQUIRE, "agent");
            asm volatile("s_waitcnt vmcnt(0)" ::: "memory");
        }
    }
    __syncthreads();
}

namespace pg8 {
constexpr int BM = 256, BK = 64, HALF = 128, HTB = HALF * BK * 2, STAGE_BYTES = 8 * HTB, NXCD = 8, WGM = 8;
__device__ __forceinline__ int lds_byte(int r, int c) { const int st = (r >> 4) * 2 + (c >> 5), rr = r & 15, cc = c & 31, ob = rr * 64 + cc * 2; return st * 1024 + (ob ^ (((ob >> 9) & 1) << 5)); }
__device__ __forceinline__ void stage_rc(int b, int& R, int& C) { const int st = b / 1024, sb = b % 1024, swz = sb ^ (((sb >> 9) & 1) << 5); R = (st >> 1) * 16 + swz / 64; C = (st & 1) * 32 + (swz % 64) / 2; }
__device__ __forceinline__ int perm32(int rho) { const int n = rho >> 4, i = rho & 15; return 8 * (i >> 2) + 4 * n + (i & 3); }

struct Unit { int pm, pn; const char* A; const char* B; };

struct DenseOrder {
    int nM, nN, nwg, G, c, K; const char* A; const char* Bt;
    __device__ void init(const void* A_, const void* Bt_, int M, int N, int K_, int G_, int c_) { A = (const char*)A_; Bt = (const char*)Bt_; nM = M / BM; nN = N / BM; nwg = nM * nN; G = G_; c = c_; K = K_; }
    __device__ bool next(int i, Unit& u) const {
        const long L = (long)i * G + c; if (L >= nwg) return false;
        int wgid = (int)L; { const int q = nwg / NXCD, r = nwg % NXCD, xcd = wgid % NXCD, off = wgid / NXCD; wgid = (xcd < r ? xcd * (q + 1) : r * (q + 1) + (xcd - r) * q) + off; }
        const int nig = WGM * nN, gid = wgid / nig, fm = gid * WGM, gsz = (nM - fm) < WGM ? (nM - fm) : WGM;
        u.pm = fm + ((wgid % nig) % gsz); u.pn = (wgid % nig) / gsz;
        u.A = A + (size_t)u.pm * 256 * K * 2; u.B = Bt + (size_t)u.pn * 256 * K * 2; return true;
    }
};
struct GroupedOrder {
    const int* tile_e; int n_mt, nN, G, c, K; const char* A; const char* Bt; size_t bstride;
    __device__ bool next(int i, Unit& u) const {
        const long L = (long)i * G + c; if (L >= (long)n_mt * nN) return false;
        u.pn = (int)(L / n_mt); u.pm = (int)(L % n_mt);
        const int e = tile_e[u.pm];
        u.A = A + (size_t)u.pm * 256 * K * 2; u.B = Bt + (size_t)e * bstride + (size_t)u.pn * 256 * K * 2; return true;
    }
};

template <class Epi, class Sched>
__device__ __forceinline__ void gemm_phase(LAS unsigned char* lds, const int K, const Sched& S, const Epi& E) {
    const int tid = tid_(), wid = __builtin_amdgcn_readfirstlane(tid >> 6), lane = tid & 63, wr = wid >> 2, wc = wid & 3, fr = lane & 15, fq = lane >> 4;
    const int nt = K / BK;
    unsigned voffA[2], voffB[2];
#pragma unroll
    for (int i = 0; i < 2; ++i) { int R, C; stage_rc(tid * 16 + i * 8192, R, C); const int Rb = Epi::PERM ? ((R & ~31) + perm32(R & 31)) : R;
        voffA[i] = (unsigned)(R * K + C) * 2u; voffB[i] = (unsigned)(Rb * K + C) * 2u; }
    const size_t kstep = (size_t)(BK * 2);
    const size_t hstep = (size_t)HALF * K * 2;
    const unsigned ldsw = (unsigned)wid * 1024u;
    const int aoff = lds_byte(wr * 64 + fr, fq * 8), boff = lds_byte(wc * 32 + fr, fq * 8);
#define PG8_SA(b, h) (((b) * 2 + (h)) * HTB)
#define PG8_SB(b, h) ((4 + (b) * 2 + (h)) * HTB)
#define PG8_STAGE(bufoff, gbase, voff) do { _Pragma("unroll") for (int _i = 0; _i < 2; ++_i) \
        __builtin_amdgcn_global_load_lds((const unsigned*)((const char*)(gbase) + (voff)[_i]), (LAS unsigned*)(lds + (bufoff) + ldsw + _i * 8192), 16, 0, 0); } while (0)
#define PG8_LDA(dst, b, h) do { _Pragma("unroll") for (int m = 0; m < 4; ++m) _Pragma("unroll") for (int k = 0; k < 2; ++k) dst[m][k] = *(const LAS bf16x8*)(lds + PG8_SA(b, h) + aoff + m * 2048 + k * 1024); } while (0)
#define PG8_LDB(dst, b, h) do { _Pragma("unroll") for (int n = 0; n < 2; ++n) _Pragma("unroll") for (int k = 0; k < 2; ++k) dst[n][k] = *(const LAS bf16x8*)(lds + PG8_SB(b, h) + boff + n * 2048 + k * 1024); } while (0)
#define PG8_MMA(ai, bj, At, Bt) do { __builtin_amdgcn_s_setprio(1); _Pragma("unroll") for (int m = 0; m < 4; ++m) _Pragma("unroll") for (int n = 0; n < 2; ++n) _Pragma("unroll") for (int k = 0; k < 2; ++k) \
        acc[ai][bj][m][n] = __builtin_amdgcn_mfma_f32_16x16x32_bf16(Bt[n][k], At[m][k], acc[ai][bj][m][n], 0, 0, 0); __builtin_amdgcn_s_setprio(0); } while (0)
#define PG8_WAIT_V(n) asm volatile("s_waitcnt vmcnt(" #n ")" ::: "memory")
#define PG8_WAIT_L(n) asm volatile("s_waitcnt lgkmcnt(" #n ")" ::: "memory")
#define PG8_BAR __builtin_amdgcn_s_barrier()
#define PG8_SCHED __builtin_amdgcn_sched_barrier(0)
    Unit cur, nxt; int ui = 0;
    if (!S.next(0, cur)) return;
    f32x4 acc[2][2][4][2];
#pragma unroll
    for (int a = 0; a < 2; ++a)
#pragma unroll
        for (int b = 0; b < 2; ++b)
#pragma unroll
            for (int m = 0; m < 4; ++m)
#pragma unroll
                for (int n = 0; n < 2; ++n) acc[a][b][m][n] = (f32x4){0.f, 0.f, 0.f, 0.f};
    bf16x8 At[4][2], B0[2][2], B1[2][2];
    const char* cA = cur.A; const char* cB = cur.B;
    PG8_STAGE(PG8_SB(0, 0), cB, voffB); PG8_STAGE(PG8_SA(0, 0), cA, voffA); PG8_STAGE(PG8_SB(0, 1), cB + hstep, voffB); PG8_STAGE(PG8_SA(0, 1), cA + hstep, voffA);
    if (wr == 1) PG8_BAR;
    PG8_WAIT_V(4); PG8_BAR;
    PG8_STAGE(PG8_SB(1, 0), cB + kstep, voffB); PG8_STAGE(PG8_SA(1, 0), cA + kstep, voffA); PG8_STAGE(PG8_SB(1, 1), cB + hstep + kstep, voffB);
    PG8_WAIT_V(6); PG8_BAR;
    for (;;) {
        const bool has_next = S.next(ui + 1, nxt);
        const char* nA = has_next ? nxt.A : cA; const char* nB = has_next ? nxt.B : cB;
        for (int t = 0; t < nt; t += 2) {
            const bool last = (t == nt - 2);
            const char* a1 = cA + (size_t)(t + 1) * kstep;
            const char* a2 = last ? nA : cA + (size_t)(t + 2) * kstep; const char* b2 = last ? nB : cB + (size_t)(t + 2) * kstep;
            const char* a3 = a2 + kstep; const char* b3 = b2 + kstep;
            PG8_LDB(B0, 0, 0); PG8_SCHED; PG8_LDA(At, 0, 0); PG8_STAGE(PG8_SA(1, 1), a1 + hstep, voffA);
            PG8_WAIT_L(8); PG8_BAR; PG8_WAIT_L(0); PG8_MMA(0, 0, At, B0); PG8_BAR; PG8_SCHED;
            PG8_LDB(B1, 0, 1); PG8_STAGE(PG8_SB(0, 0), b2, voffB);
            PG8_BAR; PG8_WAIT_L(0); PG8_MMA(0, 1, At, B1); PG8_BAR;
            PG8_LDA(At, 0, 1); PG8_STAGE(PG8_SA(0, 0), a2, voffA);
            PG8_BAR; PG8_WAIT_L(0); PG8_MMA(1, 0, At, B0); PG8_BAR; PG8_SCHED;
            PG8_STAGE(PG8_SB(0, 1), b2 + hstep, voffB);
            PG8_WAIT_V(6); PG8_BAR; PG8_MMA(1, 1, At, B1); PG8_BAR;
            PG8_LDB(B0, 1, 0); PG8_SCHED; PG8_LDA(At, 1, 0); PG8_STAGE(PG8_SA(0, 1), a2 + hstep, voffA);
            PG8_WAIT_L(8); PG8_BAR; PG8_WAIT_L(0); PG8_MMA(0, 0, At, B0); PG8_BAR; PG8_SCHED;
            PG8_LDB(B1, 1, 1); PG8_STAGE(PG8_SB(1, 0), b3, voffB);
            PG8_BAR; PG8_WAIT_L(0); PG8_MMA(0, 1, At, B1); PG8_BAR;
            PG8_LDA(At, 1, 1); PG8_STAGE(PG8_SA(1, 0), a3, voffA);
            PG8_BAR; PG8_WAIT_L(0); PG8_MMA(1, 0, At, B0); PG8_BAR; PG8_SCHED;
            PG8_STAGE(PG8_SB(1, 1), b3 + hstep, voffB);
            PG8_WAIT_V(6); PG8_BAR; PG8_MMA(1, 1, At, B1); PG8_BAR;
        }
        E(acc, cur, wr, wc, fr, fq);
        if (!has_next) break;
#pragma unroll
        for (int a = 0; a < 2; ++a)
#pragma unroll
            for (int b = 0; b < 2; ++b)
#pragma unroll
                for (int m = 0; m < 4; ++m)
#pragma unroll
                    for (int n = 0; n < 2; ++n) acc[a][b][m][n] = (f32x4){0.f, 0.f, 0.f, 0.f};
        cur = nxt; cA = nA; cB = nB; ++ui;
    }
    PG8_WAIT_V(0);
    if (wr == 0) PG8_BAR;
    PG8_BAR;
#undef PG8_SA
#undef PG8_SB
#undef PG8_STAGE
#undef PG8_LDA
#undef PG8_LDB
#undef PG8_MMA
#undef PG8_WAIT_V
#undef PG8_WAIT_L
#undef PG8_BAR
#undef PG8_SCHED
}
}
using pg8::Unit;

struct EpiProj {
    static constexpr bool PERM = true; bf16_t* O;
    __device__ __forceinline__ void operator()(const f32x4 (&acc)[2][2][4][2], const Unit& u, int wr, int wc, int fr, int fq) const {
        const int row0 = u.pm * 256 + wr * 64 + fr, col0 = u.pn * 256 + wc * 32 + 8 * fq;
#pragma unroll
        for (int ai = 0; ai < 2; ++ai)
#pragma unroll
            for (int m = 0; m < 4; ++m) { bf16_t* rowp = O + (size_t)(row0 + ai * 128 + m * 16) * LDP + col0;
#pragma unroll
                for (int bj = 0; bj < 2; ++bj) { const f32x4 v0 = acc[ai][bj][m][0], v1 = acc[ai][bj][m][1];
                    u32x4 w; w.x = pack2(v0[0], v0[1]); w.y = pack2(v0[2], v0[3]); w.z = pack2(v1[0], v1[1]); w.w = pack2(v1[2], v1[3]);
                    *(u32x4*)(rowp + bj * 128) = w; } }
    }
};
template <int PASS> struct EpiMerge {
    static constexpr bool PERM = true; bf16_t* M; const bf16_t* proj; const float* bg;
    __device__ __forceinline__ void operator()(const f32x4 (&acc)[2][2][4][2], const Unit& u, int wr, int wc, int fr, int fq) const {
        const int row0 = u.pm * 256 + wr * 64 + fr, col0 = u.pn * 256 + wc * 32 + 8 * fq;
#pragma unroll
        for (int ai = 0; ai < 2; ++ai)
#pragma unroll
            for (int m = 0; m < 4; ++m) { const int row = row0 + ai * 128 + m * 16;
#pragma unroll
                for (int bj = 0; bj < 2; ++bj)
#pragma unroll
                    for (int n = 0; n < 2; ++n) { const int col = col0 + bj * 128 + 4 * n;
                        const u32x2 gw = *(const u32x2*)(proj + (size_t)row * LDP + (PASS ? C_G1 : C_G0) + col);
                        const f32x4 b0 = *(const f32x4*)(bg + PASS * 2048 + col);
                        bf16_t* dst = M + (size_t)row * 2048 + col;
                        u32x2 old = {0u, 0u}; if (PASS) old = *(const u32x2*)dst;
                        const f32x4 v = acc[ai][bj][m][n];
                        const float r0 = bflo(old.x) + sigmoidf_(bflo(gw.x) + b0[0]) * v[0], r1 = bfhi(old.x) + sigmoidf_(bfhi(gw.x) + b0[1]) * v[1];
                        const float r2 = bflo(old.y) + sigmoidf_(bflo(gw.y) + b0[2]) * v[2], r3 = bfhi(old.y) + sigmoidf_(bfhi(gw.y) + b0[3]) * v[3];
                        u32x2 w; w.x = pack2(r0, r1); w.y = pack2(r2, r3);
                        *(u32x2*)dst = w; }
                asm volatile("" ::: "memory"); }
    }
};
struct EpiResid {
    static constexpr bool PERM = false; float* X1; const float* X;
    __device__ __forceinline__ void operator()(const f32x4 (&acc)[2][2][4][2], const Unit& u, int wr, int wc, int fr, int fq) const {
        const int row0 = u.pm * 256 + wr * 64 + fr, col0 = u.pn * 256 + wc * 32 + 4 * fq;
#pragma unroll
        for (int ai = 0; ai < 2; ++ai)
#pragma unroll
            for (int m = 0; m < 4; ++m) { const size_t ro = (size_t)(row0 + ai * 128 + m * 16) * 2048 + col0;
#pragma unroll
                for (int bj = 0; bj < 2; ++bj)
#pragma unroll
                    for (int n = 0; n < 2; ++n) { const size_t o = ro + bj * 128 + n * 16; *(f32x4*)(X1 + o) = *(const f32x4*)(X + o) + acc[ai][bj][m][n]; } }
    }
};
struct EpiGateUp {
    static constexpr bool PERM = false; bf16_t* ACT;
    __device__ __forceinline__ void operator()(const f32x4 (&acc)[2][2][4][2], const Unit& u, int wr, int wc, int fr, int fq) const {
        const int row0 = u.pm * 256 + wr * 64 + fr, hid0 = u.pn * 128 + wc * 16 + 4 * fq;
#pragma unroll
        for (int ai = 0; ai < 2; ++ai)
#pragma unroll
            for (int m = 0; m < 4; ++m) { bf16_t* rowp = ACT + (size_t)(row0 + ai * 128 + m * 16) * 512 + hid0;
#pragma unroll
                for (int bj = 0; bj < 2; ++bj) { const f32x4 g = acc[ai][bj][m][0], up = acc[ai][bj][m][1];
                    u32x2 w; w.x = pack2(siluf_(g[0]) * up[0], siluf_(g[1]) * up[1]); w.y = pack2(siluf_(g[2]) * up[2], siluf_(g[3]) * up[3]);
                    *(u32x2*)(rowp + bj * 64) = w; } }
    }
};
struct EpiDown {
    static constexpr bool PERM = true; bf16_t* O;
    __device__ __forceinline__ void operator()(const f32x4 (&acc)[2][2][4][2], const Unit& u, int wr, int wc, int fr, int fq) const {
        const int row0 = u.pm * 256 + wr * 64 + fr, col0 = u.pn * 256 + wc * 32 + 8 * fq;
#pragma unroll
        for (int ai = 0; ai < 2; ++ai)
#pragma unroll
            for (int m = 0; m < 4; ++m) { bf16_t* rowp = O + (size_t)(row0 + ai * 128 + m * 16) * 2048 + col0;
#pragma unroll
                for (int bj = 0; bj < 2; ++bj) { const f32x4 v0 = acc[ai][bj][m][0], v1 = acc[ai][bj][m][1];
                    u32x4 w; w.x = pack2(v0[0], v0[1]); w.y = pack2(v0[2], v0[3]); w.z = pack2(v1[0], v1[1]); w.w = pack2(v1[2], v1[3]);
                    *(u32x4*)(rowp + bj * 128) = w; } }
    }
};

namespace att {
constexpr int D = 128, ASTR = LDP, OSTR = 1024, MSTR = T_;
constexpr float SCALE = 0.08838834764831845f, THR = 8.f;
constexpr bool WSKIP = false;
constexpr int NW = 8, QBLK = 32, KVBLK = 64, QB = NW * QBLK;
constexpr int SHM_V = KVBLK * D * 2, SHM_K = KVBLK * D * 2;
constexpr int ATT_LDS = 2 * SHM_V + 2 * SHM_K + NW * 64 * 4;
typedef short s16x4 __attribute__((ext_vector_type(4)));
typedef float f32x16 __attribute__((ext_vector_type(16)));
template <class A, class Bt> struct same_t { static constexpr bool v = false; };
template <class A> struct same_t<A, A> { static constexpr bool v = true; };
#define KSWZ(row, colB) ((row) * 256 + ((colB) ^ (((row) & 7) << 4)))
#define SBAR() __builtin_amdgcn_sched_barrier(0)
__device__ __forceinline__ int v_st(int k, int c) { const int kk = (k & ~0xC) | ((k & 4) << 1) | ((k & 8) >> 1); return ((kk >> 3) * 4 + (c >> 5)) * 512 + ((kk & 7) * 32 + (c & 31)) * 2; }
__device__ __forceinline__ int v_rd_base(int lane) { return ((lane & 3) << 3) | (((lane >> 2) & 3) << 6) | (((lane >> 4) & 1) << 5) | (((lane >> 5) & 1) << 8); }
constexpr int v_rd_off(int d0, int ks, int half) { return d0 * 512 + ks * 4096 + half * 2048; }
__device__ __forceinline__ int crow(int r, int hi) { return (r & 3) + 8 * (r >> 2) + 4 * hi; }
__device__ __forceinline__ unsigned cvtpk(float lo, float hi) {
    unsigned r; asm volatile("v_cvt_pk_bf16_f32 %0, %1, %2" : "=v"(r) : "v"(lo), "v"(hi)); return r;
}
__device__ __forceinline__ bf16x8 pack8(f32x4 a, f32x4 b) {
    u32x4 w = {cvtpk(a[0], a[1]), cvtpk(a[2], a[3]), cvtpk(b[0], b[1]), cvtpk(b[2], b[3])};
    return *reinterpret_cast<bf16x8*>(&w);
}
template <class T> __device__ __forceinline__ bf16x8 load8(const T* p) {
    if constexpr (same_t<T, float>::v) { return pack8(*(const f32x4*)p, *(const f32x4*)(p + 4)); }
    else { return *reinterpret_cast<const bf16x8*>(p); }
}
__device__ __forceinline__ void mask_tile(f32x16& p0, f32x16& p1, int dq, unsigned W) {
    const float NEG = -__builtin_inff();
#pragma unroll
    for (int r = 0; r < 16; ++r) {
        const int c = (r & 3) + 8 * (r >> 2);
        if ((unsigned)(dq - c) >= W) p0[r] = NEG;
        if ((unsigned)(dq - c - 32) >= W) p1[r] = NEG;
    }
}
__device__ __forceinline__ void mask_bits(f32x16& p0, f32x16& p1, unsigned long long mw, int hi) {
    const float NEG = -__builtin_inff(); const unsigned lo = (unsigned)mw >> (4 * hi), hw = (unsigned)(mw >> 32) >> (4 * hi);
#pragma unroll
    for (int r = 0; r < 16; ++r) { const int c = (r & 3) + 8 * (r >> 2);
        if (!((lo >> c) & 1u)) p0[r] = NEG;
        if (!((hw >> c) & 1u)) p1[r] = NEG; }
}
__device__ __forceinline__ void partialSM(f32x16& p0, f32x16& p1, float& m_reg, float& mn, float& alpha) {
    float pmax = p0[0]; for (int r = 1; r < 16; ++r) pmax = fmaxf(pmax, p0[r]); for (int r = 0; r < 16; ++r) pmax = fmaxf(pmax, p1[r]);
    { auto rr = __builtin_amdgcn_permlane32_swap(__float_as_uint(pmax), __float_as_uint(pmax), false, false);
      pmax = fmaxf(__uint_as_float(rr[0]), __uint_as_float(rr[1])); }
    constexpr float C2 = 1.4426950408889634f * SCALE;
    if (__builtin_expect(__all((pmax - m_reg) * SCALE <= THR), 1)) { mn = m_reg; alpha = 1.f; }
    else { mn = fmaxf(m_reg, pmax); alpha = __builtin_amdgcn_exp2f((m_reg - mn) * C2); m_reg = mn; }
    const float mnL = -mn * C2;
    for (int r = 0; r < 16; ++r) p0[r] = fmaf(p0[r], C2, mnL); for (int r = 0; r < 16; ++r) p1[r] = fmaf(p1[r], C2, mnL);
    for (int r = 0; r < 16; ++r) p0[r] = __builtin_amdgcn_exp2f(p0[r]);
}
__device__ __forceinline__ void finishSM(f32x16& p0, f32x16& p1, float alpha, float& l_reg, bf16x8& pa0, bf16x8& pa1, bf16x8& pa2, bf16x8& pa3) {
    for (int r = 0; r < 16; ++r) p1[r] = __builtin_amdgcn_exp2f(p1[r]);
    float ps = 0; for (int r = 0; r < 16; ++r) ps += p0[r]; for (int r = 0; r < 16; ++r) ps += p1[r];
    { auto rr = __builtin_amdgcn_permlane32_swap(__float_as_uint(ps), __float_as_uint(ps), false, false);
      ps = __uint_as_float(rr[0]) + __uint_as_float(rr[1]); }
    l_reg = l_reg * alpha + ps;
#define PK4(P, B_, OUT) do { unsigned a0 = cvtpk(P[B_+0], P[B_+1]), a1 = cvtpk(P[B_+2], P[B_+3]);                          \
        unsigned b0 = cvtpk(P[B_+4], P[B_+5]), b1 = cvtpk(P[B_+6], P[B_+7]);                                             \
        auto r0 = __builtin_amdgcn_permlane32_swap(a0, b0, false, false); auto r1 = __builtin_amdgcn_permlane32_swap(a1, b1, false, false); \
        u32x4 w = {r0[0], r1[0], r0[1], r1[1]}; OUT = *reinterpret_cast<bf16x8*>(&w); } while (0)
    PK4(p0, 0, pa0); PK4(p0, 8, pa1); PK4(p1, 0, pa2); PK4(p1, 8, pa3);
#undef PK4
}
template <int KB, bool SK>
__device__ __forceinline__ void qkt(f32x16& p0, f32x16& p1, const char* K_lds, int r32, int hi, const bf16x8* qr, bool act) {
    if (SK && !act) { const float NEG = -__builtin_inff();
#pragma unroll
        for (int r = 0; r < 16; ++r) { p0[r] = NEG; p1[r] = NEG; } return; }
    p0 = f32x16{}; p1 = f32x16{};
    const char* kb[4];
#pragma unroll
    for (int dd = 0; dd < 4; ++dd) kb[dd] = K_lds + KB * SHM_K + KSWZ(r32, (dd * 16 + hi * 8) * 2);
#pragma unroll
    for (int d0 = 0; d0 < 8; ++d0) { const char* a = kb[d0 & 3] + (d0 >> 2) * 128;
        bf16x8 b0 = *reinterpret_cast<const bf16x8*>(a);
        bf16x8 b1 = *reinterpret_cast<const bf16x8*>(a + 32 * 256);
        p0 = __builtin_amdgcn_mfma_f32_32x32x16_bf16(b0, qr[d0], p0, 0, 0, 0);
        p1 = __builtin_amdgcn_mfma_f32_32x32x16_bf16(b1, qr[d0], p1, 0, 0, 0); }
}
template <int VB, bool SK>
__device__ __forceinline__ void pv_tile(f32x16* o, int vb0, bf16x8 pa0, bf16x8 pa1, bf16x8 pa2, bf16x8 pa3, bool act) {
    if (SK && !act) return;
#define TRRD(dst, off) asm volatile("ds_read_b64_tr_b16 %0, %1 offset:%2" : "=&v"(dst) : "v"(vb0), "i"(off) : "memory")
#define PV_D0(d0) do { s16x4 l0, l1, l2, l3, h0, h1, h2, h3; constexpr int b_ = VB * SHM_V + v_rd_off(d0, 0, 0);     \
        TRRD(l0, b_); TRRD(h0, b_ + 2048); TRRD(l1, b_ + 4096); TRRD(h1, b_ + 6144); TRRD(l2, b_ + 8192); TRRD(h2, b_ + 10240); TRRD(l3, b_ + 12288); TRRD(h3, b_ + 14336); \
        asm volatile("s_waitcnt lgkmcnt(0)" ::: "memory"); SBAR();                 \
        o[d0] = __builtin_amdgcn_mfma_f32_32x32x16_bf16(pa0, (bf16x8){l0[0], l0[1], l0[2], l0[3], h0[0], h0[1], h0[2], h0[3]}, o[d0], 0, 0, 0);   \
        o[d0] = __builtin_amdgcn_mfma_f32_32x32x16_bf16(pa1, (bf16x8){l1[0], l1[1], l1[2], l1[3], h1[0], h1[1], h1[2], h1[3]}, o[d0], 0, 0, 0);   \
        o[d0] = __builtin_amdgcn_mfma_f32_32x32x16_bf16(pa2, (bf16x8){l2[0], l2[1], l2[2], l2[3], h2[0], h2[1], h2[2], h2[3]}, o[d0], 0, 0, 0);   \
        o[d0] = __builtin_amdgcn_mfma_f32_32x32x16_bf16(pa3, (bf16x8){l3[0], l3[1], l3[2], l3[3], h3[0], h3[1], h3[2], h3[3]}, o[d0], 0, 0, 0); } while (0)
    PV_D0(0); PV_D0(1); PV_D0(2); PV_D0(3);
#undef PV_D0
#undef TRRD
}

template <class TIn, class TOut> struct BlockRef { const TIn* Q; const TIn* K; const TIn* V; TOut* O; int P0; const unsigned long long* MK; };
template <class TIn> struct Seam {
    bf16x8 qr[8];
    bf16x8 st_v0, st_v1, st_k0, st_k1; f32x4 sf0, sf1, sf2, sf3;
    f32x4 tq[16];
};
__device__ __forceinline__ int swa_jlo(int P0, int W) { const int lowk = P0 - W + 1; return lowk > 0 ? lowk / KVBLK : 0; }
#define ROW(p, k0, rr) ((p) + (size_t)((k0) + (rr)) * ASTR + sc)
#define VMW() asm volatile("s_waitcnt vmcnt(0)" ::: "memory")
#define VMWN(n) asm volatile("s_waitcnt vmcnt(%0)" :: "i"(n) : "memory")
#define SLOAD_H(Kp, Vp, k0) do { S.st_v0 = load8<TIn>(ROW(Vp, k0, sr)); S.st_v1 = load8<TIn>(ROW(Vp, k0, 32 + sr));              \
                         S.st_k0 = load8<TIn>(ROW(Kp, k0, sr)); S.st_k1 = load8<TIn>(ROW(Kp, k0, 32 + sr)); } while (0)
#define SWRITE_HK(bf) do { *(bf16x8*)(K_lds + (bf) * SHM_K + kws) = S.st_k0; *(bf16x8*)(K_lds + (bf) * SHM_K + kws + 32 * 256) = S.st_k1; } while (0)
#define SWRITE_HV(bf) do { *(bf16x8*)(V_lds + (bf) * SHM_V + vst0) = S.st_v0; *(bf16x8*)(V_lds + (bf) * SHM_V + vst1) = S.st_v1; } while (0)
#define SWRITE_H(bf) do { SWRITE_HV(bf); SWRITE_HK(bf); } while (0)
#define SLOAD_F(p, k0) do { S.sf0 = *(const f32x4*)ROW(p, k0, sr); S.sf1 = *(const f32x4*)(ROW(p, k0, sr) + 4);                \
                            S.sf2 = *(const f32x4*)ROW(p, k0, 32 + sr); S.sf3 = *(const f32x4*)(ROW(p, k0, 32 + sr) + 4); } while (0)
#define SWRITE_KF(bf) do { *(bf16x8*)(K_lds + (bf) * SHM_K + kws) = pack8(S.sf0, S.sf1); *(bf16x8*)(K_lds + (bf) * SHM_K + kws + 32 * 256) = pack8(S.sf2, S.sf3); } while (0)
#define SWRITE_VF(bf) do { *(bf16x8*)(V_lds + (bf) * SHM_V + vst0) = pack8(S.sf0, S.sf1); *(bf16x8*)(V_lds + (bf) * SHM_V + vst1) = pack8(S.sf2, S.sf3); } while (0)
template <class TIn, class TOut>
__device__ __forceinline__ void causal_swa_prime(const BlockRef<TIn, TOut>& cur, int W, char* lds, Seam<TIn>& S) {
    constexpr bool F32 = same_t<TIn, float>::v;
    const int tid = tid_(), wid = __builtin_amdgcn_readfirstlane(tid >> 6), lane = tid & 63, r32 = lane & 31, hi = lane >> 5;
    const int sr = tid >> 4, sc = (tid & 15) * 8, kws = KSWZ(sr, sc * 2); char* K_lds = lds + 2 * SHM_V;
    const int kb0 = swa_jlo(cur.P0, W) * KVBLK;
    for (int d0 = 0; d0 < 8; ++d0) S.qr[d0] = load8<TIn>(cur.Q + (size_t)(wid * QBLK + r32) * ASTR + d0 * 16 + hi * 8);
    if constexpr (F32) { SLOAD_F((const float*)cur.K, kb0); VMW(); SWRITE_KF(0); SBAR(); SLOAD_F((const float*)cur.V, kb0); }
    else { SLOAD_H(cur.K, cur.V, kb0); VMW(); SWRITE_HK(0); }
    __syncthreads();
}
template <class TIn, class TOut>
__device__ __forceinline__ void causal_swa_block(const BlockRef<TIn, TOut>& cur, const BlockRef<TIn, TOut>& nxt, int skv, int W, char* lds, Seam<TIn>& S) {
    constexpr bool F32 = same_t<TIn, float>::v;
    const int tid = tid_(), wid = __builtin_amdgcn_readfirstlane(tid >> 6), lane = tid & 63, r32 = lane & 31, hi = lane >> 5;
    const int j_lo = swa_jlo(cur.P0, W);
    int j_hi = (cur.P0 + QB - 1) / KVBLK + 1; if (j_hi > skv / KVBLK) j_hi = skv / KVBLK;
    const int NT = j_hi - j_lo;
    const int kbn = swa_jlo(nxt.P0, W) * KVBLK;
    const int qlo = cur.P0 + wid * QBLK, qm = qlo + r32 - 4 * hi;
    char* V_lds = lds; char* K_lds = lds + 2 * SHM_V;
    float* ws = (float*)(lds + 2 * SHM_V + 2 * SHM_K) + wid * 64; float* li_l = ws, * al_l = ws + 32;
    float m_reg = -1e30f, l_reg = 0; f32x16 o[4] = {};
    const int sr = tid >> 4, sc = (tid & 15) * 8, vst0 = v_st(sr, sc), vst1 = v_st(32 + sr, sc), kws = KSWZ(sr, sc * 2);
    const int vb0 = (int)(uintptr_t)V_lds + v_rd_base(lane);
    const TIn* Kh = cur.K; const TIn* Vh = cur.V;
#define RESC(a) do { if (__any((a) < 1.f)) { if (hi == 0) al_l[r32] = (a); asm volatile("s_waitcnt lgkmcnt(0)" ::: "memory");              \
                     for (int d_ = 0; d_ < 4; ++d_) for (int r = 0; r < 16; ++r) o[d_][r] *= al_l[crow(r, hi)]; } } while (0)
#define KBASE(t) ((j_lo + (t)) * KVBLK)
#define ACT(t) (KBASE(t) <= qlo + QBLK - 1 && KBASE(t) + KVBLK - 1 >= qlo - W + 1)
#define MASKT(P0_, P1_, t) do { mask_bits(P0_, P1_, mw, hi); } while (0)
#define MLOAD(t) do { mw = cur.MK[(size_t)(j_lo + (t)) * MSTR + wid * QBLK + r32]; } while (0)
    constexpr int NQL = F32 ? 16 : 8;
    constexpr bool SK = WSKIP && !F32;
#define SEAM_K0() do { VMWN(NQL); if constexpr (F32) { SWRITE_KF(0); SBAR(); SLOAD_F((const float*)nxt.V, kbn); } else { SWRITE_HK(0); } SBAR(); } while (0)
    f32x16 pA0, pA1, pB0, pB1; float mnA, mnB, alA, alB; bf16x8 pa0, pa1, pa2, pa3; unsigned long long mw = 0ull;
    if constexpr (F32) { VMW(); SWRITE_VF(0); SBAR(); } else { SWRITE_HV(0); SBAR(); }
    if (NT > 1) { if constexpr (F32) SLOAD_F((const float*)Kh, KBASE(1)); else SLOAD_H(Kh, Vh, KBASE(1)); }
    MLOAD(0); SBAR(); qkt<0, SK>(pA0, pA1, K_lds, r32, hi, S.qr, ACT(0));
    if constexpr (F32) { if (NT > 1) { VMW(); SWRITE_KF(1); SBAR(); SLOAD_F((const float*)Vh, KBASE(1)); } }
    MASKT(pA0, pA1, 0); partialSM(pA0, pA1, m_reg, mnA, alA);
    if (NT > 1) { VMW(); if constexpr (F32) { SWRITE_VF(1); SBAR(); if (NT > 2) SLOAD_F((const float*)Kh, KBASE(2)); } else SWRITE_H(1); }
    __syncthreads();
#define HALF_STEP(PX0, PX1, mnX, alX, PY0, PY1, alY, t, KB, VB, SB) do {                                                      \
        MLOAD(t); SBAR(); qkt<KB, SK>(PX0, PX1, K_lds, r32, hi, S.qr, ACT(t));                                             \
        finishSM(PY0, PY1, alY, l_reg, pa0, pa1, pa2, pa3); SBAR();                                                           \
        if ((t) + 1 < NT) { if constexpr (F32) { VMW(); SWRITE_KF(SB); SBAR(); SLOAD_F((const float*)Vh, KBASE((t) + 1)); }  \
                            else { SLOAD_H(Kh, Vh, KBASE((t) + 1)); } SBAR(); }                                               \
        pv_tile<VB, SK>(o, vb0, pa0, pa1, pa2, pa3, ACT((t) - 1)); MASKT(PX0, PX1, (t)); partialSM(PX0, PX1, m_reg, mnX, alX);                                        \
        __syncthreads();                                                                                                      \
        if ((t) + 1 < NT) { VMW(); if constexpr (F32) { SWRITE_VF(SB); SBAR(); if ((t) + 2 < NT) SLOAD_F((const float*)Kh, KBASE((t) + 2)); } \
                            else { SWRITE_H(SB); } }                                                                          \
        RESC(alX); __syncthreads(); } while (0)
    for (int t = 1; t + 1 < NT; t += 2) {
        HALF_STEP(pB0, pB1, mnB, alB, pA0, pA1, alA, t, 1, 0, 0);
        HALF_STEP(pA0, pA1, mnA, alA, pB0, pB1, alB, t + 1, 0, 1, 1);
    }
    const bool even = (NT & 1) == 0;
    if (even) { MLOAD(NT - 1); SBAR(); qkt<1, SK>(pB0, pB1, K_lds, r32, hi, S.qr, ACT(NT - 1)); SBAR(); }
#define QROW(e) (nxt.Q + (size_t)(wid * QBLK + r32) * ASTR + ((e) >> 1) * 16 + hi * 8 + ((e) & 1) * 4)
    if constexpr (F32) { SLOAD_F((const float*)nxt.K, kbn); SBAR();
#pragma unroll
        for (int e = 0; e < 8; ++e) S.tq[e] = *(const f32x4*)QROW(e); }
    else { SLOAD_H(nxt.K, nxt.V, kbn); SBAR();
#pragma unroll
        for (int d0 = 0; d0 < 8; ++d0) S.qr[d0] = load8<TIn>(nxt.Q + (size_t)(wid * QBLK + r32) * ASTR + d0 * 16 + hi * 8); }
    SBAR();
    finishSM(pA0, pA1, alA, l_reg, pa0, pa1, pa2, pa3); SBAR();
    if constexpr (F32) {
#pragma unroll
        for (int e = 8; e < 16; ++e) S.tq[e] = *(const f32x4*)QROW(e); SBAR(); }
#undef QROW
    pv_tile<0, SK>(o, vb0, pa0, pa1, pa2, pa3, ACT(even ? NT - 2 : NT - 1));
    if (even) { MASKT(pB0, pB1, NT - 1); partialSM(pB0, pB1, m_reg, mnB, alB); __syncthreads(); RESC(alB);
        finishSM(pB0, pB1, alB, l_reg, pa0, pa1, pa2, pa3); SBAR(); pv_tile<1, SK>(o, vb0, pa0, pa1, pa2, pa3, ACT(NT - 1)); }
    SBAR(); SEAM_K0();
    if (hi == 0) li_l[r32] = l_reg; asm volatile("s_waitcnt lgkmcnt(0)" ::: "memory");
    float rli[16];
#pragma unroll
    for (int r = 0; r < 16; ++r) rli[r] = __builtin_amdgcn_rcpf(li_l[crow(r, hi)]);
    TOut* Ow = cur.O + (size_t)(wid * QBLK) * OSTR;
#pragma unroll
    for (int r = 0; r < 16; ++r) { const int orow = crow(r, hi);
#pragma unroll
        for (int d0 = 0; d0 < 4; ++d0) { const float v = o[d0][r] * rli[r];
            if constexpr (same_t<TOut, float>::v) { Ow[(size_t)orow * OSTR + d0 * 32 + r32] = v; }
            else { const float vn = dpp_f<0xB1>(v);
                   if ((r32 & 1) == 0) *(unsigned*)(Ow + (size_t)orow * OSTR + d0 * 32 + r32) = cvtpk(v, vn); } } }
    if constexpr (F32) {
#pragma unroll
        for (int d0 = 0; d0 < 8; ++d0) S.qr[d0] = pack8(S.tq[2 * d0], S.tq[2 * d0 + 1]); }
    __syncthreads();
#undef RESC
#undef KBASE
#undef ACT
#undef MASKT
#undef MLOAD
#undef SEAM_K0
#undef HALF_STEP
}
#undef ROW
#undef VMW
#undef VMWN
#undef SLOAD_H
#undef SWRITE_HK
#undef SWRITE_HV
#undef SWRITE_H
#undef SLOAD_F
#undef SWRITE_KF
#undef SWRITE_VF
}

template <class Load4, class DstRow>
__device__ __forceinline__ void convert_tiles(LAS float* tile  , bf16_t* dst, int K, int N, Load4 load4, DstRow dstrow, int c, int G, int& tile_counter) {
    const int tid = tid_(), nk = K / 64, total = nk * (N / 256);
    const int kr = tid >> 6, n4 = (tid & 63) * 4;
    int tt = (c - tile_counter % G + G) % G;
    tile_counter += total;
    f32x4 r[8];
    if (tt < total) { const int k0 = (tt % nk) * 64, n0 = (tt / nk) * 256;
#pragma unroll
        for (int i = 0; i < 8; ++i) r[i] = load4(k0 + kr + 8 * i, n0 + n4); }
    while (tt < total) {
        const int k0 = (tt % nk) * 64, n0 = (tt / nk) * 256;
        __syncthreads();
#pragma unroll
        for (int i = 0; i < 8; ++i) { LAS float* q = tile + (kr + 8 * i) * 257 + n4; q[0] = r[i][0]; q[1] = r[i][1]; q[2] = r[i][2]; q[3] = r[i][3]; }
        const int nx = tt + G;
        if (nx < total) { const int k1 = (nx % nk) * 64, n1 = (nx / nk) * 256;
#pragma unroll
            for (int i = 0; i < 8; ++i) r[i] = load4(k1 + kr + 8 * i, n1 + n4); }
        __syncthreads();
        const int kc = tid & 7;
#pragma unroll
        for (int i = 0; i < 4; ++i) { const int nl = (tid >> 3) + 64 * i; float v[8];
#pragma unroll
            for (int j = 0; j < 8; ++j) v[j] = tile[(kc * 8 + j) * 257 + nl];
            u32x4 w; w.x = pack2(v[0], v[1]); w.y = pack2(v[2], v[3]); w.z = pack2(v[4], v[5]); w.w = pack2(v[6], v[7]);
            *(u32x4*)(dst + (size_t)dstrow(n0 + nl) * K + k0 + kc * 8) = w; }
        tt = nx;
    }
}

__device__ __forceinline__ int in_col_map(int n) {
    if (n < 4096) return n;
    if (n < 7680) return n + 16;
    if (n < 11776) return n + 88;
    if (n < 11840) return 7696 + (n - 11776);
    if (n < 11848) return 4096 + (n - 11840);
    if (n < 11856) return 4104 + (n - 11848);
    if (n < 11864) return 7760 + (n - 11856);
    return -1;
}

__device__ __forceinline__ void phase0(const Params& p, LAS unsigned char* lds) {
    const int G = gridDim.x, c = blockIdx.x, tid = tid_();
    unsigned char* ws = opq(p.ws);
    if (c == 0 && tid < 256) ((unsigned*)(ws + OFF_SMALL + SM_CTRL))[tid] = 0u;
    int counter = 0;
    { const float* w = p.w_in;
      convert_tiles((LAS float*)lds, (bf16_t*)(ws + OFF_WT_IN), 2048, LDP, [w](int k, int n) -> f32x4 {
          const float* row = w + (size_t)k * IN_COLS;
          if (n < 11776) { const int o = n < 4096 ? n : (n < 7680 ? n + 16 : n + 88); return *(const f32x4*)(row + o); }
          f32x4 v;
#pragma unroll
          for (int j = 0; j < 4; ++j) { const int o = in_col_map(n + j); v[j] = o < 0 ? 0.f : row[o]; }
          return v; }, [](int n) { return n; }, c, G, counter); }
    { const float* w = p.w_proj_dn; convert_tiles((LAS float*)lds, (bf16_t*)(ws + OFF_WT_DN), 1024, 2048, [w](int k, int n) -> f32x4 { return *(const f32x4*)(w + (size_t)k * 2048 + n); }, [](int n) { return n; }, c, G, counter); }
    { const float* w = p.w_proj_att; convert_tiles((LAS float*)lds, (bf16_t*)(ws + OFF_WT_AT), 1024, 2048, [w](int k, int n) -> f32x4 { return *(const f32x4*)(w + (size_t)k * 2048 + n); }, [](int n) { return n; }, c, G, counter); }
    { const float* w = p.w_out; convert_tiles((LAS float*)lds, (bf16_t*)(ws + OFF_WT_OUT), 2048, 2048, [w](int k, int n) -> f32x4 { return *(const f32x4*)(w + (size_t)k * 2048 + n); }, [](int n) { return n; }, c, G, counter); }
    { bf16_t* wh = (bf16_t*)(ws + OFF_WR); bf16_t* wl = (bf16_t*)(ws + OFF_WR + 512 * 1024);
      for (int i = c * 512 + tid; i < 5 * 64 * 64 * 8; i += G * 512) { const int e = i & 7, ln = (i >> 3) & 63, kk = (i >> 9) & 63, j = i >> 15;
          const int k = 32 * kk + 8 * (ln >> 4) + e, col = 16 * j + (ln & 15);
          const float v = col < 64 ? p.w_router[(size_t)k * 64 + col] : (col < 72 ? p.w_group[(size_t)k * 8 + col - 64] : 0.f);
          const bf16_t hi = f2bf(v); wh[i] = hi; wl[i] = f2bf(v - bf2f(hi)); } }
    { float* ct = (float*)(ws + OFF_COS); float* st = (float*)(ws + OFF_SIN);
      for (int i = c * 512 + tid; i < T_ * 16; i += G * 512) { const int t = i >> 4;
          const float invf = exp2f(-(float)(i & 15) * 1.1832230355827609f);
          const float ang = (float)p.positions[t] * invf;
          double r = (double)ang * 0.15915494309189535; r -= floor(r);
          ct[i] = __builtin_amdgcn_cosf((float)r); st[i] = __builtin_amdgcn_sinf((float)r); } }
    const int wid = tid >> 6, lane = tid & 63; bf16_t* h = (bf16_t*)(ws + OFF_H);
    for (int row = c * 8 + wid; row < T_; row += G * 8) {
        const float* xr = p.x + (size_t)row * 2048; f32x4 v[8]; float ss = 0.f;
#pragma unroll
        for (int i = 0; i < 8; ++i) { v[i] = *(const f32x4*)(xr + i * 256 + 4 * lane); ss += v[i][0] * v[i][0] + v[i][1] * v[i][1] + v[i][2] * v[i][2] + v[i][3] * v[i][3]; }
        ss = wave_sum(ss); const float rs = rsqrtf(ss * (1.0f / 2048.0f) + EPS);
#pragma unroll
        for (int i = 0; i < 8; ++i) { const f32x4 g = *(const f32x4*)(p.norm_mix + i * 256 + 4 * lane);
            u32x2 w; w.x = pack2(v[i][0] * rs * g[0], v[i][1] * rs * g[1]); w.y = pack2(v[i][2] * rs * g[2], v[i][3] * rs * g[3]);
            *(u32x2*)(h + (size_t)row * 2048 + i * 256 + 4 * lane) = w; }
    }
}

__device__ __forceinline__ void phase_rope(const Params& p) {
    const int G = gridDim.x, c = blockIdx.x, tid = tid_();
    unsigned char* ws = opq(p.ws); bf16_t* proj = (bf16_t*)(ws + OFF_PROJ); bf16_t* kidx = (bf16_t*)(ws + OFF_SMALL + SM_KIDX); float* wq = (float*)(ws + OFF_SMALL + SM_WQ);
    const float* ct = (const float*)(ws + OFF_COS); const float* st = (const float*)(ws + OFF_SIN);
    const int gtid = c * 512 + tid, gsz = G * 512;
    for (int id = gtid; id < 2 * T_ * 8; id += gsz) { const int tsel = id >= T_ * 8, rem = id - tsel * T_ * 8, t = rem >> 3, hh = rem & 7;
        bf16_t* q = proj + (size_t)t * LDP + (tsel ? C_AK : C_AQ) + hh * 128;
        u32x4 d[4]; f32x4 cv[4], sv[4];
#pragma unroll
        for (int i = 0; i < 4; ++i) { d[i] = *(const u32x4*)(q + 8 * i); cv[i] = *(const f32x4*)(ct + (size_t)t * 16 + 4 * i); sv[i] = *(const f32x4*)(st + (size_t)t * 16 + 4 * i); }
#pragma unroll
        for (int hf = 0; hf < 2; ++hf) { u32x4& a = d[hf]; u32x4& bq = d[hf + 2];
#pragma unroll
            for (int j = 0; j < 4; ++j) { const unsigned wa = a[j], wb = bq[j]; const int i0 = 8 * hf + 2 * j;
                const float c0 = cv[i0 >> 2][i0 & 3], s0 = sv[i0 >> 2][i0 & 3], c1 = cv[(i0 + 1) >> 2][(i0 + 1) & 3], s1 = sv[(i0 + 1) >> 2][(i0 + 1) & 3];
                const float x10 = bflo(wa), x11 = bfhi(wa), x20 = bflo(wb), x21 = bfhi(wb);
                a[j] = pack2(x10 * c0 - x20 * s0, x11 * c1 - x21 * s1); bq[j] = pack2(x20 * c0 + x10 * s0, x21 * c1 + x11 * s1); } }
#pragma unroll
        for (int i = 0; i < 4; ++i) *(u32x4*)(q + 8 * i) = d[i]; }
    for (int id = gtid; id < T_ * 8; id += gsz) { const int t = id >> 3, hh = id & 7;
        bf16_t* q = proj + (size_t)t * LDP + C_IQ + hh * 64;
        u32x4 a = *(const u32x4*)q, bq = *(const u32x4*)(q + 8); f32x4 cv[4], sv[4];
#pragma unroll
        for (int i = 0; i < 4; ++i) { cv[i] = *(const f32x4*)(ct + (size_t)t * 16 + 4 * i); sv[i] = *(const f32x4*)(st + (size_t)t * 16 + 4 * i); }
#pragma unroll
        for (int j = 0; j < 4; ++j) { const unsigned wa = a[j], wb = bq[j];
            const float c0 = cv[j][0], s0 = sv[j][0], c1 = cv[j][2], s1 = sv[j][2];
            const float x10 = bflo(wa), x11 = bfhi(wa), x20 = bflo(wb), x21 = bfhi(wb);
            a[j] = pack2(x10 * c0 - x20 * s0, x11 * c1 - x21 * s1); bq[j] = pack2(x20 * c0 + x10 * s0, x21 * c1 + x11 * s1); }
        *(u32x4*)q = a; *(u32x4*)(q + 8) = bq; }
    for (int t = gtid; t < T_; t += gsz) { const bf16_t* row = proj + (size_t)t * LDP;
        float v[64]; float ss = 0.f;
#pragma unroll
        for (int i = 0; i < 8; ++i) { const u32x4 dd = *(const u32x4*)(row + C_IK + 8 * i);
#pragma unroll
            for (int j = 0; j < 4; ++j) { v[8 * i + 2 * j] = bflo(dd[j]); v[8 * i + 2 * j + 1] = bfhi(dd[j]); ss += v[8 * i + 2 * j] * v[8 * i + 2 * j] + v[8 * i + 2 * j + 1] * v[8 * i + 2 * j + 1]; } }
        const float rs = rsqrtf(ss * (1.0f / 64.0f) + EPS);
#pragma unroll
        for (int d = 0; d < 64; ++d) v[d] = v[d] * rs * p.idx_k_norm[d];
#pragma unroll
        for (int i = 0; i < 8; ++i) { const float cc = ct[(size_t)t * 16 + 2 * i], sn = st[(size_t)t * 16 + 2 * i]; const float x1 = v[i], x2 = v[8 + i]; v[i] = x1 * cc - x2 * sn; v[8 + i] = x2 * cc + x1 * sn; }
#pragma unroll
        for (int ch = 0; ch < 8; ++ch) { const int kk = ch >> 2, fq2 = ch & 3; u32x4 w; w.x = pack2(v[8 * ch], v[8 * ch + 1]); w.y = pack2(v[8 * ch + 2], v[8 * ch + 3]); w.z = pack2(v[8 * ch + 4], v[8 * ch + 5]); w.w = pack2(v[8 * ch + 6], v[8 * ch + 7]);
            *(u32x4*)(kidx + ((size_t)((t >> 4) * 2 + kk) * 64 + fq2 * 16 + (t & 15)) * 8) = w; }
        const u32x4 ww = *(const u32x4*)(row + C_IW); const float sc = 0.044194173824159216f;
        f32x4 w0 = {bflo(ww.x) * sc, bfhi(ww.x) * sc, bflo(ww.y) * sc, bfhi(ww.y) * sc}, w1 = {bflo(ww.z) * sc, bfhi(ww.z) * sc, bflo(ww.w) * sc, bfhi(ww.w) * sc};
        *(f32x4*)(wq + (size_t)t * 8) = w0; *(f32x4*)(wq + (size_t)t * 8 + 4) = w1; }
}

__device__ __forceinline__ bf16x8 ldfrag(const LAS bf16_t* X, int stride, int rt, int ks, int fr, int fq) { return *(const LAS bf16x8*)(X + (16 * rt + fr) * stride + 32 * ks + 8 * fq); }
__device__ __forceinline__ void dn_prep_load(const Params& p, int item, u32x4 (&xr)[3][2][4], float (&ba)[2]) {
    const int tid = tid_(), n = item >> 3, h = item & 7, t0 = n * 64, c = tid & 15, i0 = tid >> 4;
    const bf16_t* proj = (const bf16_t*)(opq(p.ws) + OFF_PROJ);
#pragma unroll
    for (int sel = 0; sel < 3; ++sel) { const int col = sel * 1024 + h * 128 + 8 * c;
#pragma unroll
        for (int rr = 0; rr < 2; ++rr)
#pragma unroll
            for (int j = 0; j < 4; ++j) { const int tt = t0 + i0 + 32 * rr - 3 + j; xr[sel][rr][j] = (u32x4){0u, 0u, 0u, 0u}; if (tt >= 0) xr[sel][rr][j] = *(const u32x4*)(proj + (size_t)tt * LDP + col); } }
    ba[0] = 0.f; ba[1] = 0.f;
    if (tid < 64) { const int t = t0 + tid; ba[0] = bf2f(proj[(size_t)t * LDP + C_B + h]); ba[1] = bf2f(proj[(size_t)t * LDP + C_A + h]); }
}
__device__ __forceinline__ void dn_prep_item(const Params& p, int item, int next_item, LAS unsigned char* lds, u32x4 (&xr)[3][2][4], float (&ba)[2]) {
    const int tid = tid_(), w = tid >> 6, lane = tid & 63, fr = lane & 15, fq = lane >> 4, n = item >> 3, h = item & 7, t0 = n * 64;
    unsigned char* ws = opq(p.ws); const bf16_t* proj = (const bf16_t*)(ws + OFF_PROJ);
    LAS bf16_t* Kr = (LAS bf16_t*)lds; LAS bf16_t* Qr = Kr + 64 * 136; LAS bf16_t* KTs = Qr + 64 * 136; LAS bf16_t* VTs = KTs + 128 * 72;
    LAS bf16_t* Pb = VTs + 128 * 72;
    LAS float* Gs = (LAS float*)(Pb + 6 * 64 * 72); LAS float* bs = Gs + 64; LAS float* eg = bs + 64;
    bf16_t* wb = (bf16_t*)(ws + OFF_DNP + DNP_W) + (size_t)item * 8192; bf16_t* uT = (bf16_t*)(ws + OFF_DNP + DNP_UT) + (size_t)item * 8192;
    bf16_t* qd = (bf16_t*)(ws + OFF_DNP + DNP_QD) + (size_t)item * 8192; bf16_t* kdT = (bf16_t*)(ws + OFF_DNP + DNP_KDT) + (size_t)item * 8192;
    bf16_t* attn = (bf16_t*)(ws + OFF_DNP + DNP_ATT) + (size_t)item * 4096;
    __syncthreads();
    if (tid < 64) { const float bl = ba[0], al = ba[1] + p.dt_bias[h];
        const float sp = fmaxf(al, 0.f) + log1pf(__expf(-fabsf(al))); float g = -__expf(p.a_log[h]) * sp;
        for (int o = 1; o < 64; o <<= 1) { const float u = shfl_up_(g, o); if (tid >= o) g += u; }
        Gs[tid] = g; bs[tid] = sigmoidf_(bl); eg[tid] = __expf(g);
        if (tid == 63) ((float*)(ws + OFF_SMALL + SM_GLAST))[item] = __expf(g); }
    __syncthreads();
    { const int c = tid & 15, i0 = tid >> 4;
#pragma unroll
      for (int sel = 0; sel < 3; ++sel) { const int col = sel * 1024 + h * 128 + 8 * c;
          f32x4 wv[4][2];
#pragma unroll
          for (int j = 0; j < 4; ++j) { wv[j][0] = *(const f32x4*)(p.conv_w + j * 3072 + col); wv[j][1] = *(const f32x4*)(p.conv_w + j * 3072 + col + 4); }
#pragma unroll
          for (int rr = 0; rr < 2; ++rr) { const int i = i0 + 32 * rr; float y[8];
#pragma unroll
              for (int e = 0; e < 8; ++e) y[e] = 0.f;
#pragma unroll
              for (int j = 0; j < 4; ++j) { const u32x4 xv = xr[sel][rr][j];
                  y[0] += wv[j][0][0] * bflo(xv.x); y[1] += wv[j][0][1] * bfhi(xv.x); y[2] += wv[j][0][2] * bflo(xv.y); y[3] += wv[j][0][3] * bfhi(xv.y);
                  y[4] += wv[j][1][0] * bflo(xv.z); y[5] += wv[j][1][1] * bfhi(xv.z); y[6] += wv[j][1][2] * bflo(xv.w); y[7] += wv[j][1][3] * bfhi(xv.w); }
              float ss = 0.f;
#pragma unroll
              for (int e = 0; e < 8; ++e) { y[e] = siluf_(y[e]); ss += y[e] * y[e]; }
              const float bi = bs[i], ei = eg[i];
              if (sel < 2) { ss = sum16(ss); const float rn = rsqrtf(ss + EPS) * (sel == 0 ? 0.08838834764831845f : 1.0f);
#pragma unroll
                  for (int e = 0; e < 8; ++e) y[e] *= rn; }
              if (sel == 0) { u32x4 pk; pk.x = pack2(y[0], y[1]); pk.y = pack2(y[2], y[3]); pk.z = pack2(y[4], y[5]); pk.w = pack2(y[6], y[7]);
                  *(LAS u32x4*)(Qr + i * 136 + 8 * c) = pk;
                  u32x4 pd; pd.x = pack2(y[0] * ei, y[1] * ei); pd.y = pack2(y[2] * ei, y[3] * ei); pd.z = pack2(y[4] * ei, y[5] * ei); pd.w = pack2(y[6] * ei, y[7] * ei);
                  *(u32x4*)(qd + i * 128 + 8 * c) = pd; }
              else if (sel == 1) { u32x4 pk; pk.x = pack2(y[0], y[1]); pk.y = pack2(y[2], y[3]); pk.z = pack2(y[4], y[5]); pk.w = pack2(y[6], y[7]);
                  *(LAS u32x4*)(Kr + i * 136 + 8 * c) = pk; const float f = bi * ei;
#pragma unroll
                  for (int e = 0; e < 8; ++e) KTs[(8 * c + e) * 72 + i] = f2bf(y[e] * f); }
              else {
#pragma unroll
                  for (int e = 0; e < 8; ++e) VTs[(8 * c + e) * 72 + i] = f2bf(y[e] * bi); } } } }
    if (next_item >= 0) dn_prep_load(p, next_item, xr, ba);
    __syncthreads();
    { const float g63 = Gs[63];
#pragma unroll
      for (int rr = 0; rr < 2; ++rr) { const int u = tid + 512 * rr, d = u >> 3, ic = u & 7; float v[8];
#pragma unroll
          for (int e = 0; e < 8; ++e) v[e] = bf2f(Kr[(8 * ic + e) * 136 + d]) * __expf(g63 - Gs[8 * ic + e]);
          u32x4 pk; pk.x = pack2(v[0], v[1]); pk.y = pack2(v[2], v[3]); pk.z = pack2(v[4], v[5]); pk.w = pack2(v[6], v[7]);
          *(u32x4*)(kdT + d * 64 + 8 * ic) = pk; } }
    LAS bf16_t* P0 = Pb; LAS bf16_t* P1 = Pb + 64 * 72; LAS bf16_t* PT0 = Pb + 2 * 64 * 72; LAS bf16_t* PT1 = Pb + 3 * 64 * 72; LAS bf16_t* TT0 = Pb + 4 * 64 * 72; LAS bf16_t* TT1 = Pb + 5 * 64 * 72;
#pragma unroll
    for (int pp = 0; pp < 2; ++pp) { const int pr = 2 * w + pp, it = pr >> 2, jt = pr & 3;
        f32x4 akk = {0.f, 0.f, 0.f, 0.f}, aqk = {0.f, 0.f, 0.f, 0.f};
#pragma unroll
        for (int ks = 0; ks < 4; ++ks) { const bf16x8 ki = ldfrag(Kr, 136, it, ks, fr, fq), kj = ldfrag(Kr, 136, jt, ks, fr, fq), qi = ldfrag(Qr, 136, it, ks, fr, fq);
            akk = __builtin_amdgcn_mfma_f32_16x16x32_bf16(ki, kj, akk, 0, 0, 0);
            aqk = __builtin_amdgcn_mfma_f32_16x16x32_bf16(kj, qi, aqk, 0, 0, 0); }
        { const int j = 16 * jt + fr; const float Gj = Gs[j]; float mv[4];
#pragma unroll
          for (int r = 0; r < 4; ++r) { const int i = 16 * it + 4 * fq + r; mv[r] = j < i ? -bs[i] * akk[r] * __expf(Gs[i] - Gj) : 0.f; P0[i * 72 + j] = f2bf(mv[r]); }
          u32x2 pk; pk.x = pack2(mv[0], mv[1]); pk.y = pack2(mv[2], mv[3]); *(LAS u32x2*)(PT0 + j * 72 + 16 * it + 4 * fq) = pk; }
        { const int i = 16 * it + fr; const float Gi = Gs[i]; float av[4];
#pragma unroll
          for (int r = 0; r < 4; ++r) { const int j = 16 * jt + 4 * fq + r; av[r] = j <= i ? aqk[r] * __expf(Gi - Gs[j]) : 0.f; }
          u32x2 pk; pk.x = pack2(av[0], av[1]); pk.y = pack2(av[2], av[3]); *(u32x2*)(attn + i * 64 + 16 * jt + 4 * fq) = pk; } }
    f32x4 tm[2];
#pragma unroll
    for (int pp = 0; pp < 2; ++pp) { const int pr = 2 * w + pp, it = pr >> 2, jt = pr & 3;
#pragma unroll
        for (int r = 0; r < 4; ++r) tm[pp][r] = (16 * it + 4 * fq + r == 16 * jt + fr) ? 1.f : 0.f;
        u32x2 pk; pk.x = pack2(tm[pp][0], tm[pp][1]); pk.y = pack2(tm[pp][2], tm[pp][3]); *(LAS u32x2*)(TT0 + (16 * jt + fr) * 72 + 16 * it + 4 * fq) = pk; }
    __syncthreads();
#pragma unroll
    for (int k = 0; k < 6; ++k) {
        const LAS bf16_t* Pc = (k & 1) ? P1 : P0; const LAS bf16_t* PTc = (k & 1) ? PT1 : PT0; const LAS bf16_t* TTc = (k & 1) ? TT1 : TT0;
        LAS bf16_t* Pn = (k & 1) ? P0 : P1; LAS bf16_t* PTn = (k & 1) ? PT0 : PT1; LAS bf16_t* TTn = (k & 1) ? TT0 : TT1;
#pragma unroll
        for (int pp = 0; pp < 2; ++pp) { const int pr = 2 * w + pp, it = pr >> 2, jt = pr & 3;
            f32x4 x = {0.f, 0.f, 0.f, 0.f}, y = {0.f, 0.f, 0.f, 0.f};
#pragma unroll
            for (int ks = 0; ks < 2; ++ks) { const bf16x8 pa = ldfrag(Pc, 72, it, ks, fr, fq);
                x = __builtin_amdgcn_mfma_f32_16x16x32_bf16(pa, ldfrag(TTc, 72, jt, ks, fr, fq), x, 0, 0, 0);
                if (k < 5) y = __builtin_amdgcn_mfma_f32_16x16x32_bf16(pa, ldfrag(PTc, 72, jt, ks, fr, fq), y, 0, 0, 0); }
            tm[pp] += x;
            if (k < 5) { u32x2 pk; pk.x = pack2(tm[pp][0], tm[pp][1]); pk.y = pack2(tm[pp][2], tm[pp][3]); *(LAS u32x2*)(TTn + (16 * jt + fr) * 72 + 16 * it + 4 * fq) = pk;
#pragma unroll
                for (int r = 0; r < 4; ++r) Pn[(16 * it + 4 * fq + r) * 72 + 16 * jt + fr] = f2bf(y[r]);
                u32x2 pq; pq.x = pack2(y[0], y[1]); pq.y = pack2(y[2], y[3]); *(LAS u32x2*)(PTn + (16 * jt + fr) * 72 + 16 * it + 4 * fq) = pq; }
            else {
#pragma unroll
                for (int r = 0; r < 4; ++r) P0[(16 * it + 4 * fq + r) * 72 + 16 * jt + fr] = f2bf(tm[pp][r]); } }
        __syncthreads();
    }
#pragma unroll
    for (int q4 = 0; q4 < 4; ++q4) { const int tl = 4 * w + q4;
        { const int dt = tl >> 2, it = tl & 3; f32x4 a = {0.f, 0.f, 0.f, 0.f};
#pragma unroll
          for (int ks = 0; ks < 2; ++ks) a = __builtin_amdgcn_mfma_f32_16x16x32_bf16(ldfrag(KTs, 72, dt, ks, fr, fq), ldfrag(P0, 72, it, ks, fr, fq), a, 0, 0, 0);
          u32x2 pk; pk.x = pack2(a[0], a[1]); pk.y = pack2(a[2], a[3]); *(u32x2*)(wb + (16 * it + fr) * 128 + 16 * dt + 4 * fq) = pk; }
        { const int it = tl >> 3, vt = tl & 7; f32x4 a = {0.f, 0.f, 0.f, 0.f};
#pragma unroll
          for (int ks = 0; ks < 2; ++ks) a = __builtin_amdgcn_mfma_f32_16x16x32_bf16(ldfrag(P0, 72, it, ks, fr, fq), ldfrag(VTs, 72, vt, ks, fr, fq), a, 0, 0, 0);
          u32x2 pk; pk.x = pack2(a[0], a[1]); pk.y = pack2(a[2], a[3]); *(u32x2*)(uT + (16 * vt + fr) * 64 + 16 * it + 4 * fq) = pk; } }
}

__device__ __forceinline__ void dn_scan(const Params& p, int b, LAS unsigned char* lds) {
    const int tid = tid_(), w = tid >> 6, lane = tid & 63, fr = lane & 15, fq = lane >> 4, h = b >> 2, e0 = (b & 3) * 32;
    unsigned char* ws = opq(p.ws);
    const bf16_t* wbuf = (const bf16_t*)(ws + OFF_DNP + DNP_W); const bf16_t* uT = (const bf16_t*)(ws + OFF_DNP + DNP_UT); const bf16_t* kdT = (const bf16_t*)(ws + OFF_DNP + DNP_KDT);
    const float* glast = (const float*)(ws + OFF_SMALL + SM_GLAST);
    bf16_t* Sold = (bf16_t*)(ws + OFF_SCAN); bf16_t* vnT = (bf16_t*)(ws + OFF_SCAN + 64 * MB);
    LAS bf16_t* Sb = (LAS bf16_t*)lds;
    LAS bf16_t* Vn = (LAS bf16_t*)(lds + 32 * 136 * 2);
    f32x4 S[2] = {{0.f, 0.f, 0.f, 0.f}, {0.f, 0.f, 0.f, 0.f}};
    __syncthreads();
    bf16x8 kd[2], wf[4], kdn[2], wfn[4]; u32x2 u4[2] = {{0u, 0u}, {0u, 0u}}, u4n[2] = {{0u, 0u}, {0u, 0u}}; float gl, gln;
#define DN_LOAD(KD, WF, U4, GL, n_) do { const int it_ = (n_) * 8 + h;                                                                               \
        _Pragma("unroll") for (int kk = 0; kk < 2; ++kk) KD[kk] = *(const bf16x8*)(kdT + (size_t)it_ * 8192 + (16 * w + fr) * 64 + kk * 32 + 8 * fq); \
        if (w < 4) { _Pragma("unroll") for (int kk = 0; kk < 4; ++kk) WF[kk] = *(const bf16x8*)(wbuf + (size_t)it_ * 8192 + (16 * w + fr) * 128 + kk * 32 + 8 * fq); \
            _Pragma("unroll") for (int sl = 0; sl < 2; ++sl) U4[sl] = *(const u32x2*)(uT + (size_t)it_ * 8192 + (e0 + 16 * sl + fr) * 64 + 16 * w + 4 * fq); } \
        GL = glast[it_]; } while (0)
    DN_LOAD(kd, wf, u4, gl, 0);
#pragma unroll 1
    for (int n = 0; n < 256; ++n) {
        const int item = n * 8 + h;
        if (n + 1 < 256) DN_LOAD(kdn, wfn, u4n, gln, n + 1);
#pragma unroll
        for (int sl = 0; sl < 2; ++sl) { u32x2 sw; sw.x = pack2(S[sl][0], S[sl][1]); sw.y = pack2(S[sl][2], S[sl][3]);
            *(LAS u32x2*)(Sb + (16 * sl + fr) * 136 + 16 * w + 4 * fq) = sw;
            *(u32x2*)(Sold + (size_t)item * 16384 + (e0 + 16 * sl + fr) * 128 + 16 * w + 4 * fq) = sw; }
        __syncthreads();
        if (w < 4) {
#pragma unroll
            for (int sl = 0; sl < 2; ++sl) { f32x4 va = {0.f, 0.f, 0.f, 0.f};
#pragma unroll
                for (int kk = 0; kk < 4; ++kk) { const bf16x8 bb = *(const LAS bf16x8*)(Sb + (16 * sl + fr) * 136 + kk * 32 + 8 * fq); va = __builtin_amdgcn_mfma_f32_16x16x32_bf16(wf[kk], bb, va, 0, 0, 0); }
                u32x2 vw; vw.x = pack2(bflo(u4[sl].x) - va[0], bfhi(u4[sl].x) - va[1]); vw.y = pack2(bflo(u4[sl].y) - va[2], bfhi(u4[sl].y) - va[3]);
                *(LAS u32x2*)(Vn + (16 * sl + fr) * 72 + 16 * w + 4 * fq) = vw;
                *(u32x2*)(vnT + (size_t)item * 8192 + (e0 + 16 * sl + fr) * 64 + 16 * w + 4 * fq) = vw; } }
        __syncthreads();
#pragma unroll
        for (int sl = 0; sl < 2; ++sl) { S[sl] = S[sl] * gl;
#pragma unroll
            for (int kk = 0; kk < 2; ++kk) { const bf16x8 bb = *(const LAS bf16x8*)(Vn + (16 * sl + fr) * 72 + kk * 32 + 8 * fq); S[sl] = __builtin_amdgcn_mfma_f32_16x16x32_bf16(kd[kk], bb, S[sl], 0, 0, 0); } }
#pragma unroll
        for (int kk = 0; kk < 2; ++kk) kd[kk] = kdn[kk];
#pragma unroll
        for (int kk = 0; kk < 4; ++kk) wf[kk] = wfn[kk];
        u4[0] = u4n[0]; u4[1] = u4n[1]; gl = gln;
    }
#undef DN_LOAD
}

__device__ __forceinline__ float relu_(float x) { return __builtin_amdgcn_fmed3f(x, 0.f, __builtin_inff()); }
__device__ __forceinline__ float unsortable(unsigned u) { return __uint_as_float((u & 0x80000000u) ? (u ^ 0x80000000u) : ~u); }
__device__ __forceinline__ unsigned sortable(float f) { const unsigned u = __float_as_uint(f); return (u & 0x80000000u) ? ~u : (u | 0x80000000u); }

template <bool EXACT>
__device__ __forceinline__ unsigned compact_q(LAS unsigned* kq, LAS unsigned* iq, int n, int lane, int& nkeep) {
    unsigned key[8], idx[8]; bool val[8];
#pragma unroll
    for (int i = 0; i < 8; ++i) { const int e = lane + 64 * i; val[i] = e < n; key[i] = val[i] ? kq[e] : 0u; idx[i] = val[i] ? iq[e] : 0xffffffffu; }
    unsigned th = 0u; int cur = n;
#pragma unroll 1
    for (int b = 31; b >= 0; --b) { const unsigned cand = th | (1u << b); int c = 0;
#pragma unroll
        for (int i = 0; i < 8; ++i) c += __popcll(__ballot(val[i] && key[i] >= cand));
        if (c >= 256) { th = cand; cur = c; if (!EXACT && c <= 288) break; } }
    if (!EXACT) { int base = 0;
#pragma unroll
        for (int i = 0; i < 8; ++i) { const bool keep = val[i] && key[i] >= th; const unsigned long long m = __ballot(keep);
            const int pos = base + __popcll(m & ((1ull << lane) - 1ull)); if (keep) { kq[pos] = key[i]; iq[pos] = idx[i]; } base += __popcll(m); }
        nkeep = cur; return th - 1u; }
    int cgt = 0, ceq = 0;
#pragma unroll
    for (int i = 0; i < 8; ++i) { cgt += __popcll(__ballot(val[i] && key[i] > th)); ceq += __popcll(__ballot(val[i] && key[i] == th)); }
    const int need = 256 - cgt; unsigned beta = 0xffffffffu;
    if (ceq > need) { beta = 0u;
#pragma unroll 1
        for (int b = 14; b >= 0; --b) { const unsigned cand = beta | (1u << b); int c = 0;
#pragma unroll
            for (int i = 0; i < 8; ++i) c += __popcll(__ballot(val[i] && key[i] == th && idx[i] < cand));
            if (c < need) beta = cand; } }
    int base = 0;
#pragma unroll
    for (int i = 0; i < 8; ++i) { const bool keep = val[i] && (key[i] > th || (key[i] == th && idx[i] <= beta)); const unsigned long long m = __ballot(keep);
        const int pos = base + __popcll(m & ((1ull << lane) - 1ull)); if (keep) { kq[pos] = key[i]; iq[pos] = idx[i]; } base += __popcll(m); }
    nkeep = 256; return th;
}

__device__ __forceinline__ unsigned compact_hist(LAS unsigned* kq, LAS unsigned* iq, int n, int lane, int& nkeep, LAS unsigned* hist, unsigned lo) {
    unsigned key[8], idx[8]; bool val[8]; unsigned mx = 0u;
#pragma unroll
    for (int i = 0; i < 8; ++i) { const int e = lane + 64 * i; val[i] = e < n; key[i] = val[i] ? kq[e] : 0u; idx[i] = val[i] ? iq[e] : 0xffffffffu; mx = key[i] > mx ? key[i] : mx; }
#pragma unroll
    for (int o = 32; o >= 1; o >>= 1) { const unsigned t = (unsigned)shfl_xor_((int)mx, o); mx = t > mx ? t : mx; }
    const unsigned range = mx - lo; const int nb = 32 - __clz((int)(range | 1u)); const int sh = nb > 8 ? nb - 8 : 0;
#pragma unroll
    for (int i = 0; i < 4; ++i) hist[lane + 64 * i] = 0u;
#pragma unroll
    for (int i = 0; i < 8; ++i) if (val[i]) { unsigned b = (key[i] - lo) >> sh; b = b < 255u ? b : 255u; __hip_atomic_fetch_add(hist + b, 1u, __ATOMIC_RELAXED, __HIP_MEMORY_SCOPE_WORKGROUP); }
    const u32x4 cb = *(const LAS u32x4*)(hist + 4 * lane);
    int S = (int)(cb.x + cb.y + cb.z + cb.w);
#pragma unroll
    for (int o = 1; o < 64; o <<= 1) { const int t = bperm_i((lane + o) & 63, S); if (lane + o < 64) S += t; }
    const unsigned long long ge = __ballot(S >= 256); const int L = 63 - __clzll((long long)ge);
    int above = bperm_i((L + 1) & 63, S); if (L == 63) above = 0;
    const unsigned c3 = (unsigned)bperm_i(L, (int)cb.w), c2 = (unsigned)bperm_i(L, (int)cb.z), c1 = (unsigned)bperm_i(L, (int)cb.y), c0 = (unsigned)bperm_i(L, (int)cb.x);
    int bsel, cur;
    if (above + (int)c3 >= 256) { bsel = 3; cur = above + (int)c3; } else if (above + (int)(c3 + c2) >= 256) { bsel = 2; cur = above + (int)(c3 + c2); }
    else if (above + (int)(c3 + c2 + c1) >= 256) { bsel = 1; cur = above + (int)(c3 + c2 + c1); } else { bsel = 0; cur = above + (int)(c3 + c2 + c1 + c0); }
    if (cur > 352) return compact_q<false>(kq, iq, n, lane, nkeep);
    const unsigned th = lo + ((unsigned)(4 * L + bsel) << sh);
    int base = 0;
#pragma unroll
    for (int i = 0; i < 8; ++i) { const bool keep = val[i] && key[i] >= th; const unsigned long long m = __ballot(keep);
        const int pos = base + __popcll(m & ((1ull << lane) - 1ull)); if (keep) { kq[pos] = key[i]; iq[pos] = idx[i]; } base += __popcll(m); }
    nkeep = cur; return th - 1u;
}

__device__ __forceinline__ void dsa_block(const Params& p, int qb, LAS unsigned char* lds) {
    const int tid = tid_(), w = tid >> 6, lane = tid & 63, fr = lane & 15, fq = lane >> 4, t0 = qb * 32;
    unsigned char* ws = opq(p.ws); const bf16_t* proj = (const bf16_t*)(ws + OFF_PROJ); const bf16_t* kidx = (const bf16_t*)(ws + OFF_SMALL + SM_KIDX); const float* wq = (const float*)(ws + OFF_SMALL + SM_WQ);
    LAS unsigned* ckey = (LAS unsigned*)lds;
    LAS unsigned* cidx = (LAS unsigned*)(lds + 65536);
    LAS unsigned* cnt = (LAS unsigned*)(lds + 131072);
    __syncthreads();
    bf16x8 af[2][2]; f32x4 wr[2]; int tmy[2];
    const int hb = fq & 1, qoff = (fq >> 1) ? w + 8 : w;
#pragma unroll
    for (int m = 0; m < 2; ++m) { const int tqr = t0 + 16 * m + ((fr >> 3) ? w + 8 : w);
#pragma unroll
        for (int kk = 0; kk < 2; ++kk) af[m][kk] = *(const bf16x8*)(proj + (size_t)tqr * LDP + C_IQ + (fr & 7) * 64 + kk * 32 + 8 * fq);
        tmy[m] = t0 + 16 * m + qoff; wr[m] = *(const f32x4*)(wq + (size_t)tmy[m] * 8 + 4 * hb); }
    const unsigned msk = hb ? 0xffffffffu : 0u, lt = (1u << (lane & 31)) - 1u;
    unsigned tauu[2] = {0u, 0u};
    LAS unsigned* hist = (LAS unsigned*)(lds + 132096 + w * 1024);
    float tauf[2] = {-__builtin_inff(), -__builtin_inff()};
    if (tid < 32) cnt[tid] = 0u;
    __syncthreads();
    const int ntile = (t0 + 31) / 128 + 1;
    bf16x8 bfr[8][2], bfn[8][2];
#pragma unroll
    for (int j = 0; j < 8; ++j)
#pragma unroll
        for (int kk = 0; kk < 2; ++kk) bfr[j][kk] = *(const bf16x8*)(kidx + ((size_t)(j * 2 + kk) * 64 + lane) * 8);
#pragma unroll 1
    for (int kt = 0; kt < ntile; ++kt) {
        if (kt + 1 < ntile) {
#pragma unroll
            for (int j = 0; j < 8; ++j)
#pragma unroll
                for (int kk = 0; kk < 2; ++kk) bfn[j][kk] = *(const bf16x8*)(kidx + ((size_t)(((kt + 1) * 8 + j) * 2 + kk) * 64 + lane) * 8); }
        const bool lastt = kt == ntile - 1; const int lim = lastt ? 256 : 384;
#pragma unroll
        for (int m = 0; m < 2; ++m) {
            float pt[8];
#pragma unroll
            for (int j = 0; j < 8; ++j) { f32x4 a = {0.f, 0.f, 0.f, 0.f};
                a = __builtin_amdgcn_mfma_f32_16x16x32_bf16(af[m][0], bfr[j][0], a, 0, 0, 0); a = __builtin_amdgcn_mfma_f32_16x16x32_bf16(af[m][1], bfr[j][1], a, 0, 0, 0);
                pt[j] = wr[m][0] * relu_(a[0]) + wr[m][1] * relu_(a[1]) + wr[m][2] * relu_(a[2]) + wr[m][3] * relu_(a[3]); }
            const int myq = 16 * m + qoff; LAS unsigned* kq = ckey + myq * 512; LAS unsigned* iq = cidx + myq * 512;
#pragma unroll
            for (int i = 0; i < 4; ++i) {
                const auto sw = __builtin_amdgcn_permlane16_swap(__float_as_uint(pt[i]), __float_as_uint(pt[4 + i]), false, false);
                const float v = __uint_as_float(sw[0]) + __uint_as_float(sw[1]);
                const int s = kt * 128 + 16 * (4 * hb + i) + fr;
                if (s <= tmy[m] && v > tauf[m]) {
                    const unsigned pos = __hip_atomic_fetch_add(cnt + myq, 1u, __ATOMIC_RELAXED, __HIP_MEMORY_SCOPE_WORKGROUP);
                    if (pos < 512u) { kq[pos] = sortable(v); iq[pos] = (unsigned)s; } } }
            const int c0 = __builtin_amdgcn_readfirstlane((int)cnt[16 * m + w]), c1 = __builtin_amdgcn_readfirstlane((int)cnt[16 * m + w + 8]);
            if (c0 > lim) { int nk; const int n0 = c0 < 512 ? c0 : 512; const unsigned lo0 = (unsigned)__builtin_amdgcn_readlane((int)tauu[m], 0);
                const unsigned th = lastt ? compact_q<true>(ckey + (16 * m + w) * 512, cidx + (16 * m + w) * 512, n0, lane, nk) : compact_hist(ckey + (16 * m + w) * 512, cidx + (16 * m + w) * 512, n0, lane, nk, hist, lo0);
                if (lane == 0) cnt[16 * m + w] = (unsigned)nk; if (lane < 32) { tauf[m] = unsortable(th); tauu[m] = th; } }
            if (c1 > lim) { int nk; const int n1 = c1 < 512 ? c1 : 512; const unsigned lo1 = (unsigned)__builtin_amdgcn_readlane((int)tauu[m], 32);
                const unsigned th = lastt ? compact_q<true>(ckey + (16 * m + w + 8) * 512, cidx + (16 * m + w + 8) * 512, n1, lane, nk) : compact_hist(ckey + (16 * m + w + 8) * 512, cidx + (16 * m + w + 8) * 512, n1, lane, nk, hist, lo1);
                if (lane == 0) cnt[16 * m + w + 8] = (unsigned)nk; if (lane >= 32) { tauf[m] = unsortable(th); tauu[m] = th; } }
        }
#pragma unroll
        for (int j = 0; j < 8; ++j)
#pragma unroll
            for (int kk = 0; kk < 2; ++kk) bfr[j][kk] = bfn[j][kk];
    }
    __syncthreads();
    LAS unsigned* mk = ckey;
    for (int i = tid; i < 32 * 512; i += 512) mk[i] = 0u;
    __syncthreads();
#pragma unroll 1
    for (int rep = 0; rep < 4; ++rep) { const int q = w + 8 * rep; const int n = min((int)cnt[q], 256);
        for (int e = lane; e < n; e += 64) { const unsigned s = cidx[q * 512 + e]; __hip_atomic_fetch_or(mk + q * 512 + (s >> 5), 1u << (s & 31u), __ATOMIC_RELAXED, __HIP_MEMORY_SCOPE_WORKGROUP); } }
    __syncthreads();
    unsigned long long* mg = (unsigned long long*)(ws + OFF_MASK);
    const int nkt = (((t0 & ~255) + 255) >> 6) + 1;
    for (int i = tid; i < nkt * 32; i += 512) { const int kt = i >> 5, q = i & 31; const unsigned long long lo = mk[q * 512 + 2 * kt], hi2 = mk[q * 512 + 2 * kt + 1];
        mg[(size_t)kt * T_ + t0 + q] = lo | (hi2 << 32); }
}

__device__ __forceinline__ void phase3(const Params& p, LAS unsigned char* lds) {
    const int c = blockIdx.x, tid = tid_();
    if (c < 32) dn_scan(p, c, lds);
    unsigned* queue = (unsigned*)(opq(p.ws) + OFF_SMALL + SM_CTRL) + 200;
    LAS int* tk = (LAS int*)(lds + 131072 + 512);
    for (;;) {
        __syncthreads();
        if (tid == 0) *tk = (int)atomicAdd(queue, 1u);
        __syncthreads();
        const int ticket = *tk;
        if (ticket >= 512) break;
        dsa_block(p, 511 - ticket, lds);
    }
}

__device__ __forceinline__ void dn_out_item(const Params& p, int item, LAS unsigned char* lds) {
    const int tid = tid_(), w = tid >> 6, lane = tid & 63, fr = lane & 15, fq = lane >> 4, m = w & 3, nh = w >> 2, n = item >> 3, h = item & 7;
    unsigned char* ws = opq(p.ws); const bf16_t* proj = (const bf16_t*)(ws + OFF_PROJ);
    const bf16_t* qd = (const bf16_t*)(ws + OFF_DNP + DNP_QD) + (size_t)item * 8192; const bf16_t* attn = (const bf16_t*)(ws + OFF_DNP + DNP_ATT) + (size_t)item * 4096;
    const bf16_t* Sold = (const bf16_t*)(ws + OFF_SCAN) + (size_t)item * 16384; const bf16_t* vnT = (const bf16_t*)(ws + OFF_SCAN + 64 * MB) + (size_t)item * 8192;
    bf16_t* ydn = (bf16_t*)(ws + OFF_Y);
    LAS float* red = (LAS float*)lds;
    f32x4 acc[4];
#pragma unroll
    for (int nt = 0; nt < 4; ++nt) acc[nt] = (f32x4){0.f, 0.f, 0.f, 0.f};
#pragma unroll
    for (int kk = 0; kk < 4; ++kk) { const bf16x8 a = *(const bf16x8*)(qd + (16 * m + fr) * 128 + kk * 32 + 8 * fq);
#pragma unroll
        for (int nt = 0; nt < 4; ++nt) { const bf16x8 b = *(const bf16x8*)(Sold + (size_t)(16 * (4 * nh + nt) + fr) * 128 + kk * 32 + 8 * fq); acc[nt] = __builtin_amdgcn_mfma_f32_16x16x32_bf16(a, b, acc[nt], 0, 0, 0); } }
#pragma unroll
    for (int kk = 0; kk < 2; ++kk) { const bf16x8 a = *(const bf16x8*)(attn + (16 * m + fr) * 64 + kk * 32 + 8 * fq);
#pragma unroll
        for (int nt = 0; nt < 4; ++nt) { const bf16x8 b = *(const bf16x8*)(vnT + (size_t)(16 * (4 * nh + nt) + fr) * 64 + kk * 32 + 8 * fq); acc[nt] = __builtin_amdgcn_mfma_f32_16x16x32_bf16(a, b, acc[nt], 0, 0, 0); } }
    float ssq[4];
#pragma unroll
    for (int j = 0; j < 4; ++j) { float s = 0.f;
#pragma unroll
        for (int nt = 0; nt < 4; ++nt) s += acc[nt][j] * acc[nt][j];
        ssq[j] = sum16(s); }
    __syncthreads();
    if (fr == 0) {
#pragma unroll
        for (int j = 0; j < 4; ++j) red[(16 * m + 4 * fq + j) * 2 + nh] = ssq[j]; }
    __syncthreads();
#pragma unroll
    for (int j = 0; j < 4; ++j) { const int i = 16 * m + 4 * fq + j, t = n * 64 + i; const float rs = rsqrtf((red[i * 2] + red[i * 2 + 1]) * (1.0f / 128.0f) + EPS);
#pragma unroll
        for (int nt = 0; nt < 4; ++nt) { const int dv = 16 * (4 * nh + nt) + fr; const float z = bf2f(proj[(size_t)t * LDP + C_Z + h * 128 + dv]);
            ydn[(size_t)t * 1024 + h * 128 + dv] = f2bf(acc[nt][j] * rs * p.dn_norm_w[dv] * siluf_(z)); } }
}

__device__ __forceinline__ void phase_attn(const Params& p, LAS unsigned char* lds) {
    const int G = gridDim.x, c = blockIdx.x; unsigned char* ws = opq(p.ws);
    const bf16_t* proj = (const bf16_t*)(ws + OFF_PROJ); bf16_t* yat = (bf16_t*)(ws + OFF_Y + 32 * MB); const unsigned long long* mk = (const unsigned long long*)(ws + OFF_MASK);
    typedef att::BlockRef<bf16_t, bf16_t> BR;
    auto mkref = [&](int L, int pass) { const int h = L & 7, x = L >> 3, qb = pass ? 63 - x : x; BR r;
        r.Q = proj + (size_t)qb * 256 * LDP + C_AQ + h * 128; r.K = proj + C_AK + h * 128; r.V = proj + C_AV + h * 128;
        r.O = yat + (size_t)qb * 256 * 1024 + h * 128; r.P0 = qb * 256; r.MK = mk + qb * 256; return r; };
    int L = c;
    if (L < 256) {
        int pass = 0; BR cur = mkref(L, 0); att::Seam<bf16_t> S;
        att::causal_swa_prime<bf16_t, bf16_t>(cur, 1 << 30, (char*)lds, S);
        for (;;) {
            const bool more_pass = pass == 0, more_item = L + G < 256, last = !more_pass && !more_item;
            int passn = pass + 1, Ln = L; if (!more_pass) { passn = 0; Ln = more_item ? L + G : L; }
            const BR nxt = last ? cur : mkref(Ln, passn);
            att::causal_swa_block<bf16_t, bf16_t>(cur, nxt, T_, 1 << 30, (char*)lds, S);
            if (last) break;
            cur = nxt; pass = passn; L = Ln;
        }
    }
    __syncthreads();
    for (int item = c; item < NITEM; item += G) dn_out_item(p, item, lds);
}

__device__ __forceinline__ void phase_router(const Params& p, LAS unsigned char* lds) {
    const int G = gridDim.x, c = blockIdx.x, tid = tid_(), w = tid >> 6, lane = tid & 63, fr = lane & 15, fq = lane >> 4;
    unsigned char* ws = opq(p.ws); const float* x1 = (const float*)(ws + OFF_X1); bf16_t* h2 = (bf16_t*)(ws + OFF_H);
    int* rexp = (int*)(ws + OFF_SMALL + SM_ROUTE); float* rwt = (float*)(ws + OFF_SMALL + SM_ROUTE + 128 * 1024);
    unsigned* ecnt = (unsigned*)(ws + OFF_SMALL + SM_CTRL);
    const bf16_t* wh = (const bf16_t*)(ws + OFF_WR); const bf16_t* wl = (const bf16_t*)(ws + OFF_WR + 512 * 1024);
    constexpr int HS = 2056;
    LAS bf16_t* hiL = (LAS bf16_t*)lds; LAS bf16_t* loL = hiL + 16 * HS;
    LAS float* red = (LAS float*)lds;
    LAS float* lgt = (LAS float*)(lds + 133120);
    for (int tile = c; tile < T_ / 16; tile += G) {
        const int tb = tile * 16;
        __syncthreads();
#pragma unroll 1
        for (int rep = 0; rep < 2; ++rep) { const int tl = 2 * w + rep, t = tb + tl; const float* xr = x1 + (size_t)t * 2048; f32x4 v[8]; float ss = 0.f;
#pragma unroll
            for (int i = 0; i < 8; ++i) { v[i] = *(const f32x4*)(xr + i * 256 + 4 * lane); ss += v[i][0] * v[i][0] + v[i][1] * v[i][1] + v[i][2] * v[i][2] + v[i][3] * v[i][3]; }
            ss = wave_sum(ss); const float rs = rsqrtf(ss * (1.0f / 2048.0f) + EPS);
#pragma unroll
            for (int i = 0; i < 8; ++i) { const int k = i * 256 + 4 * lane; const f32x4 g = *(const f32x4*)(p.norm_ffn + k);
                const float a0 = v[i][0] * rs * g[0], a1 = v[i][1] * rs * g[1], a2 = v[i][2] * rs * g[2], a3 = v[i][3] * rs * g[3];
                u32x2 ph; ph.x = pack2(a0, a1); ph.y = pack2(a2, a3);
                u32x2 pl; pl.x = pack2(a0 - bflo(ph.x), a1 - bfhi(ph.x)); pl.y = pack2(a2 - bflo(ph.y), a3 - bfhi(ph.y));
                *(u32x2*)(h2 + (size_t)t * 2048 + k) = ph;
                *(LAS u32x2*)(hiL + tl * HS + k) = ph; *(LAS u32x2*)(loL + tl * HS + k) = pl; } }
        __syncthreads();
        f32x4 acc[5];
#pragma unroll
        for (int j = 0; j < 5; ++j) acc[j] = (f32x4){0.f, 0.f, 0.f, 0.f};
#pragma unroll 2
        for (int kk = 0; kk < 8; ++kk) { const int ks = 8 * w + kk;
            const bf16x8 ah = *(const LAS bf16x8*)(hiL + fr * HS + 32 * ks + 8 * fq), al = *(const LAS bf16x8*)(loL + fr * HS + 32 * ks + 8 * fq);
#pragma unroll
            for (int j = 0; j < 5; ++j) { const size_t o = ((size_t)(j * 64 + ks) * 64 + lane) * 8; const bf16x8 bh = *(const bf16x8*)(wh + o), bl = *(const bf16x8*)(wl + o);
                acc[j] = __builtin_amdgcn_mfma_f32_16x16x32_bf16(ah, bh, acc[j], 0, 0, 0);
                acc[j] = __builtin_amdgcn_mfma_f32_16x16x32_bf16(ah, bl, acc[j], 0, 0, 0);
                acc[j] = __builtin_amdgcn_mfma_f32_16x16x32_bf16(al, bh, acc[j], 0, 0, 0); } }
        __syncthreads();
#pragma unroll
        for (int j = 0; j < 5; ++j)
#pragma unroll
            for (int r = 0; r < 4; ++r) red[(w * 16 + 4 * fq + r) * 80 + 16 * j + fr] = acc[j][r];
        __syncthreads();
        for (int o = tid; o < 16 * 80; o += 512) { float sacc = 0.f;
#pragma unroll
            for (int ww = 0; ww < 8; ++ww) sacc += red[ww * 1280 + o];
            lgt[o] = sacc; }
        __syncthreads();
        if (tid < 16) { const int t = tb + tid; LAS float* l = lgt + tid * 80;
            float gmax = -3.0e38f; int gs = 0; float gl[8];
#pragma unroll
            for (int g = 0; g < 8; ++g) { gl[g] = l[64 + g] + p.b_group[g]; if (gl[g] > gmax) { gmax = gl[g]; gs = g; } }
            float gsum = 0.f;
#pragma unroll
            for (int g = 0; g < 8; ++g) gsum += __expf(gl[g] - gmax);
            const float pg = 1.0f / gsum;
            float el[8]; float m1 = -3.0e38f, m2 = -3.0e38f; int i1 = 0, i2 = 0;
#pragma unroll
            for (int e = 0; e < 8; ++e) { el[e] = l[gs * 8 + e] + p.b_router[gs * 8 + e]; }
#pragma unroll
            for (int e = 0; e < 8; ++e) if (el[e] > m1) { m1 = el[e]; i1 = e; }
#pragma unroll
            for (int e = 0; e < 8; ++e) if (e != i1 && el[e] > m2) { m2 = el[e]; i2 = e; }
            const float e2 = __expf(m2 - m1); const float w1 = pg / (1.0f + e2), w2 = pg * e2 / (1.0f + e2);
            const int ex1 = gs * 8 + i1, ex2 = gs * 8 + i2;
            rexp[t * 2] = ex1; rexp[t * 2 + 1] = ex2; rwt[t * 2] = w1; rwt[t * 2 + 1] = w2;
            atomicAdd(ecnt + ex1, 1u); atomicAdd(ecnt + ex2, 1u); }
    }
}

__device__ __forceinline__ void expert_starts(const unsigned* ecnt, LAS int* pstart, int tid) {
    if (tid < 64) { const int cn = (int)ecnt[tid]; const int pad = (cn + 127) / 128 * 128; int s = pad;
        for (int o = 1; o < 64; o <<= 1) { const int u = shfl_up_(s, o); if (tid >= o) s += u; }
        pstart[tid] = s - pad; if (tid == 63) pstart[64] = s; }
}
__device__ __forceinline__ void phase_slots(const Params& p, LAS unsigned char* lds) {
    const int G = gridDim.x, c = blockIdx.x, tid = tid_();
    unsigned char* ws = opq(p.ws); const unsigned* ecnt = (const unsigned*)(ws + OFF_SMALL + SM_CTRL); unsigned* fill = (unsigned*)(ws + OFF_SMALL + SM_CTRL) + 64;
    const int* rexp = (const int*)(ws + OFF_SMALL + SM_ROUTE); int* rpos = (int*)(ws + OFF_SMALL + SM_ROUTE + 256 * 1024); int* rowtok = (int*)(ws + OFF_ROWTOK);
    LAS int* pstart = (LAS int*)lds;
    __syncthreads();
    expert_starts(ecnt, pstart, tid);
    __syncthreads();
    for (int a = c * 512 + tid; a < 2 * T_; a += G * 512) { const int e = rexp[a]; const int pos = pstart[e] + (int)atomicAdd(fill + e, 1u); rpos[a] = pos; rowtok[pos] = a >> 1; }
}

#define MOE_BAR() do { asm volatile("s_waitcnt lgkmcnt(0)" ::: "memory"); __builtin_amdgcn_s_barrier(); asm volatile("" ::: "memory"); } while (0)
__device__ __forceinline__ void vm_wait(int n) {
    if (n >= 20) asm volatile("s_waitcnt vmcnt(20)" ::: "memory"); else if (n >= 16) asm volatile("s_waitcnt vmcnt(16)" ::: "memory");
    else if (n >= 14) asm volatile("s_waitcnt vmcnt(14)" ::: "memory"); else if (n >= 12) asm volatile("s_waitcnt vmcnt(12)" ::: "memory");
    else if (n >= 10) asm volatile("s_waitcnt vmcnt(10)" ::: "memory"); else if (n >= 8) asm volatile("s_waitcnt vmcnt(8)" ::: "memory");
    else if (n >= 6) asm volatile("s_waitcnt vmcnt(6)" ::: "memory"); else if (n >= 4) asm volatile("s_waitcnt vmcnt(4)" ::: "memory");
    else if (n >= 2) asm volatile("s_waitcnt vmcnt(2)" ::: "memory"); else asm volatile("s_waitcnt vmcnt(0)" ::: "memory");
}
template <int MODE, int NT>
__device__ __forceinline__ void moe_kloop(const Params& p, LAS unsigned char* lds, int e, int nt, int rs, int cnt) {
    constexpr int K = MODE == 0 ? 2048 : 512, NK = K / 64, WLD = MODE == 0 ? 512 : 2048, NA = NT ? NT : 1;
    const int tid = tid_(), w = __builtin_amdgcn_readfirstlane(tid >> 6), lane = tid & 63, fr = lane & 15, fq = lane >> 4;
    unsigned char* ws = opq(p.ws);
    LAS float* Rw = (LAS float*)(lds + w * 4096);
    LAS bf16_t* Wb0 = (LAS bf16_t*)(lds + 32768);
    LAS unsigned char* Ar = lds + 69632 + w * 10240;
    LAS int* tokl = (LAS int*)(lds + 151552);
    const bf16_t* Asrc = (const bf16_t*)(ws + (MODE == 0 ? OFF_H : OFF_ACT));
    const float* W0; const float* W1;
    if (MODE == 0) { W0 = p.w_exp_gate + (size_t)e * 2048 * 512 + nt * 64; W1 = p.w_exp_up + (size_t)e * 2048 * 512 + nt * 64; }
    else { W0 = p.w_exp_down + (size_t)e * 512 * 2048 + nt * 128; W1 = W0 + 64; }
    auto issueA = [&](int ks) {
#pragma unroll 1
        for (int mt = 0; mt < NT; ++mt)
#pragma unroll
            for (int i = 0; i < 2; ++i) { const int pch = lane + 64 * i, r = pch >> 3, csrc = (pch & 7) ^ (r & 7);
                const size_t row = MODE == 0 ? (size_t)tokl[mt * 128 + 16 * w + r] * 2048 : (size_t)(rs + mt * 128 + 16 * w + r) * 512;
                __builtin_amdgcn_global_load_lds((const unsigned*)(Asrc + row + ks * 64 + csrc * 8), (LAS unsigned*)(Ar + mt * 2048 + pch * 16), 16, 0, 0); } };
    auto issueW = [&](int ks) {
#pragma unroll
        for (int i = 0; i < 4; ++i) { const int pch = lane + 64 * i, r = pch >> 5, cc = pch & 31;
            const float* src = (cc < 16 ? W0 + 4 * cc : W1 + 4 * (cc - 16)) + (size_t)(ks * 64 + 8 * w + r) * WLD;
            __builtin_amdgcn_global_load_lds((const unsigned*)src, (LAS unsigned*)((LAS unsigned char*)Rw + pch * 16), 16, 0, 0); } };
    auto convertW = [&](int buf) {
        LAS bf16_t* Wb = Wb0 + buf * (128 * 72);
#pragma unroll
        for (int c2 = 0; c2 < 2; ++c2) { const int nm = lane + 64 * c2; float v[8];
#pragma unroll
            for (int r = 0; r < 8; ++r) v[r] = Rw[r * 128 + nm];
            const int nrow = MODE == 0 ? (((nm & 63) >> 4) * 2 + (nm >> 6)) * 16 + (nm & 15) : nm;
            u32x4 pk; pk.x = pack2(v[0], v[1]); pk.y = pack2(v[2], v[3]); pk.z = pack2(v[4], v[5]); pk.w = pack2(v[6], v[7]);
            *(LAS u32x4*)(Wb + nrow * 72 + 8 * w) = pk; } };
    f32x4 acc[NA][8];
#pragma unroll
    for (int a = 0; a < NA; ++a)
#pragma unroll
        for (int n = 0; n < 8; ++n) acc[a][n] = (f32x4){0.f, 0.f, 0.f, 0.f};
    issueW(0); asm volatile("s_waitcnt vmcnt(0)" ::: "memory"); convertW(0);
    asm volatile("s_waitcnt lgkmcnt(0)" ::: "memory");
    issueA(0);
    if (NK > 1) issueW(1);
#pragma unroll 1
    for (int ks = 0; ks < NK; ++ks) {
        MOE_BAR();
        const LAS bf16_t* Wb = Wb0 + (ks & 1) * (128 * 72);
        if (ks + 1 < NK) asm volatile("s_waitcnt vmcnt(4)" ::: "memory");
        else asm volatile("s_waitcnt vmcnt(0)" ::: "memory");
        bf16x8 af[NA][2];
#pragma unroll
        for (int mt = 0; mt < NT; ++mt)
#pragma unroll
            for (int k2 = 0; k2 < 2; ++k2) af[mt][k2] = *(const LAS bf16x8*)(Ar + mt * 2048 + (fr * 8 + ((4 * k2 + fq) ^ (fr & 7))) * 16);
        if (NT > 0 && ks + 1 < NK) { asm volatile("s_waitcnt lgkmcnt(0)" ::: "memory"); issueA(ks + 1); }
#pragma unroll
        for (int k2 = 0; k2 < 2; ++k2)
#pragma unroll
            for (int n = 0; n < 8; ++n) { const bf16x8 b = *(const LAS bf16x8*)(Wb + (16 * n + fr) * 72 + 32 * k2 + 8 * fq);
#pragma unroll
                for (int mt = 0; mt < NT; ++mt) acc[mt][n] = __builtin_amdgcn_mfma_f32_16x16x32_bf16(b, af[mt][k2], acc[mt][n], 0, 0, 0); }
        if (ks + 1 < NK) {
            if (NT == 0) asm volatile("s_waitcnt vmcnt(0)" ::: "memory"); else vm_wait(2 * NT);
            convertW((ks + 1) & 1);
            asm volatile("s_waitcnt lgkmcnt(0)" ::: "memory");
            if (ks + 2 < NK) issueW(ks + 2);
        }
    }
#pragma unroll
    for (int mt = 0; mt < NT; ++mt) { const int rl = mt * 128 + 16 * w + fr;
        if (rl < cnt) {
            if (MODE == 0) { bf16_t* dst = (bf16_t*)(ws + OFF_ACT) + (size_t)(rs + rl) * 512 + nt * 64 + 4 * fq;
#pragma unroll
                for (int g = 0; g < 4; ++g) { const f32x4 gt = acc[mt][2 * g], u = acc[mt][2 * g + 1];
                    u32x2 pk; pk.x = pack2(siluf_(gt[0]) * u[0], siluf_(gt[1]) * u[1]); pk.y = pack2(siluf_(gt[2]) * u[2], siluf_(gt[3]) * u[3]); *(u32x2*)(dst + 16 * g) = pk; } }
            else { bf16_t* dst = (bf16_t*)(ws + OFF_YE) + (size_t)(rs + rl) * 2048 + nt * 128 + 4 * fq;
#pragma unroll
                for (int n = 0; n < 8; ++n) { const f32x4 v = acc[mt][n]; u32x2 pk; pk.x = pack2(v[0], v[1]); pk.y = pack2(v[2], v[3]); *(u32x2*)(dst + 16 * n) = pk; } } } }
    asm volatile("s_waitcnt vmcnt(0)" ::: "memory");
}
template <int MODE>
__device__ __forceinline__ void moe_item(const Params& p, LAS unsigned char* lds, int e, int nt, int rs, int cnt) {
    const int tid = tid_(), w = __builtin_amdgcn_readfirstlane(tid >> 6);
    unsigned char* ws = opq(p.ws); LAS int* tokl = (LAS int*)(lds + 151552);
    MOE_BAR();
    if (MODE == 0) { const int* rowtok = (const int*)(ws + OFF_ROWTOK); for (int i = tid; i < 640; i += 512) tokl[i] = rowtok[rs + (i < cnt ? i : 0)]; }
    MOE_BAR();
    const int mine = cnt - 16 * w; const int ntw = mine <= 0 ? 0 : (mine + 127) >> 7;
    if (ntw >= 5) moe_kloop<MODE, 5>(p, lds, e, nt, rs, cnt);
    else if (ntw == 4) moe_kloop<MODE, 4>(p, lds, e, nt, rs, cnt);
    else if (ntw == 3) moe_kloop<MODE, 3>(p, lds, e, nt, rs, cnt);
    else if (ntw == 2) moe_kloop<MODE, 2>(p, lds, e, nt, rs, cnt);
    else if (ntw == 1) moe_kloop<MODE, 1>(p, lds, e, nt, rs, cnt);
    else moe_kloop<MODE, 0>(p, lds, e, nt, rs, cnt);
}
template <int MODE>
__device__ __forceinline__ void phase_moe(const Params& p, LAS unsigned char* lds) {
    const int G = gridDim.x, c = blockIdx.x, tid = tid_();
    unsigned char* ws = opq(p.ws); const unsigned* ecnt = (const unsigned*)(ws + OFF_SMALL + SM_CTRL);
    LAS int* pstart = (LAS int*)(lds + 154112); LAS int* order = pstart + 80;
    __syncthreads();
    expert_starts(ecnt, pstart, tid);
    if (tid < 64) { const unsigned mine = ecnt[tid]; int rk = 0;
        for (int j = 0; j < 64; ++j) { const unsigned o = ecnt[j]; rk += (o > mine || (o == mine && j < tid)) ? 1 : 0; }
        order[rk] = tid; }
    __syncthreads();
    constexpr int PER = MODE == 0 ? 8 : 16;
    if (G == 256) {
        const int x = c & 7, sl = c >> 3, kk = sl / PER, nt = sl % PER; constexpr int EPR = 256 / PER;
        for (int j = 0; j < 64 / EPR; ++j) { const int within = 8 * kk + x; const int rnk = EPR * j + ((j & 1) ? EPR - 1 - within : within);
            const int e = order[rnk]; const int cn = (int)ecnt[e], rs = pstart[e];
            for (int seg = 0; seg < cn; seg += 640) moe_item<MODE>(p, lds, e, nt, rs + seg, min(cn - seg, 640)); }
    } else {
        for (int it = c; it < 64 * PER; it += G) { const int e = it / PER, nt = it % PER; const int cn = (int)ecnt[e], rs = pstart[e];
            for (int seg = 0; seg < cn; seg += 640) moe_item<MODE>(p, lds, e, nt, rs + seg, min(cn - seg, 640)); }
    }
    __syncthreads();
}

__device__ __forceinline__ void phase_final(const Params& p) {
    const int G = gridDim.x, c = blockIdx.x, tid = tid_(), w = tid >> 6, lane = tid & 63;
    unsigned char* ws = opq(p.ws); const float* x1 = (const float*)(ws + OFF_X1); const bf16_t* ye = (const bf16_t*)(ws + OFF_YE);
    const float* rwt = (const float*)(ws + OFF_SMALL + SM_ROUTE + 128 * 1024); const int* rpos = (const int*)(ws + OFF_SMALL + SM_ROUTE + 256 * 1024);
    for (int t = c * 8 + w; t < T_; t += G * 8) {
        const float w0 = rwt[t * 2], w1 = rwt[t * 2 + 1]; const bf16_t* y0 = ye + (size_t)rpos[t * 2] * 2048; const bf16_t* y1 = ye + (size_t)rpos[t * 2 + 1] * 2048;
        f32x4 v[8]; float ss = 0.f;
#pragma unroll
        for (int i = 0; i < 8; ++i) { const int k = i * 256 + 4 * lane; v[i] = *(const f32x4*)(x1 + (size_t)t * 2048 + k);
            const u32x2 a = *(const u32x2*)(y0 + k), b = *(const u32x2*)(y1 + k);
            v[i][0] += w0 * bflo(a.x) + w1 * bflo(b.x); v[i][1] += w0 * bfhi(a.x) + w1 * bfhi(b.x); v[i][2] += w0 * bflo(a.y) + w1 * bflo(b.y); v[i][3] += w0 * bfhi(a.y) + w1 * bfhi(b.y);
            ss += v[i][0] * v[i][0] + v[i][1] * v[i][1] + v[i][2] * v[i][2] + v[i][3] * v[i][3]; }
        ss = wave_sum(ss); const float rs = rsqrtf(ss * (1.0f / 2048.0f) + EPS);
#pragma unroll
        for (int i = 0; i < 8; ++i) { const int k = i * 256 + 4 * lane; const f32x4 g = *(const f32x4*)(p.norm_final + k);
            f32x4 o; o[0] = v[i][0] * rs * g[0]; o[1] = v[i][1] * rs * g[1]; o[2] = v[i][2] * rs * g[2]; o[3] = v[i][3] * rs * g[3];
            *(f32x4*)(p.out + (size_t)t * 2048 + k) = o; }
    }
}

template <int PH>
__device__ __forceinline__ void run_phase(const Params& p, LAS unsigned char* lds) {
    const int G = gridDim.x, c = blockIdx.x; unsigned char* ws = opq(p.ws);
    if constexpr (PH == 0) phase0(p, lds);
    if constexpr (PH == 1) { pg8::DenseOrder S; S.init(ws + OFF_H, ws + OFF_WT_IN, T_, LDP, 2048, G, c); EpiProj E; E.O = (bf16_t*)(ws + OFF_PROJ); pg8::gemm_phase(lds, 2048, S, E); }
    if constexpr (PH == 2) { phase_rope(p); u32x4 xr[3][2][4]; float ba[2]; if (c < NITEM) dn_prep_load(p, c, xr, ba);
        for (int item = c; item < NITEM; item += G) dn_prep_item(p, item, item + G < NITEM ? item + G : -1, lds, xr, ba); }
    if constexpr (PH == 3) phase3(p, lds);
    if constexpr (PH == 4) phase_attn(p, lds);
    if constexpr (PH == 5) { pg8::DenseOrder S; S.init(ws + OFF_Y, ws + OFF_WT_DN, T_, 2048, 1024, G, c); EpiMerge<0> E; E.M = (bf16_t*)(ws + OFF_H); E.proj = (const bf16_t*)(ws + OFF_PROJ); E.bg = p.b_gates; pg8::gemm_phase(lds, 1024, S, E);
              pg8::DenseOrder S2; S2.init(ws + OFF_Y + 32 * MB, ws + OFF_WT_AT, T_, 2048, 1024, G, c); EpiMerge<1> E2; E2.M = E.M; E2.proj = E.proj; E2.bg = p.b_gates; pg8::gemm_phase(lds, 1024, S2, E2); }
    if constexpr (PH == 6) { pg8::DenseOrder S; S.init(ws + OFF_H, ws + OFF_WT_OUT, T_, 2048, 2048, G, c); EpiResid E; E.X1 = (float*)(ws + OFF_X1); E.X = p.x; pg8::gemm_phase(lds, 2048, S, E); }
    if constexpr (PH == 7) phase_router(p, lds);
    if constexpr (PH == 8) phase_slots(p, lds);
    if constexpr (PH == 9) phase_moe<0>(p, lds);
    if constexpr (PH == 10) phase_moe<1>(p, lds);
    if constexpr (PH == 11) phase_final(p);
}

template <int PH>
__device__ __forceinline__ void phase_step(const Params& p, LAS unsigned char* lds, cg::grid_group& grid, const XcdBarrier& xb, unsigned long long& tp) {
#ifdef ONLY_PHASE
    if constexpr (PH != ONLY_PHASE) return;
#endif
    unsigned long long t0 = 0;
    if constexpr (PH == PROBE_PHASE) t0 = __builtin_amdgcn_s_memrealtime();
    run_phase<PH>(p, lds);
    if constexpr (PH + 1 < NPHASE) { if constexpr (PH == 0) grid.sync(); else xcd_barrier(xb); }
    if constexpr (PH == PROBE_PHASE) tp = __builtin_amdgcn_s_memrealtime() - t0;
}

__global__ void __launch_bounds__(512, 2) mega_kernel(Params p) {
    extern __shared__ __attribute__((aligned(16))) unsigned char shm[];
    LAS unsigned char* lds = (LAS unsigned char*)shm;
    cg::grid_group grid = cg::this_grid();
    volatile LAS unsigned* xst = (volatile LAS unsigned*)(lds + LDS_BYTES - 16);
    if (threadIdx.x == 0) { xst[0] = 0u; xst[1] = 0u; }
    __syncthreads();
    const XcdBarrier xb = xcd_barrier_post((unsigned*)(p.ws + OFF_SMALL + SM_BAR), xst);
    unsigned long long tp = 0;
    phase_step<0>(p, lds, grid, xb, tp); phase_step<1>(p, lds, grid, xb, tp); phase_step<2>(p, lds, grid, xb, tp); phase_step<3>(p, lds, grid, xb, tp);
    phase_step<4>(p, lds, grid, xb, tp); phase_step<5>(p, lds, grid, xb, tp); phase_step<6>(p, lds, grid, xb, tp); phase_step<7>(p, lds, grid, xb, tp);
    phase_step<8>(p, lds, grid, xb, tp); phase_step<9>(p, lds, grid, xb, tp); phase_step<10>(p, lds, grid, xb, tp); phase_step<11>(p, lds, grid, xb, tp);
#if PROBE_PHASE >= 0
    if (blockIdx.x == 0) { const unsigned long long te = __builtin_amdgcn_s_memrealtime(); while (__builtin_amdgcn_s_memrealtime() - te < (unsigned long long)PROBE_MULT * tp) __builtin_amdgcn_s_sleep(8); }
#endif
}

extern "C" void kernel_launch(void* const* d_in, const int* in_sizes, int n_in, void* d_out, int out_size, void* d_ws, size_t ws_size, hipStream_t stream) {
    (void)in_sizes; (void)n_in; (void)out_size;
    static int grid_blocks = 0;
    if (!grid_blocks) {
        int dev = 0, cus = 0, per_cu = 0;
        hipGetDevice(&dev);
        hipDeviceGetAttribute(&cus, hipDeviceAttributeMultiprocessorCount, dev);
        hipFuncSetAttribute((const void*)mega_kernel, hipFuncAttributeMaxDynamicSharedMemorySize, LDS_BYTES);
        hipOccupancyMaxActiveBlocksPerMultiprocessor(&per_cu, mega_kernel, 512, LDS_BYTES);
        if (per_cu > 1) per_cu = 1;
        grid_blocks = cus * per_cu;
        if (grid_blocks <= 0) { fprintf(stderr, "occupancy query failed\n"); grid_blocks = 0; return; }
    }
    if (ws_size < WS_NEED) { fprintf(stderr, "workspace too small: %zu < %zu\n", ws_size, (size_t)WS_NEED); return; }
    Params p{};
    p.x = (const float*)d_in[0]; p.positions = (const int*)d_in[1]; p.norm_mix = (const float*)d_in[2]; p.w_in = (const float*)d_in[3]; p.b_gates = (const float*)d_in[4];
    p.conv_w = (const float*)d_in[5]; p.a_log = (const float*)d_in[6]; p.dt_bias = (const float*)d_in[7]; p.dn_norm_w = (const float*)d_in[8]; p.idx_k_norm = (const float*)d_in[9];
    p.w_proj_dn = (const float*)d_in[10]; p.w_proj_att = (const float*)d_in[11]; p.w_out = (const float*)d_in[12]; p.norm_ffn = (const float*)d_in[13]; p.w_group = (const float*)d_in[14];
    p.b_group = (const float*)d_in[15]; p.w_router = (const float*)d_in[16]; p.b_router = (const float*)d_in[17]; p.w_exp_gate = (const float*)d_in[18]; p.w_exp_up = (const float*)d_in[19];
    p.w_exp_down = (const float*)d_in[20]; p.norm_final = (const float*)d_in[21]; p.out = (float*)d_out; p.ws = (unsigned char*)d_ws;
    (void)hipMemsetAsync((unsigned char*)d_ws + OFF_SMALL + SM_BAR, 0, XCD_BAR_WORDS * 4, stream);
    void* args[] = {&p};
    hipError_t e = hipLaunchCooperativeKernel((const void*)mega_kernel, dim3(grid_blocks), dim3(512), args, LDS_BYTES, stream);
    if (e != hipSuccess) fprintf(stderr, "cooperative launch failed: %s (grid %d)\n", hipGetErrorString(e), grid_blocks);
}
```

```cpp
#include <hip/hip_runtime.h>
#include <hip/hip_cooperative_groups.h>
#include <cstdio>
#include <cstdint>
namespace cg = cooperative_groups;

#define LAS __attribute__((address_space(3)))
typedef unsigned short bf16_t;
typedef short bf16x8 __attribute__((ext_vector_type(8)));
typedef float f32x4 __attribute__((ext_vector_type(4)));
typedef float f32x2 __attribute__((ext_vector_type(2)));
typedef unsigned u32x4 __attribute__((ext_vector_type(4)));
typedef unsigned u32x2 __attribute__((ext_vector_type(2)));

#ifndef PROBE_PHASE
#define PROBE_PHASE -1
#endif
#define PROBE_MULT 8
#ifndef SINGLE_LAUNCH
#define SINGLE_LAUNCH 1
#endif

constexpr int T_ = 16384, D_ = 2048, IN_COLS = 11864, LDP = 12032;
constexpr int C_DNQ = 0, C_DNK = 1024, C_DNV = 2048, C_Z = 3072, C_AQ = 4096, C_AK = 5120, C_AV = 6144, C_IQ = 7168,
              C_G0 = 7680, C_G1 = 9728, C_IK = 11776, C_B = 11840, C_A = 11848, C_IW = 11856;
constexpr int NITEM = 2048;
constexpr int PMAX = 40960;
constexpr float EPS = 1e-6f;
constexpr int LDS_BYTES = 156 * 1024;
constexpr int NPHASE = 12;

constexpr size_t MB = 1ull << 20;
constexpr size_t OFF_WT_IN  = 0;
constexpr size_t OFF_WT_DN  = 50 * MB;
constexpr size_t OFF_WT_AT  = 55 * MB;
constexpr size_t OFF_WT_OUT = 60 * MB;
constexpr size_t OFF_COS    = 54 * MB;
constexpr size_t OFF_SIN    = 59 * MB;
constexpr size_t OFF_WR     = 68 * MB;
constexpr size_t OFF_SMALL  = 69 * MB;
constexpr size_t OFF_H      = 72 * MB;
constexpr size_t OFF_PROJ   = 136 * MB;
constexpr size_t OFF_DNP    = 512 * MB;
constexpr size_t OFF_SCAN   = 656 * MB;
constexpr size_t OFF_Y      = 752 * MB;
constexpr size_t OFF_X1     = 816 * MB;
constexpr size_t WS_NEED    = 944 * MB;
constexpr size_t OFF_MASK   = 816 * MB;
constexpr size_t OFF_ROWTOK = 520 * MB;
constexpr size_t OFF_YE     = 528 * MB;
constexpr size_t OFF_ACT    = 712 * MB;
constexpr size_t SM_KIDX   = 0;
constexpr size_t SM_WQ     = 2 * MB;
constexpr size_t SM_ROUTE  = 2 * MB + 512 * 1024;
constexpr size_t SM_GLAST  = 2 * MB + 960 * 1024;
constexpr size_t SM_CTRL   = 2 * MB + 1000 * 1024;
constexpr size_t SM_BAR    = 2 * MB + 1008 * 1024;
constexpr size_t DNP_W = 0, DNP_UT = 32 * MB, DNP_QD = 64 * MB, DNP_KDT = 96 * MB, DNP_ATT = 128 * MB;

struct Params {
    const float* x; const int* positions; const float* norm_mix; const float* w_in; const float* b_gates; const float* conv_w;
    const float* a_log; const float* dt_bias; const float* dn_norm_w; const float* idx_k_norm; const float* w_proj_dn;
    const float* w_proj_att; const float* w_out; const float* norm_ffn; const float* w_group; const float* b_group;
    const float* w_router; const float* b_router; const float* w_exp_gate; const float* w_exp_up; const float* w_exp_down;
    const float* norm_final; float* out; unsigned char* ws;
};

__device__ __forceinline__ int tid_() { int t = threadIdx.x; asm volatile("" : "+v"(t)); return t; }
__device__ __forceinline__ unsigned char* opq(unsigned char* q) { unsigned long long z = 0ull; asm volatile("" : "+s"(z)); return q + z; }
__device__ __forceinline__ bf16_t f2bf(float f) { unsigned u = __float_as_uint(f); u += 0x7fffu + ((u >> 16) & 1u); return (bf16_t)(u >> 16); }
__device__ __forceinline__ float bf2f(bf16_t b) { return __uint_as_float(((unsigned)b) << 16); }
__device__ __forceinline__ unsigned pack2(float lo, float hi) { return (unsigned)f2bf(lo) | ((unsigned)f2bf(hi) << 16); }
__device__ __forceinline__ float bflo(unsigned w) { return __uint_as_float(w << 16); }
__device__ __forceinline__ float bfhi(unsigned w) { return __uint_as_float(w & 0xffff0000u); }
__device__ __forceinline__ float sigmoidf_(float x) { return 1.0f / (1.0f + __expf(-x)); }
__device__ __forceinline__ float siluf_(float x) { return x / (1.0f + __expf(-x)); }
template <int CTRL> __device__ __forceinline__ float dpp_f(float v) { return __int_as_float(__builtin_amdgcn_update_dpp(0, __float_as_int(v), CTRL, 0xf, 0xf, true)); }
__device__ __forceinline__ float sum16(float v) {
    v += dpp_f<0xB1>(v); v += dpp_f<0x4E>(v); v += dpp_f<0x141>(v); v += dpp_f<0x140>(v); return v;
}
__device__ __forceinline__ int lane_() { return tid_() & 63; }
__device__ __forceinline__ int bperm_i(int srclane, int v) { return __builtin_amdgcn_ds_bpermute(srclane << 2, v); }
__device__ __forceinline__ float shfl_xor_(float v, int o) { return __int_as_float(bperm_i(lane_() ^ o, __float_as_int(v))); }
__device__ __forceinline__ int shfl_xor_(int v, int o) { return bperm_i(lane_() ^ o, v); }
__device__ __forceinline__ float shfl_(float v, int src) { return __int_as_float(bperm_i(src, __float_as_int(v))); }
__device__ __forceinline__ int shfl_(int v, int src) { return bperm_i(src, v); }
__device__ __forceinline__ float shfl_up_(float v, int o) { return __int_as_float(bperm_i((lane_() - o) & 63, __float_as_int(v))); }
__device__ __forceinline__ int shfl_up_(int v, int o) { return bperm_i((lane_() - o) & 63, v); }
__device__ __forceinline__ float wave_sum(float v) { for (int o = 32; o >= 1; o >>= 1) v += shfl_xor_(v, o); return v; }

#define XB_TMO      128
#define XB_XCNT(j)  (256  + 64 * (j))
#define XB_XSUB(j)  (1280 + 64 * (j))
#define XB_XGEN(j)  (2304 + 64 * (j))
#define XB_TOP      3328
#define XB_TOPGEN   3392
#define XCD_BAR_WORDS 3456
#define XB_SPIN_CAP (1u << 18)

__device__ __forceinline__ unsigned xb_ld(unsigned* p)              { return __hip_atomic_load(p, __ATOMIC_RELAXED, __HIP_MEMORY_SCOPE_AGENT); }
__device__ __forceinline__ unsigned xb_add(unsigned* p, unsigned v) { return __hip_atomic_fetch_add(p, v, __ATOMIC_RELAXED, __HIP_MEMORY_SCOPE_AGENT); }
__device__ __forceinline__ unsigned xb_xcc_id() { return (unsigned)__builtin_amdgcn_s_getreg((3 << 11) | 20) & 0xFu; }
#define XB_SPIN(cond, bar) do { unsigned _sp = 0; while (cond) { __builtin_amdgcn_s_sleep(1); \
    if ((++_sp & 255u) == 0u) { if (xb_ld(&(bar)[XB_TMO])) break; if (_sp > XB_SPIN_CAP) { atomicAdd(&(bar)[XB_TMO], 1u); break; } } } } while (0)

struct XcdBarrier {
    unsigned* bar; unsigned x;
    volatile LAS unsigned* st;
};

__device__ __forceinline__ XcdBarrier xcd_barrier_post(unsigned* bar, volatile LAS unsigned* st) {
    XcdBarrier b; b.bar = bar; b.x = xb_xcc_id(); b.st = st;
    if (threadIdx.x == 0) (void)xb_add(&bar[XB_XCNT(b.x)], 1u);
    return b;
}
__device__ __forceinline__ void xcd_barrier_complete(unsigned* bar, unsigned x, unsigned& nloc, unsigned& nx) {
    const unsigned G = gridDim.x * gridDim.y * gridDim.z;
    unsigned sum, cnt, mine, sp = 0u;
    for (;;) {
        sum = 0u; cnt = 0u; mine = 0u;
#pragma unroll
        for (unsigned j = 0; j < 16; ++j) { const unsigned c = xb_ld(&bar[XB_XCNT(j)]); sum += c; cnt += (c > 0u) ? 1u : 0u; mine = (j == x) ? c : mine; }
        if (sum == G) break;
        __builtin_amdgcn_s_sleep(1);
        if ((++sp & 255u) == 0u) { if (xb_ld(&bar[XB_TMO])) break; if (sp > XB_SPIN_CAP) { atomicAdd(&bar[XB_TMO], 1u); break; } }
    }
    nloc = mine > 0u ? mine : 1u; nx = cnt > 0u ? cnt : 1u;
}

__device__ __forceinline__ void xcd_barrier(const XcdBarrier& b) {
    asm volatile("s_waitcnt vmcnt(0)" ::: "memory");
    __syncthreads();
    if (threadIdx.x == 0) {
        unsigned* bar = b.bar;
        __builtin_amdgcn_s_waitcnt(0);
        unsigned nloc = b.st[0], nx = b.st[1];
        if (nloc == 0u) { xcd_barrier_complete(bar, b.x, nloc, nx); b.st[0] = nloc; b.st[1] = nx; }
        const unsigned old = xb_add(&bar[XB_XSUB(b.x)], 1u);
        const unsigned gen = old / nloc;
        if (old + 1u == (gen + 1u) * nloc) {
            __builtin_amdgcn_fence(__ATOMIC_RELEASE, "agent");
            asm volatile("s_waitcnt vmcnt(0)" ::: "memory");
            const unsigned og = xb_add(&bar[XB_TOP], 1u);
            const unsigned tg = og / nx;
            if (og + 1u == (tg + 1u) * nx) xb_add(&bar[XB_TOPGEN], 1u);
            else XB_SPIN(xb_ld(&bar[XB_TOPGEN]) == tg, bar);
            __builtin_amdgcn_fence(__ATOMIC_ACQUIRE, "agent");
            xb_add(&bar[XB_XGEN(b.x)], 1u);
            asm volatile("s_waitcnt vmcnt(0)" ::: "memory");
        } else {
            XB_SPIN(xb_ld(&bar[XB_XGEN(b.x)]) == gen, bar);
            __builtin_amdgcn_fence(__ATOMIC_ACQUIRE, "agent");
            asm volatile("s_waitcnt vmcnt(0)" ::: "memory");
        }
    }
    __syncthreads();
}

namespace pg8 {
constexpr int BM = 256, BK = 64, HALF = 128, HTB = HALF * BK * 2, STAGE_BYTES = 8 * HTB, NXCD = 8, WGM = 8;
__device__ __forceinline__ int lds_byte(int r, int c) { const int st = (r >> 4) * 2 + (c >> 5), rr = r & 15, cc = c & 31, ob = rr * 64 + cc * 2; return st * 1024 + (ob ^ (((ob >> 9) & 1) << 5)); }
__device__ __forceinline__ void stage_rc(int b, int& R, int& C) { const int st = b / 1024, sb = b % 1024, swz = sb ^ (((sb >> 9) & 1) << 5); R = (st >> 1) * 16 + swz / 64; C = (st & 1) * 32 + (swz % 64) / 2; }
__device__ __forceinline__ int perm32(int rho) { const int n = rho >> 4, i = rho & 15; return 8 * (i >> 2) + 4 * n + (i & 3); }

struct Unit { int pm, pn; const char* A; const char* B; };

struct DenseOrder {
    int nM, nN, nwg, G, c, K; const char* A; const char* Bt;
    __device__ void init(const void* A_, const void* Bt_, int M, int N, int K_, int G_, int c_) { A = (const char*)A_; Bt = (const char*)Bt_; nM = M / BM; nN = N / BM; nwg = nM * nN; G = G_; c = c_; K = K_; }
    __device__ bool next(int i, Unit& u) const {
        const long L = (long)i * G + c; if (L >= nwg) return false;
        int wgid = (int)L; { const int q = nwg / NXCD, r = nwg % NXCD, xcd = wgid % NXCD, off = wgid / NXCD; wgid = (xcd < r ? xcd * (q + 1) : r * (q + 1) + (xcd - r) * q) + off; }
        const int nig = WGM * nN, gid = wgid / nig, fm = gid * WGM, gsz = (nM - fm) < WGM ? (nM - fm) : WGM;
        u.pm = fm + ((wgid % nig) % gsz); u.pn = (wgid % nig) / gsz;
        u.A = A + (size_t)u.pm * 256 * K * 2; u.B = Bt + (size_t)u.pn * 256 * K * 2; return true;
    }
};
struct GroupedOrder {
    const int* tile_e; int n_mt, nN, G, c, K; const char* A; const char* Bt; size_t bstride;
    __device__ bool next(int i, Unit& u) const {
        const long L = (long)i * G + c; if (L >= (long)n_mt * nN) return false;
        u.pn = (int)(L / n_mt); u.pm = (int)(L % n_mt);
        const int e = tile_e[u.pm];
        u.A = A + (size_t)u.pm * 256 * K * 2; u.B = Bt + (size_t)e * bstride + (size_t)u.pn * 256 * K * 2; return true;
    }
};

template <class Epi, class Sched>
__device__ __forceinline__ void gemm_phase(LAS unsigned char* lds, const int K, const Sched& S, const Epi& E) {
    const int tid = tid_(), wid = __builtin_amdgcn_readfirstlane(tid >> 6), lane = tid & 63, wr = wid >> 2, wc = wid & 3, fr = lane & 15, fq = lane >> 4;
    const int nt = K / BK;
    unsigned voffA[2], voffB[2];
#pragma unroll
    for (int i = 0; i < 2; ++i) { int R, C; stage_rc(tid * 16 + i * 8192, R, C); const int Rb = Epi::PERM ? ((R & ~31) + perm32(R & 31)) : R;
        voffA[i] = (unsigned)(R * K + C) * 2u; voffB[i] = (unsigned)(Rb * K + C) * 2u; }
    const size_t kstep = (size_t)(BK * 2);
    const size_t hstep = (size_t)HALF * K * 2;
    const unsigned ldsw = (unsigned)wid * 1024u;
    const int aoff = lds_byte(wr * 64 + fr, fq * 8), boff = lds_byte(wc * 32 + fr, fq * 8);
#define PG8_SA(b, h) (((b) * 2 + (h)) * HTB)
#define PG8_SB(b, h) ((4 + (b) * 2 + (h)) * HTB)
#define PG8_STAGE(bufoff, gbase, voff) do { _Pragma("unroll") for (int _i = 0; _i < 2; ++_i) \
        __builtin_amdgcn_global_load_lds((const unsigned*)((const char*)(gbase) + (voff)[_i]), (LAS unsigned*)(lds + (bufoff) + ldsw + _i * 8192), 16, 0, 0); } while (0)
#define PG8_LDA(dst, b, h) do { _Pragma("unroll") for (int m = 0; m < 4; ++m) _Pragma("unroll") for (int k = 0; k < 2; ++k) dst[m][k] = *(const LAS bf16x8*)(lds + PG8_SA(b, h) + aoff + m * 2048 + k * 1024); } while (0)
#define PG8_LDB(dst, b, h) do { _Pragma("unroll") for (int n = 0; n < 2; ++n) _Pragma("unroll") for (int k = 0; k < 2; ++k) dst[n][k] = *(const LAS bf16x8*)(lds + PG8_SB(b, h) + boff + n * 2048 + k * 1024); } while (0)
#define PG8_MMA(ai, bj, At, Bt) do { __builtin_amdgcn_s_setprio(1); _Pragma("unroll") for (int m = 0; m < 4; ++m) _Pragma("unroll") for (int n = 0; n < 2; ++n) _Pragma("unroll") for (int k = 0; k < 2; ++k) \
        acc[ai][bj][m][n] = __builtin_amdgcn_mfma_f32_16x16x32_bf16(Bt[n][k], At[m][k], acc[ai][bj][m][n], 0, 0, 0); __builtin_amdgcn_s_setprio(0); } while (0)
#define PG8_WAIT_V(n) asm volatile("s_waitcnt vmcnt(" #n ")" ::: "memory")
#define PG8_WAIT_L(n) asm volatile("s_waitcnt lgkmcnt(" #n ")" ::: "memory")
#define PG8_BAR __builtin_amdgcn_s_barrier()
#define PG8_SCHED __builtin_amdgcn_sched_barrier(0)
    Unit cur, nxt; int ui = 0;
    if (!S.next(0, cur)) return;
    f32x4 acc[2][2][4][2];
#pragma unroll
    for (int a = 0; a < 2; ++a)
#pragma unroll
        for (int b = 0; b < 2; ++b)
#pragma unroll
            for (int m = 0; m < 4; ++m)
#pragma unroll
                for (int n = 0; n < 2; ++n) acc[a][b][m][n] = (f32x4){0.f, 0.f, 0.f, 0.f};
    bf16x8 At[4][2], B0[2][2], B1[2][2];
    const char* cA = cur.A; const char* cB = cur.B;
    PG8_STAGE(PG8_SB(0, 0), cB, voffB); PG8_STAGE(PG8_SA(0, 0), cA, voffA); PG8_STAGE(PG8_SB(0, 1), cB + hstep, voffB); PG8_STAGE(PG8_SA(0, 1), cA + hstep, voffA);
    if (wr == 1) PG8_BAR;
    PG8_WAIT_V(4); PG8_BAR;
    PG8_STAGE(PG8_SB(1, 0), cB + kstep, voffB); PG8_STAGE(PG8_SA(1, 0), cA + kstep, voffA); PG8_STAGE(PG8_SB(1, 1), cB + hstep + kstep, voffB);
    PG8_WAIT_V(6); PG8_BAR;
    for (;;) {
        const bool has_next = S.next(ui + 1, nxt);
        const char* nA = has_next ? nxt.A : cA; const char* nB = has_next ? nxt.B : cB;
        for (int t = 0; t < nt; t += 2) {
            const bool last = (t == nt - 2);
            const char* a1 = cA + (size_t)(t + 1) * kstep;
            const char* a2 = last ? nA : cA + (size_t)(t + 2) * kstep; const char* b2 = last ? nB : cB + (size_t)(t + 2) * kstep;
            const char* a3 = a2 + kstep; const char* b3 = b2 + kstep;
            PG8_LDB(B0, 0, 0); PG8_SCHED; PG8_LDA(At, 0, 0); PG8_STAGE(PG8_SA(1, 1), a1 + hstep, voffA);
            PG8_WAIT_L(8); PG8_BAR; PG8_WAIT_L(0); PG8_MMA(0, 0, At, B0); PG8_BAR; PG8_SCHED;
            PG8_LDB(B1, 0, 1); PG8_STAGE(PG8_SB(0, 0), b2, voffB);
            PG8_BAR; PG8_WAIT_L(0); PG8_MMA(0, 1, At, B1); PG8_BAR;
            PG8_LDA(At, 0, 1); PG8_STAGE(PG8_SA(0, 0), a2, voffA);
            PG8_BAR; PG8_WAIT_L(0); PG8_MMA(1, 0, At, B0); PG8_BAR; PG8_SCHED;
            PG8_STAGE(PG8_SB(0, 1), b2 + hstep, voffB);
            PG8_WAIT_V(6); PG8_BAR; PG8_MMA(1, 1, At, B1); PG8_BAR;
            PG8_LDB(B0, 1, 0); PG8_SCHED; PG8_LDA(At, 1, 0); PG8_STAGE(PG8_SA(0, 1), a2 + hstep, voffA);
            PG8_WAIT_L(8); PG8_BAR; PG8_WAIT_L(0); PG8_MMA(0, 0, At, B0); PG8_BAR; PG8_SCHED;
            PG8_LDB(B1, 1, 1); PG8_STAGE(PG8_SB(1, 0), b3, voffB);
            PG8_BAR; PG8_WAIT_L(0); PG8_MMA(0, 1, At, B1); PG8_BAR;
            PG8_LDA(At, 1, 1); PG8_STAGE(PG8_SA(1, 0), a3, voffA);
            PG8_BAR; PG8_WAIT_L(0); PG8_MMA(1, 0, At, B0); PG8_BAR; PG8_SCHED;
            PG8_STAGE(PG8_SB(1, 1), b3 + hstep, voffB);
            PG8_WAIT_V(6); PG8_BAR; PG8_MMA(1, 1, At, B1); PG8_BAR;
        }
        E(acc, cur, wr, wc, fr, fq);
        if (!has_next) break;
#pragma unroll
        for (int a = 0; a < 2; ++a)
#pragma unroll
            for (int b = 0; b < 2; ++b)
#pragma unroll
                for (int m = 0; m < 4; ++m)
#pragma unroll
                    for (int n = 0; n < 2; ++n) acc[a][b][m][n] = (f32x4){0.f, 0.f, 0.f, 0.f};
        cur = nxt; cA = nA; cB = nB; ++ui;
    }
    PG8_WAIT_V(0);
    if (wr == 0) PG8_BAR;
    PG8_BAR;
#undef PG8_SA
#undef PG8_SB
#undef PG8_STAGE
#undef PG8_LDA
#undef PG8_LDB
#undef PG8_MMA
#undef PG8_WAIT_V
#undef PG8_WAIT_L
#undef PG8_BAR
#undef PG8_SCHED
}
}
using pg8::Unit;

struct EpiProj {
    static constexpr bool PERM = true; bf16_t* O;
    __device__ __forceinline__ void operator()(const f32x4 (&acc)[2][2][4][2], const Unit& u, int wr, int wc, int fr, int fq) const {
        const int row0 = u.pm * 256 + wr * 64 + fr, col0 = u.pn * 256 + wc * 32 + 8 * fq;
#pragma unroll
        for (int ai = 0; ai < 2; ++ai)
#pragma unroll
            for (int m = 0; m < 4; ++m) { bf16_t* rowp = O + (size_t)(row0 + ai * 128 + m * 16) * LDP + col0;
#pragma unroll
                for (int bj = 0; bj < 2; ++bj) { const f32x4 v0 = acc[ai][bj][m][0], v1 = acc[ai][bj][m][1];
                    u32x4 w; w.x = pack2(v0[0], v0[1]); w.y = pack2(v0[2], v0[3]); w.z = pack2(v1[0], v1[1]); w.w = pack2(v1[2], v1[3]);
                    *(u32x4*)(rowp + bj * 128) = w; } }
    }
};
template <int PASS> struct EpiMerge {
    static constexpr bool PERM = true; bf16_t* M; const bf16_t* proj; const float* bg;
    __device__ __forceinline__ void operator()(const f32x4 (&acc)[2][2][4][2], const Unit& u, int wr, int wc, int fr, int fq) const {
        const int row0 = u.pm * 256 + wr * 64 + fr, col0 = u.pn * 256 + wc * 32 + 8 * fq;
#pragma unroll
        for (int ai = 0; ai < 2; ++ai)
#pragma unroll
            for (int m = 0; m < 4; ++m) { const int row = row0 + ai * 128 + m * 16;
#pragma unroll
                for (int bj = 0; bj < 2; ++bj)
#pragma unroll
                    for (int n = 0; n < 2; ++n) { const int col = col0 + bj * 128 + 4 * n;
                        const u32x2 gw = *(const u32x2*)(proj + (size_t)row * LDP + (PASS ? C_G1 : C_G0) + col);
                        const f32x4 b0 = *(const f32x4*)(bg + PASS * 2048 + col);
                        bf16_t* dst = M + (size_t)row * 2048 + col;
                        u32x2 old = {0u, 0u}; if (PASS) old = *(const u32x2*)dst;
                        const f32x4 v = acc[ai][bj][m][n];
                        const float r0 = bflo(old.x) + sigmoidf_(bflo(gw.x) + b0[0]) * v[0], r1 = bfhi(old.x) + sigmoidf_(bfhi(gw.x) + b0[1]) * v[1];
                        const float r2 = bflo(old.y) + sigmoidf_(bflo(gw.y) + b0[2]) * v[2], r3 = bfhi(old.y) + sigmoidf_(bfhi(gw.y) + b0[3]) * v[3];
                        u32x2 w; w.x = pack2(r0, r1); w.y = pack2(r2, r3);
                        *(u32x2*)dst = w; }
                asm volatile("" ::: "memory"); }
    }
};
struct EpiResid {
    static constexpr bool PERM = false; float* X1; const float* X;
    __device__ __forceinline__ void operator()(const f32x4 (&acc)[2][2][4][2], const Unit& u, int wr, int wc, int fr, int fq) const {
        const int row0 = u.pm * 256 + wr * 64 + fr, col0 = u.pn * 256 + wc * 32 + 4 * fq;
#pragma unroll
        for (int ai = 0; ai < 2; ++ai)
#pragma unroll
            for (int m = 0; m < 4; ++m) { const size_t ro = (size_t)(row0 + ai * 128 + m * 16) * 2048 + col0;
#pragma unroll
                for (int bj = 0; bj < 2; ++bj)
#pragma unroll
                    for (int n = 0; n < 2; ++n) { const size_t o = ro + bj * 128 + n * 16; *(f32x4*)(X1 + o) = *(const f32x4*)(X + o) + acc[ai][bj][m][n]; } }
    }
};
struct EpiGateUp {
    static constexpr bool PERM = false; bf16_t* ACT;
    __device__ __forceinline__ void operator()(const f32x4 (&acc)[2][2][4][2], const Unit& u, int wr, int wc, int fr, int fq) const {
        const int row0 = u.pm * 256 + wr * 64 + fr, hid0 = u.pn * 128 + wc * 16 + 4 * fq;
#pragma unroll
        for (int ai = 0; ai < 2; ++ai)
#pragma unroll
            for (int m = 0; m < 4; ++m) { bf16_t* rowp = ACT + (size_t)(row0 + ai * 128 + m * 16) * 512 + hid0;
#pragma unroll
                for (int bj = 0; bj < 2; ++bj) { const f32x4 g = acc[ai][bj][m][0], up = acc[ai][bj][m][1];
                    u32x2 w; w.x = pack2(siluf_(g[0]) * up[0], siluf_(g[1]) * up[1]); w.y = pack2(siluf_(g[2]) * up[2], siluf_(g[3]) * up[3]);
                    *(u32x2*)(rowp + bj * 64) = w; } }
    }
};
struct EpiDown {
    static constexpr bool PERM = true; bf16_t* O;
    __device__ __forceinline__ void operator()(const f32x4 (&acc)[2][2][4][2], const Unit& u, int wr, int wc, int fr, int fq) const {
        const int row0 = u.pm * 256 + wr * 64 + fr, col0 = u.pn * 256 + wc * 32 + 8 * fq;
#pragma unroll
        for (int ai = 0; ai < 2; ++ai)
#pragma unroll
            for (int m = 0; m < 4; ++m) { bf16_t* rowp = O + (size_t)(row0 + ai * 128 + m * 16) * 2048 + col0;
#pragma unroll
                for (int bj = 0; bj < 2; ++bj) { const f32x4 v0 = acc[ai][bj][m][0], v1 = acc[ai][bj][m][1];
                    u32x4 w; w.x = pack2(v0[0], v0[1]); w.y = pack2(v0[2], v0[3]); w.z = pack2(v1[0], v1[1]); w.w = pack2(v1[2], v1[3]);
                    *(u32x4*)(rowp + bj * 128) = w; } }
    }
};

namespace att {
constexpr int D = 128, ASTR = LDP, OSTR = 1024, MSTR = T_;
constexpr float SCALE = 0.08838834764831845f, THR = 8.f;
constexpr bool WSKIP = false;
constexpr int NW = 8, QBLK = 32, KVBLK = 64, QB = NW * QBLK;
constexpr int SHM_V = KVBLK * D * 2, SHM_K = KVBLK * D * 2;
constexpr int ATT_LDS = 2 * SHM_V + 2 * SHM_K + NW * 64 * 4;
typedef short s16x4 __attribute__((ext_vector_type(4)));
typedef float f32x16 __attribute__((ext_vector_type(16)));
template <class A, class Bt> struct same_t { static constexpr bool v = false; };
template <class A> struct same_t<A, A> { static constexpr bool v = true; };
#define KSWZ(row, colB) ((row) * 256 + ((colB) ^ (((row) & 7) << 4)))
#define SBAR() __builtin_amdgcn_sched_barrier(0)
__device__ __forceinline__ int v_st(int k, int c) { const int kk = (k & ~0xC) | ((k & 4) << 1) | ((k & 8) >> 1); return ((kk >> 3) * 4 + (c >> 5)) * 512 + ((kk & 7) * 32 + (c & 31)) * 2; }
__device__ __forceinline__ int v_rd_base(int lane) { return ((lane & 3) << 3) | (((lane >> 2) & 3) << 6) | (((lane >> 4) & 1) << 5) | (((lane >> 5) & 1) << 8); }
constexpr int v_rd_off(int d0, int ks, int half) { return d0 * 512 + ks * 4096 + half * 2048; }
__device__ __forceinline__ int crow(int r, int hi) { return (r & 3) + 8 * (r >> 2) + 4 * hi; }
__device__ __forceinline__ unsigned cvtpk(float lo, float hi) {
    unsigned r; asm volatile("v_cvt_pk_bf16_f32 %0, %1, %2" : "=v"(r) : "v"(lo), "v"(hi)); return r;
}
__device__ __forceinline__ bf16x8 pack8(f32x4 a, f32x4 b) {
    u32x4 w = {cvtpk(a[0], a[1]), cvtpk(a[2], a[3]), cvtpk(b[0], b[1]), cvtpk(b[2], b[3])};
    return *reinterpret_cast<bf16x8*>(&w);
}
template <class T> __device__ __forceinline__ bf16x8 load8(const T* p) {
    if constexpr (same_t<T, float>::v) { return pack8(*(const f32x4*)p, *(const f32x4*)(p + 4)); }
    else { return *reinterpret_cast<const bf16x8*>(p); }
}
__device__ __forceinline__ void mask_tile(f32x16& p0, f32x16& p1, int dq, unsigned W) {
    const float NEG = -__builtin_inff();
#pragma unroll
    for (int r = 0; r < 16; ++r) {
        const int c = (r & 3) + 8 * (r >> 2);
        if ((unsigned)(dq - c) >= W) p0[r] = NEG;
        if ((unsigned)(dq - c - 32) >= W) p1[r] = NEG;
    }
}
__device__ __forceinline__ void mask_bits(f32x16& p0, f32x16& p1, unsigned long long mw, int hi) {
    const float NEG = -__builtin_inff(); const unsigned lo = (unsigned)mw >> (4 * hi), hw = (unsigned)(mw >> 32) >> (4 * hi);
#pragma unroll
    for (int r = 0; r < 16; ++r) { const int c = (r & 3) + 8 * (r >> 2);
        if (!((lo >> c) & 1u)) p0[r] = NEG;
        if (!((hw >> c) & 1u)) p1[r] = NEG; }
}
__device__ __forceinline__ void partialSM(f32x16& p0, f32x16& p1, float& m_reg, float& mn, float& alpha) {
    float pmax = p0[0]; for (int r = 1; r < 16; ++r) pmax = fmaxf(pmax, p0[r]); for (int r = 0; r < 16; ++r) pmax = fmaxf(pmax, p1[r]);
    { auto rr = __builtin_amdgcn_permlane32_swap(__float_as_uint(pmax), __float_as_uint(pmax), false, false);
      pmax = fmaxf(__uint_as_float(rr[0]), __uint_as_float(rr[1])); }
    constexpr float C2 = 1.4426950408889634f * SCALE;
    if (__builtin_expect(__all((pmax - m_reg) * SCALE <= THR), 1)) { mn = m_reg; alpha = 1.f; }
    else { mn = fmaxf(m_reg, pmax); alpha = __builtin_amdgcn_exp2f((m_reg - mn) * C2); m_reg = mn; }
    const float mnL = -mn * C2;
    for (int r = 0; r < 16; ++r) p0[r] = fmaf(p0[r], C2, mnL); for (int r = 0; r < 16; ++r) p1[r] = fmaf(p1[r], C2, mnL);
    for (int r = 0; r < 16; ++r) p0[r] = __builtin_amdgcn_exp2f(p0[r]);
}
__device__ __forceinline__ void finishSM(f32x16& p0, f32x16& p1, float alpha, float& l_reg, bf16x8& pa0, bf16x8& pa1, bf16x8& pa2, bf16x8& pa3) {
    for (int r = 0; r < 16; ++r) p1[r] = __builtin_amdgcn_exp2f(p1[r]);
    float ps = 0; for (int r = 0; r < 16; ++r) ps += p0[r]; for (int r = 0; r < 16; ++r) ps += p1[r];
    { auto rr = __builtin_amdgcn_permlane32_swap(__float_as_uint(ps), __float_as_uint(ps), false, false);
      ps = __uint_as_float(rr[0]) + __uint_as_float(rr[1]); }
    l_reg = l_reg * alpha + ps;
#define PK4(P, B_, OUT) do { unsigned a0 = cvtpk(P[B_+0], P[B_+1]), a1 = cvtpk(P[B_+2], P[B_+3]);                          \
        unsigned b0 = cvtpk(P[B_+4], P[B_+5]), b1 = cvtpk(P[B_+6], P[B_+7]);                                             \
        auto r0 = __builtin_amdgcn_permlane32_swap(a0, b0, false, false); auto r1 = __builtin_amdgcn_permlane32_swap(a1, b1, false, false); \
        u32x4 w = {r0[0], r1[0], r0[1], r1[1]}; OUT = *reinterpret_cast<bf16x8*>(&w); } while (0)
    PK4(p0, 0, pa0); PK4(p0, 8, pa1); PK4(p1, 0, pa2); PK4(p1, 8, pa3);
#undef PK4
}
template <int KB, bool SK>
__device__ __forceinline__ void qkt(f32x16& p0, f32x16& p1, const char* K_lds, int r32, int hi, const bf16x8* qr, bool act) {
    if (SK && !act) { const float NEG = -__builtin_inff();
#pragma unroll
        for (int r = 0; r < 16; ++r) { p0[r] = NEG; p1[r] = NEG; } return; }
    p0 = f32x16{}; p1 = f32x16{};
    const char* kb[4];
#pragma unroll
    for (int dd = 0; dd < 4; ++dd) kb[dd] = K_lds + KB * SHM_K + KSWZ(r32, (dd * 16 + hi * 8) * 2);
#pragma unroll
    for (int d0 = 0; d0 < 8; ++d0) { const char* a = kb[d0 & 3] + (d0 >> 2) * 128;
        bf16x8 b0 = *reinterpret_cast<const bf16x8*>(a);
        bf16x8 b1 = *reinterpret_cast<const bf16x8*>(a + 32 * 256);
        p0 = __builtin_amdgcn_mfma_f32_32x32x16_bf16(b0, qr[d0], p0, 0, 0, 0);
        p1 = __builtin_amdgcn_mfma_f32_32x32x16_bf16(b1, qr[d0], p1, 0, 0, 0); }
}
template <int VB, bool SK>
__device__ __forceinline__ void pv_tile(f32x16* o, int vb0, bf16x8 pa0, bf16x8 pa1, bf16x8 pa2, bf16x8 pa3, bool act) {
    if (SK && !act) return;
#define TRRD(dst, off) asm volatile("ds_read_b64_tr_b16 %0, %1 offset:%2" : "=&v"(dst) : "v"(vb0), "i"(off) : "memory")
#define PV_D0(d0) do { s16x4 l0, l1, l2, l3, h0, h1, h2, h3; constexpr int b_ = VB * SHM_V + v_rd_off(d0, 0, 0);     \
        TRRD(l0, b_); TRRD(h0, b_ + 2048); TRRD(l1, b_ + 4096); TRRD(h1, b_ + 6144); TRRD(l2, b_ + 8192); TRRD(h2, b_ + 10240); TRRD(l3, b_ + 12288); TRRD(h3, b_ + 14336); \
        asm volatile("s_waitcnt lgkmcnt(0)" ::: "memory"); SBAR();                 \
        o[d0] = __builtin_amdgcn_mfma_f32_32x32x16_bf16(pa0, (bf16x8){l0[0], l0[1], l0[2], l0[3], h0[0], h0[1], h0[2], h0[3]}, o[d0], 0, 0, 0);   \
        o[d0] = __builtin_amdgcn_mfma_f32_32x32x16_bf16(pa1, (bf16x8){l1[0], l1[1], l1[2], l1[3], h1[0], h1[1], h1[2], h1[3]}, o[d0], 0, 0, 0);   \
        o[d0] = __builtin_amdgcn_mfma_f32_32x32x16_bf16(pa2, (bf16x8){l2[0], l2[1], l2[2], l2[3], h2[0], h2[1], h2[2], h2[3]}, o[d0], 0, 0, 0);   \
        o[d0] = __builtin_amdgcn_mfma_f32_32x32x16_bf16(pa3, (bf16x8){l3[0], l3[1], l3[2], l3[3], h3[0], h3[1], h3[2], h3[3]}, o[d0], 0, 0, 0); } while (0)
    PV_D0(0); PV_D0(1); PV_D0(2); PV_D0(3);
#undef PV_D0
#undef TRRD
}

template <class TIn, class TOut> struct BlockRef { const TIn* Q; const TIn* K; const TIn* V; TOut* O; int P0; const unsigned long long* MK; };
template <class TIn> struct Seam {
    bf16x8 qr[8];
    bf16x8 st_v0, st_v1, st_k0, st_k1; f32x4 sf0, sf1, sf2, sf3;
    f32x4 tq[16];
};
__device__ __forceinline__ int swa_jlo(int P0, int W) { const int lowk = P0 - W + 1; return lowk > 0 ? lowk / KVBLK : 0; }
#define ROW(p, k0, rr) ((p) + (size_t)((k0) + (rr)) * ASTR + sc)
#define VMW() asm volatile("s_waitcnt vmcnt(0)" ::: "memory")
#define VMWN(n) asm volatile("s_waitcnt vmcnt(%0)" :: "i"(n) : "memory")
#define SLOAD_H(Kp, Vp, k0) do { S.st_v0 = load8<TIn>(ROW(Vp, k0, sr)); S.st_v1 = load8<TIn>(ROW(Vp, k0, 32 + sr));              \
                         S.st_k0 = load8<TIn>(ROW(Kp, k0, sr)); S.st_k1 = load8<TIn>(ROW(Kp, k0, 32 + sr)); } while (0)
#define SWRITE_HK(bf) do { *(bf16x8*)(K_lds + (bf) * SHM_K + kws) = S.st_k0; *(bf16x8*)(K_lds + (bf) * SHM_K + kws + 32 * 256) = S.st_k1; } while (0)
#define SWRITE_HV(bf) do { *(bf16x8*)(V_lds + (bf) * SHM_V + vst0) = S.st_v0; *(bf16x8*)(V_lds + (bf) * SHM_V + vst1) = S.st_v1; } while (0)
#define SWRITE_H(bf) do { SWRITE_HV(bf); SWRITE_HK(bf); } while (0)
#define SLOAD_F(p, k0) do { S.sf0 = *(const f32x4*)ROW(p, k0, sr); S.sf1 = *(const f32x4*)(ROW(p, k0, sr) + 4);                \
                            S.sf2 = *(const f32x4*)ROW(p, k0, 32 + sr); S.sf3 = *(const f32x4*)(ROW(p, k0, 32 + sr) + 4); } while (0)
#define SWRITE_KF(bf) do { *(bf16x8*)(K_lds + (bf) * SHM_K + kws) = pack8(S.sf0, S.sf1); *(bf16x8*)(K_lds + (bf) * SHM_K + kws + 32 * 256) = pack8(S.sf2, S.sf3); } while (0)
#define SWRITE_VF(bf) do { *(bf16x8*)(V_lds + (bf) * SHM_V + vst0) = pack8(S.sf0, S.sf1); *(bf16x8*)(V_lds + (bf) * SHM_V + vst1) = pack8(S.sf2, S.sf3); } while (0)
template <class TIn, class TOut>
__device__ __forceinline__ void causal_swa_prime(const BlockRef<TIn, TOut>& cur, int W, char* lds, Seam<TIn>& S) {
    constexpr bool F32 = same_t<TIn, float>::v;
    const int tid = tid_(), wid = __builtin_amdgcn_readfirstlane(tid >> 6), lane = tid & 63, r32 = lane & 31, hi = lane >> 5;
    const int sr = tid >> 4, sc = (tid & 15) * 8, kws = KSWZ(sr, sc * 2); char* K_lds = lds + 2 * SHM_V;
    const int kb0 = swa_jlo(cur.P0, W) * KVBLK;
    for (int d0 = 0; d0 < 8; ++d0) S.qr[d0] = load8<TIn>(cur.Q + (size_t)(wid * QBLK + r32) * ASTR + d0 * 16 + hi * 8);
    if constexpr (F32) { SLOAD_F((const float*)cur.K, kb0); VMW(); SWRITE_KF(0); SBAR(); SLOAD_F((const float*)cur.V, kb0); }
    else { SLOAD_H(cur.K, cur.V, kb0); VMW(); SWRITE_HK(0); }
    __syncthreads();
}
template <class TIn, class TOut>
__device__ __forceinline__ void causal_swa_block(const BlockRef<TIn, TOut>& cur, const BlockRef<TIn, TOut>& nxt, int skv, int W, char* lds, Seam<TIn>& S) {
    constexpr bool F32 = same_t<TIn, float>::v;
    const int tid = tid_(), wid = __builtin_amdgcn_readfirstlane(tid >> 6), lane = tid & 63, r32 = lane & 31, hi = lane >> 5;
    const int j_lo = swa_jlo(cur.P0, W);
    int j_hi = (cur.P0 + QB - 1) / KVBLK + 1; if (j_hi > skv / KVBLK) j_hi = skv / KVBLK;
    const int NT = j_hi - j_lo;
    const int kbn = swa_jlo(nxt.P0, W) * KVBLK;
    const int qlo = cur.P0 + wid * QBLK, qm = qlo + r32 - 4 * hi;
    char* V_lds = lds; char* K_lds = lds + 2 * SHM_V;
    float* ws = (float*)(lds + 2 * SHM_V + 2 * SHM_K) + wid * 64; float* li_l = ws, * al_l = ws + 32;
    float m_reg = -1e30f, l_reg = 0; f32x16 o[4] = {};
    const int sr = tid >> 4, sc = (tid & 15) * 8, vst0 = v_st(sr, sc), vst1 = v_st(32 + sr, sc), kws = KSWZ(sr, sc * 2);
    const int vb0 = (int)(uintptr_t)V_lds + v_rd_base(lane);
    const TIn* Kh = cur.K; const TIn* Vh = cur.V;
#define RESC(a) do { if (__any((a) < 1.f)) { if (hi == 0) al_l[r32] = (a); asm volatile("s_waitcnt lgkmcnt(0)" ::: "memory");              \
                     for (int d_ = 0; d_ < 4; ++d_) for (int r = 0; r < 16; ++r) o[d_][r] *= al_l[crow(r, hi)]; } } while (0)
#define KBASE(t) ((j_lo + (t)) * KVBLK)
#define ACT(t) (KBASE(t) <= qlo + QBLK - 1 && KBASE(t) + KVBLK - 1 >= qlo - W + 1)
#define MASKT(P0_, P1_, t) do { mask_bits(P0_, P1_, mw, hi); } while (0)
#define MLOAD(t) do { mw = cur.MK[(size_t)(j_lo + (t)) * MSTR + wid * QBLK + r32]; } while (0)
    constexpr int NQL = F32 ? 16 : 8;
    constexpr bool SK = WSKIP && !F32;
#define SEAM_K0() do { VMWN(NQL); if constexpr (F32) { SWRITE_KF(0); SBAR(); SLOAD_F((const float*)nxt.V, kbn); } else { SWRITE_HK(0); } SBAR(); } while (0)
    f32x16 pA0, pA1, pB0, pB1; float mnA, mnB, alA, alB; bf16x8 pa0, pa1, pa2, pa3; unsigned long long mw = 0ull;
    if constexpr (F32) { VMW(); SWRITE_VF(0); SBAR(); } else { SWRITE_HV(0); SBAR(); }
    if (NT > 1) { if constexpr (F32) SLOAD_F((const float*)Kh, KBASE(1)); else SLOAD_H(Kh, Vh, KBASE(1)); }
    MLOAD(0); SBAR(); qkt<0, SK>(pA0, pA1, K_lds, r32, hi, S.qr, ACT(0));
    if constexpr (F32) { if (NT > 1) { VMW(); SWRITE_KF(1); SBAR(); SLOAD_F((const float*)Vh, KBASE(1)); } }
    MASKT(pA0, pA1, 0); partialSM(pA0, pA1, m_reg, mnA, alA);
    if (NT > 1) { VMW(); if constexpr (F32) { SWRITE_VF(1); SBAR(); if (NT > 2) SLOAD_F((const float*)Kh, KBASE(2)); } else SWRITE_H(1); }
    __syncthreads();
#define HALF_STEP(PX0, PX1, mnX, alX, PY0, PY1, alY, t, KB, VB, SB) do {                                                      \
        MLOAD(t); SBAR(); qkt<KB, SK>(PX0, PX1, K_lds, r32, hi, S.qr, ACT(t));                                             \
        finishSM(PY0, PY1, alY, l_reg, pa0, pa1, pa2, pa3); SBAR();                                                           \
        if ((t) + 1 < NT) { if constexpr (F32) { VMW(); SWRITE_KF(SB); SBAR(); SLOAD_F((const float*)Vh, KBASE((t) + 1)); }  \
                            else { SLOAD_H(Kh, Vh, KBASE((t) + 1)); } SBAR(); }                                               \
        pv_tile<VB, SK>(o, vb0, pa0, pa1, pa2, pa3, ACT((t) - 1)); MASKT(PX0, PX1, (t)); partialSM(PX0, PX1, m_reg, mnX, alX);                                        \
        __syncthreads();                                                                                                      \
        if ((t) + 1 < NT) { VMW(); if constexpr (F32) { SWRITE_VF(SB); SBAR(); if ((t) + 2 < NT) SLOAD_F((const float*)Kh, KBASE((t) + 2)); } \
                            else { SWRITE_H(SB); } }                                                                          \
        RESC(alX); __syncthreads(); } while (0)
    for (int t = 1; t + 1 < NT; t += 2) {
        HALF_STEP(pB0, pB1, mnB, alB, pA0, pA1, alA, t, 1, 0, 0);
        HALF_STEP(pA0, pA1, mnA, alA, pB0, pB1, alB, t + 1, 0, 1, 1);
    }
    const bool even = (NT & 1) == 0;
    if (even) { MLOAD(NT - 1); SBAR(); qkt<1, SK>(pB0, pB1, K_lds, r32, hi, S.qr, ACT(NT - 1)); SBAR(); }
#define QROW(e) (nxt.Q + (size_t)(wid * QBLK + r32) * ASTR + ((e) >> 1) * 16 + hi * 8 + ((e) & 1) * 4)
    if constexpr (F32) { SLOAD_F((const float*)nxt.K, kbn); SBAR();
#pragma unroll
        for (int e = 0; e < 8; ++e) S.tq[e] = *(const f32x4*)QROW(e); }
    else { SLOAD_H(nxt.K, nxt.V, kbn); SBAR();
#pragma unroll
        for (int d0 = 0; d0 < 8; ++d0) S.qr[d0] = load8<TIn>(nxt.Q + (size_t)(wid * QBLK + r32) * ASTR + d0 * 16 + hi * 8); }
    SBAR();
    finishSM(pA0, pA1, alA, l_reg, pa0, pa1, pa2, pa3); SBAR();
    if constexpr (F32) {
#pragma unroll
        for (int e = 8; e < 16; ++e) S.tq[e] = *(const f32x4*)QROW(e); SBAR(); }
#undef QROW
    pv_tile<0, SK>(o, vb0, pa0, pa1, pa2, pa3, ACT(even ? NT - 2 : NT - 1));
    if (even) { MASKT(pB0, pB1, NT - 1); partialSM(pB0, pB1, m_reg, mnB, alB); __syncthreads(); RESC(alB);
        finishSM(pB0, pB1, alB, l_reg, pa0, pa1, pa2, pa3); SBAR(); pv_tile<1, SK>(o, vb0, pa0, pa1, pa2, pa3, ACT(NT - 1)); }
    SBAR(); SEAM_K0();
    if (hi == 0) li_l[r32] = l_reg; asm volatile("s_waitcnt lgkmcnt(0)" ::: "memory");
    float rli[16];
#pragma unroll
    for (int r = 0; r < 16; ++r) rli[r] = __builtin_amdgcn_rcpf(li_l[crow(r, hi)]);
    TOut* Ow = cur.O + (size_t)(wid * QBLK) * OSTR;
#pragma unroll
    for (int r = 0; r < 16; ++r) { const int orow = crow(r, hi);
#pragma unroll
        for (int d0 = 0; d0 < 4; ++d0) { const float v = o[d0][r] * rli[r];
            if constexpr (same_t<TOut, float>::v) { Ow[(size_t)orow * OSTR + d0 * 32 + r32] = v; }
            else { const float vn = dpp_f<0xB1>(v);
                   if ((r32 & 1) == 0) *(unsigned*)(Ow + (size_t)orow * OSTR + d0 * 32 + r32) = cvtpk(v, vn); } } }
    if constexpr (F32) {
#pragma unroll
        for (int d0 = 0; d0 < 8; ++d0) S.qr[d0] = pack8(S.tq[2 * d0], S.tq[2 * d0 + 1]); }
    __syncthreads();
#undef RESC
#undef KBASE
#undef ACT
#undef MASKT
#undef MLOAD
#undef SEAM_K0
#undef HALF_STEP
}
#undef ROW
#undef VMW
#undef VMWN
#undef SLOAD_H
#undef SWRITE_HK
#undef SWRITE_HV
#undef SWRITE_H
#undef SLOAD_F
#undef SWRITE_KF
#undef SWRITE_VF
}

template <class Load4, class DstRow>
__device__ __forceinline__ void convert_tiles(LAS float* tile  , bf16_t* dst, int K, int N, Load4 load4, DstRow dstrow, int c, int G, int& tile_counter) {
    const int tid = tid_(), nk = K / 64, total = nk * (N / 256);
    const int kr = tid >> 6, n4 = (tid & 63) * 4;
    int tt = (c - tile_counter % G + G) % G;
    tile_counter += total;
    f32x4 r[8];
    if (tt < total) { const int k0 = (tt % nk) * 64, n0 = (tt / nk) * 256;
#pragma unroll
        for (int i = 0; i < 8; ++i) r[i] = load4(k0 + kr + 8 * i, n0 + n4); }
    while (tt < total) {
        const int k0 = (tt % nk) * 64, n0 = (tt / nk) * 256;
        __syncthreads();
#pragma unroll
        for (int i = 0; i < 8; ++i) { LAS float* q = tile + (kr + 8 * i) * 257 + n4; q[0] = r[i][0]; q[1] = r[i][1]; q[2] = r[i][2]; q[3] = r[i][3]; }
        const int nx = tt + G;
        if (nx < total) { const int k1 = (nx % nk) * 64, n1 = (nx / nk) * 256;
#pragma unroll
            for (int i = 0; i < 8; ++i) r[i] = load4(k1 + kr + 8 * i, n1 + n4); }
        __syncthreads();
        const int kc = tid & 7;
#pragma unroll
        for (int i = 0; i < 4; ++i) { const int nl = (tid >> 3) + 64 * i; float v[8];
#pragma unroll
            for (int j = 0; j < 8; ++j) v[j] = tile[(kc * 8 + j) * 257 + nl];
            u32x4 w; w.x = pack2(v[0], v[1]); w.y = pack2(v[2], v[3]); w.z = pack2(v[4], v[5]); w.w = pack2(v[6], v[7]);
            *(u32x4*)(dst + (size_t)dstrow(n0 + nl) * K + k0 + kc * 8) = w; }
        tt = nx;
    }
}

__device__ __forceinline__ int in_col_map(int n) {
    if (n < 4096) return n;
    if (n < 7680) return n + 16;
    if (n < 11776) return n + 88;
    if (n < 11840) return 7696 + (n - 11776);
    if (n < 11848) return 4096 + (n - 11840);
    if (n < 11856) return 4104 + (n - 11848);
    if (n < 11864) return 7760 + (n - 11856);
    return -1;
}

__device__ __forceinline__ void phase0(const Params& p, LAS unsigned char* lds) {
    const int G = gridDim.x, c = blockIdx.x, tid = tid_();
    unsigned char* ws = opq(p.ws);
    if (c == 0 && tid < 256) ((unsigned*)(ws + OFF_SMALL + SM_CTRL))[tid] = 0u;
    int counter = 0;
    { const float* w = p.w_in;
      convert_tiles((LAS float*)lds, (bf16_t*)(ws + OFF_WT_IN), 2048, LDP, [w](int k, int n) -> f32x4 {
          const float* row = w + (size_t)k * IN_COLS;
          if (n < 11776) { const int o = n < 4096 ? n : (n < 7680 ? n + 16 : n + 88); return *(const f32x4*)(row + o); }
          f32x4 v;
#pragma unroll
          for (int j = 0; j < 4; ++j) { const int o = in_col_map(n + j); v[j] = o < 0 ? 0.f : row[o]; }
          return v; }, [](int n) { return n; }, c, G, counter); }
    { const float* w = p.w_proj_dn; convert_tiles((LAS float*)lds, (bf16_t*)(ws + OFF_WT_DN), 1024, 2048, [w](int k, int n) -> f32x4 { return *(const f32x4*)(w + (size_t)k * 2048 + n); }, [](int n) { return n; }, c, G, counter); }
    { const float* w = p.w_proj_att; convert_tiles((LAS float*)lds, (bf16_t*)(ws + OFF_WT_AT), 1024, 2048, [w](int k, int n) -> f32x4 { return *(const f32x4*)(w + (size_t)k * 2048 + n); }, [](int n) { return n; }, c, G, counter); }
    { const float* w = p.w_out; convert_tiles((LAS float*)lds, (bf16_t*)(ws + OFF_WT_OUT), 2048, 2048, [w](int k, int n) -> f32x4 { return *(const f32x4*)(w + (size_t)k * 2048 + n); }, [](int n) { return n; }, c, G, counter); }
    { bf16_t* wh = (bf16_t*)(ws + OFF_WR); bf16_t* wl = (bf16_t*)(ws + OFF_WR + 512 * 1024);
      for (int i = c * 512 + tid; i < 5 * 64 * 64 * 8; i += G * 512) { const int e = i & 7, ln = (i >> 3) & 63, kk = (i >> 9) & 63, j = i >> 15;
          const int k = 32 * kk + 8 * (ln >> 4) + e, col = 16 * j + (ln & 15);
          const float v = col < 64 ? p.w_router[(size_t)k * 64 + col] : (col < 72 ? p.w_group[(size_t)k * 8 + col - 64] : 0.f);
          const bf16_t hi = f2bf(v); wh[i] = hi; wl[i] = f2bf(v - bf2f(hi)); } }
    { float* ct = (float*)(ws + OFF_COS); float* st = (float*)(ws + OFF_SIN);
      for (int i = c * 512 + tid; i < T_ * 16; i += G * 512) { const int t = i >> 4;
          const float invf = exp2f(-(float)(i & 15) * 1.1832230355827609f);
          const float ang = (float)p.positions[t] * invf;
          double r = (double)ang * 0.15915494309189535; r -= floor(r);
          ct[i] = __builtin_amdgcn_cosf((float)r); st[i] = __builtin_amdgcn_sinf((float)r); } }
    const int wid = tid >> 6, lane = tid & 63; bf16_t* h = (bf16_t*)(ws + OFF_H);
    for (int row = c * 8 + wid; row < T_; row += G * 8) {
        const float* xr = p.x + (size_t)row * 2048; f32x4 v[8]; float ss = 0.f;
#pragma unroll
        for (int i = 0; i < 8; ++i) { v[i] = *(const f32x4*)(xr + i * 256 + 4 * lane); ss += v[i][0] * v[i][0] + v[i][1] * v[i][1] + v[i][2] * v[i][2] + v[i][3] * v[i][3]; }
        ss = wave_sum(ss); const float rs = rsqrtf(ss * (1.0f / 2048.0f) + EPS);
#pragma unroll
        for (int i = 0; i < 8; ++i) { const f32x4 g = *(const f32x4*)(p.norm_mix + i * 256 + 4 * lane);
            u32x2 w; w.x = pack2(v[i][0] * rs * g[0], v[i][1] * rs * g[1]); w.y = pack2(v[i][2] * rs * g[2], v[i][3] * rs * g[3]);
            *(u32x2*)(h + (size_t)row * 2048 + i * 256 + 4 * lane) = w; }
    }
}

__device__ __forceinline__ void phase_rope(const Params& p) {
    const int G = gridDim.x, c = blockIdx.x, tid = tid_();
    unsigned char* ws = opq(p.ws); bf16_t* proj = (bf16_t*)(ws + OFF_PROJ); bf16_t* kidx = (bf16_t*)(ws + OFF_SMALL + SM_KIDX); float* wq = (float*)(ws + OFF_SMALL + SM_WQ);
    const float* ct = (const float*)(ws + OFF_COS); const float* st = (const float*)(ws + OFF_SIN);
    const int gtid = c * 512 + tid, gsz = G * 512;
    for (int id = gtid; id < 2 * T_ * 8; id += gsz) { const int tsel = id >= T_ * 8, rem = id - tsel * T_ * 8, t = rem >> 3, hh = rem & 7;
        bf16_t* q = proj + (size_t)t * LDP + (tsel ? C_AK : C_AQ) + hh * 128;
        u32x4 d[4]; f32x4 cv[4], sv[4];
#pragma unroll
        for (int i = 0; i < 4; ++i) { d[i] = *(const u32x4*)(q + 8 * i); cv[i] = *(const f32x4*)(ct + (size_t)t * 16 + 4 * i); sv[i] = *(const f32x4*)(st + (size_t)t * 16 + 4 * i); }
#pragma unroll
        for (int hf = 0; hf < 2; ++hf) { u32x4& a = d[hf]; u32x4& bq = d[hf + 2];
#pragma unroll
            for (int j = 0; j < 4; ++j) { const unsigned wa = a[j], wb = bq[j]; const int i0 = 8 * hf + 2 * j;
                const float c0 = cv[i0 >> 2][i0 & 3], s0 = sv[i0 >> 2][i0 & 3], c1 = cv[(i0 + 1) >> 2][(i0 + 1) & 3], s1 = sv[(i0 + 1) >> 2][(i0 + 1) & 3];
                const float x10 = bflo(wa), x11 = bfhi(wa), x20 = bflo(wb), x21 = bfhi(wb);
                a[j] = pack2(x10 * c0 - x20 * s0, x11 * c1 - x21 * s1); bq[j] = pack2(x20 * c0 + x10 * s0, x21 * c1 + x11 * s1); } }
#pragma unroll
        for (int i = 0; i < 4; ++i) *(u32x4*)(q + 8 * i) = d[i]; }
    for (int id = gtid; id < T_ * 8; id += gsz) { const int t = id >> 3, hh = id & 7;
        bf16_t* q = proj + (size_t)t * LDP + C_IQ + hh * 64;
        u32x4 a = *(const u32x4*)q, bq = *(const u32x4*)(q + 8); f32x4 cv[4], sv[4];
#pragma unroll
        for (int i = 0; i < 4; ++i) { cv[i] = *(const f32x4*)(ct + (size_t)t * 16 + 4 * i); sv[i] = *(const f32x4*)(st + (size_t)t * 16 + 4 * i); }
#pragma unroll
        for (int j = 0; j < 4; ++j) { const unsigned wa = a[j], wb = bq[j];
            const float c0 = cv[j][0], s0 = sv[j][0], c1 = cv[j][2], s1 = sv[j][2];
            const float x10 = bflo(wa), x11 = bfhi(wa), x20 = bflo(wb), x21 = bfhi(wb);
            a[j] = pack2(x10 * c0 - x20 * s0, x11 * c1 - x21 * s1); bq[j] = pack2(x20 * c0 + x10 * s0, x21 * c1 + x11 * s1); }
        *(u32x4*)q = a; *(u32x4*)(q + 8) = bq; }
    for (int t = gtid; t < T_; t += gsz) { const bf16_t* row = proj + (size_t)t * LDP;
        float v[64]; float ss = 0.f;
#pragma unroll
        for (int i = 0; i < 8; ++i) { const u32x4 dd = *(const u32x4*)(row + C_IK + 8 * i);
#pragma unroll
            for (int j = 0; j < 4; ++j) { v[8 * i + 2 * j] = bflo(dd[j]); v[8 * i + 2 * j + 1] = bfhi(dd[j]); ss += v[8 * i + 2 * j] * v[8 * i + 2 * j] + v[8 * i + 2 * j + 1] * v[8 * i + 2 * j + 1]; } }
        const float rs = rsqrtf(ss * (1.0f / 64.0f) + EPS);
#pragma unroll
        for (int d = 0; d < 64; ++d) v[d] = v[d] * rs * p.idx_k_norm[d];
#pragma unroll
        for (int i = 0; i < 8; ++i) { const float cc = ct[(size_t)t * 16 + 2 * i], sn = st[(size_t)t * 16 + 2 * i]; const float x1 = v[i], x2 = v[8 + i]; v[i] = x1 * cc - x2 * sn; v[8 + i] = x2 * cc + x1 * sn; }
#pragma unroll
        for (int ch = 0; ch < 8; ++ch) { const int kk = ch >> 2, fq2 = ch & 3; u32x4 w; w.x = pack2(v[8 * ch], v[8 * ch + 1]); w.y = pack2(v[8 * ch + 2], v[8 * ch + 3]); w.z = pack2(v[8 * ch + 4], v[8 * ch + 5]); w.w = pack2(v[8 * ch + 6], v[8 * ch + 7]);
            *(u32x4*)(kidx + ((size_t)((t >> 4) * 2 + kk) * 64 + fq2 * 16 + (t & 15)) * 8) = w; }
        const u32x4 ww = *(const u32x4*)(row + C_IW); const float sc = 0.044194173824159216f;
        f32x4 w0 = {bflo(ww.x) * sc, bfhi(ww.x) * sc, bflo(ww.y) * sc, bfhi(ww.y) * sc}, w1 = {bflo(ww.z) * sc, bfhi(ww.z) * sc, bflo(ww.w) * sc, bfhi(ww.w) * sc};
        *(f32x4*)(wq + (size_t)t * 8) = w0; *(f32x4*)(wq + (size_t)t * 8 + 4) = w1; }
}

__device__ __forceinline__ bf16x8 ldfrag(const LAS bf16_t* X, int stride, int rt, int ks, int fr, int fq) { return *(const LAS bf16x8*)(X + (16 * rt + fr) * stride + 32 * ks + 8 * fq); }
__device__ __forceinline__ void dn_prep_load(const Params& p, int item, u32x4 (&xr)[3][2][4], float (&ba)[2]) {
    const int tid = tid_(), n = item >> 3, h = item & 7, t0 = n * 64, c = tid & 15, i0 = tid >> 4;
    const bf16_t* proj = (const bf16_t*)(opq(p.ws) + OFF_PROJ);
#pragma unroll
    for (int sel = 0; sel < 3; ++sel) { const int col = sel * 1024 + h * 128 + 8 * c;
#pragma unroll
        for (int rr = 0; rr < 2; ++rr)
#pragma unroll
            for (int j = 0; j < 4; ++j) { const int tt = t0 + i0 + 32 * rr - 3 + j; xr[sel][rr][j] = (u32x4){0u, 0u, 0u, 0u}; if (tt >= 0) xr[sel][rr][j] = *(const u32x4*)(proj + (size_t)tt * LDP + col); } }
    ba[0] = 0.f; ba[1] = 0.f;
    if (tid < 64) { const int t = t0 + tid; ba[0] = bf2f(proj[(size_t)t * LDP + C_B + h]); ba[1] = bf2f(proj[(size_t)t * LDP + C_A + h]); }
}
__device__ __forceinline__ void dn_prep_item(const Params& p, int item, int next_item, LAS unsigned char* lds, u32x4 (&xr)[3][2][4], float (&ba)[2]) {
    const int tid = tid_(), w = tid >> 6, lane = tid & 63, fr = lane & 15, fq = lane >> 4, n = item >> 3, h = item & 7, t0 = n * 64;
    unsigned char* ws = opq(p.ws); const bf16_t* proj = (const bf16_t*)(ws + OFF_PROJ);
    LAS bf16_t* Kr = (LAS bf16_t*)lds; LAS bf16_t* Qr = Kr + 64 * 136; LAS bf16_t* KTs = Qr + 64 * 136; LAS bf16_t* VTs = KTs + 128 * 72;
    LAS bf16_t* Pb = VTs + 128 * 72;
    LAS float* Gs = (LAS float*)(Pb + 6 * 64 * 72); LAS float* bs = Gs + 64; LAS float* eg = bs + 64;
    bf16_t* wb = (bf16_t*)(ws + OFF_DNP + DNP_W) + (size_t)item * 8192; bf16_t* uT = (bf16_t*)(ws + OFF_DNP + DNP_UT) + (size_t)item * 8192;
    bf16_t* qd = (bf16_t*)(ws + OFF_DNP + DNP_QD) + (size_t)item * 8192; bf16_t* kdT = (bf16_t*)(ws + OFF_DNP + DNP_KDT) + (size_t)item * 8192;
    bf16_t* attn = (bf16_t*)(ws + OFF_DNP + DNP_ATT) + (size_t)item * 4096;
    __syncthreads();
    if (tid < 64) { const float bl = ba[0], al = ba[1] + p.dt_bias[h];
        const float sp = fmaxf(al, 0.f) + log1pf(__expf(-fabsf(al))); float g = -__expf(p.a_log[h]) * sp;
        for (int o = 1; o < 64; o <<= 1) { const float u = shfl_up_(g, o); if (tid >= o) g += u; }
        Gs[tid] = g; bs[tid] = sigmoidf_(bl); eg[tid] = __expf(g);
        if (tid == 63) ((float*)(ws + OFF_SMALL + SM_GLAST))[item] = __expf(g); }
    __syncthreads();
    { const int c = tid & 15, i0 = tid >> 4;
#pragma unroll
      for (int sel = 0; sel < 3; ++sel) { const int col = sel * 1024 + h * 128 + 8 * c;
          f32x4 wv[4][2];
#pragma unroll
          for (int j = 0; j < 4; ++j) { wv[j][0] = *(const f32x4*)(p.conv_w + j * 3072 + col); wv[j][1] = *(const f32x4*)(p.conv_w + j * 3072 + col + 4); }
#pragma unroll
          for (int rr = 0; rr < 2; ++rr) { const int i = i0 + 32 * rr; float y[8];
#pragma unroll
              for (int e = 0; e < 8; ++e) y[e] = 0.f;
#pragma unroll
              for (int j = 0; j < 4; ++j) { const u32x4 xv = xr[sel][rr][j];
                  y[0] += wv[j][0][0] * bflo(xv.x); y[1] += wv[j][0][1] * bfhi(xv.x); y[2] += wv[j][0][2] * bflo(xv.y); y[3] += wv[j][0][3] * bfhi(xv.y);
                  y[4] += wv[j][1][0] * bflo(xv.z); y[5] += wv[j][1][1] * bfhi(xv.z); y[6] += wv[j][1][2] * bflo(xv.w); y[7] += wv[j][1][3] * bfhi(xv.w); }
              float ss = 0.f;
#pragma unroll
              for (int e = 0; e < 8; ++e) { y[e] = siluf_(y[e]); ss += y[e] * y[e]; }
              const float bi = bs[i], ei = eg[i];
              if (sel < 2) { ss = sum16(ss); const float rn = rsqrtf(ss + EPS) * (sel == 0 ? 0.08838834764831845f : 1.0f);
#pragma unroll
                  for (int e = 0; e < 8; ++e) y[e] *= rn; }
              if (sel == 0) { u32x4 pk; pk.x = pack2(y[0], y[1]); pk.y = pack2(y[2], y[3]); pk.z = pack2(y[4], y[5]); pk.w = pack2(y[6], y[7]);
                  *(LAS u32x4*)(Qr + i * 136 + 8 * c) = pk;
                  u32x4 pd; pd.x = pack2(y[0] * ei, y[1] * ei); pd.y = pack2(y[2] * ei, y[3] * ei); pd.z = pack2(y[4] * ei, y[5] * ei); pd.w = pack2(y[6] * ei, y[7] * ei);
                  *(u32x4*)(qd + i * 128 + 8 * c) = pd; }
              else if (sel == 1) { u32x4 pk; pk.x = pack2(y[0], y[1]); pk.y = pack2(y[2], y[3]); pk.z = pack2(y[4], y[5]); pk.w = pack2(y[6], y[7]);
                  *(LAS u32x4*)(Kr + i * 136 + 8 * c) = pk; const float f = bi * ei;
#pragma unroll
                  for (int e = 0; e < 8; ++e) KTs[(8 * c + e) * 72 + i] = f2bf(y[e] * f); }
              else {
#pragma unroll
                  for (int e = 0; e < 8; ++e) VTs[(8 * c + e) * 72 + i] = f2bf(y[e] * bi); } } } }
    if (next_item >= 0) dn_prep_load(p, next_item, xr, ba);
    __syncthreads();
    { const float g63 = Gs[63];
#pragma unroll
      for (int rr = 0; rr < 2; ++rr) { const int u = tid + 512 * rr, d = u >> 3, ic = u & 7; float v[8];
#pragma unroll
          for (int e = 0; e < 8; ++e) v[e] = bf2f(Kr[(8 * ic + e) * 136 + d]) * __expf(g63 - Gs[8 * ic + e]);
          u32x4 pk; pk.x = pack2(v[0], v[1]); pk.y = pack2(v[2], v[3]); pk.z = pack2(v[4], v[5]); pk.w = pack2(v[6], v[7]);
          *(u32x4*)(kdT + d * 64 + 8 * ic) = pk; } }
    LAS bf16_t* P0 = Pb; LAS bf16_t* P1 = Pb + 64 * 72; LAS bf16_t* PT0 = Pb + 2 * 64 * 72; LAS bf16_t* PT1 = Pb + 3 * 64 * 72; LAS bf16_t* TT0 = Pb + 4 * 64 * 72; LAS bf16_t* TT1 = Pb + 5 * 64 * 72;
#pragma unroll
    for (int pp = 0; pp < 2; ++pp) { const int pr = 2 * w + pp, it = pr >> 2, jt = pr & 3;
        f32x4 akk = {0.f, 0.f, 0.f, 0.f}, aqk = {0.f, 0.f, 0.f, 0.f};
#pragma unroll
        for (int ks = 0; ks < 4; ++ks) { const bf16x8 ki = ldfrag(Kr, 136, it, ks, fr, fq), kj = ldfrag(Kr, 136, jt, ks, fr, fq), qi = ldfrag(Qr, 136, it, ks, fr, fq);
            akk = __builtin_amdgcn_mfma_f32_16x16x32_bf16(ki, kj, akk, 0, 0, 0);
            aqk = __builtin_amdgcn_mfma_f32_16x16x32_bf16(kj, qi, aqk, 0, 0, 0); }
        { const int j = 16 * jt + fr; const float Gj = Gs[j]; float mv[4];
#pragma unroll
          for (int r = 0; r < 4; ++r) { const int i = 16 * it + 4 * fq + r; mv[r] = j < i ? -bs[i] * akk[r] * __expf(Gs[i] - Gj) : 0.f; P0[i * 72 + j] = f2bf(mv[r]); }
          u32x2 pk; pk.x = pack2(mv[0], mv[1]); pk.y = pack2(mv[2], mv[3]); *(LAS u32x2*)(PT0 + j * 72 + 16 * it + 4 * fq) = pk; }
        { const int i = 16 * it + fr; const float Gi = Gs[i]; float av[4];
#pragma unroll
          for (int r = 0; r < 4; ++r) { const int j = 16 * jt + 4 * fq + r; av[r] = j <= i ? aqk[r] * __expf(Gi - Gs[j]) : 0.f; }
          u32x2 pk; pk.x = pack2(av[0], av[1]); pk.y = pack2(av[2], av[3]); *(u32x2*)(attn + i * 64 + 16 * jt + 4 * fq) = pk; } }
    f32x4 tm[2];
#pragma unroll
    for (int pp = 0; pp < 2; ++pp) { const int pr = 2 * w + pp, it = pr >> 2, jt = pr & 3;
#pragma unroll
        for (int r = 0; r < 4; ++r) tm[pp][r] = (16 * it + 4 * fq + r == 16 * jt + fr) ? 1.f : 0.f;
        u32x2 pk; pk.x = pack2(tm[pp][0], tm[pp][1]); pk.y = pack2(tm[pp][2], tm[pp][3]); *(LAS u32x2*)(TT0 + (16 * jt + fr) * 72 + 16 * it + 4 * fq) = pk; }
    __syncthreads();
#pragma unroll
    for (int k = 0; k < 6; ++k) {
        const LAS bf16_t* Pc = (k & 1) ? P1 : P0; const LAS bf16_t* PTc = (k & 1) ? PT1 : PT0; const LAS bf16_t* TTc = (k & 1) ? TT1 : TT0;
        LAS bf16_t* Pn = (k & 1) ? P0 : P1; LAS bf16_t* PTn = (k & 1) ? PT0 : PT1; LAS bf16_t* TTn = (k & 1) ? TT0 : TT1;
#pragma unroll
        for (int pp = 0; pp < 2; ++pp) { const int pr = 2 * w + pp, it = pr >> 2, jt = pr & 3;
            f32x4 x = {0.f, 0.f, 0.f, 0.f}, y = {0.f, 0.f, 0.f, 0.f};
#pragma unroll
            for (int ks = 0; ks < 2; ++ks) { const bf16x8 pa = ldfrag(Pc, 72, it, ks, fr, fq);
                x = __builtin_amdgcn_mfma_f32_16x16x32_bf16(pa, ldfrag(TTc, 72, jt, ks, fr, fq), x, 0, 0, 0);
                if (k < 5) y = __builtin_amdgcn_mfma_f32_16x16x32_bf16(pa, ldfrag(PTc, 72, jt, ks, fr, fq), y, 0, 0, 0); }
            tm[pp] += x;
            if (k < 5) { u32x2 pk; pk.x = pack2(tm[pp][0], tm[pp][1]); pk.y = pack2(tm[pp][2], tm[pp][3]); *(LAS u32x2*)(TTn + (16 * jt + fr) * 72 + 16 * it + 4 * fq) = pk;
#pragma unroll
                for (int r = 0; r < 4; ++r) Pn[(16 * it + 4 * fq + r) * 72 + 16 * jt + fr] = f2bf(y[r]);
                u32x2 pq; pq.x = pack2(y[0], y[1]); pq.y = pack2(y[2], y[3]); *(LAS u32x2*)(PTn + (16 * jt + fr) * 72 + 16 * it + 4 * fq) = pq; }
            else {
#pragma unroll
                for (int r = 0; r < 4; ++r) P0[(16 * it + 4 * fq + r) * 72 + 16 * jt + fr] = f2bf(tm[pp][r]); } }
        __syncthreads();
    }
#pragma unroll
    for (int q4 = 0; q4 < 4; ++q4) { const int tl = 4 * w + q4;
        { const int dt = tl >> 2, it = tl & 3; f32x4 a = {0.f, 0.f, 0.f, 0.f};
#pragma unroll
          for (int ks = 0; ks < 2; ++ks) a = __builtin_amdgcn_mfma_f32_16x16x32_bf16(ldfrag(KTs, 72, dt, ks, fr, fq), ldfrag(P0, 72, it, ks, fr, fq), a, 0, 0, 0);
          u32x2 pk; pk.x = pack2(a[0], a[1]); pk.y = pack2(a[2], a[3]); *(u32x2*)(wb + (16 * it + fr) * 128 + 16 * dt + 4 * fq) = pk; }
        { const int it = tl >> 3, vt = tl & 7; f32x4 a = {0.f, 0.f, 0.f, 0.f};
#pragma unroll
          for (int ks = 0; ks < 2; ++ks) a = __builtin_amdgcn_mfma_f32_16x16x32_bf16(ldfrag(P0, 72, it, ks, fr, fq), ldfrag(VTs, 72, vt, ks, fr, fq), a, 0, 0, 0);
          u32x2 pk; pk.x = pack2(a[0], a[1]); pk.y = pack2(a[2], a[3]); *(u32x2*)(uT + (16 * vt + fr) * 64 + 16 * it + 4 * fq) = pk; } }
}

__device__ __forceinline__ void dn_scan(const Params& p, int b, LAS unsigned char* lds) {
    const int tid = tid_(), w = tid >> 6, lane = tid & 63, fr = lane & 15, fq = lane >> 4, h = b >> 2, e0 = (b & 3) * 32;
    unsigned char* ws = opq(p.ws);
    const bf16_t* wbuf = (const bf16_t*)(ws + OFF_DNP + DNP_W); const bf16_t* uT = (const bf16_t*)(ws + OFF_DNP + DNP_UT); const bf16_t* kdT = (const bf16_t*)(ws + OFF_DNP + DNP_KDT);
    const float* glast = (const float*)(ws + OFF_SMALL + SM_GLAST);
    bf16_t* Sold = (bf16_t*)(ws + OFF_SCAN); bf16_t* vnT = (bf16_t*)(ws + OFF_SCAN + 64 * MB);
    LAS bf16_t* Sb = (LAS bf16_t*)lds;
    LAS bf16_t* Vn = (LAS bf16_t*)(lds + 32 * 136 * 2);
    f32x4 S[2] = {{0.f, 0.f, 0.f, 0.f}, {0.f, 0.f, 0.f, 0.f}};
    __syncthreads();
    bf16x8 kd[2], wf[4], kdn[2], wfn[4]; u32x2 u4[2] = {{0u, 0u}, {0u, 0u}}, u4n[2] = {{0u, 0u}, {0u, 0u}}; float gl, gln;
#define DN_LOAD(KD, WF, U4, GL, n_) do { const int it_ = (n_) * 8 + h;                                                                               \
        _Pragma("unroll") for (int kk = 0; kk < 2; ++kk) KD[kk] = *(const bf16x8*)(kdT + (size_t)it_ * 8192 + (16 * w + fr) * 64 + kk * 32 + 8 * fq); \
        if (w < 4) { _Pragma("unroll") for (int kk = 0; kk < 4; ++kk) WF[kk] = *(const bf16x8*)(wbuf + (size_t)it_ * 8192 + (16 * w + fr) * 128 + kk * 32 + 8 * fq); \
            _Pragma("unroll") for (int sl = 0; sl < 2; ++sl) U4[sl] = *(const u32x2*)(uT + (size_t)it_ * 8192 + (e0 + 16 * sl + fr) * 64 + 16 * w + 4 * fq); } \
        GL = glast[it_]; } while (0)
    DN_LOAD(kd, wf, u4, gl, 0);
#pragma unroll 1
    for (int n = 0; n < 256; ++n) {
        const int item = n * 8 + h;
        if (n + 1 < 256) DN_LOAD(kdn, wfn, u4n, gln, n + 1);
#pragma unroll
        for (int sl = 0; sl < 2; ++sl) { u32x2 sw; sw.x = pack2(S[sl][0], S[sl][1]); sw.y = pack2(S[sl][2], S[sl][3]);
            *(LAS u32x2*)(Sb + (16 * sl + fr) * 136 + 16 * w + 4 * fq) = sw;
            *(u32x2*)(Sold + (size_t)item * 16384 + (e0 + 16 * sl + fr) * 128 + 16 * w + 4 * fq) = sw; }
        __syncthreads();
        if (w < 4) {
#pragma unroll
            for (int sl = 0; sl < 2; ++sl) { f32x4 va = {0.f, 0.f, 0.f, 0.f};
#pragma unroll
                for (int kk = 0; kk < 4; ++kk) { const bf16x8 bb = *(const LAS bf16x8*)(Sb + (16 * sl + fr) * 136 + kk * 32 + 8 * fq); va = __builtin_amdgcn_mfma_f32_16x16x32_bf16(wf[kk], bb, va, 0, 0, 0); }
                u32x2 vw; vw.x = pack2(bflo(u4[sl].x) - va[0], bfhi(u4[sl].x) - va[1]); vw.y = pack2(bflo(u4[sl].y) - va[2], bfhi(u4[sl].y) - va[3]);
                *(LAS u32x2*)(Vn + (16 * sl + fr) * 72 + 16 * w + 4 * fq) = vw;
                *(u32x2*)(vnT + (size_t)item * 8192 + (e0 + 16 * sl + fr) * 64 + 16 * w + 4 * fq) = vw; } }
        __syncthreads();
#pragma unroll
        for (int sl = 0; sl < 2; ++sl) { S[sl] = S[sl] * gl;
#pragma unroll
            for (int kk = 0; kk < 2; ++kk) { const bf16x8 bb = *(const LAS bf16x8*)(Vn + (16 * sl + fr) * 72 + kk * 32 + 8 * fq); S[sl] = __builtin_amdgcn_mfma_f32_16x16x32_bf16(kd[kk], bb, S[sl], 0, 0, 0); } }
#pragma unroll
        for (int kk = 0; kk < 2; ++kk) kd[kk] = kdn[kk];
#pragma unroll
        for (int kk = 0; kk < 4; ++kk) wf[kk] = wfn[kk];
        u4[0] = u4n[0]; u4[1] = u4n[1]; gl = gln;
    }
#undef DN_LOAD
}

__device__ __forceinline__ float relu_(float x) { return __builtin_amdgcn_fmed3f(x, 0.f, __builtin_inff()); }
__device__ __forceinline__ float unsortable(unsigned u) { return __uint_as_float((u & 0x80000000u) ? (u ^ 0x80000000u) : ~u); }
__device__ __forceinline__ unsigned sortable(float f) { const unsigned u = __float_as_uint(f); return (u & 0x80000000u) ? ~u : (u | 0x80000000u); }

template <bool EXACT>
__device__ __forceinline__ unsigned compact_q(LAS unsigned* kq, LAS unsigned* iq, int n, int lane, int& nkeep) {
    unsigned key[8], idx[8]; bool val[8];
#pragma unroll
    for (int i = 0; i < 8; ++i) { const int e = lane + 64 * i; val[i] = e < n; key[i] = val[i] ? kq[e] : 0u; idx[i] = val[i] ? iq[e] : 0xffffffffu; }
    unsigned th = 0u; int cur = n;
#pragma unroll 1
    for (int b = 31; b >= 0; --b) { const unsigned cand = th | (1u << b); int c = 0;
#pragma unroll
        for (int i = 0; i < 8; ++i) c += __popcll(__ballot(val[i] && key[i] >= cand));
        if (c >= 256) { th = cand; cur = c; if (!EXACT && c <= 288) break; } }
    if (!EXACT) { int base = 0;
#pragma unroll
        for (int i = 0; i < 8; ++i) { const bool keep = val[i] && key[i] >= th; const unsigned long long m = __ballot(keep);
            const int pos = base + __popcll(m & ((1ull << lane) - 1ull)); if (keep) { kq[pos] = key[i]; iq[pos] = idx[i]; } base += __popcll(m); }
        nkeep = cur; return th - 1u; }
    int cgt = 0, ceq = 0;
#pragma unroll
    for (int i = 0; i < 8; ++i) { cgt += __popcll(__ballot(val[i] && key[i] > th)); ceq += __popcll(__ballot(val[i] && key[i] == th)); }
    const int need = 256 - cgt; unsigned beta = 0xffffffffu;
    if (ceq > need) { beta = 0u;
#pragma unroll 1
        for (int b = 14; b >= 0; --b) { const unsigned cand = beta | (1u << b); int c = 0;
#pragma unroll
            for (int i = 0; i < 8; ++i) c += __popcll(__ballot(val[i] && key[i] == th && idx[i] < cand));
            if (c < need) beta = cand; } }
    int base = 0;
#pragma unroll
    for (int i = 0; i < 8; ++i) { const bool keep = val[i] && (key[i] > th || (key[i] == th && idx[i] <= beta)); const unsigned long long m = __ballot(keep);
        const int pos = base + __popcll(m & ((1ull << lane) - 1ull)); if (keep) { kq[pos] = key[i]; iq[pos] = idx[i]; } base += __popcll(m); }
    nkeep = 256; return th;
}

__device__ __forceinline__ unsigned compact_hist(LAS unsigned* kq, LAS unsigned* iq, int n, int lane, int& nkeep, LAS unsigned* hist, unsigned lo) {
    unsigned key[8], idx[8]; bool val[8]; unsigned mx = 0u;
#pragma unroll
    for (int i = 0; i < 8; ++i) { const int e = lane + 64 * i; val[i] = e < n; key[i] = val[i] ? kq[e] : 0u; idx[i] = val[i] ? iq[e] : 0xffffffffu; mx = key[i] > mx ? key[i] : mx; }
#pragma unroll
    for (int o = 32; o >= 1; o >>= 1) { const unsigned t = (unsigned)shfl_xor_((int)mx, o); mx = t > mx ? t : mx; }
    const unsigned range = mx - lo; const int nb = 32 - __clz((int)(range | 1u)); const int sh = nb > 8 ? nb - 8 : 0;
#pragma unroll
    for (int i = 0; i < 4; ++i) hist[lane + 64 * i] = 0u;
#pragma unroll
    for (int i = 0; i < 8; ++i) if (val[i]) { unsigned b = (key[i] - lo) >> sh; b = b < 255u ? b : 255u; __hip_atomic_fetch_add(hist + b, 1u, __ATOMIC_RELAXED, __HIP_MEMORY_SCOPE_WORKGROUP); }
    const u32x4 cb = *(const LAS u32x4*)(hist + 4 * lane);
    int S = (int)(cb.x + cb.y + cb.z + cb.w);
#pragma unroll
    for (int o = 1; o < 64; o <<= 1) { const int t = bperm_i((lane + o) & 63, S); if (lane + o < 64) S += t; }
    const unsigned long long ge = __ballot(S >= 256); const int L = 63 - __clzll((long long)ge);
    int above = bperm_i((L + 1) & 63, S); if (L == 63) above = 0;
    const unsigned c3 = (unsigned)bperm_i(L, (int)cb.w), c2 = (unsigned)bperm_i(L, (int)cb.z), c1 = (unsigned)bperm_i(L, (int)cb.y), c0 = (unsigned)bperm_i(L, (int)cb.x);
    int bsel, cur;
    if (above + (int)c3 >= 256) { bsel = 3; cur = above + (int)c3; } else if (above + (int)(c3 + c2) >= 256) { bsel = 2; cur = above + (int)(c3 + c2); }
    else if (above + (int)(c3 + c2 + c1) >= 256) { bsel = 1; cur = above + (int)(c3 + c2 + c1); } else { bsel = 0; cur = above + (int)(c3 + c2 + c1 + c0); }
    if (cur > 352) return compact_q<false>(kq, iq, n, lane, nkeep);
    const unsigned th = lo + ((unsigned)(4 * L + bsel) << sh);
    int base = 0;
#pragma unroll
    for (int i = 0; i < 8; ++i) { const bool keep = val[i] && key[i] >= th; const unsigned long long m = __ballot(keep);
        const int pos = base + __popcll(m & ((1ull << lane) - 1ull)); if (keep) { kq[pos] = key[i]; iq[pos] = idx[i]; } base += __popcll(m); }
    nkeep = cur; return th - 1u;
}

__device__ __forceinline__ void dsa_block(const Params& p, int qb, LAS unsigned char* lds) {
    const int tid = tid_(), w = tid >> 6, lane = tid & 63, fr = lane & 15, fq = lane >> 4, t0 = qb * 32;
    unsigned char* ws = opq(p.ws); const bf16_t* proj = (const bf16_t*)(ws + OFF_PROJ); const bf16_t* kidx = (const bf16_t*)(ws + OFF_SMALL + SM_KIDX); const float* wq = (const float*)(ws + OFF_SMALL + SM_WQ);
    LAS unsigned* ckey = (LAS unsigned*)lds;
    LAS unsigned* cidx = (LAS unsigned*)(lds + 65536);
    LAS unsigned* cnt = (LAS unsigned*)(lds + 131072);
    __syncthreads();
    bf16x8 af[2][2]; f32x4 wr[2]; int tmy[2];
    const int hb = fq & 1, qoff = (fq >> 1) ? w + 8 : w;
#pragma unroll
    for (int m = 0; m < 2; ++m) { const int tqr = t0 + 16 * m + ((fr >> 3) ? w + 8 : w);
#pragma unroll
        for (int kk = 0; kk < 2; ++kk) af[m][kk] = *(const bf16x8*)(proj + (size_t)tqr * LDP + C_IQ + (fr & 7) * 64 + kk * 32 + 8 * fq);
        tmy[m] = t0 + 16 * m + qoff; wr[m] = *(const f32x4*)(wq + (size_t)tmy[m] * 8 + 4 * hb); }
    const unsigned msk = hb ? 0xffffffffu : 0u, lt = (1u << (lane & 31)) - 1u;
    unsigned tauu[2] = {0u, 0u};
    LAS unsigned* hist = (LAS unsigned*)(lds + 132096 + w * 1024);
    float tauf[2] = {-__builtin_inff(), -__builtin_inff()};
    if (tid < 32) cnt[tid] = 0u;
    __syncthreads();
    const int ntile = (t0 + 31) / 128 + 1;
    bf16x8 bfr[8][2], bfn[8][2];
#pragma unroll
    for (int j = 0; j < 8; ++j)
#pragma unroll
        for (int kk = 0; kk < 2; ++kk) bfr[j][kk] = *(const bf16x8*)(kidx + ((size_t)(j * 2 + kk) * 64 + lane) * 8);
#pragma unroll 1
    for (int kt = 0; kt < ntile; ++kt) {
        if (kt + 1 < ntile) {
#pragma unroll
            for (int j = 0; j < 8; ++j)
#pragma unroll
                for (int kk = 0; kk < 2; ++kk) bfn[j][kk] = *(const bf16x8*)(kidx + ((size_t)(((kt + 1) * 8 + j) * 2 + kk) * 64 + lane) * 8); }
        const bool lastt = kt == ntile - 1; const int lim = lastt ? 256 : 384;
#pragma unroll
        for (int m = 0; m < 2; ++m) {
            float pt[8];
#pragma unroll
            for (int j = 0; j < 8; ++j) { f32x4 a = {0.f, 0.f, 0.f, 0.f};
                a = __builtin_amdgcn_mfma_f32_16x16x32_bf16(af[m][0], bfr[j][0], a, 0, 0, 0); a = __builtin_amdgcn_mfma_f32_16x16x32_bf16(af[m][1], bfr[j][1], a, 0, 0, 0);
                pt[j] = wr[m][0] * relu_(a[0]) + wr[m][1] * relu_(a[1]) + wr[m][2] * relu_(a[2]) + wr[m][3] * relu_(a[3]); }
            const int myq = 16 * m + qoff; LAS unsigned* kq = ckey + myq * 512; LAS unsigned* iq = cidx + myq * 512;
#pragma unroll
            for (int i = 0; i < 4; ++i) {
                const auto sw = __builtin_amdgcn_permlane16_swap(__float_as_uint(pt[i]), __float_as_uint(pt[4 + i]), false, false);
                const float v = __uint_as_float(sw[0]) + __uint_as_float(sw[1]);
                const int s = kt * 128 + 16 * (4 * hb + i) + fr;
                if (s <= tmy[m] && v > tauf[m]) {
                    const unsigned pos = __hip_atomic_fetch_add(cnt + myq, 1u, __ATOMIC_RELAXED, __HIP_MEMORY_SCOPE_WORKGROUP);
                    if (pos < 512u) { kq[pos] = sortable(v); iq[pos] = (unsigned)s; } } }
            const int c0 = __builtin_amdgcn_readfirstlane((int)cnt[16 * m + w]), c1 = __builtin_amdgcn_readfirstlane((int)cnt[16 * m + w + 8]);
            if (c0 > lim) { int nk; const int n0 = c0 < 512 ? c0 : 512; const unsigned lo0 = (unsigned)__builtin_amdgcn_readlane((int)tauu[m], 0);
                const unsigned th = lastt ? compact_q<true>(ckey + (16 * m + w) * 512, cidx + (16 * m + w) * 512, n0, lane, nk) : compact_hist(ckey + (16 * m + w) * 512, cidx + (16 * m + w) * 512, n0, lane, nk, hist, lo0);
                if (lane == 0) cnt[16 * m + w] = (unsigned)nk; if (lane < 32) { tauf[m] = unsortable(th); tauu[m] = th; } }
            if (c1 > lim) { int nk; const int n1 = c1 < 512 ? c1 : 512; const unsigned lo1 = (unsigned)__builtin_amdgcn_readlane((int)tauu[m], 32);
                const unsigned th = lastt ? compact_q<true>(ckey + (16 * m + w + 8) * 512, cidx + (16 * m + w + 8) * 512, n1, lane, nk) : compact_hist(ckey + (16 * m + w + 8) * 512, cidx + (16 * m + w + 8) * 512, n1, lane, nk, hist, lo1);
                if (lane == 0) cnt[16 * m + w + 8] = (unsigned)nk; if (lane >= 32) { tauf[m] = unsortable(th); tauu[m] = th; } }
        }
#pragma unroll
        for (int j = 0; j < 8; ++j)
#pragma unroll
            for (int kk = 0; kk < 2; ++kk) bfr[j][kk] = bfn[j][kk];
    }
    __syncthreads();
    LAS unsigned* mk = ckey;
    for (int i = tid; i < 32 * 512; i += 512) mk[i] = 0u;
    __syncthreads();
#pragma unroll 1
    for (int rep = 0; rep < 4; ++rep) { const int q = w + 8 * rep; const int n = min((int)cnt[q], 256);
        for (int e = lane; e < n; e += 64) { const unsigned s = cidx[q * 512 + e]; __hip_atomic_fetch_or(mk + q * 512 + (s >> 5), 1u << (s & 31u), __ATOMIC_RELAXED, __HIP_MEMORY_SCOPE_WORKGROUP); } }
    __syncthreads();
    unsigned long long* mg = (unsigned long long*)(ws + OFF_MASK);
    const int nkt = (((t0 & ~255) + 255) >> 6) + 1;
    for (int i = tid; i < nkt * 32; i += 512) { const int kt = i >> 5, q = i & 31; const unsigned long long lo = mk[q * 512 + 2 * kt], hi2 = mk[q * 512 + 2 * kt + 1];
        mg[(size_t)kt * T_ + t0 + q] = lo | (hi2 << 32); }
}

__device__ __forceinline__ void phase3(const Params& p, LAS unsigned char* lds) {
    const int c = blockIdx.x, tid = tid_();
    if (c < 32) dn_scan(p, c, lds);
    unsigned* queue = (unsigned*)(opq(p.ws) + OFF_SMALL + SM_CTRL) + 200;
    LAS int* tk = (LAS int*)(lds + 131072 + 512);
    for (;;) {
        __syncthreads();
        if (tid == 0) *tk = (int)atomicAdd(queue, 1u);
        __syncthreads();
        const int ticket = *tk;
        if (ticket >= 512) break;
        dsa_block(p, 511 - ticket, lds);
    }
}

__device__ __forceinline__ void dn_out_item(const Params& p, int item, LAS unsigned char* lds) {
    const int tid = tid_(), w = tid >> 6, lane = tid & 63, fr = lane & 15, fq = lane >> 4, m = w & 3, nh = w >> 2, n = item >> 3, h = item & 7;
    unsigned char* ws = opq(p.ws); const bf16_t* proj = (const bf16_t*)(ws + OFF_PROJ);
    const bf16_t* qd = (const bf16_t*)(ws + OFF_DNP + DNP_QD) + (size_t)item * 8192; const bf16_t* attn = (const bf16_t*)(ws + OFF_DNP + DNP_ATT) + (size_t)item * 4096;
    const bf16_t* Sold = (const bf16_t*)(ws + OFF_SCAN) + (size_t)item * 16384; const bf16_t* vnT = (const bf16_t*)(ws + OFF_SCAN + 64 * MB) + (size_t)item * 8192;
    bf16_t* ydn = (bf16_t*)(ws + OFF_Y);
    LAS float* red = (LAS float*)lds;
    f32x4 acc[4];
#pragma unroll
    for (int nt = 0; nt < 4; ++nt) acc[nt] = (f32x4){0.f, 0.f, 0.f, 0.f};
#pragma unroll
    for (int kk = 0; kk < 4; ++kk) { const bf16x8 a = *(const bf16x8*)(qd + (16 * m + fr) * 128 + kk * 32 + 8 * fq);
#pragma unroll
        for (int nt = 0; nt < 4; ++nt) { const bf16x8 b = *(const bf16x8*)(Sold + (size_t)(16 * (4 * nh + nt) + fr) * 128 + kk * 32 + 8 * fq); acc[nt] = __builtin_amdgcn_mfma_f32_16x16x32_bf16(a, b, acc[nt], 0, 0, 0); } }
#pragma unroll
    for (int kk = 0; kk < 2; ++kk) { const bf16x8 a = *(const bf16x8*)(attn + (16 * m + fr) * 64 + kk * 32 + 8 * fq);
#pragma unroll
        for (int nt = 0; nt < 4; ++nt) { const bf16x8 b = *(const bf16x8*)(vnT + (size_t)(16 * (4 * nh + nt) + fr) * 64 + kk * 32 + 8 * fq); acc[nt] = __builtin_amdgcn_mfma_f32_16x16x32_bf16(a, b, acc[nt], 0, 0, 0); } }
    float ssq[4];
#pragma unroll
    for (int j = 0; j < 4; ++j) { float s = 0.f;
#pragma unroll
        for (int nt = 0; nt < 4; ++nt) s += acc[nt][j] * acc[nt][j];
        ssq[j] = sum16(s); }
    __syncthreads();
    if (fr == 0) {
#pragma unroll
        for (int j = 0; j < 4; ++j) red[(16 * m + 4 * fq + j) * 2 + nh] = ssq[j]; }
    __syncthreads();
#pragma unroll
    for (int j = 0; j < 4; ++j) { const int i = 16 * m + 4 * fq + j, t = n * 64 + i; const float rs = rsqrtf((red[i * 2] + red[i * 2 + 1]) * (1.0f / 128.0f) + EPS);
#pragma unroll
        for (int nt = 0; nt < 4; ++nt) { const int dv = 16 * (4 * nh + nt) + fr; const float z = bf2f(proj[(size_t)t * LDP + C_Z + h * 128 + dv]);
            ydn[(size_t)t * 1024 + h * 128 + dv] = f2bf(acc[nt][j] * rs * p.dn_norm_w[dv] * siluf_(z)); } }
}

__device__ __forceinline__ void phase_attn(const Params& p, LAS unsigned char* lds) {
    const int G = gridDim.x, c = blockIdx.x; unsigned char* ws = opq(p.ws);
    const bf16_t* proj = (const bf16_t*)(ws + OFF_PROJ); bf16_t* yat = (bf16_t*)(ws + OFF_Y + 32 * MB); const unsigned long long* mk = (const unsigned long long*)(ws + OFF_MASK);
    typedef att::BlockRef<bf16_t, bf16_t> BR;
    auto mkref = [&](int L, int pass) { const int h = L & 7, x = L >> 3, qb = pass ? 63 - x : x; BR r;
        r.Q = proj + (size_t)qb * 256 * LDP + C_AQ + h * 128; r.K = proj + C_AK + h * 128; r.V = proj + C_AV + h * 128;
        r.O = yat + (size_t)qb * 256 * 1024 + h * 128; r.P0 = qb * 256; r.MK = mk + qb * 256; return r; };
    int L = c;
    if (L < 256) {
        int pass = 0; BR cur = mkref(L, 0); att::Seam<bf16_t> S;
        att::causal_swa_prime<bf16_t, bf16_t>(cur, 1 << 30, (char*)lds, S);
        for (;;) {
            const bool more_pass = pass == 0, more_item = L + G < 256, last = !more_pass && !more_item;
            int passn = pass + 1, Ln = L; if (!more_pass) { passn = 0; Ln = more_item ? L + G : L; }
            const BR nxt = last ? cur : mkref(Ln, passn);
            att::causal_swa_block<bf16_t, bf16_t>(cur, nxt, T_, 1 << 30, (char*)lds, S);
            if (last) break;
            cur = nxt; pass = passn; L = Ln;
        }
    }
    __syncthreads();
    for (int item = c; item < NITEM; item += G) dn_out_item(p, item, lds);
}

__device__ __forceinline__ void phase_router(const Params& p, LAS unsigned char* lds) {
    const int G = gridDim.x, c = blockIdx.x, tid = tid_(), w = tid >> 6, lane = tid & 63, fr = lane & 15, fq = lane >> 4;
    unsigned char* ws = opq(p.ws); const float* x1 = (const float*)(ws + OFF_X1); bf16_t* h2 = (bf16_t*)(ws + OFF_H);
    int* rexp = (int*)(ws + OFF_SMALL + SM_ROUTE); float* rwt = (float*)(ws + OFF_SMALL + SM_ROUTE + 128 * 1024);
    unsigned* ecnt = (unsigned*)(ws + OFF_SMALL + SM_CTRL);
    const bf16_t* wh = (const bf16_t*)(ws + OFF_WR); const bf16_t* wl = (const bf16_t*)(ws + OFF_WR + 512 * 1024);
    constexpr int HS = 2056;
    LAS bf16_t* hiL = (LAS bf16_t*)lds; LAS bf16_t* loL = hiL + 16 * HS;
    LAS float* red = (LAS float*)lds;
    LAS float* lgt = (LAS float*)(lds + 133120);
    for (int tile = c; tile < T_ / 16; tile += G) {
        const int tb = tile * 16;
        __syncthreads();
#pragma unroll 1
        for (int rep = 0; rep < 2; ++rep) { const int tl = 2 * w + rep, t = tb + tl; const float* xr = x1 + (size_t)t * 2048; f32x4 v[8]; float ss = 0.f;
#pragma unroll
            for (int i = 0; i < 8; ++i) { v[i] = *(const f32x4*)(xr + i * 256 + 4 * lane); ss += v[i][0] * v[i][0] + v[i][1] * v[i][1] + v[i][2] * v[i][2] + v[i][3] * v[i][3]; }
            ss = wave_sum(ss); const float rs = rsqrtf(ss * (1.0f / 2048.0f) + EPS);
#pragma unroll
            for (int i = 0; i < 8; ++i) { const int k = i * 256 + 4 * lane; const f32x4 g = *(const f32x4*)(p.norm_ffn + k);
                const float a0 = v[i][0] * rs * g[0], a1 = v[i][1] * rs * g[1], a2 = v[i][2] * rs * g[2], a3 = v[i][3] * rs * g[3];
                u32x2 ph; ph.x = pack2(a0, a1); ph.y = pack2(a2, a3);
                u32x2 pl; pl.x = pack2(a0 - bflo(ph.x), a1 - bfhi(ph.x)); pl.y = pack2(a2 - bflo(ph.y), a3 - bfhi(ph.y));
                *(u32x2*)(h2 + (size_t)t * 2048 + k) = ph;
                *(LAS u32x2*)(hiL + tl * HS + k) = ph; *(LAS u32x2*)(loL + tl * HS + k) = pl; } }
        __syncthreads();
        f32x4 acc[5];
#pragma unroll
        for (int j = 0; j < 5; ++j) acc[j] = (f32x4){0.f, 0.f, 0.f, 0.f};
#pragma unroll 2
        for (int kk = 0; kk < 8; ++kk) { const int ks = 8 * w + kk;
            const bf16x8 ah = *(const LAS bf16x8*)(hiL + fr * HS + 32 * ks + 8 * fq), al = *(const LAS bf16x8*)(loL + fr * HS + 32 * ks + 8 * fq);
#pragma unroll
            for (int j = 0; j < 5; ++j) { const size_t o = ((size_t)(j * 64 + ks) * 64 + lane) * 8; const bf16x8 bh = *(const bf16x8*)(wh + o), bl = *(const bf16x8*)(wl + o);
                acc[j] = __builtin_amdgcn_mfma_f32_16x16x32_bf16(ah, bh, acc[j], 0, 0, 0);
                acc[j] = __builtin_amdgcn_mfma_f32_16x16x32_bf16(ah, bl, acc[j], 0, 0, 0);
                acc[j] = __builtin_amdgcn_mfma_f32_16x16x32_bf16(al, bh, acc[j], 0, 0, 0); } }
        __syncthreads();
#pragma unroll
        for (int j = 0; j < 5; ++j)
#pragma unroll
            for (int r = 0; r < 4; ++r) red[(w * 16 + 4 * fq + r) * 80 + 16 * j + fr] = acc[j][r];
        __syncthreads();
        for (int o = tid; o < 16 * 80; o += 512) { float sacc = 0.f;
#pragma unroll
            for (int ww = 0; ww < 8; ++ww) sacc += red[ww * 1280 + o];
            lgt[o] = sacc; }
        __syncthreads();
        if (tid < 16) { const int t = tb + tid; LAS float* l = lgt + tid * 80;
            float gmax = -3.0e38f; int gs = 0; float gl[8];
#pragma unroll
            for (int g = 0; g < 8; ++g) { gl[g] = l[64 + g] + p.b_group[g]; if (gl[g] > gmax) { gmax = gl[g]; gs = g; } }
            float gsum = 0.f;
#pragma unroll
            for (int g = 0; g < 8; ++g) gsum += __expf(gl[g] - gmax);
            const float pg = 1.0f / gsum;
            float el[8]; float m1 = -3.0e38f, m2 = -3.0e38f; int i1 = 0, i2 = 0;
#pragma unroll
            for (int e = 0; e < 8; ++e) { el[e] = l[gs * 8 + e] + p.b_router[gs * 8 + e]; }
#pragma unroll
            for (int e = 0; e < 8; ++e) if (el[e] > m1) { m1 = el[e]; i1 = e; }
#pragma unroll
            for (int e = 0; e < 8; ++e) if (e != i1 && el[e] > m2) { m2 = el[e]; i2 = e; }
            const float e2 = __expf(m2 - m1); const float w1 = pg / (1.0f + e2), w2 = pg * e2 / (1.0f + e2);
            const int ex1 = gs * 8 + i1, ex2 = gs * 8 + i2;
            rexp[t * 2] = ex1; rexp[t * 2 + 1] = ex2; rwt[t * 2] = w1; rwt[t * 2 + 1] = w2;
            atomicAdd(ecnt + ex1, 1u); atomicAdd(ecnt + ex2, 1u); }
    }
}

__device__ __forceinline__ void expert_starts(const unsigned* ecnt, LAS int* pstart, int tid) {
    if (tid < 64) { const int cn = (int)ecnt[tid]; const int pad = (cn + 127) / 128 * 128; int s = pad;
        for (int o = 1; o < 64; o <<= 1) { const int u = shfl_up_(s, o); if (tid >= o) s += u; }
        pstart[tid] = s - pad; if (tid == 63) pstart[64] = s; }
}
__device__ __forceinline__ void phase_slots(const Params& p, LAS unsigned char* lds) {
    const int G = gridDim.x, c = blockIdx.x, tid = tid_();
    unsigned char* ws = opq(p.ws); const unsigned* ecnt = (const unsigned*)(ws + OFF_SMALL + SM_CTRL); unsigned* fill = (unsigned*)(ws + OFF_SMALL + SM_CTRL) + 64;
    const int* rexp = (const int*)(ws + OFF_SMALL + SM_ROUTE); int* rpos = (int*)(ws + OFF_SMALL + SM_ROUTE + 256 * 1024); int* rowtok = (int*)(ws + OFF_ROWTOK);
    LAS int* pstart = (LAS int*)lds;
    __syncthreads();
    expert_starts(ecnt, pstart, tid);
    __syncthreads();
    for (int a = c * 512 + tid; a < 2 * T_; a += G * 512) { const int e = rexp[a]; const int pos = pstart[e] + (int)atomicAdd(fill + e, 1u); rpos[a] = pos; rowtok[pos] = a >> 1; }
}

#define MOE_BAR() do { asm volatile("s_waitcnt lgkmcnt(0)" ::: "memory"); __builtin_amdgcn_s_barrier(); asm volatile("" ::: "memory"); } while (0)
__device__ __forceinline__ void vm_wait(int n) {
    if (n >= 20) asm volatile("s_waitcnt vmcnt(20)" ::: "memory"); else if (n >= 16) asm volatile("s_waitcnt vmcnt(16)" ::: "memory");
    else if (n >= 14) asm volatile("s_waitcnt vmcnt(14)" ::: "memory"); else if (n >= 12) asm volatile("s_waitcnt vmcnt(12)" ::: "memory");
    else if (n >= 10) asm volatile("s_waitcnt vmcnt(10)" ::: "memory"); else if (n >= 8) asm volatile("s_waitcnt vmcnt(8)" ::: "memory");
    else if (n >= 6) asm volatile("s_waitcnt vmcnt(6)" ::: "memory"); else if (n >= 4) asm volatile("s_waitcnt vmcnt(4)" ::: "memory");
    else if (n >= 2) asm volatile("s_waitcnt vmcnt(2)" ::: "memory"); else asm volatile("s_waitcnt vmcnt(0)" ::: "memory");
}
template <int MODE, int NT>
__device__ __forceinline__ void moe_kloop(const Params& p, LAS unsigned char* lds, int e, int nt, int rs, int cnt) {
    constexpr int K = MODE == 0 ? 2048 : 512, NK = K / 64, WLD = MODE == 0 ? 512 : 2048, NA = NT ? NT : 1;
    const int tid = tid_(), w = __builtin_amdgcn_readfirstlane(tid >> 6), lane = tid & 63, fr = lane & 15, fq = lane >> 4;
    unsigned char* ws = opq(p.ws);
    LAS float* Rw = (LAS float*)(lds + w * 4096);
    LAS bf16_t* Wb0 = (LAS bf16_t*)(lds + 32768);
    LAS unsigned char* Ar = lds + 69632 + w * 10240;
    LAS int* tokl = (LAS int*)(lds + 151552);
    const bf16_t* Asrc = (const bf16_t*)(ws + (MODE == 0 ? OFF_H : OFF_ACT));
    const float* W0; const float* W1;
    if (MODE == 0) { W0 = p.w_exp_gate + (size_t)e * 2048 * 512 + nt * 64; W1 = p.w_exp_up + (size_t)e * 2048 * 512 + nt * 64; }
    else { W0 = p.w_exp_down + (size_t)e * 512 * 2048 + nt * 128; W1 = W0 + 64; }
    auto issueA = [&](int ks) {
        const int r0 = lane >> 3, cs0 = (lane & 7) ^ (r0 & 7);
        unsigned ro[NA][2];
#pragma unroll
        for (int mt = 0; mt < NT; ++mt)
#pragma unroll
            for (int i = 0; i < 2; ++i)
                ro[mt][i] = MODE == 0 ? (unsigned)tokl[mt * 128 + 16 * w + r0 + 8 * i] * 2048u : (unsigned)(rs + mt * 128 + 16 * w + r0 + 8 * i) * 512u;
#pragma unroll
        for (int mt = 0; mt < NT; ++mt) {
#pragma unroll
            for (int i = 0; i < 2; ++i)
                __builtin_amdgcn_global_load_lds((const unsigned*)(Asrc + (size_t)(ro[mt][i] + (unsigned)(ks * 64 + cs0 * 8))), (LAS unsigned*)(Ar + mt * 2048 + i * 1024), 16, 0, 0);
            __builtin_amdgcn_sched_barrier(0); } };
    auto issueW = [&](int ks) {
#pragma unroll
        for (int i = 0; i < 4; ++i) { const int pch = lane + 64 * i, r = pch >> 5, cc = pch & 31;
            const float* src = (cc < 16 ? W0 + 4 * cc : W1 + 4 * (cc - 16)) + (size_t)(ks * 64 + 8 * w + r) * WLD;
            __builtin_amdgcn_global_load_lds((const unsigned*)src, (LAS unsigned*)((LAS unsigned char*)Rw + i * 1024), 16, 0, 0); } };
    auto convertW = [&](int buf) {
        LAS bf16_t* Wb = Wb0 + buf * (128 * 72);
#pragma unroll
        for (int c2 = 0; c2 < 2; ++c2) { const int nm = lane + 64 * c2; float v[8];
#pragma unroll
            for (int r = 0; r < 8; ++r) v[r] = Rw[r * 128 + nm];
            const int nrow = MODE == 0 ? (((nm & 63) >> 4) * 2 + (nm >> 6)) * 16 + (nm & 15) : nm;
            u32x4 pk; pk.x = pack2(v[0], v[1]); pk.y = pack2(v[2], v[3]); pk.z = pack2(v[4], v[5]); pk.w = pack2(v[6], v[7]);
            *(LAS u32x4*)(Wb + nrow * 72 + 8 * w) = pk; } };
    auto rawpack = [&](int c2) -> u32x4 { const int nm = lane + 64 * c2; float v[8];
#pragma unroll
        for (int r = 0; r < 8; ++r) v[r] = Rw[r * 128 + nm];
        u32x4 pk; pk.x = pack2(v[0], v[1]); pk.y = pack2(v[2], v[3]); pk.z = pack2(v[4], v[5]); pk.w = pack2(v[6], v[7]); return pk; };
    auto wbstore = [&](int buf, int c2, u32x4 pk) { const int nm = lane + 64 * c2;
        const int nrow = MODE == 0 ? (((nm & 63) >> 4) * 2 + (nm >> 6)) * 16 + (nm & 15) : nm;
        *(LAS u32x4*)(Wb0 + buf * (128 * 72) + nrow * 72 + 8 * w) = pk; };
    f32x4 acc[NA][8];
#pragma unroll
    for (int a = 0; a < NA; ++a)
#pragma unroll
        for (int n = 0; n < 8; ++n) acc[a][n] = (f32x4){0.f, 0.f, 0.f, 0.f};
    issueW(0); asm volatile("s_waitcnt vmcnt(0)" ::: "memory"); convertW(0);
    asm volatile("s_waitcnt lgkmcnt(0)" ::: "memory");
    issueA(0);
    if (NK > 1) issueW(1);
#pragma unroll 1
    for (int ks = 0; ks < NK; ++ks) {
        MOE_BAR();
        const LAS bf16_t* Wb = Wb0 + (ks & 1) * (128 * 72);
        if (ks + 1 < NK) asm volatile("s_waitcnt vmcnt(4)" ::: "memory");
        else asm volatile("s_waitcnt vmcnt(0)" ::: "memory");
        bf16x8 af[NA][2];
#pragma unroll
        for (int mt = 0; mt < NT; ++mt)
#pragma unroll
            for (int k2 = 0; k2 < 2; ++k2) af[mt][k2] = *(const LAS bf16x8*)(Ar + mt * 2048 + (fr * 8 + ((4 * k2 + fq) ^ (fr & 7))) * 16);
        if (ks + 1 < NK) asm volatile("s_waitcnt vmcnt(0)" ::: "memory");
        const int ksn = ks + 1 < NK ? ks + 1 : ks;
        const int r0 = lane >> 3, cs0 = (lane & 7) ^ (r0 & 7);
        auto rowoff = [&](int l) -> unsigned { const int mt = l >> 1, i = l & 1;
            return MODE == 0 ? (unsigned)tokl[mt * 128 + 16 * w + r0 + 8 * i] * 2048u : (unsigned)(rs + mt * 128 + 16 * w + r0 + 8 * i) * 512u; };
        unsigned off = NT > 0 ? rowoff(0) : 0u;
        float rv[8];
        bf16x8 b = *(const LAS bf16x8*)(Wb + fr * 72 + 8 * fq);
        asm volatile("s_waitcnt lgkmcnt(0)" ::: "memory");
#pragma unroll
        for (int f = 0; f < 16; ++f) { const int k2 = f >> 3, n = f & 7; bf16x8 bn = b;
            if (f + 1 < 16) bn = *(const LAS bf16x8*)(Wb + (16 * ((f + 1) & 7) + fr) * 72 + 32 * ((f + 1) >> 3) + 8 * fq);
            if (f < 2 * NT) {
                __builtin_amdgcn_global_load_lds((const unsigned*)(Asrc + (size_t)(off + (unsigned)(ksn * 64 + cs0 * 8))), (LAS unsigned*)(Ar + (f >> 1) * 2048 + (f & 1) * 1024), 16, 0, 0);
                if (f + 1 < 2 * NT) off = rowoff(f + 1); }
            if (f == 0 || f == 4) {
#pragma unroll
                for (int r = 0; r < 8; ++r) rv[r] = Rw[r * 128 + lane + (f == 0 ? 0 : 64)]; }
            if (f == 3 || f == 7) { u32x4 pk; pk.x = pack2(rv[0], rv[1]); pk.y = pack2(rv[2], rv[3]); pk.z = pack2(rv[4], rv[5]); pk.w = pack2(rv[6], rv[7]);
                wbstore((ks + 1) & 1, f == 3 ? 0 : 1, pk); }
            __builtin_amdgcn_sched_barrier(6);
#pragma unroll
            for (int mt = 0; mt < NT; ++mt) acc[mt][n] = __builtin_amdgcn_mfma_f32_16x16x32_bf16(b, af[mt][k2], acc[mt][n], 0, 0, 0);
            __builtin_amdgcn_sched_barrier(6);
            b = bn; }
        asm volatile("s_waitcnt lgkmcnt(0)" ::: "memory");
        if (ks + 2 < NK) issueW(ks + 2);
    }
#pragma unroll
    for (int mt = 0; mt < NT; ++mt) { const int rl = mt * 128 + 16 * w + fr;
        if (rl < cnt) {
            if (MODE == 0) { bf16_t* dst = (bf16_t*)(ws + OFF_ACT) + (size_t)(rs + rl) * 512 + nt * 64 + 4 * fq;
#pragma unroll
                for (int g = 0; g < 4; ++g) { const f32x4 gt = acc[mt][2 * g], u = acc[mt][2 * g + 1];
                    u32x2 pk; pk.x = pack2(siluf_(gt[0]) * u[0], siluf_(gt[1]) * u[1]); pk.y = pack2(siluf_(gt[2]) * u[2], siluf_(gt[3]) * u[3]); *(u32x2*)(dst + 16 * g) = pk; } }
            else { bf16_t* dst = (bf16_t*)(ws + OFF_YE) + (size_t)(rs + rl) * 2048 + nt * 128 + 4 * fq;
#pragma unroll
                for (int n = 0; n < 8; ++n) { const f32x4 v = acc[mt][n]; u32x2 pk; pk.x = pack2(v[0], v[1]); pk.y = pack2(v[2], v[3]); *(u32x2*)(dst + 16 * n) = pk; } } } }
    asm volatile("s_waitcnt vmcnt(0)" ::: "memory");
}
template <int MODE>
__device__ __forceinline__ void moe_item(const Params& p, LAS unsigned char* lds, int e, int nt, int rs, int cnt) {
    const int tid = tid_(), w = __builtin_amdgcn_readfirstlane(tid >> 6);
    unsigned char* ws = opq(p.ws); LAS int* tokl = (LAS int*)(lds + 151552);
    MOE_BAR();
    if (MODE == 0) { const int* rowtok = (const int*)(ws + OFF_ROWTOK); for (int i = tid; i < 640; i += 512) tokl[i] = rowtok[rs + (i < cnt ? i : 0)]; }
    MOE_BAR();
    const int mine = cnt - 16 * w; const int ntw = mine <= 0 ? 0 : (mine + 127) >> 7;
    if (ntw >= 5) moe_kloop<MODE, 5>(p, lds, e, nt, rs, cnt);
    else if (ntw == 4) moe_kloop<MODE, 4>(p, lds, e, nt, rs, cnt);
    else if (ntw == 3) moe_kloop<MODE, 3>(p, lds, e, nt, rs, cnt);
    else if (ntw == 2) moe_kloop<MODE, 2>(p, lds, e, nt, rs, cnt);
    else if (ntw == 1) moe_kloop<MODE, 1>(p, lds, e, nt, rs, cnt);
    else moe_kloop<MODE, 0>(p, lds, e, nt, rs, cnt);
}
template <int MODE>
__device__ __forceinline__ void phase_moe(const Params& p, LAS unsigned char* lds) {
    const int G = gridDim.x, c = blockIdx.x, tid = tid_();
    unsigned char* ws = opq(p.ws); const unsigned* ecnt = (const unsigned*)(ws + OFF_SMALL + SM_CTRL);
    LAS int* pstart = (LAS int*)(lds + 154112); LAS int* order = pstart + 80;
    __syncthreads();
    expert_starts(ecnt, pstart, tid);
    if (tid < 64) { const unsigned mine = ecnt[tid]; int rk = 0;
        for (int j = 0; j < 64; ++j) { const unsigned o = ecnt[j]; rk += (o > mine || (o == mine && j < tid)) ? 1 : 0; }
        order[rk] = tid; }
    __syncthreads();
    constexpr int PER = MODE == 0 ? 8 : 16;
    if (G == 256) {
        const int x = c & 7, sl = c >> 3, kk = sl / PER, nt = sl % PER; constexpr int EPR = 256 / PER;
        for (int j = 0; j < 64 / EPR; ++j) { const int within = 8 * kk + x; const int rnk = EPR * j + ((j & 1) ? EPR - 1 - within : within);
            const int e = order[rnk]; const int cn = (int)ecnt[e], rs = pstart[e];
            for (int seg = 0; seg < cn; seg += 640) moe_item<MODE>(p, lds, e, nt, rs + seg, min(cn - seg, 640)); }
    } else {
        for (int it = c; it < 64 * PER; it += G) { const int e = it / PER, nt = it % PER; const int cn = (int)ecnt[e], rs = pstart[e];
            for (int seg = 0; seg < cn; seg += 640) moe_item<MODE>(p, lds, e, nt, rs + seg, min(cn - seg, 640)); }
    }
    __syncthreads();
}

__device__ __forceinline__ void phase_final(const Params& p) {
    const int G = gridDim.x, c = blockIdx.x, tid = tid_(), w = tid >> 6, lane = tid & 63;
    unsigned char* ws = opq(p.ws); const float* x1 = (const float*)(ws + OFF_X1); const bf16_t* ye = (const bf16_t*)(ws + OFF_YE);
    const float* rwt = (const float*)(ws + OFF_SMALL + SM_ROUTE + 128 * 1024); const int* rpos = (const int*)(ws + OFF_SMALL + SM_ROUTE + 256 * 1024);
    for (int t = c * 8 + w; t < T_; t += G * 8) {
        const float w0 = rwt[t * 2], w1 = rwt[t * 2 + 1]; const bf16_t* y0 = ye + (size_t)rpos[t * 2] * 2048; const bf16_t* y1 = ye + (size_t)rpos[t * 2 + 1] * 2048;
        f32x4 v[8]; float ss = 0.f;
#pragma unroll
        for (int i = 0; i < 8; ++i) { const int k = i * 256 + 4 * lane; v[i] = *(const f32x4*)(x1 + (size_t)t * 2048 + k);
            const u32x2 a = *(const u32x2*)(y0 + k), b = *(const u32x2*)(y1 + k);
            v[i][0] += w0 * bflo(a.x) + w1 * bflo(b.x); v[i][1] += w0 * bfhi(a.x) + w1 * bfhi(b.x); v[i][2] += w0 * bflo(a.y) + w1 * bflo(b.y); v[i][3] += w0 * bfhi(a.y) + w1 * bfhi(b.y);
            ss += v[i][0] * v[i][0] + v[i][1] * v[i][1] + v[i][2] * v[i][2] + v[i][3] * v[i][3]; }
        ss = wave_sum(ss); const float rs = rsqrtf(ss * (1.0f / 2048.0f) + EPS);
#pragma unroll
        for (int i = 0; i < 8; ++i) { const int k = i * 256 + 4 * lane; const f32x4 g = *(const f32x4*)(p.norm_final + k);
            f32x4 o; o[0] = v[i][0] * rs * g[0]; o[1] = v[i][1] * rs * g[1]; o[2] = v[i][2] * rs * g[2]; o[3] = v[i][3] * rs * g[3];
            *(f32x4*)(p.out + (size_t)t * 2048 + k) = o; }
    }
}

template <int PH>
__device__ __forceinline__ void run_phase(const Params& p, LAS unsigned char* lds) {
    const int G = gridDim.x, c = blockIdx.x; unsigned char* ws = opq(p.ws);
    if constexpr (PH == 0) phase0(p, lds);
    if constexpr (PH == 1) { pg8::DenseOrder S; S.init(ws + OFF_H, ws + OFF_WT_IN, T_, LDP, 2048, G, c); EpiProj E; E.O = (bf16_t*)(ws + OFF_PROJ); pg8::gemm_phase(lds, 2048, S, E); }
    if constexpr (PH == 2) { phase_rope(p); u32x4 xr[3][2][4]; float ba[2]; if (c < NITEM) dn_prep_load(p, c, xr, ba);
        for (int item = c; item < NITEM; item += G) dn_prep_item(p, item, item + G < NITEM ? item + G : -1, lds, xr, ba); }
    if constexpr (PH == 3) phase3(p, lds);
    if constexpr (PH == 4) phase_attn(p, lds);
    if constexpr (PH == 5) { pg8::DenseOrder S; S.init(ws + OFF_Y, ws + OFF_WT_DN, T_, 2048, 1024, G, c); EpiMerge<0> E; E.M = (bf16_t*)(ws + OFF_H); E.proj = (const bf16_t*)(ws + OFF_PROJ); E.bg = p.b_gates; pg8::gemm_phase(lds, 1024, S, E);
              pg8::DenseOrder S2; S2.init(ws + OFF_Y + 32 * MB, ws + OFF_WT_AT, T_, 2048, 1024, G, c); EpiMerge<1> E2; E2.M = E.M; E2.proj = E.proj; E2.bg = p.b_gates; pg8::gemm_phase(lds, 1024, S2, E2); }
    if constexpr (PH == 6) { pg8::DenseOrder S; S.init(ws + OFF_H, ws + OFF_WT_OUT, T_, 2048, 2048, G, c); EpiResid E; E.X1 = (float*)(ws + OFF_X1); E.X = p.x; pg8::gemm_phase(lds, 2048, S, E); }
    if constexpr (PH == 7) phase_router(p, lds);
    if constexpr (PH == 8) phase_slots(p, lds);
    if constexpr (PH == 9) phase_moe<0>(p, lds);
    if constexpr (PH == 10) phase_moe<1>(p, lds);
    if constexpr (PH == 11) phase_final(p);
}

template <int PH>
__device__ __forceinline__ void phase_step(const Params& p, LAS unsigned char* lds, cg::grid_group& grid, const XcdBarrier& xb, unsigned long long& tp) {
#ifdef ONLY_PHASE
    if constexpr (PH != ONLY_PHASE) return;
#endif
    unsigned long long t0 = 0;
    if constexpr (PH == PROBE_PHASE) t0 = __builtin_amdgcn_s_memrealtime();
    run_phase<PH>(p, lds);
    if constexpr (PH + 1 < NPHASE) { if constexpr (PH == 0) grid.sync(); else xcd_barrier(xb); }
    if constexpr (PH == PROBE_PHASE) tp = __builtin_amdgcn_s_memrealtime() - t0;
}

__global__ void __launch_bounds__(512, 2) mega_kernel(Params p) {
    extern __shared__ __attribute__((aligned(16))) unsigned char shm[];
    LAS unsigned char* lds = (LAS unsigned char*)shm;
    cg::grid_group grid = cg::this_grid();
    volatile LAS unsigned* xst = (volatile LAS unsigned*)(lds + LDS_BYTES - 16);
    if (threadIdx.x == 0) { xst[0] = 0u; xst[1] = 0u; }
    __syncthreads();
    const XcdBarrier xb = xcd_barrier_post((unsigned*)(p.ws + OFF_SMALL + SM_BAR), xst);
    unsigned long long tp = 0;
    phase_step<0>(p, lds, grid, xb, tp); phase_step<1>(p, lds, grid, xb, tp); phase_step<2>(p, lds, grid, xb, tp); phase_step<3>(p, lds, grid, xb, tp);
    phase_step<4>(p, lds, grid, xb, tp); phase_step<5>(p, lds, grid, xb, tp); phase_step<6>(p, lds, grid, xb, tp); phase_step<7>(p, lds, grid, xb, tp);
    phase_step<8>(p, lds, grid, xb, tp); phase_step<9>(p, lds, grid, xb, tp); phase_step<10>(p, lds, grid, xb, tp); phase_step<11>(p, lds, grid, xb, tp);
#if PROBE_PHASE >= 0
    if (blockIdx.x == 0) { const unsigned long long te = __builtin_amdgcn_s_memrealtime(); while (__builtin_amdgcn_s_memrealtime() - te < (unsigned long long)PROBE_MULT * tp) __builtin_amdgcn_s_sleep(8); }
#endif
}

extern "C" void kernel_launch(void* const* d_in, const int* in_sizes, int n_in, void* d_out, int out_size, void* d_ws, size_t ws_size, hipStream_t stream) {
    (void)in_sizes; (void)n_in; (void)out_size;
    static int grid_blocks = 0;
    if (!grid_blocks) {
        int dev = 0, cus = 0, per_cu = 0;
        hipGetDevice(&dev);
        hipDeviceGetAttribute(&cus, hipDeviceAttributeMultiprocessorCount, dev);
        hipFuncSetAttribute((const void*)mega_kernel, hipFuncAttributeMaxDynamicSharedMemorySize, LDS_BYTES);
        hipOccupancyMaxActiveBlocksPerMultiprocessor(&per_cu, mega_kernel, 512, LDS_BYTES);
        if (per_cu > 1) per_cu = 1;
        grid_blocks = cus * per_cu;
        if (grid_blocks <= 0) { fprintf(stderr, "occupancy query failed\n"); grid_blocks = 0; return; }
    }
    if (ws_size < WS_NEED) { fprintf(stderr, "workspace too small: %zu < %zu\n", ws_size, (size_t)WS_NEED); return; }
    Params p{};
    p.x = (const float*)d_in[0]; p.positions = (const int*)d_in[1]; p.norm_mix = (const float*)d_in[2]; p.w_in = (const float*)d_in[3]; p.b_gates = (const float*)d_in[4];
    p.conv_w = (const float*)d_in[5]; p.a_log = (const float*)d_in[6]; p.dt_bias = (const float*)d_in[7]; p.dn_norm_w = (const float*)d_in[8]; p.idx_k_norm = (const float*)d_in[9];
    p.w_proj_dn = (const float*)d_in[10]; p.w_proj_att = (const float*)d_in[11]; p.w_out = (const float*)d_in[12]; p.norm_ffn = (const float*)d_in[13]; p.w_group = (const float*)d_in[14];
    p.b_group = (const float*)d_in[15]; p.w_router = (const float*)d_in[16]; p.b_router = (const float*)d_in[17]; p.w_exp_gate = (const float*)d_in[18]; p.w_exp_up = (const float*)d_in[19];
    p.w_exp_down = (const float*)d_in[20]; p.norm_final = (const float*)d_in[21]; p.out = (float*)d_out; p.ws = (unsigned char*)d_ws;
    (void)hipMemsetAsync((unsigned char*)d_ws + OFF_SMALL + SM_BAR, 0, XCD_BAR_WORDS * 4, stream);
    void* args[] = {&p};
    hipError_t e = hipLaunchCooperativeKernel((const void*)mega_kernel, dim3(grid_blocks), dim3(512), args, LDS_BYTES, stream);
    if (e != hipSuccess) fprintf(stderr, "cooperative launch failed: %s (grid %d)\n", hipGetErrorString(e), grid_blocks);
}
```

```cpp
#include <hip/hip_runtime.h>
#include <hip/hip_cooperative_groups.h>
#include <cstdio>
#include <cstdint>
namespace cg = cooperative_groups;

#define LAS __attribute__((address_space(3)))
typedef unsigned short bf16_t;
typedef short bf16x8 __attribute__((ext_vector_type(8)));
typedef float f32x4 __attribute__((ext_vector_type(4)));
typedef float f32x2 __attribute__((ext_vector_type(2)));
typedef unsigned u32x4 __attribute__((ext_vector_type(4)));
typedef unsigned u32x2 __attribute__((ext_vector_type(2)));

#ifndef PROBE_PHASE
#define PROBE_PHASE -1
#endif
#define PROBE_MULT 8
#ifndef SINGLE_LAUNCH
#define SINGLE_LAUNCH 1
#endif

constexpr int T_ = 16384, D_ = 2048, IN_COLS = 11864, LDP = 12032;
constexpr int C_DNQ = 0, C_DNK = 1024, C_DNV = 2048, C_Z = 3072, C_AQ = 4096, C_AK = 5120, C_AV = 6144, C_IQ = 7168,
              C_G0 = 7680, C_G1 = 9728, C_IK = 11776, C_B = 11840, C_A = 11848, C_IW = 11856;
constexpr int NITEM = 2048;
constexpr int PMAX = 40960;
constexpr float EPS = 1e-6f;
constexpr int LDS_BYTES = 156 * 1024;
constexpr int NPHASE = 12;

constexpr size_t MB = 1ull << 20;
constexpr size_t OFF_WT_IN  = 0;
constexpr size_t OFF_WT_DN  = 50 * MB;
constexpr size_t OFF_WT_AT  = 55 * MB;
constexpr size_t OFF_WT_OUT = 60 * MB;
constexpr size_t OFF_COS    = 54 * MB;
constexpr size_t OFF_SIN    = 59 * MB;
constexpr size_t OFF_WR     = 68 * MB;
constexpr size_t OFF_SMALL  = 69 * MB;
constexpr size_t OFF_H      = 72 * MB;
constexpr size_t OFF_PROJ   = 136 * MB;
constexpr size_t OFF_DNP    = 512 * MB;
constexpr size_t OFF_SCAN   = 656 * MB;
constexpr size_t OFF_Y      = 752 * MB;
constexpr size_t OFF_X1     = 816 * MB;
constexpr size_t WS_NEED    = 944 * MB;
constexpr size_t OFF_MASK   = 816 * MB;
constexpr size_t OFF_ROWTOK = 520 * MB;
constexpr size_t OFF_YE     = 528 * MB;
constexpr size_t OFF_ACT    = 712 * MB;
constexpr size_t SM_KIDX   = 0;
constexpr size_t SM_WQ     = 2 * MB;
constexpr size_t SM_ROUTE  = 2 * MB + 512 * 1024;
constexpr size_t SM_GLAST  = 2 * MB + 960 * 1024;
constexpr size_t SM_CTRL   = 2 * MB + 1000 * 1024;
constexpr size_t SM_BAR    = 2 * MB + 1008 * 1024;
constexpr size_t DNP_W = 0, DNP_UT = 32 * MB, DNP_QD = 64 * MB, DNP_KDT = 96 * MB, DNP_ATT = 128 * MB;

struct Params {
    const float* x; const int* positions; const float* norm_mix; const float* w_in; const float* b_gates; const float* conv_w;
    const float* a_log; const float* dt_bias; const float* dn_norm_w; const float* idx_k_norm; const float* w_proj_dn;
    const float* w_proj_att; const float* w_out; const float* norm_ffn; const float* w_group; const float* b_group;
    const float* w_router; const float* b_router; const float* w_exp_gate; const float* w_exp_up; const float* w_exp_down;
    const float* norm_final; float* out; unsigned char* ws;
};

__device__ __forceinline__ int tid_() { int t = threadIdx.x; asm volatile("" : "+v"(t)); return t; }
__device__ __forceinline__ unsigned char* opq(unsigned char* q) { unsigned long long z = 0ull; asm volatile("" : "+s"(z)); return q + z; }
__device__ __forceinline__ bf16_t f2bf(float f) { unsigned u = __float_as_uint(f); u += 0x7fffu + ((u >> 16) & 1u); return (bf16_t)(u >> 16); }
__device__ __forceinline__ float bf2f(bf16_t b) { return __uint_as_float(((unsigned)b) << 16); }
__device__ __forceinline__ unsigned pack2(float lo, float hi) { return (unsigned)f2bf(lo) | ((unsigned)f2bf(hi) << 16); }
__device__ __forceinline__ float bflo(unsigned w) { return __uint_as_float(w << 16); }
__device__ __forceinline__ float bfhi(unsigned w) { return __uint_as_float(w & 0xffff0000u); }
__device__ __forceinline__ float sigmoidf_(float x) { return 1.0f / (1.0f + __expf(-x)); }
__device__ __forceinline__ float siluf_(float x) { return x / (1.0f + __expf(-x)); }
template <int CTRL> __device__ __forceinline__ float dpp_f(float v) { return __int_as_float(__builtin_amdgcn_update_dpp(0, __float_as_int(v), CTRL, 0xf, 0xf, true)); }
__device__ __forceinline__ float sum16(float v) {
    v += dpp_f<0xB1>(v); v += dpp_f<0x4E>(v); v += dpp_f<0x141>(v); v += dpp_f<0x140>(v); return v;
}
__device__ __forceinline__ int lane_() { return tid_() & 63; }
__device__ __forceinline__ int bperm_i(int srclane, int v) { return __builtin_amdgcn_ds_bpermute(srclane << 2, v); }
__device__ __forceinline__ float shfl_xor_(float v, int o) { return __int_as_float(bperm_i(lane_() ^ o, __float_as_int(v))); }
__device__ __forceinline__ int shfl_xor_(int v, int o) { return bperm_i(lane_() ^ o, v); }
__device__ __forceinline__ float shfl_(float v, int src) { return __int_as_float(bperm_i(src, __float_as_int(v))); }
__device__ __forceinline__ int shfl_(int v, int src) { return bperm_i(src, v); }
__device__ __forceinline__ float shfl_up_(float v, int o) { return __int_as_float(bperm_i((lane_() - o) & 63, __float_as_int(v))); }
__device__ __forceinline__ int shfl_up_(int v, int o) { return bperm_i((lane_() - o) & 63, v); }
__device__ __forceinline__ float wave_sum(float v) { for (int o = 32; o >= 1; o >>= 1) v += shfl_xor_(v, o); return v; }

#define XB_TMO      128
#define XB_XCNT(j)  (256  + 64 * (j))
#define XB_XSUB(j)  (1280 + 64 * (j))
#define XB_XGEN(j)  (2304 + 64 * (j))
#define XB_TOP      3328
#define XB_TOPGEN   3392
#define XCD_BAR_WORDS 3456
#define XB_SPIN_CAP (1u << 18)

__device__ __forceinline__ unsigned xb_ld(unsigned* p)              { return __hip_atomic_load(p, __ATOMIC_RELAXED, __HIP_MEMORY_SCOPE_AGENT); }
__device__ __forceinline__ unsigned xb_add(unsigned* p, unsigned v) { return __hip_atomic_fetch_add(p, v, __ATOMIC_RELAXED, __HIP_MEMORY_SCOPE_AGENT); }
__device__ __forceinline__ unsigned xb_xcc_id() { return (unsigned)__builtin_amdgcn_s_getreg((3 << 11) | 20) & 0xFu; }
#define XB_SPIN(cond, bar) do { unsigned _sp = 0; while (cond) { __builtin_amdgcn_s_sleep(1); \
    if ((++_sp & 255u) == 0u) { if (xb_ld(&(bar)[XB_TMO])) break; if (_sp > XB_SPIN_CAP) { atomicAdd(&(bar)[XB_TMO], 1u); break; } } } } while (0)

struct XcdBarrier {
    unsigned* bar; unsigned x;
    volatile LAS unsigned* st;
};

__device__ __forceinline__ XcdBarrier xcd_barrier_post(unsigned* bar, volatile LAS unsigned* st) {
    XcdBarrier b; b.bar = bar; b.x = xb_xcc_id(); b.st = st;
    if (threadIdx.x == 0) (void)xb_add(&bar[XB_XCNT(b.x)], 1u);
    return b;
}
__device__ __forceinline__ void xcd_barrier_complete(unsigned* bar, unsigned x, unsigned& nloc, unsigned& nx) {
    const unsigned G = gridDim.x * gridDim.y * gridDim.z;
    unsigned sum, cnt, mine, sp = 0u;
    for (;;) {
        sum = 0u; cnt = 0u; mine = 0u;
#pragma unroll
        for (unsigned j = 0; j < 16; ++j) { const unsigned c = xb_ld(&bar[XB_XCNT(j)]); sum += c; cnt += (c > 0u) ? 1u : 0u; mine = (j == x) ? c : mine; }
        if (sum == G) break;
        __builtin_amdgcn_s_sleep(1);
        if ((++sp & 255u) == 0u) { if (xb_ld(&bar[XB_TMO])) break; if (sp > XB_SPIN_CAP) { atomicAdd(&bar[XB_TMO], 1u); break; } }
    }
    nloc = mine > 0u ? mine : 1u; nx = cnt > 0u ? cnt : 1u;
}

__device__ __forceinline__ void xcd_barrier(const XcdBarrier& b) {
    asm volatile("s_waitcnt vmcnt(0)" ::: "memory");
    __syncthreads();
    if (threadIdx.x == 0) {
        unsigned* bar = b.bar;
        __builtin_amdgcn_s_waitcnt(0);
        unsigned nloc = b.st[0], nx = b.st[1];
        if (nloc == 0u) { xcd_barrier_complete(bar, b.x, nloc, nx); b.st[0] = nloc; b.st[1] = nx; }
        const unsigned old = xb_add(&bar[XB_XSUB(b.x)], 1u);
        const unsigned gen = old / nloc;
        if (old + 1u == (gen + 1u) * nloc) {
            __builtin_amdgcn_fence(__ATOMIC_RELEASE, "agent");
            asm volatile("s_waitcnt vmcnt(0)" ::: "memory");
            const unsigned og = xb_add(&bar[XB_TOP], 1u);
            const unsigned tg = og / nx;
            if (og + 1u == (tg + 1u) * nx) xb_add(&bar[XB_TOPGEN], 1u);
            else XB_SPIN(xb_ld(&bar[XB_TOPGEN]) == tg, bar);
            __builtin_amdgcn_fence(__ATOMIC_ACQUIRE, "agent");
            xb_add(&bar[XB_XGEN(b.x)], 1u);
            asm volatile("s_waitcnt vmcnt(0)" ::: "memory");
        } else {
            XB_SPIN(xb_ld(&bar[XB_XGEN(b.x)]) == gen, bar);
            __builtin_amdgcn_fence(__ATOMIC_ACQUIRE, "agent");
            asm volatile("s_waitcnt vmcnt(0)" ::: "memory");
        }
    }
    __syncthreads();
}

namespace pg8 {
constexpr int BM = 256, BK = 64, HALF = 128, HTB = HALF * BK * 2, STAGE_BYTES = 8 * HTB, NXCD = 8, WGM = 8;
__device__ __forceinline__ int lds_byte(int r, int c) { const int st = (r >> 4) * 2 + (c >> 5), rr = r & 15, cc = c & 31, ob = rr * 64 + cc * 2; return st * 1024 + (ob ^ (((ob >> 9) & 1) << 5)); }
__device__ __forceinline__ void stage_rc(int b, int& R, int& C) { const int st = b / 1024, sb = b % 1024, swz = sb ^ (((sb >> 9) & 1) << 5); R = (st >> 1) * 16 + swz / 64; C = (st & 1) * 32 + (swz % 64) / 2; }
__device__ __forceinline__ int perm32(int rho) { const int n = rho >> 4, i = rho & 15; return 8 * (i >> 2) + 4 * n + (i & 3); }

struct Unit { int pm, pn; const char* A; const char* B; };

struct DenseOrder {
    int nM, nN, nwg, G, c, K; const char* A; const char* Bt;
    __device__ void init(const void* A_, const void* Bt_, int M, int N, int K_, int G_, int c_) { A = (const char*)A_; Bt = (const char*)Bt_; nM = M / BM; nN = N / BM; nwg = nM * nN; G = G_; c = c_; K = K_; }
    __device__ bool next(int i, Unit& u) const {
        const long L = (long)i * G + c; if (L >= nwg) return false;
        int wgid = (int)L; { const int q = nwg / NXCD, r = nwg % NXCD, xcd = wgid % NXCD, off = wgid / NXCD; wgid = (xcd < r ? xcd * (q + 1) : r * (q + 1) + (xcd - r) * q) + off; }
        const int nig = WGM * nN, gid = wgid / nig, fm = gid * WGM, gsz = (nM - fm) < WGM ? (nM - fm) : WGM;
        u.pm = fm + ((wgid % nig) % gsz); u.pn = (wgid % nig) / gsz;
        u.A = A + (size_t)u.pm * 256 * K * 2; u.B = Bt + (size_t)u.pn * 256 * K * 2; return true;
    }
};
struct GroupedOrder {
    const int* tile_e; int n_mt, nN, G, c, K; const char* A; const char* Bt; size_t bstride;
    __device__ bool next(int i, Unit& u) const {
        const long L = (long)i * G + c; if (L >= (long)n_mt * nN) return false;
        u.pn = (int)(L / n_mt); u.pm = (int)(L % n_mt);
        const int e = tile_e[u.pm];
        u.A = A + (size_t)u.pm * 256 * K * 2; u.B = Bt + (size_t)e * bstride + (size_t)u.pn * 256 * K * 2; return true;
    }
};

template <class Epi, class Sched>
__device__ __forceinline__ void gemm_phase(LAS unsigned char* lds, const int K, const Sched& S, const Epi& E) {
    const int tid = tid_(), wid = __builtin_amdgcn_readfirstlane(tid >> 6), lane = tid & 63, wr = wid >> 2, wc = wid & 3, fr = lane & 15, fq = lane >> 4;
    const int nt = K / BK;
    unsigned voffA[2], voffB[2];
#pragma unroll
    for (int i = 0; i < 2; ++i) { int R, C; stage_rc(tid * 16 + i * 8192, R, C); const int Rb = Epi::PERM ? ((R & ~31) + perm32(R & 31)) : R;
        voffA[i] = (unsigned)(R * K + C) * 2u; voffB[i] = (unsigned)(Rb * K + C) * 2u; }
    const size_t kstep = (size_t)(BK * 2);
    const size_t hstep = (size_t)HALF * K * 2;
    const unsigned ldsw = (unsigned)wid * 1024u;
    const int aoff = lds_byte(wr * 64 + fr, fq * 8), boff = lds_byte(wc * 32 + fr, fq * 8);
#define PG8_SA(b, h) (((b) * 2 + (h)) * HTB)
#define PG8_SB(b, h) ((4 + (b) * 2 + (h)) * HTB)
#define PG8_STAGE(bufoff, gbase, voff) do { _Pragma("unroll") for (int _i = 0; _i < 2; ++_i) \
        __builtin_amdgcn_global_load_lds((const unsigned*)((const char*)(gbase) + (voff)[_i]), (LAS unsigned*)(lds + (bufoff) + ldsw + _i * 8192), 16, 0, 0); } while (0)
#define PG8_LDA(dst, b, h) do { _Pragma("unroll") for (int m = 0; m < 4; ++m) _Pragma("unroll") for (int k = 0; k < 2; ++k) dst[m][k] = *(const LAS bf16x8*)(lds + PG8_SA(b, h) + aoff + m * 2048 + k * 1024); } while (0)
#define PG8_LDB(dst, b, h) do { _Pragma("unroll") for (int n = 0; n < 2; ++n) _Pragma("unroll") for (int k = 0; k < 2; ++k) dst[n][k] = *(const LAS bf16x8*)(lds + PG8_SB(b, h) + boff + n * 2048 + k * 1024); } while (0)
#define PG8_MMA(ai, bj, At, Bt) do { __builtin_amdgcn_s_setprio(1); _Pragma("unroll") for (int m = 0; m < 4; ++m) _Pragma("unroll") for (int n = 0; n < 2; ++n) _Pragma("unroll") for (int k = 0; k < 2; ++k) \
        acc[ai][bj][m][n] = __builtin_amdgcn_mfma_f32_16x16x32_bf16(Bt[n][k], At[m][k], acc[ai][bj][m][n], 0, 0, 0); __builtin_amdgcn_s_setprio(0); } while (0)
#define PG8_WAIT_V(n) asm volatile("s_waitcnt vmcnt(" #n ")" ::: "memory")
#define PG8_WAIT_L(n) asm volatile("s_waitcnt lgkmcnt(" #n ")" ::: "memory")
#define PG8_BAR __builtin_amdgcn_s_barrier()
#define PG8_SCHED __builtin_amdgcn_sched_barrier(0)
    Unit cur, nxt; int ui = 0;
    if (!S.next(0, cur)) return;
    f32x4 acc[2][2][4][2];
#pragma unroll
    for (int a = 0; a < 2; ++a)
#pragma unroll
        for (int b = 0; b < 2; ++b)
#pragma unroll
            for (int m = 0; m < 4; ++m)
#pragma unroll
                for (int n = 0; n < 2; ++n) acc[a][b][m][n] = (f32x4){0.f, 0.f, 0.f, 0.f};
    bf16x8 At[4][2], B0[2][2], B1[2][2];
    const char* cA = cur.A; const char* cB = cur.B;
    PG8_STAGE(PG8_SB(0, 0), cB, voffB); PG8_STAGE(PG8_SA(0, 0), cA, voffA); PG8_STAGE(PG8_SB(0, 1), cB + hstep, voffB); PG8_STAGE(PG8_SA(0, 1), cA + hstep, voffA);
    if (wr == 1) PG8_BAR;
    PG8_WAIT_V(4); PG8_BAR;
    PG8_STAGE(PG8_SB(1, 0), cB + kstep, voffB); PG8_STAGE(PG8_SA(1, 0), cA + kstep, voffA); PG8_STAGE(PG8_SB(1, 1), cB + hstep + kstep, voffB);
    PG8_WAIT_V(6); PG8_BAR;
    for (;;) {
        const bool has_next = S.next(ui + 1, nxt);
        const char* nA = has_next ? nxt.A : cA; const char* nB = has_next ? nxt.B : cB;
        for (int t = 0; t < nt; t += 2) {
            const bool last = (t == nt - 2);
            const char* a1 = cA + (size_t)(t + 1) * kstep;
            const char* a2 = last ? nA : cA + (size_t)(t + 2) * kstep; const char* b2 = last ? nB : cB + (size_t)(t + 2) * kstep;
            const char* a3 = a2 + kstep; const char* b3 = b2 + kstep;
            PG8_LDB(B0, 0, 0); PG8_SCHED; PG8_LDA(At, 0, 0); PG8_STAGE(PG8_SA(1, 1), a1 + hstep, voffA);
            PG8_WAIT_L(8); PG8_BAR; PG8_WAIT_L(0); PG8_MMA(0, 0, At, B0); PG8_BAR; PG8_SCHED;
            PG8_LDB(B1, 0, 1); PG8_STAGE(PG8_SB(0, 0), b2, voffB);
            PG8_BAR; PG8_WAIT_L(0); PG8_MMA(0, 1, At, B1); PG8_BAR;
            PG8_LDA(At, 0, 1); PG8_STAGE(PG8_SA(0, 0), a2, voffA);
            PG8_BAR; PG8_WAIT_L(0); PG8_MMA(1, 0, At, B0); PG8_BAR; PG8_SCHED;
            PG8_STAGE(PG8_SB(0, 1), b2 + hstep, voffB);
            PG8_WAIT_V(6); PG8_BAR; PG8_MMA(1, 1, At, B1); PG8_BAR;
            PG8_LDB(B0, 1, 0); PG8_SCHED; PG8_LDA(At, 1, 0); PG8_STAGE(PG8_SA(0, 1), a2 + hstep, voffA);
            PG8_WAIT_L(8); PG8_BAR; PG8_WAIT_L(0); PG8_MMA(0, 0, At, B0); PG8_BAR; PG8_SCHED;
            PG8_LDB(B1, 1, 1); PG8_STAGE(PG8_SB(1, 0), b3, voffB);
            PG8_BAR; PG8_WAIT_L(0); PG8_MMA(0, 1, At, B1); PG8_BAR;
            PG8_LDA(At, 1, 1); PG8_STAGE(PG8_SA(1, 0), a3, voffA);
            PG8_BAR; PG8_WAIT_L(0); PG8_MMA(1, 0, At, B0); PG8_BAR; PG8_SCHED;
            PG8_STAGE(PG8_SB(1, 1), b3 + hstep, voffB);
            PG8_WAIT_V(6); PG8_BAR; PG8_MMA(1, 1, At, B1); PG8_BAR;
        }
        E(acc, cur, wr, wc, fr, fq);
        if (!has_next) break;
#pragma unroll
        for (int a = 0; a < 2; ++a)
#pragma unroll
            for (int b = 0; b < 2; ++b)
#pragma unroll
                for (int m = 0; m < 4; ++m)
#pragma unroll
                    for (int n = 0; n < 2; ++n) acc[a][b][m][n] = (f32x4){0.f, 0.f, 0.f, 0.f};
        cur = nxt; cA = nA; cB = nB; ++ui;
    }
    PG8_WAIT_V(0);
    if (wr == 0) PG8_BAR;
    PG8_BAR;
#undef PG8_SA
#undef PG8_SB
#undef PG8_STAGE
#undef PG8_LDA
#undef PG8_LDB
#undef PG8_MMA
#undef PG8_WAIT_V
#undef PG8_WAIT_L
#undef PG8_BAR
#undef PG8_SCHED
}
}
using pg8::Unit;

struct EpiProj {
    static constexpr bool PERM = true; bf16_t* O;
    __device__ __forceinline__ void operator()(const f32x4 (&acc)[2][2][4][2], const Unit& u, int wr, int wc, int fr, int fq) const {
        const int row0 = u.pm * 256 + wr * 64 + fr, col0 = u.pn * 256 + wc * 32 + 8 * fq;
#pragma unroll
        for (int ai = 0; ai < 2; ++ai)
#pragma unroll
            for (int m = 0; m < 4; ++m) { bf16_t* rowp = O + (size_t)(row0 + ai * 128 + m * 16) * LDP + col0;
#pragma unroll
                for (int bj = 0; bj < 2; ++bj) { const f32x4 v0 = acc[ai][bj][m][0], v1 = acc[ai][bj][m][1];
                    u32x4 w; w.x = pack2(v0[0], v0[1]); w.y = pack2(v0[2], v0[3]); w.z = pack2(v1[0], v1[1]); w.w = pack2(v1[2], v1[3]);
                    *(u32x4*)(rowp + bj * 128) = w; } }
    }
};
template <int PASS> struct EpiMerge {
    static constexpr bool PERM = true; bf16_t* M; const bf16_t* proj; const float* bg;
    __device__ __forceinline__ void operator()(const f32x4 (&acc)[2][2][4][2], const Unit& u, int wr, int wc, int fr, int fq) const {
        const int row0 = u.pm * 256 + wr * 64 + fr, col0 = u.pn * 256 + wc * 32 + 8 * fq;
#pragma unroll
        for (int ai = 0; ai < 2; ++ai)
#pragma unroll
            for (int m = 0; m < 4; ++m) { const int row = row0 + ai * 128 + m * 16;
#pragma unroll
                for (int bj = 0; bj < 2; ++bj)
#pragma unroll
                    for (int n = 0; n < 2; ++n) { const int col = col0 + bj * 128 + 4 * n;
                        const u32x2 gw = *(const u32x2*)(proj + (size_t)row * LDP + (PASS ? C_G1 : C_G0) + col);
                        const f32x4 b0 = *(const f32x4*)(bg + PASS * 2048 + col);
                        bf16_t* dst = M + (size_t)row * 2048 + col;
                        u32x2 old = {0u, 0u}; if (PASS) old = *(const u32x2*)dst;
                        const f32x4 v = acc[ai][bj][m][n];
                        const float r0 = bflo(old.x) + sigmoidf_(bflo(gw.x) + b0[0]) * v[0], r1 = bfhi(old.x) + sigmoidf_(bfhi(gw.x) + b0[1]) * v[1];
                        const float r2 = bflo(old.y) + sigmoidf_(bflo(gw.y) + b0[2]) * v[2], r3 = bfhi(old.y) + sigmoidf_(bfhi(gw.y) + b0[3]) * v[3];
                        u32x2 w; w.x = pack2(r0, r1); w.y = pack2(r2, r3);
                        *(u32x2*)dst = w; }
                asm volatile("" ::: "memory"); }
    }
};
struct EpiResid {
    static constexpr bool PERM = false; float* X1; const float* X;
    __device__ __forceinline__ void operator()(const f32x4 (&acc)[2][2][4][2], const Unit& u, int wr, int wc, int fr, int fq) const {
        const int row0 = u.pm * 256 + wr * 64 + fr, col0 = u.pn * 256 + wc * 32 + 4 * fq;
#pragma unroll
        for (int ai = 0; ai < 2; ++ai)
#pragma unroll
            for (int m = 0; m < 4; ++m) { const size_t ro = (size_t)(row0 + ai * 128 + m * 16) * 2048 + col0;
#pragma unroll
                for (int bj = 0; bj < 2; ++bj)
#pragma unroll
                    for (int n = 0; n < 2; ++n) { const size_t o = ro + bj * 128 + n * 16; *(f32x4*)(X1 + o) = *(const f32x4*)(X + o) + acc[ai][bj][m][n]; } }
    }
};
struct EpiGateUp {
    static constexpr bool PERM = false; bf16_t* ACT;
    __device__ __forceinline__ void operator()(const f32x4 (&acc)[2][2][4][2], const Unit& u, int wr, int wc, int fr, int fq) const {
        const int row0 = u.pm * 256 + wr * 64 + fr, hid0 = u.pn * 128 + wc * 16 + 4 * fq;
#pragma unroll
        for (int ai = 0; ai < 2; ++ai)
#pragma unroll
            for (int m = 0; m < 4; ++m) { bf16_t* rowp = ACT + (size_t)(row0 + ai * 128 + m * 16) * 512 + hid0;
#pragma unroll
                for (int bj = 0; bj < 2; ++bj) { const f32x4 g = acc[ai][bj][m][0], up = acc[ai][bj][m][1];
                    u32x2 w; w.x = pack2(siluf_(g[0]) * up[0], siluf_(g[1]) * up[1]); w.y = pack2(siluf_(g[2]) * up[2], siluf_(g[3]) * up[3]);
                    *(u32x2*)(rowp + bj * 64) = w; } }
    }
};
struct EpiDown {
    static constexpr bool PERM = true; bf16_t* O;
    __device__ __forceinline__ void operator()(const f32x4 (&acc)[2][2][4][2], const Unit& u, int wr, int wc, int fr, int fq) const {
        const int row0 = u.pm * 256 + wr * 64 + fr, col0 = u.pn * 256 + wc * 32 + 8 * fq;
#pragma unroll
        for (int ai = 0; ai < 2; ++ai)
#pragma unroll
            for (int m = 0; m < 4; ++m) { bf16_t* rowp = O + (size_t)(row0 + ai * 128 + m * 16) * 2048 + col0;
#pragma unroll
                for (int bj = 0; bj < 2; ++bj) { const f32x4 v0 = acc[ai][bj][m][0], v1 = acc[ai][bj][m][1];
                    u32x4 w; w.x = pack2(v0[0], v0[1]); w.y = pack2(v0[2], v0[3]); w.z = pack2(v1[0], v1[1]); w.w = pack2(v1[2], v1[3]);
                    *(u32x4*)(rowp + bj * 128) = w; } }
    }
};

namespace att {
constexpr int D = 128, ASTR = LDP, OSTR = 1024, MSTR = T_;
constexpr float SCALE = 0.08838834764831845f, THR = 8.f;
constexpr bool WSKIP = false;
constexpr int NW = 8, QBLK = 32, KVBLK = 64, QB = NW * QBLK;
constexpr int SHM_V = KVBLK * D * 2, SHM_K = KVBLK * D * 2;
constexpr int ATT_LDS = 2 * SHM_V + 2 * SHM_K + NW * 64 * 4;
typedef short s16x4 __attribute__((ext_vector_type(4)));
typedef float f32x16 __attribute__((ext_vector_type(16)));
template <class A, class Bt> struct same_t { static constexpr bool v = false; };
template <class A> struct same_t<A, A> { static constexpr bool v = true; };
#define KSWZ(row, colB) ((row) * 256 + ((colB) ^ (((row) & 7) << 4)))
#define SBAR() __builtin_amdgcn_sched_barrier(0)
__device__ __forceinline__ int v_st(int k, int c) { const int kk = (k & ~0xC) | ((k & 4) << 1) | ((k & 8) >> 1); return ((kk >> 3) * 4 + (c >> 5)) * 512 + ((kk & 7) * 32 + (c & 31)) * 2; }
__device__ __forceinline__ int v_rd_base(int lane) { return ((lane & 3) << 3) | (((lane >> 2) & 3) << 6) | (((lane >> 4) & 1) << 5) | (((lane >> 5) & 1) << 8); }
constexpr int v_rd_off(int d0, int ks, int half) { return d0 * 512 + ks * 4096 + half * 2048; }
__device__ __forceinline__ int crow(int r, int hi) { return (r & 3) + 8 * (r >> 2) + 4 * hi; }
__device__ __forceinline__ unsigned cvtpk(float lo, float hi) {
    unsigned r; asm volatile("v_cvt_pk_bf16_f32 %0, %1, %2" : "=v"(r) : "v"(lo), "v"(hi)); return r;
}
__device__ __forceinline__ bf16x8 pack8(f32x4 a, f32x4 b) {
    u32x4 w = {cvtpk(a[0], a[1]), cvtpk(a[2], a[3]), cvtpk(b[0], b[1]), cvtpk(b[2], b[3])};
    return *reinterpret_cast<bf16x8*>(&w);
}
template <class T> __device__ __forceinline__ bf16x8 load8(const T* p) {
    if constexpr (same_t<T, float>::v) { return pack8(*(const f32x4*)p, *(const f32x4*)(p + 4)); }
    else { return *reinterpret_cast<const bf16x8*>(p); }
}
__device__ __forceinline__ void mask_tile(f32x16& p0, f32x16& p1, int dq, unsigned W) {
    const float NEG = -__builtin_inff();
#pragma unroll
    for (int r = 0; r < 16; ++r) {
        const int c = (r & 3) + 8 * (r >> 2);
        if ((unsigned)(dq - c) >= W) p0[r] = NEG;
        if ((unsigned)(dq - c - 32) >= W) p1[r] = NEG;
    }
}
__device__ __forceinline__ void mask_bits(f32x16& p0, f32x16& p1, unsigned long long mw, int hi) {
    const float NEG = -__builtin_inff(); const unsigned lo = (unsigned)mw >> (4 * hi), hw = (unsigned)(mw >> 32) >> (4 * hi);
#pragma unroll
    for (int r = 0; r < 16; ++r) { const int c = (r & 3) + 8 * (r >> 2);
        if (!((lo >> c) & 1u)) p0[r] = NEG;
        if (!((hw >> c) & 1u)) p1[r] = NEG; }
}
__device__ __forceinline__ void partialSM(f32x16& p0, f32x16& p1, float& m_reg, float& mn, float& alpha) {
    float pmax = p0[0]; for (int r = 1; r < 16; ++r) pmax = fmaxf(pmax, p0[r]); for (int r = 0; r < 16; ++r) pmax = fmaxf(pmax, p1[r]);
    { auto rr = __builtin_amdgcn_permlane32_swap(__float_as_uint(pmax), __float_as_uint(pmax), false, false);
      pmax = fmaxf(__uint_as_float(rr[0]), __uint_as_float(rr[1])); }
    constexpr float C2 = 1.4426950408889634f * SCALE;
    if (__builtin_expect(__all((pmax - m_reg) * SCALE <= THR), 1)) { mn = m_reg; alpha = 1.f; }
    else { mn = fmaxf(m_reg, pmax); alpha = __builtin_amdgcn_exp2f((m_reg - mn) * C2); m_reg = mn; }
    const float mnL = -mn * C2;
    for (int r = 0; r < 16; ++r) p0[r] = fmaf(p0[r], C2, mnL); for (int r = 0; r < 16; ++r) p1[r] = fmaf(p1[r], C2, mnL);
    for (int r = 0; r < 16; ++r) p0[r] = __builtin_amdgcn_exp2f(p0[r]);
}
__device__ __forceinline__ void finishSM(f32x16& p0, f32x16& p1, float alpha, float& l_reg, bf16x8& pa0, bf16x8& pa1, bf16x8& pa2, bf16x8& pa3) {
    for (int r = 0; r < 16; ++r) p1[r] = __builtin_amdgcn_exp2f(p1[r]);
    float ps = 0; for (int r = 0; r < 16; ++r) ps += p0[r]; for (int r = 0; r < 16; ++r) ps += p1[r];
    { auto rr = __builtin_amdgcn_permlane32_swap(__float_as_uint(ps), __float_as_uint(ps), false, false);
      ps = __uint_as_float(rr[0]) + __uint_as_float(rr[1]); }
    l_reg = l_reg * alpha + ps;
#define PK4(P, B_, OUT) do { unsigned a0 = cvtpk(P[B_+0], P[B_+1]), a1 = cvtpk(P[B_+2], P[B_+3]);                          \
        unsigned b0 = cvtpk(P[B_+4], P[B_+5]), b1 = cvtpk(P[B_+6], P[B_+7]);                                             \
        auto r0 = __builtin_amdgcn_permlane32_swap(a0, b0, false, false); auto r1 = __builtin_amdgcn_permlane32_swap(a1, b1, false, false); \
        u32x4 w = {r0[0], r1[0], r0[1], r1[1]}; OUT = *reinterpret_cast<bf16x8*>(&w); } while (0)
    PK4(p0, 0, pa0); PK4(p0, 8, pa1); PK4(p1, 0, pa2); PK4(p1, 8, pa3);
#undef PK4
}
template <int KB, bool SK>
__device__ __forceinline__ void qkt(f32x16& p0, f32x16& p1, const char* K_lds, int r32, int hi, const bf16x8* qr, bool act) {
    if (SK && !act) { const float NEG = -__builtin_inff();
#pragma unroll
        for (int r = 0; r < 16; ++r) { p0[r] = NEG; p1[r] = NEG; } return; }
    p0 = f32x16{}; p1 = f32x16{};
    const char* kb[4];
#pragma unroll
    for (int dd = 0; dd < 4; ++dd) kb[dd] = K_lds + KB * SHM_K + KSWZ(r32, (dd * 16 + hi * 8) * 2);
#pragma unroll
    for (int d0 = 0; d0 < 8; ++d0) { const char* a = kb[d0 & 3] + (d0 >> 2) * 128;
        bf16x8 b0 = *reinterpret_cast<const bf16x8*>(a);
        bf16x8 b1 = *reinterpret_cast<const bf16x8*>(a + 32 * 256);
        p0 = __builtin_amdgcn_mfma_f32_32x32x16_bf16(b0, qr[d0], p0, 0, 0, 0);
        p1 = __builtin_amdgcn_mfma_f32_32x32x16_bf16(b1, qr[d0], p1, 0, 0, 0); }
}
template <int VB, bool SK>
__device__ __forceinline__ void pv_tile(f32x16* o, int vb0, bf16x8 pa0, bf16x8 pa1, bf16x8 pa2, bf16x8 pa3, bool act) {
    if (SK && !act) return;
#define TRRD(dst, off) asm volatile("ds_read_b64_tr_b16 %0, %1 offset:%2" : "=&v"(dst) : "v"(vb0), "i"(off) : "memory")
#define PV_D0(d0) do { s16x4 l0, l1, l2, l3, h0, h1, h2, h3; constexpr int b_ = VB * SHM_V + v_rd_off(d0, 0, 0);     \
        TRRD(l0, b_); TRRD(h0, b_ + 2048); TRRD(l1, b_ + 4096); TRRD(h1, b_ + 6144); TRRD(l2, b_ + 8192); TRRD(h2, b_ + 10240); TRRD(l3, b_ + 12288); TRRD(h3, b_ + 14336); \
        asm volatile("s_waitcnt lgkmcnt(0)" ::: "memory"); SBAR();                 \
        o[d0] = __builtin_amdgcn_mfma_f32_32x32x16_bf16(pa0, (bf16x8){l0[0], l0[1], l0[2], l0[3], h0[0], h0[1], h0[2], h0[3]}, o[d0], 0, 0, 0);   \
        o[d0] = __builtin_amdgcn_mfma_f32_32x32x16_bf16(pa1, (bf16x8){l1[0], l1[1], l1[2], l1[3], h1[0], h1[1], h1[2], h1[3]}, o[d0], 0, 0, 0);   \
        o[d0] = __builtin_amdgcn_mfma_f32_32x32x16_bf16(pa2, (bf16x8){l2[0], l2[1], l2[2], l2[3], h2[0], h2[1], h2[2], h2[3]}, o[d0], 0, 0, 0);   \
        o[d0] = __builtin_amdgcn_mfma_f32_32x32x16_bf16(pa3, (bf16x8){l3[0], l3[1], l3[2], l3[3], h3[0], h3[1], h3[2], h3[3]}, o[d0], 0, 0, 0); } while (0)
    PV_D0(0); PV_D0(1); PV_D0(2); PV_D0(3);
#undef PV_D0
#undef TRRD
}

template <class TIn, class TOut> struct BlockRef { const TIn* Q; const TIn* K; const TIn* V; TOut* O; int P0; const unsigned long long* MK; };
template <class TIn> struct Seam {
    bf16x8 qr[8];
    bf16x8 st_v0, st_v1, st_k0, st_k1; f32x4 sf0, sf1, sf2, sf3;
    f32x4 tq[16];
};
__device__ __forceinline__ int swa_jlo(int P0, int W) { const int lowk = P0 - W + 1; return lowk > 0 ? lowk / KVBLK : 0; }
#define ROW(p, k0, rr) ((p) + (size_t)((k0) + (rr)) * ASTR + sc)
#define VMW() asm volatile("s_waitcnt vmcnt(0)" ::: "memory")
#define VMWN(n) asm volatile("s_waitcnt vmcnt(%0)" :: "i"(n) : "memory")
#define SLOAD_H(Kp, Vp, k0) do { S.st_v0 = load8<TIn>(ROW(Vp, k0, sr)); S.st_v1 = load8<TIn>(ROW(Vp, k0, 32 + sr));              \
                         S.st_k0 = load8<TIn>(ROW(Kp, k0, sr)); S.st_k1 = load8<TIn>(ROW(Kp, k0, 32 + sr)); } while (0)
#define SWRITE_HK(bf) do { *(bf16x8*)(K_lds + (bf) * SHM_K + kws) = S.st_k0; *(bf16x8*)(K_lds + (bf) * SHM_K + kws + 32 * 256) = S.st_k1; } while (0)
#define SWRITE_HV(bf) do { *(bf16x8*)(V_lds + (bf) * SHM_V + vst0) = S.st_v0; *(bf16x8*)(V_lds + (bf) * SHM_V + vst1) = S.st_v1; } while (0)
#define SWRITE_H(bf) do { SWRITE_HV(bf); SWRITE_HK(bf); } while (0)
#define SLOAD_F(p, k0) do { S.sf0 = *(const f32x4*)ROW(p, k0, sr); S.sf1 = *(const f32x4*)(ROW(p, k0, sr) + 4);                \
                            S.sf2 = *(const f32x4*)ROW(p, k0, 32 + sr); S.sf3 = *(const f32x4*)(ROW(p, k0, 32 + sr) + 4); } while (0)
#define SWRITE_KF(bf) do { *(bf16x8*)(K_lds + (bf) * SHM_K + kws) = pack8(S.sf0, S.sf1); *(bf16x8*)(K_lds + (bf) * SHM_K + kws + 32 * 256) = pack8(S.sf2, S.sf3); } while (0)
#define SWRITE_VF(bf) do { *(bf16x8*)(V_lds + (bf) * SHM_V + vst0) = pack8(S.sf0, S.sf1); *(bf16x8*)(V_lds + (bf) * SHM_V + vst1) = pack8(S.sf2, S.sf3); } while (0)
template <class TIn, class TOut>
__device__ __forceinline__ void causal_swa_prime(const BlockRef<TIn, TOut>& cur, int W, char* lds, Seam<TIn>& S) {
    constexpr bool F32 = same_t<TIn, float>::v;
    const int tid = tid_(), wid = __builtin_amdgcn_readfirstlane(tid >> 6), lane = tid & 63, r32 = lane & 31, hi = lane >> 5;
    const int sr = tid >> 4, sc = (tid & 15) * 8, kws = KSWZ(sr, sc * 2); char* K_lds = lds + 2 * SHM_V;
    const int kb0 = swa_jlo(cur.P0, W) * KVBLK;
    for (int d0 = 0; d0 < 8; ++d0) S.qr[d0] = load8<TIn>(cur.Q + (size_t)(wid * QBLK + r32) * ASTR + d0 * 16 + hi * 8);
    if constexpr (F32) { SLOAD_F((const float*)cur.K, kb0); VMW(); SWRITE_KF(0); SBAR(); SLOAD_F((const float*)cur.V, kb0); }
    else { SLOAD_H(cur.K, cur.V, kb0); VMW(); SWRITE_HK(0); }
    __syncthreads();
}
template <class TIn, class TOut>
__device__ __forceinline__ void causal_swa_block(const BlockRef<TIn, TOut>& cur, const BlockRef<TIn, TOut>& nxt, int skv, int W, char* lds, Seam<TIn>& S) {
    constexpr bool F32 = same_t<TIn, float>::v;
    const int tid = tid_(), wid = __builtin_amdgcn_readfirstlane(tid >> 6), lane = tid & 63, r32 = lane & 31, hi = lane >> 5;
    const int j_lo = swa_jlo(cur.P0, W);
    int j_hi = (cur.P0 + QB - 1) / KVBLK + 1; if (j_hi > skv / KVBLK) j_hi = skv / KVBLK;
    const int NT = j_hi - j_lo;
    const int kbn = swa_jlo(nxt.P0, W) * KVBLK;
    const int qlo = cur.P0 + wid * QBLK, qm = qlo + r32 - 4 * hi;
    char* V_lds = lds; char* K_lds = lds + 2 * SHM_V;
    float* ws = (float*)(lds + 2 * SHM_V + 2 * SHM_K) + wid * 64; float* li_l = ws, * al_l = ws + 32;
    float m_reg = -1e30f, l_reg = 0; f32x16 o[4] = {};
    const int sr = tid >> 4, sc = (tid & 15) * 8, vst0 = v_st(sr, sc), vst1 = v_st(32 + sr, sc), kws = KSWZ(sr, sc * 2);
    const int vb0 = (int)(uintptr_t)V_lds + v_rd_base(lane);
    const TIn* Kh = cur.K; const TIn* Vh = cur.V;
#define RESC(a) do { if (__any((a) < 1.f)) { if (hi == 0) al_l[r32] = (a); asm volatile("s_waitcnt lgkmcnt(0)" ::: "memory");              \
                     for (int d_ = 0; d_ < 4; ++d_) for (int r = 0; r < 16; ++r) o[d_][r] *= al_l[crow(r, hi)]; } } while (0)
#define KBASE(t) ((j_lo + (t)) * KVBLK)
#define ACT(t) (KBASE(t) <= qlo + QBLK - 1 && KBASE(t) + KVBLK - 1 >= qlo - W + 1)
#define MASKT(P0_, P1_, t) do { mask_bits(P0_, P1_, mw, hi); } while (0)
#define MLOAD(t) do { mw = cur.MK[(size_t)(j_lo + (t)) * MSTR + wid * QBLK + r32]; } while (0)
    constexpr int NQL = F32 ? 16 : 8;
    constexpr bool SK = WSKIP && !F32;
#define SEAM_K0() do { VMWN(NQL); if constexpr (F32) { SWRITE_KF(0); SBAR(); SLOAD_F((const float*)nxt.V, kbn); } else { SWRITE_HK(0); } SBAR(); } while (0)
    f32x16 pA0, pA1, pB0, pB1; float mnA, mnB, alA, alB; bf16x8 pa0, pa1, pa2, pa3; unsigned long long mw = 0ull;
    if constexpr (F32) { VMW(); SWRITE_VF(0); SBAR(); } else { SWRITE_HV(0); SBAR(); }
    if (NT > 1) { if constexpr (F32) SLOAD_F((const float*)Kh, KBASE(1)); else SLOAD_H(Kh, Vh, KBASE(1)); }
    MLOAD(0); SBAR(); qkt<0, SK>(pA0, pA1, K_lds, r32, hi, S.qr, ACT(0));
    if constexpr (F32) { if (NT > 1) { VMW(); SWRITE_KF(1); SBAR(); SLOAD_F((const float*)Vh, KBASE(1)); } }
    MASKT(pA0, pA1, 0); partialSM(pA0, pA1, m_reg, mnA, alA);
    if (NT > 1) { VMW(); if constexpr (F32) { SWRITE_VF(1); SBAR(); if (NT > 2) SLOAD_F((const float*)Kh, KBASE(2)); } else SWRITE_H(1); }
    __syncthreads();
#define HALF_STEP(PX0, PX1, mnX, alX, PY0, PY1, alY, t, KB, VB, SB) do {                                                      \
        MLOAD(t); SBAR(); qkt<KB, SK>(PX0, PX1, K_lds, r32, hi, S.qr, ACT(t));                                             \
        finishSM(PY0, PY1, alY, l_reg, pa0, pa1, pa2, pa3); SBAR();                                                           \
        if ((t) + 1 < NT) { if constexpr (F32) { VMW(); SWRITE_KF(SB); SBAR(); SLOAD_F((const float*)Vh, KBASE((t) + 1)); }  \
                            else { SLOAD_H(Kh, Vh, KBASE((t) + 1)); } SBAR(); }                                               \
        pv_tile<VB, SK>(o, vb0, pa0, pa1, pa2, pa3, ACT((t) - 1)); MASKT(PX0, PX1, (t)); partialSM(PX0, PX1, m_reg, mnX, alX);                                        \
        __syncthreads();                                                                                                      \
        if ((t) + 1 < NT) { VMW(); if constexpr (F32) { SWRITE_VF(SB); SBAR(); if ((t) + 2 < NT) SLOAD_F((const float*)Kh, KBASE((t) + 2)); } \
                            else { SWRITE_H(SB); } }                                                                          \
        RESC(alX); __syncthreads(); } while (0)
    for (int t = 1; t + 1 < NT; t += 2) {
        HALF_STEP(pB0, pB1, mnB, alB, pA0, pA1, alA, t, 1, 0, 0);
        HALF_STEP(pA0, pA1, mnA, alA, pB0, pB1, alB, t + 1, 0, 1, 1);
    }
    const bool even = (NT & 1) == 0;
    if (even) { MLOAD(NT - 1); SBAR(); qkt<1, SK>(pB0, pB1, K_lds, r32, hi, S.qr, ACT(NT - 1)); SBAR(); }
#define QROW(e) (nxt.Q + (size_t)(wid * QBLK + r32) * ASTR + ((e) >> 1) * 16 + hi * 8 + ((e) & 1) * 4)
    if constexpr (F32) { SLOAD_F((const float*)nxt.K, kbn); SBAR();
#pragma unroll
        for (int e = 0; e < 8; ++e) S.tq[e] = *(const f32x4*)QROW(e); }
    else { SLOAD_H(nxt.K, nxt.V, kbn); SBAR();
#pragma unroll
        for (int d0 = 0; d0 < 8; ++d0) S.qr[d0] = load8<TIn>(nxt.Q + (size_t)(wid * QBLK + r32) * ASTR + d0 * 16 + hi * 8); }
    SBAR();
    finishSM(pA0, pA1, alA, l_reg, pa0, pa1, pa2, pa3); SBAR();
    if constexpr (F32) {
#pragma unroll
        for (int e = 8; e < 16; ++e) S.tq[e] = *(const f32x4*)QROW(e); SBAR(); }
#undef QROW
    pv_tile<0, SK>(o, vb0, pa0, pa1, pa2, pa3, ACT(even ? NT - 2 : NT - 1));
    if (even) { MASKT(pB0, pB1, NT - 1); partialSM(pB0, pB1, m_reg, mnB, alB); __syncthreads(); RESC(alB);
        finishSM(pB0, pB1, alB, l_reg, pa0, pa1, pa2, pa3); SBAR(); pv_tile<1, SK>(o, vb0, pa0, pa1, pa2, pa3, ACT(NT - 1)); }
    SBAR(); SEAM_K0();
    if (hi == 0) li_l[r32] = l_reg; asm volatile("s_waitcnt lgkmcnt(0)" ::: "memory");
    float rli[16];
#pragma unroll
    for (int r = 0; r < 16; ++r) rli[r] = __builtin_amdgcn_rcpf(li_l[crow(r, hi)]);
    TOut* Ow = cur.O + (size_t)(wid * QBLK) * OSTR;
#pragma unroll
    for (int r = 0; r < 16; ++r) { const int orow = crow(r, hi);
#pragma unroll
        for (int d0 = 0; d0 < 4; ++d0) { const float v = o[d0][r] * rli[r];
            if constexpr (same_t<TOut, float>::v) { Ow[(size_t)orow * OSTR + d0 * 32 + r32] = v; }
            else { const float vn = dpp_f<0xB1>(v);
                   if ((r32 & 1) == 0) *(unsigned*)(Ow + (size_t)orow * OSTR + d0 * 32 + r32) = cvtpk(v, vn); } } }
    if constexpr (F32) {
#pragma unroll
        for (int d0 = 0; d0 < 8; ++d0) S.qr[d0] = pack8(S.tq[2 * d0], S.tq[2 * d0 + 1]); }
    __syncthreads();
#undef RESC
#undef KBASE
#undef ACT
#undef MASKT
#undef MLOAD
#undef SEAM_K0
#undef HALF_STEP
}
#undef ROW
#undef VMW
#undef VMWN
#undef SLOAD_H
#undef SWRITE_HK
#undef SWRITE_HV
#undef SWRITE_H
#undef SLOAD_F
#undef SWRITE_KF
#undef SWRITE_VF
}

template <class Load4, class DstRow>
__device__ __forceinline__ void convert_tiles(LAS float* tile  , bf16_t* dst, int K, int N, Load4 load4, DstRow dstrow, int c, int G, int& tile_counter) {
    const int tid = tid_(), nk = K / 64, total = nk * (N / 256);
    const int kr = tid >> 6, n4 = (tid & 63) * 4;
    int tt = (c - tile_counter % G + G) % G;
    tile_counter += total;
    f32x4 r[8];
    if (tt < total) { const int k0 = (tt % nk) * 64, n0 = (tt / nk) * 256;
#pragma unroll
        for (int i = 0; i < 8; ++i) r[i] = load4(k0 + kr + 8 * i, n0 + n4); }
    while (tt < total) {
        const int k0 = (tt % nk) * 64, n0 = (tt / nk) * 256;
        __syncthreads();
#pragma unroll
        for (int i = 0; i < 8; ++i) { LAS float* q = tile + (kr + 8 * i) * 257 + n4; q[0] = r[i][0]; q[1] = r[i][1]; q[2] = r[i][2]; q[3] = r[i][3]; }
        const int nx = tt + G;
        if (nx < total) { const int k1 = (nx % nk) * 64, n1 = (nx / nk) * 256;
#pragma unroll
            for (int i = 0; i < 8; ++i) r[i] = load4(k1 + kr + 8 * i, n1 + n4); }
        __syncthreads();
        const int kc = tid & 7;
#pragma unroll
        for (int i = 0; i < 4; ++i) { const int nl = (tid >> 3) + 64 * i; float v[8];
#pragma unroll
            for (int j = 0; j < 8; ++j) v[j] = tile[(kc * 8 + j) * 257 + nl];
            u32x4 w; w.x = pack2(v[0], v[1]); w.y = pack2(v[2], v[3]); w.z = pack2(v[4], v[5]); w.w = pack2(v[6], v[7]);
            *(u32x4*)(dst + (size_t)dstrow(n0 + nl) * K + k0 + kc * 8) = w; }
        tt = nx;
    }
}

__device__ __forceinline__ int in_col_map(int n) {
    if (n < 4096) return n;
    if (n < 7680) return n + 16;
    if (n < 11776) return n + 88;
    if (n < 11840) return 7696 + (n - 11776);
    if (n < 11848) return 4096 + (n - 11840);
    if (n < 11856) return 4104 + (n - 11848);
    if (n < 11864) return 7760 + (n - 11856);
    return -1;
}

__device__ __forceinline__ void phase0(const Params& p, LAS unsigned char* lds) {
    const int G = gridDim.x, c = blockIdx.x, tid = tid_();
    unsigned char* ws = opq(p.ws);
    if (c == 0 && tid < 256) ((unsigned*)(ws + OFF_SMALL + SM_CTRL))[tid] = 0u;
    int counter = 0;
    { const float* w = p.w_in;
      convert_tiles((LAS float*)lds, (bf16_t*)(ws + OFF_WT_IN), 2048, LDP, [w](int k, int n) -> f32x4 {
          const float* row = w + (size_t)k * IN_COLS;
          if (n < 11776) { const int o = n < 4096 ? n : (n < 7680 ? n + 16 : n + 88); return *(const f32x4*)(row + o); }
          f32x4 v;
#pragma unroll
          for (int j = 0; j < 4; ++j) { const int o = in_col_map(n + j); v[j] = o < 0 ? 0.f : row[o]; }
          return v; }, [](int n) { return n; }, c, G, counter); }
    { const float* w = p.w_proj_dn; convert_tiles((LAS float*)lds, (bf16_t*)(ws + OFF_WT_DN), 1024, 2048, [w](int k, int n) -> f32x4 { return *(const f32x4*)(w + (size_t)k * 2048 + n); }, [](int n) { return n; }, c, G, counter); }
    { const float* w = p.w_proj_att; convert_tiles((LAS float*)lds, (bf16_t*)(ws + OFF_WT_AT), 1024, 2048, [w](int k, int n) -> f32x4 { return *(const f32x4*)(w + (size_t)k * 2048 + n); }, [](int n) { return n; }, c, G, counter); }
    { const float* w = p.w_out; convert_tiles((LAS float*)lds, (bf16_t*)(ws + OFF_WT_OUT), 2048, 2048, [w](int k, int n) -> f32x4 { return *(const f32x4*)(w + (size_t)k * 2048 + n); }, [](int n) { return n; }, c, G, counter); }
    { bf16_t* wh = (bf16_t*)(ws + OFF_WR); bf16_t* wl = (bf16_t*)(ws + OFF_WR + 512 * 1024);
      for (int i = c * 512 + tid; i < 5 * 64 * 64 * 8; i += G * 512) { const int e = i & 7, ln = (i >> 3) & 63, kk = (i >> 9) & 63, j = i >> 15;
          const int k = 32 * kk + 8 * (ln >> 4) + e, col = 16 * j + (ln & 15);
          const float v = col < 64 ? p.w_router[(size_t)k * 64 + col] : (col < 72 ? p.w_group[(size_t)k * 8 + col - 64] : 0.f);
          const bf16_t hi = f2bf(v); wh[i] = hi; wl[i] = f2bf(v - bf2f(hi)); } }
    { float* ct = (float*)(ws + OFF_COS); float* st = (float*)(ws + OFF_SIN);
      for (int i = c * 512 + tid; i < T_ * 16; i += G * 512) { const int t = i >> 4;
          const float invf = exp2f(-(float)(i & 15) * 1.1832230355827609f);
          const float ang = (float)p.positions[t] * invf;
          double r = (double)ang * 0.15915494309189535; r -= floor(r);
          ct[i] = __builtin_amdgcn_cosf((float)r); st[i] = __builtin_amdgcn_sinf((float)r); } }
    const int wid = tid >> 6, lane = tid & 63; bf16_t* h = (bf16_t*)(ws + OFF_H);
    for (int row = c * 8 + wid; row < T_; row += G * 8) {
        const float* xr = p.x + (size_t)row * 2048; f32x4 v[8]; float ss = 0.f;
#pragma unroll
        for (int i = 0; i < 8; ++i) { v[i] = *(const f32x4*)(xr + i * 256 + 4 * lane); ss += v[i][0] * v[i][0] + v[i][1] * v[i][1] + v[i][2] * v[i][2] + v[i][3] * v[i][3]; }
        ss = wave_sum(ss); const float rs = rsqrtf(ss * (1.0f / 2048.0f) + EPS);
#pragma unroll
        for (int i = 0; i < 8; ++i) { const f32x4 g = *(const f32x4*)(p.norm_mix + i * 256 + 4 * lane);
            u32x2 w; w.x = pack2(v[i][0] * rs * g[0], v[i][1] * rs * g[1]); w.y = pack2(v[i][2] * rs * g[2], v[i][3] * rs * g[3]);
            *(u32x2*)(h + (size_t)row * 2048 + i * 256 + 4 * lane) = w; }
    }
}

__device__ __forceinline__ void phase_rope(const Params& p) {
    const int G = gridDim.x, c = blockIdx.x, tid = tid_();
    unsigned char* ws = opq(p.ws); bf16_t* proj = (bf16_t*)(ws + OFF_PROJ); bf16_t* kidx = (bf16_t*)(ws + OFF_SMALL + SM_KIDX); float* wq = (float*)(ws + OFF_SMALL + SM_WQ);
    const float* ct = (const float*)(ws + OFF_COS); const float* st = (const float*)(ws + OFF_SIN);
    const int gtid = c * 512 + tid, gsz = G * 512;
    for (int id = gtid; id < 2 * T_ * 8; id += gsz) { const int tsel = id >= T_ * 8, rem = id - tsel * T_ * 8, t = rem >> 3, hh = rem & 7;
        bf16_t* q = proj + (size_t)t * LDP + (tsel ? C_AK : C_AQ) + hh * 128;
        u32x4 d[4]; f32x4 cv[4], sv[4];
#pragma unroll
        for (int i = 0; i < 4; ++i) { d[i] = *(const u32x4*)(q + 8 * i); cv[i] = *(const f32x4*)(ct + (size_t)t * 16 + 4 * i); sv[i] = *(const f32x4*)(st + (size_t)t * 16 + 4 * i); }
#pragma unroll
        for (int hf = 0; hf < 2; ++hf) { u32x4& a = d[hf]; u32x4& bq = d[hf + 2];
#pragma unroll
            for (int j = 0; j < 4; ++j) { const unsigned wa = a[j], wb = bq[j]; const int i0 = 8 * hf + 2 * j;
                const float c0 = cv[i0 >> 2][i0 & 3], s0 = sv[i0 >> 2][i0 & 3], c1 = cv[(i0 + 1) >> 2][(i0 + 1) & 3], s1 = sv[(i0 + 1) >> 2][(i0 + 1) & 3];
                const float x10 = bflo(wa), x11 = bfhi(wa), x20 = bflo(wb), x21 = bfhi(wb);
                a[j] = pack2(x10 * c0 - x20 * s0, x11 * c1 - x21 * s1); bq[j] = pack2(x20 * c0 + x10 * s0, x21 * c1 + x11 * s1); } }
#pragma unroll
        for (int i = 0; i < 4; ++i) *(u32x4*)(q + 8 * i) = d[i]; }
    for (int id = gtid; id < T_ * 8; id += gsz) { const int t = id >> 3, hh = id & 7;
        bf16_t* q = proj + (size_t)t * LDP + C_IQ + hh * 64;
        u32x4 a = *(const u32x4*)q, bq = *(const u32x4*)(q + 8); f32x4 cv[4], sv[4];
#pragma unroll
        for (int i = 0; i < 4; ++i) { cv[i] = *(const f32x4*)(ct + (size_t)t * 16 + 4 * i); sv[i] = *(const f32x4*)(st + (size_t)t * 16 + 4 * i); }
#pragma unroll
        for (int j = 0; j < 4; ++j) { const unsigned wa = a[j], wb = bq[j];
            const float c0 = cv[j][0], s0 = sv[j][0], c1 = cv[j][2], s1 = sv[j][2];
            const float x10 = bflo(wa), x11 = bfhi(wa), x20 = bflo(wb), x21 = bfhi(wb);
            a[j] = pack2(x10 * c0 - x20 * s0, x11 * c1 - x21 * s1); bq[j] = pack2(x20 * c0 + x10 * s0, x21 * c1 + x11 * s1); }
        *(u32x4*)q = a; *(u32x4*)(q + 8) = bq; }
    for (int t = gtid; t < T_; t += gsz) { const bf16_t* row = proj + (size_t)t * LDP;
        float v[64]; float ss = 0.f;
#pragma unroll
        for (int i = 0; i < 8; ++i) { const u32x4 dd = *(const u32x4*)(row + C_IK + 8 * i);
#pragma unroll
            for (int j = 0; j < 4; ++j) { v[8 * i + 2 * j] = bflo(dd[j]); v[8 * i + 2 * j + 1] = bfhi(dd[j]); ss += v[8 * i + 2 * j] * v[8 * i + 2 * j] + v[8 * i + 2 * j + 1] * v[8 * i + 2 * j + 1]; } }
        const float rs = rsqrtf(ss * (1.0f / 64.0f) + EPS);
#pragma unroll
        for (int d = 0; d < 64; ++d) v[d] = v[d] * rs * p.idx_k_norm[d];
#pragma unroll
        for (int i = 0; i < 8; ++i) { const float cc = ct[(size_t)t * 16 + 2 * i], sn = st[(size_t)t * 16 + 2 * i]; const float x1 = v[i], x2 = v[8 + i]; v[i] = x1 * cc - x2 * sn; v[8 + i] = x2 * cc + x1 * sn; }
#pragma unroll
        for (int ch = 0; ch < 8; ++ch) { const int kk = ch >> 2, fq2 = ch & 3; u32x4 w; w.x = pack2(v[8 * ch], v[8 * ch + 1]); w.y = pack2(v[8 * ch + 2], v[8 * ch + 3]); w.z = pack2(v[8 * ch + 4], v[8 * ch + 5]); w.w = pack2(v[8 * ch + 6], v[8 * ch + 7]);
            *(u32x4*)(kidx + ((size_t)((t >> 4) * 2 + kk) * 64 + fq2 * 16 + (t & 15)) * 8) = w; }
        const u32x4 ww = *(const u32x4*)(row + C_IW); const float sc = 0.044194173824159216f;
        f32x4 w0 = {bflo(ww.x) * sc, bfhi(ww.x) * sc, bflo(ww.y) * sc, bfhi(ww.y) * sc}, w1 = {bflo(ww.z) * sc, bfhi(ww.z) * sc, bflo(ww.w) * sc, bfhi(ww.w) * sc};
        *(f32x4*)(wq + (size_t)t * 8) = w0; *(f32x4*)(wq + (size_t)t * 8 + 4) = w1; }
}

__device__ __forceinline__ bf16x8 ldfrag(const LAS bf16_t* X, int stride, int rt, int ks, int fr, int fq) { return *(const LAS bf16x8*)(X + (16 * rt + fr) * stride + 32 * ks + 8 * fq); }
__device__ __forceinline__ void dn_prep_load(const Params& p, int item, u32x4 (&xr)[3][2][4], float (&ba)[2]) {
    const int tid = tid_(), n = item >> 3, h = item & 7, t0 = n * 64, c = tid & 15, i0 = tid >> 4;
    const bf16_t* proj = (const bf16_t*)(opq(p.ws) + OFF_PROJ);
#pragma unroll
    for (int sel = 0; sel < 3; ++sel) { const int col = sel * 1024 + h * 128 + 8 * c;
#pragma unroll
        for (int rr = 0; rr < 2; ++rr)
#pragma unroll
            for (int j = 0; j < 4; ++j) { const int tt = t0 + i0 + 32 * rr - 3 + j; xr[sel][rr][j] = (u32x4){0u, 0u, 0u, 0u}; if (tt >= 0) xr[sel][rr][j] = *(const u32x4*)(proj + (size_t)tt * LDP + col); } }
    ba[0] = 0.f; ba[1] = 0.f;
    if (tid < 64) { const int t = t0 + tid; ba[0] = bf2f(proj[(size_t)t * LDP + C_B + h]); ba[1] = bf2f(proj[(size_t)t * LDP + C_A + h]); }
}
__device__ __forceinline__ void dn_prep_item(const Params& p, int item, int next_item, LAS unsigned char* lds, u32x4 (&xr)[3][2][4], float (&ba)[2]) {
    const int tid = tid_(), w = tid >> 6, lane = tid & 63, fr = lane & 15, fq = lane >> 4, n = item >> 3, h = item & 7, t0 = n * 64;
    unsigned char* ws = opq(p.ws); const bf16_t* proj = (const bf16_t*)(ws + OFF_PROJ);
    LAS bf16_t* Kr = (LAS bf16_t*)lds; LAS bf16_t* Qr = Kr + 64 * 136; LAS bf16_t* KTs = Qr + 64 * 136; LAS bf16_t* VTs = KTs + 128 * 72;
    LAS bf16_t* Pb = VTs + 128 * 72;
    LAS float* Gs = (LAS float*)(Pb + 6 * 64 * 72); LAS float* bs = Gs + 64; LAS float* eg = bs + 64;
    bf16_t* wb = (bf16_t*)(ws + OFF_DNP + DNP_W) + (size_t)item * 8192; bf16_t* uT = (bf16_t*)(ws + OFF_DNP + DNP_UT) + (size_t)item * 8192;
    bf16_t* qd = (bf16_t*)(ws + OFF_DNP + DNP_QD) + (size_t)item * 8192; bf16_t* kdT = (bf16_t*)(ws + OFF_DNP + DNP_KDT) + (size_t)item * 8192;
    bf16_t* attn = (bf16_t*)(ws + OFF_DNP + DNP_ATT) + (size_t)item * 4096;
    __syncthreads();
    if (tid < 64) { const float bl = ba[0], al = ba[1] + p.dt_bias[h];
        const float sp = fmaxf(al, 0.f) + log1pf(__expf(-fabsf(al))); float g = -__expf(p.a_log[h]) * sp;
        for (int o = 1; o < 64; o <<= 1) { const float u = shfl_up_(g, o); if (tid >= o) g += u; }
        Gs[tid] = g; bs[tid] = sigmoidf_(bl); eg[tid] = __expf(g);
        if (tid == 63) ((float*)(ws + OFF_SMALL + SM_GLAST))[item] = __expf(g); }
    __syncthreads();
    { const int c = tid & 15, i0 = tid >> 4;
#pragma unroll
      for (int sel = 0; sel < 3; ++sel) { const int col = sel * 1024 + h * 128 + 8 * c;
          f32x4 wv[4][2];
#pragma unroll
          for (int j = 0; j < 4; ++j) { wv[j][0] = *(const f32x4*)(p.conv_w + j * 3072 + col); wv[j][1] = *(const f32x4*)(p.conv_w + j * 3072 + col + 4); }
#pragma unroll
          for (int rr = 0; rr < 2; ++rr) { const int i = i0 + 32 * rr; float y[8];
#pragma unroll
              for (int e = 0; e < 8; ++e) y[e] = 0.f;
#pragma unroll
              for (int j = 0; j < 4; ++j) { const u32x4 xv = xr[sel][rr][j];
                  y[0] += wv[j][0][0] * bflo(xv.x); y[1] += wv[j][0][1] * bfhi(xv.x); y[2] += wv[j][0][2] * bflo(xv.y); y[3] += wv[j][0][3] * bfhi(xv.y);
                  y[4] += wv[j][1][0] * bflo(xv.z); y[5] += wv[j][1][1] * bfhi(xv.z); y[6] += wv[j][1][2] * bflo(xv.w); y[7] += wv[j][1][3] * bfhi(xv.w); }
              float ss = 0.f;
#pragma unroll
              for (int e = 0; e < 8; ++e) { y[e] = siluf_(y[e]); ss += y[e] * y[e]; }
              const float bi = bs[i], ei = eg[i];
              if (sel < 2) { ss = sum16(ss); const float rn = rsqrtf(ss + EPS) * (sel == 0 ? 0.08838834764831845f : 1.0f);
#pragma unroll
                  for (int e = 0; e < 8; ++e) y[e] *= rn; }
              if (sel == 0) { u32x4 pk; pk.x = pack2(y[0], y[1]); pk.y = pack2(y[2], y[3]); pk.z = pack2(y[4], y[5]); pk.w = pack2(y[6], y[7]);
                  *(LAS u32x4*)(Qr + i * 136 + 8 * c) = pk;
                  u32x4 pd; pd.x = pack2(y[0] * ei, y[1] * ei); pd.y = pack2(y[2] * ei, y[3] * ei); pd.z = pack2(y[4] * ei, y[5] * ei); pd.w = pack2(y[6] * ei, y[7] * ei);
                  *(u32x4*)(qd + i * 128 + 8 * c) = pd; }
              else if (sel == 1) { u32x4 pk; pk.x = pack2(y[0], y[1]); pk.y = pack2(y[2], y[3]); pk.z = pack2(y[4], y[5]); pk.w = pack2(y[6], y[7]);
                  *(LAS u32x4*)(Kr + i * 136 + 8 * c) = pk; const float f = bi * ei;
#pragma unroll
                  for (int e = 0; e < 8; ++e) KTs[(8 * c + e) * 72 + i] = f2bf(y[e] * f); }
              else {
#pragma unroll
                  for (int e = 0; e < 8; ++e) VTs[(8 * c + e) * 72 + i] = f2bf(y[e] * bi); } } } }
    if (next_item >= 0) dn_prep_load(p, next_item, xr, ba);
    __syncthreads();
    { const float g63 = Gs[63];
#pragma unroll
      for (int rr = 0; rr < 2; ++rr) { const int u = tid + 512 * rr, d = u >> 3, ic = u & 7; float v[8];
#pragma unroll
          for (int e = 0; e < 8; ++e) v[e] = bf2f(Kr[(8 * ic + e) * 136 + d]) * __expf(g63 - Gs[8 * ic + e]);
          u32x4 pk; pk.x = pack2(v[0], v[1]); pk.y = pack2(v[2], v[3]); pk.z = pack2(v[4], v[5]); pk.w = pack2(v[6], v[7]);
          *(u32x4*)(kdT + d * 64 + 8 * ic) = pk; } }
    LAS bf16_t* P0 = Pb; LAS bf16_t* P1 = Pb + 64 * 72; LAS bf16_t* PT0 = Pb + 2 * 64 * 72; LAS bf16_t* PT1 = Pb + 3 * 64 * 72; LAS bf16_t* TT0 = Pb + 4 * 64 * 72; LAS bf16_t* TT1 = Pb + 5 * 64 * 72;
#pragma unroll
    for (int pp = 0; pp < 2; ++pp) { const int pr = 2 * w + pp, it = pr >> 2, jt = pr & 3;
        f32x4 akk = {0.f, 0.f, 0.f, 0.f}, aqk = {0.f, 0.f, 0.f, 0.f};
#pragma unroll
        for (int ks = 0; ks < 4; ++ks) { const bf16x8 ki = ldfrag(Kr, 136, it, ks, fr, fq), kj = ldfrag(Kr, 136, jt, ks, fr, fq), qi = ldfrag(Qr, 136, it, ks, fr, fq);
            akk = __builtin_amdgcn_mfma_f32_16x16x32_bf16(ki, kj, akk, 0, 0, 0);
            aqk = __builtin_amdgcn_mfma_f32_16x16x32_bf16(kj, qi, aqk, 0, 0, 0); }
        { const int j = 16 * jt + fr; const float Gj = Gs[j]; float mv[4];
#pragma unroll
          for (int r = 0; r < 4; ++r) { const int i = 16 * it + 4 * fq + r; mv[r] = j < i ? -bs[i] * akk[r] * __expf(Gs[i] - Gj) : 0.f; P0[i * 72 + j] = f2bf(mv[r]); }
          u32x2 pk; pk.x = pack2(mv[0], mv[1]); pk.y = pack2(mv[2], mv[3]); *(LAS u32x2*)(PT0 + j * 72 + 16 * it + 4 * fq) = pk; }
        { const int i = 16 * it + fr; const float Gi = Gs[i]; float av[4];
#pragma unroll
          for (int r = 0; r < 4; ++r) { const int j = 16 * jt + 4 * fq + r; av[r] = j <= i ? aqk[r] * __expf(Gi - Gs[j]) : 0.f; }
          u32x2 pk; pk.x = pack2(av[0], av[1]); pk.y = pack2(av[2], av[3]); *(u32x2*)(attn + i * 64 + 16 * jt + 4 * fq) = pk; } }
    f32x4 tm[2];
#pragma unroll
    for (int pp = 0; pp < 2; ++pp) { const int pr = 2 * w + pp, it = pr >> 2, jt = pr & 3;
#pragma unroll
        for (int r = 0; r < 4; ++r) tm[pp][r] = (16 * it + 4 * fq + r == 16 * jt + fr) ? 1.f : 0.f;
        u32x2 pk; pk.x = pack2(tm[pp][0], tm[pp][1]); pk.y = pack2(tm[pp][2], tm[pp][3]); *(LAS u32x2*)(TT0 + (16 * jt + fr) * 72 + 16 * it + 4 * fq) = pk; }
    __syncthreads();
#pragma unroll
    for (int k = 0; k < 6; ++k) {
        const LAS bf16_t* Pc = (k & 1) ? P1 : P0; const LAS bf16_t* PTc = (k & 1) ? PT1 : PT0; const LAS bf16_t* TTc = (k & 1) ? TT1 : TT0;
        LAS bf16_t* Pn = (k & 1) ? P0 : P1; LAS bf16_t* PTn = (k & 1) ? PT0 : PT1; LAS bf16_t* TTn = (k & 1) ? TT0 : TT1;
#pragma unroll
        for (int pp = 0; pp < 2; ++pp) { const int pr = 2 * w + pp, it = pr >> 2, jt = pr & 3;
            f32x4 x = {0.f, 0.f, 0.f, 0.f}, y = {0.f, 0.f, 0.f, 0.f};
#pragma unroll
            for (int ks = 0; ks < 2; ++ks) { const bf16x8 pa = ldfrag(Pc, 72, it, ks, fr, fq);
                x = __builtin_amdgcn_mfma_f32_16x16x32_bf16(pa, ldfrag(TTc, 72, jt, ks, fr, fq), x, 0, 0, 0);
                if (k < 5) y = __builtin_amdgcn_mfma_f32_16x16x32_bf16(pa, ldfrag(PTc, 72, jt, ks, fr, fq), y, 0, 0, 0); }
            tm[pp] += x;
            if (k < 5) { u32x2 pk; pk.x = pack2(tm[pp][0], tm[pp][1]); pk.y = pack2(tm[pp][2], tm[pp][3]); *(LAS u32x2*)(TTn + (16 * jt + fr) * 72 + 16 * it + 4 * fq) = pk;
#pragma unroll
                for (int r = 0; r < 4; ++r) Pn[(16 * it + 4 * fq + r) * 72 + 16 * jt + fr] = f2bf(y[r]);
                u32x2 pq; pq.x = pack2(y[0], y[1]); pq.y = pack2(y[2], y[3]); *(LAS u32x2*)(PTn + (16 * jt + fr) * 72 + 16 * it + 4 * fq) = pq; }
            else {
#pragma unroll
                for (int r = 0; r < 4; ++r) P0[(16 * it + 4 * fq + r) * 72 + 16 * jt + fr] = f2bf(tm[pp][r]); } }
        __syncthreads();
    }
#pragma unroll
    for (int q4 = 0; q4 < 4; ++q4) { const int tl = 4 * w + q4;
        { const int dt = tl >> 2, it = tl & 3; f32x4 a = {0.f, 0.f, 0.f, 0.f};
#pragma unroll
          for (int ks = 0; ks < 2; ++ks) a = __builtin_amdgcn_mfma_f32_16x16x32_bf16(ldfrag(KTs, 72, dt, ks, fr, fq), ldfrag(P0, 72, it, ks, fr, fq), a, 0, 0, 0);
          u32x2 pk; pk.x = pack2(a[0], a[1]); pk.y = pack2(a[2], a[3]); *(u32x2*)(wb + (16 * it + fr) * 128 + 16 * dt + 4 * fq) = pk; }
        { const int it = tl >> 3, vt = tl & 7; f32x4 a = {0.f, 0.f, 0.f, 0.f};
#pragma unroll
          for (int ks = 0; ks < 2; ++ks) a = __builtin_amdgcn_mfma_f32_16x16x32_bf16(ldfrag(P0, 72, it, ks, fr, fq), ldfrag(VTs, 72, vt, ks, fr, fq), a, 0, 0, 0);
          u32x2 pk; pk.x = pack2(a[0], a[1]); pk.y = pack2(a[2], a[3]); *(u32x2*)(uT + (16 * vt + fr) * 64 + 16 * it + 4 * fq) = pk; } }
}

__device__ __forceinline__ void dn_scan(const Params& p, int b, LAS unsigned char* lds) {
    const int tid = tid_(), w = tid >> 6, lane = tid & 63, fr = lane & 15, fq = lane >> 4, h = b >> 2, e0 = (b & 3) * 32;
    unsigned char* ws = opq(p.ws);
    const bf16_t* wbuf = (const bf16_t*)(ws + OFF_DNP + DNP_W); const bf16_t* uT = (const bf16_t*)(ws + OFF_DNP + DNP_UT); const bf16_t* kdT = (const bf16_t*)(ws + OFF_DNP + DNP_KDT);
    const float* glast = (const float*)(ws + OFF_SMALL + SM_GLAST);
    bf16_t* Sold = (bf16_t*)(ws + OFF_SCAN); bf16_t* vnT = (bf16_t*)(ws + OFF_SCAN + 64 * MB);
    LAS bf16_t* Sb = (LAS bf16_t*)lds;
    LAS bf16_t* Vn = (LAS bf16_t*)(lds + 32 * 136 * 2);
    f32x4 S[2] = {{0.f, 0.f, 0.f, 0.f}, {0.f, 0.f, 0.f, 0.f}};
    __syncthreads();
    bf16x8 kd[2], wf[4], kdn[2], wfn[4]; u32x2 u4[2] = {{0u, 0u}, {0u, 0u}}, u4n[2] = {{0u, 0u}, {0u, 0u}}; float gl, gln;
#define DN_LOAD(KD, WF, U4, GL, n_) do { const int it_ = (n_) * 8 + h;                                                                               \
        _Pragma("unroll") for (int kk = 0; kk < 2; ++kk) KD[kk] = *(const bf16x8*)(kdT + (size_t)it_ * 8192 + (16 * w + fr) * 64 + kk * 32 + 8 * fq); \
        if (w < 4) { _Pragma("unroll") for (int kk = 0; kk < 4; ++kk) WF[kk] = *(const bf16x8*)(wbuf + (size_t)it_ * 8192 + (16 * w + fr) * 128 + kk * 32 + 8 * fq); \
            _Pragma("unroll") for (int sl = 0; sl < 2; ++sl) U4[sl] = *(const u32x2*)(uT + (size_t)it_ * 8192 + (e0 + 16 * sl + fr) * 64 + 16 * w + 4 * fq); } \
        GL = glast[it_]; } while (0)
    DN_LOAD(kd, wf, u4, gl, 0);
#pragma unroll 1
    for (int n = 0; n < 256; ++n) {
        const int item = n * 8 + h;
        if (n + 1 < 256) DN_LOAD(kdn, wfn, u4n, gln, n + 1);
#pragma unroll
        for (int sl = 0; sl < 2; ++sl) { u32x2 sw; sw.x = pack2(S[sl][0], S[sl][1]); sw.y = pack2(S[sl][2], S[sl][3]);
            *(LAS u32x2*)(Sb + (16 * sl + fr) * 136 + 16 * w + 4 * fq) = sw;
            *(u32x2*)(Sold + (size_t)item * 16384 + (e0 + 16 * sl + fr) * 128 + 16 * w + 4 * fq) = sw; }
        __syncthreads();
        if (w < 4) {
#pragma unroll
            for (int sl = 0; sl < 2; ++sl) { f32x4 va = {0.f, 0.f, 0.f, 0.f};
#pragma unroll
                for (int kk = 0; kk < 4; ++kk) { const bf16x8 bb = *(const LAS bf16x8*)(Sb + (16 * sl + fr) * 136 + kk * 32 + 8 * fq); va = __builtin_amdgcn_mfma_f32_16x16x32_bf16(wf[kk], bb, va, 0, 0, 0); }
                u32x2 vw; vw.x = pack2(bflo(u4[sl].x) - va[0], bfhi(u4[sl].x) - va[1]); vw.y = pack2(bflo(u4[sl].y) - va[2], bfhi(u4[sl].y) - va[3]);
                *(LAS u32x2*)(Vn + (16 * sl + fr) * 72 + 16 * w + 4 * fq) = vw;
                *(u32x2*)(vnT + (size_t)item * 8192 + (e0 + 16 * sl + fr) * 64 + 16 * w + 4 * fq) = vw; } }
        __syncthreads();
#pragma unroll
        for (int sl = 0; sl < 2; ++sl) { S[sl] = S[sl] * gl;
#pragma unroll
            for (int kk = 0; kk < 2; ++kk) { const bf16x8 bb = *(const LAS bf16x8*)(Vn + (16 * sl + fr) * 72 + kk * 32 + 8 * fq); S[sl] = __builtin_amdgcn_mfma_f32_16x16x32_bf16(kd[kk], bb, S[sl], 0, 0, 0); } }
#pragma unroll
        for (int kk = 0; kk < 2; ++kk) kd[kk] = kdn[kk];
#pragma unroll
        for (int kk = 0; kk < 4; ++kk) wf[kk] = wfn[kk];
        u4[0] = u4n[0]; u4[1] = u4n[1]; gl = gln;
    }
#undef DN_LOAD
}

__device__ __forceinline__ float relu_(float x) { return __builtin_amdgcn_fmed3f(x, 0.f, __builtin_inff()); }
__device__ __forceinline__ float unsortable(unsigned u) { return __uint_as_float((u & 0x80000000u) ? (u ^ 0x80000000u) : ~u); }
__device__ __forceinline__ unsigned sortable(float f) { const unsigned u = __float_as_uint(f); return (u & 0x80000000u) ? ~u : (u | 0x80000000u); }

template <bool EXACT>
__device__ __forceinline__ unsigned compact_q(LAS unsigned* kq, LAS unsigned* iq, int n, int lane, int& nkeep) {
    unsigned key[8], idx[8]; bool val[8];
#pragma unroll
    for (int i = 0; i < 8; ++i) { const int e = lane + 64 * i; val[i] = e < n; key[i] = val[i] ? kq[e] : 0u; idx[i] = val[i] ? iq[e] : 0xffffffffu; }
    unsigned th = 0u; int cur = n;
#pragma unroll 1
    for (int b = 31; b >= 0; --b) { const unsigned cand = th | (1u << b); int c = 0;
#pragma unroll
        for (int i = 0; i < 8; ++i) c += __popcll(__ballot(val[i] && key[i] >= cand));
        if (c >= 256) { th = cand; cur = c; if (!EXACT && c <= 288) break; } }
    if (!EXACT) { int base = 0;
#pragma unroll
        for (int i = 0; i < 8; ++i) { const bool keep = val[i] && key[i] >= th; const unsigned long long m = __ballot(keep);
            const int pos = base + __popcll(m & ((1ull << lane) - 1ull)); if (keep) { kq[pos] = key[i]; iq[pos] = idx[i]; } base += __popcll(m); }
        nkeep = cur; return th - 1u; }
    int cgt = 0, ceq = 0;
#pragma unroll
    for (int i = 0; i < 8; ++i) { cgt += __popcll(__ballot(val[i] && key[i] > th)); ceq += __popcll(__ballot(val[i] && key[i] == th)); }
    const int need = 256 - cgt; unsigned beta = 0xffffffffu;
    if (ceq > need) { beta = 0u;
#pragma unroll 1
        for (int b = 14; b >= 0; --b) { const unsigned cand = beta | (1u << b); int c = 0;
#pragma unroll
            for (int i = 0; i < 8; ++i) c += __popcll(__ballot(val[i] && key[i] == th && idx[i] < cand));
            if (c < need) beta = cand; } }
    int base = 0;
#pragma unroll
    for (int i = 0; i < 8; ++i) { const bool keep = val[i] && (key[i] > th || (key[i] == th && idx[i] <= beta)); const unsigned long long m = __ballot(keep);
        const int pos = base + __popcll(m & ((1ull << lane) - 1ull)); if (keep) { kq[pos] = key[i]; iq[pos] = idx[i]; } base += __popcll(m); }
    nkeep = 256; return th;
}

__device__ __forceinline__ unsigned compact_hist(LAS unsigned* kq, LAS unsigned* iq, int n, int lane, int& nkeep, LAS unsigned* hist, unsigned lo) {
    unsigned key[8], idx[8]; bool val[8]; unsigned mx = 0u;
#pragma unroll
    for (int i = 0; i < 8; ++i) { const int e = lane + 64 * i; val[i] = e < n; key[i] = val[i] ? kq[e] : 0u; idx[i] = val[i] ? iq[e] : 0xffffffffu; mx = key[i] > mx ? key[i] : mx; }
#pragma unroll
    for (int o = 32; o >= 1; o >>= 1) { const unsigned t = (unsigned)shfl_xor_((int)mx, o); mx = t > mx ? t : mx; }
    const unsigned range = mx - lo; const int nb = 32 - __clz((int)(range | 1u)); const int sh = nb > 8 ? nb - 8 : 0;
#pragma unroll
    for (int i = 0; i < 4; ++i) hist[lane + 64 * i] = 0u;
#pragma unroll
    for (int i = 0; i < 8; ++i) if (val[i]) { unsigned b = (key[i] - lo) >> sh; b = b < 255u ? b : 255u; __hip_atomic_fetch_add(hist + b, 1u, __ATOMIC_RELAXED, __HIP_MEMORY_SCOPE_WORKGROUP); }
    const u32x4 cb = *(const LAS u32x4*)(hist + 4 * lane);
    int S = (int)(cb.x + cb.y + cb.z + cb.w);
#pragma unroll
    for (int o = 1; o < 64; o <<= 1) { const int t = bperm_i((lane + o) & 63, S); if (lane + o < 64) S += t; }
    const unsigned long long ge = __ballot(S >= 256); const int L = 63 - __clzll((long long)ge);
    int above = bperm_i((L + 1) & 63, S); if (L == 63) above = 0;
    const unsigned c3 = (unsigned)bperm_i(L, (int)cb.w), c2 = (unsigned)bperm_i(L, (int)cb.z), c1 = (unsigned)bperm_i(L, (int)cb.y), c0 = (unsigned)bperm_i(L, (int)cb.x);
    int bsel, cur;
    if (above + (int)c3 >= 256) { bsel = 3; cur = above + (int)c3; } else if (above + (int)(c3 + c2) >= 256) { bsel = 2; cur = above + (int)(c3 + c2); }
    else if (above + (int)(c3 + c2 + c1) >= 256) { bsel = 1; cur = above + (int)(c3 + c2 + c1); } else { bsel = 0; cur = above + (int)(c3 + c2 + c1 + c0); }
    if (cur > 352) return compact_q<false>(kq, iq, n, lane, nkeep);
    const unsigned th = lo + ((unsigned)(4 * L + bsel) << sh);
    int base = 0;
#pragma unroll
    for (int i = 0; i < 8; ++i) { const bool keep = val[i] && key[i] >= th; const unsigned long long m = __ballot(keep);
        const int pos = base + __popcll(m & ((1ull << lane) - 1ull)); if (keep) { kq[pos] = key[i]; iq[pos] = idx[i]; } base += __popcll(m); }
    nkeep = cur; return th - 1u;
}

__device__ __forceinline__ void dsa_block(const Params& p, int qb, LAS unsigned char* lds) {
    const int tid = tid_(), w = tid >> 6, lane = tid & 63, fr = lane & 15, fq = lane >> 4, t0 = qb * 32;
    unsigned char* ws = opq(p.ws); const bf16_t* proj = (const bf16_t*)(ws + OFF_PROJ); const bf16_t* kidx = (const bf16_t*)(ws + OFF_SMALL + SM_KIDX); const float* wq = (const float*)(ws + OFF_SMALL + SM_WQ);
    LAS unsigned* ckey = (LAS unsigned*)lds;
    LAS unsigned* cidx = (LAS unsigned*)(lds + 65536);
    LAS unsigned* cnt = (LAS unsigned*)(lds + 131072);
    __syncthreads();
    bf16x8 af[2][2]; f32x4 wr[2]; int tmy[2];
    const int hb = fq & 1, qoff = (fq >> 1) ? w + 8 : w;
#pragma unroll
    for (int m = 0; m < 2; ++m) { const int tqr = t0 + 16 * m + ((fr >> 3) ? w + 8 : w);
#pragma unroll
        for (int kk = 0; kk < 2; ++kk) af[m][kk] = *(const bf16x8*)(proj + (size_t)tqr * LDP + C_IQ + (fr & 7) * 64 + kk * 32 + 8 * fq);
        tmy[m] = t0 + 16 * m + qoff; wr[m] = *(const f32x4*)(wq + (size_t)tmy[m] * 8 + 4 * hb); }
    const unsigned msk = hb ? 0xffffffffu : 0u, lt = (1u << (lane & 31)) - 1u;
    unsigned tauu[2] = {0u, 0u};
    LAS unsigned* hist = (LAS unsigned*)(lds + 132096 + w * 1024);
    float tauf[2] = {-__builtin_inff(), -__builtin_inff()};
    if (tid < 32) cnt[tid] = 0u;
    __syncthreads();
    const int ntile = (t0 + 31) / 128 + 1;
    bf16x8 bfr[8][2], bfn[8][2];
#pragma unroll
    for (int j = 0; j < 8; ++j)
#pragma unroll
        for (int kk = 0; kk < 2; ++kk) bfr[j][kk] = *(const bf16x8*)(kidx + ((size_t)(j * 2 + kk) * 64 + lane) * 8);
#pragma unroll 1
    for (int kt = 0; kt < ntile; ++kt) {
        if (kt + 1 < ntile) {
#pragma unroll
            for (int j = 0; j < 8; ++j)
#pragma unroll
                for (int kk = 0; kk < 2; ++kk) bfn[j][kk] = *(const bf16x8*)(kidx + ((size_t)(((kt + 1) * 8 + j) * 2 + kk) * 64 + lane) * 8); }
        const bool lastt = kt == ntile - 1; const int lim = lastt ? 256 : 384;
#pragma unroll
        for (int m = 0; m < 2; ++m) {
            float pt[8];
#pragma unroll
            for (int j = 0; j < 8; ++j) { f32x4 a = {0.f, 0.f, 0.f, 0.f};
                a = __builtin_amdgcn_mfma_f32_16x16x32_bf16(af[m][0], bfr[j][0], a, 0, 0, 0); a = __builtin_amdgcn_mfma_f32_16x16x32_bf16(af[m][1], bfr[j][1], a, 0, 0, 0);
                pt[j] = wr[m][0] * relu_(a[0]) + wr[m][1] * relu_(a[1]) + wr[m][2] * relu_(a[2]) + wr[m][3] * relu_(a[3]); }
            const int myq = 16 * m + qoff; LAS unsigned* kq = ckey + myq * 512; LAS unsigned* iq = cidx + myq * 512;
#pragma unroll
            for (int i = 0; i < 4; ++i) {
                const auto sw = __builtin_amdgcn_permlane16_swap(__float_as_uint(pt[i]), __float_as_uint(pt[4 + i]), false, false);
                const float v = __uint_as_float(sw[0]) + __uint_as_float(sw[1]);
                const int s = kt * 128 + 16 * (4 * hb + i) + fr;
                if (s <= tmy[m] && v > tauf[m]) {
                    const unsigned pos = __hip_atomic_fetch_add(cnt + myq, 1u, __ATOMIC_RELAXED, __HIP_MEMORY_SCOPE_WORKGROUP);
                    if (pos < 512u) { kq[pos] = sortable(v); iq[pos] = (unsigned)s; } } }
            const int c0 = __builtin_amdgcn_readfirstlane((int)cnt[16 * m + w]), c1 = __builtin_amdgcn_readfirstlane((int)cnt[16 * m + w + 8]);
            if (c0 > lim) { int nk; const int n0 = c0 < 512 ? c0 : 512; const unsigned lo0 = (unsigned)__builtin_amdgcn_readlane((int)tauu[m], 0);
                const unsigned th = lastt ? compact_q<true>(ckey + (16 * m + w) * 512, cidx + (16 * m + w) * 512, n0, lane, nk) : compact_hist(ckey + (16 * m + w) * 512, cidx + (16 * m + w) * 512, n0, lane, nk, hist, lo0);
                if (lane == 0) cnt[16 * m + w] = (unsigned)nk; if (lane < 32) { tauf[m] = unsortable(th); tauu[m] = th; } }
            if (c1 > lim) { int nk; const int n1 = c1 < 512 ? c1 : 512; const unsigned lo1 = (unsigned)__builtin_amdgcn_readlane((int)tauu[m], 32);
                const unsigned th = lastt ? compact_q<true>(ckey + (16 * m + w + 8) * 512, cidx + (16 * m + w + 8) * 512, n1, lane, nk) : compact_hist(ckey + (16 * m + w + 8) * 512, cidx + (16 * m + w + 8) * 512, n1, lane, nk, hist, lo1);
                if (lane == 0) cnt[16 * m + w + 8] = (unsigned)nk; if (lane >= 32) { tauf[m] = unsortable(th); tauu[m] = th; } }
        }
#pragma unroll
        for (int j = 0; j < 8; ++j)
#pragma unroll
            for (int kk = 0; kk < 2; ++kk) bfr[j][kk] = bfn[j][kk];
    }
    __syncthreads();
    LAS unsigned* mk = ckey;
    for (int i = tid; i < 32 * 512; i += 512) mk[i] = 0u;
    __syncthreads();
#pragma unroll 1
    for (int rep = 0; rep < 4; ++rep) { const int q = w + 8 * rep; const int n = min((int)cnt[q], 256);
        for (int e = lane; e < n; e += 64) { const unsigned s = cidx[q * 512 + e]; __hip_atomic_fetch_or(mk + q * 512 + (s >> 5), 1u << (s & 31u), __ATOMIC_RELAXED, __HIP_MEMORY_SCOPE_WORKGROUP); } }
    __syncthreads();
    unsigned long long* mg = (unsigned long long*)(ws + OFF_MASK);
    const int nkt = (((t0 & ~255) + 255) >> 6) + 1;
    for (int i = tid; i < nkt * 32; i += 512) { const int kt = i >> 5, q = i & 31; const unsigned long long lo = mk[q * 512 + 2 * kt], hi2 = mk[q * 512 + 2 * kt + 1];
        mg[(size_t)kt * T_ + t0 + q] = lo | (hi2 << 32); }
}

__device__ __forceinline__ void phase3(const Params& p, LAS unsigned char* lds) {
    const int c = blockIdx.x, tid = tid_();
    if (c < 32) dn_scan(p, c, lds);
    unsigned* queue = (unsigned*)(opq(p.ws) + OFF_SMALL + SM_CTRL) + 200;
    LAS int* tk = (LAS int*)(lds + 131072 + 512);
    for (;;) {
        __syncthreads();
        if (tid == 0) *tk = (int)atomicAdd(queue, 1u);
        __syncthreads();
        const int ticket = *tk;
        if (ticket >= 512) break;
        dsa_block(p, 511 - ticket, lds);
    }
}

__device__ __forceinline__ void dn_out_item(const Params& p, int item, LAS unsigned char* lds) {
    const int tid = tid_(), w = tid >> 6, lane = tid & 63, fr = lane & 15, fq = lane >> 4, m = w & 3, nh = w >> 2, n = item >> 3, h = item & 7;
    unsigned char* ws = opq(p.ws); const bf16_t* proj = (const bf16_t*)(ws + OFF_PROJ);
    const bf16_t* qd = (const bf16_t*)(ws + OFF_DNP + DNP_QD) + (size_t)item * 8192; const bf16_t* attn = (const bf16_t*)(ws + OFF_DNP + DNP_ATT) + (size_t)item * 4096;
    const bf16_t* Sold = (const bf16_t*)(ws + OFF_SCAN) + (size_t)item * 16384; const bf16_t* vnT = (const bf16_t*)(ws + OFF_SCAN + 64 * MB) + (size_t)item * 8192;
    bf16_t* ydn = (bf16_t*)(ws + OFF_Y);
    LAS float* red = (LAS float*)lds;
    f32x4 acc[4];
#pragma unroll
    for (int nt = 0; nt < 4; ++nt) acc[nt] = (f32x4){0.f, 0.f, 0.f, 0.f};
#pragma unroll
    for (int kk = 0; kk < 4; ++kk) { const bf16x8 a = *(const bf16x8*)(qd + (16 * m + fr) * 128 + kk * 32 + 8 * fq);
#pragma unroll
        for (int nt = 0; nt < 4; ++nt) { const bf16x8 b = *(const bf16x8*)(Sold + (size_t)(16 * (4 * nh + nt) + fr) * 128 + kk * 32 + 8 * fq); acc[nt] = __builtin_amdgcn_mfma_f32_16x16x32_bf16(a, b, acc[nt], 0, 0, 0); } }
#pragma unroll
    for (int kk = 0; kk < 2; ++kk) { const bf16x8 a = *(const bf16x8*)(attn + (16 * m + fr) * 64 + kk * 32 + 8 * fq);
#pragma unroll
        for (int nt = 0; nt < 4; ++nt) { const bf16x8 b = *(const bf16x8*)(vnT + (size_t)(16 * (4 * nh + nt) + fr) * 64 + kk * 32 + 8 * fq); acc[nt] = __builtin_amdgcn_mfma_f32_16x16x32_bf16(a, b, acc[nt], 0, 0, 0); } }
    float ssq[4];
#pragma unroll
    for (int j = 0; j < 4; ++j) { float s = 0.f;
#pragma unroll
        for (int nt = 0; nt < 4; ++nt) s += acc[nt][j] * acc[nt][j];
        ssq[j] = sum16(s); }
    __syncthreads();
    if (fr == 0) {
#pragma unroll
        for (int j = 0; j < 4; ++j) red[(16 * m + 4 * fq + j) * 2 + nh] = ssq[j]; }
    __syncthreads();
#pragma unroll
    for (int j = 0; j < 4; ++j) { const int i = 16 * m + 4 * fq + j, t = n * 64 + i; const float rs = rsqrtf((red[i * 2] + red[i * 2 + 1]) * (1.0f / 128.0f) + EPS);
#pragma unroll
        for (int nt = 0; nt < 4; ++nt) { const int dv = 16 * (4 * nh + nt) + fr; const float z = bf2f(proj[(size_t)t * LDP + C_Z + h * 128 + dv]);
            ydn[(size_t)t * 1024 + h * 128 + dv] = f2bf(acc[nt][j] * rs * p.dn_norm_w[dv] * siluf_(z)); } }
}

__device__ __forceinline__ void phase_attn(const Params& p, LAS unsigned char* lds) {
    const int G = gridDim.x, c = blockIdx.x; unsigned char* ws = opq(p.ws);
    const bf16_t* proj = (const bf16_t*)(ws + OFF_PROJ); bf16_t* yat = (bf16_t*)(ws + OFF_Y + 32 * MB); const unsigned long long* mk = (const unsigned long long*)(ws + OFF_MASK);
    typedef att::BlockRef<bf16_t, bf16_t> BR;
    auto mkref = [&](int L, int pass) { const int h = L & 7, x = L >> 3, qb = pass ? 63 - x : x; BR r;
        r.Q = proj + (size_t)qb * 256 * LDP + C_AQ + h * 128; r.K = proj + C_AK + h * 128; r.V = proj + C_AV + h * 128;
        r.O = yat + (size_t)qb * 256 * 1024 + h * 128; r.P0 = qb * 256; r.MK = mk + qb * 256; return r; };
    int L = c;
    if (L < 256) {
        int pass = 0; BR cur = mkref(L, 0); att::Seam<bf16_t> S;
        att::causal_swa_prime<bf16_t, bf16_t>(cur, 1 << 30, (char*)lds, S);
        for (;;) {
            const bool more_pass = pass == 0, more_item = L + G < 256, last = !more_pass && !more_item;
            int passn = pass + 1, Ln = L; if (!more_pass) { passn = 0; Ln = more_item ? L + G : L; }
            const BR nxt = last ? cur : mkref(Ln, passn);
            att::causal_swa_block<bf16_t, bf16_t>(cur, nxt, T_, 1 << 30, (char*)lds, S);
            if (last) break;
            cur = nxt; pass = passn; L = Ln;
        }
    }
    __syncthreads();
    for (int item = c; item < NITEM; item += G) dn_out_item(p, item, lds);
}

__device__ __forceinline__ void phase_router(const Params& p, LAS unsigned char* lds) {
    const int G = gridDim.x, c = blockIdx.x, tid = tid_(), w = tid >> 6, lane = tid & 63, fr = lane & 15, fq = lane >> 4;
    unsigned char* ws = opq(p.ws); const float* x1 = (const float*)(ws + OFF_X1); bf16_t* h2 = (bf16_t*)(ws + OFF_H);
    int* rexp = (int*)(ws + OFF_SMALL + SM_ROUTE); float* rwt = (float*)(ws + OFF_SMALL + SM_ROUTE + 128 * 1024); float* rstab = (float*)(ws + OFF_SMALL + SM_ROUTE + 384 * 1024);
    int* rpos = (int*)(ws + OFF_SMALL + SM_ROUTE + 256 * 1024); unsigned* cntT = (unsigned*)(ws + OFF_SMALL + SM_KIDX);
    LAS int* exl = (LAS int*)(lds + 104 * 1024);
    const bf16_t* wh = (const bf16_t*)(ws + OFF_WR); const bf16_t* wl = (const bf16_t*)(ws + OFF_WR + 512 * 1024);
    LAS float* red = (LAS float*)lds;
    LAS float* lgt = (LAS float*)(lds + 8 * 32 * 81 * 4);
    LAS float* gL = (LAS float*)(lds + 96 * 1024);
#pragma clang loop vectorize(disable) interleave(disable)
    for (int i = tid; i < 2048; i += 512) gL[i] = p.norm_ffn[i];
    __syncthreads();
    for (int tile = c; tile < T_ / 32; tile += G) {
        const int tb = tile * 32;
        f32x4 acc[2][5];
#pragma unroll
        for (int s2 = 0; s2 < 2; ++s2)
#pragma unroll
            for (int j = 0; j < 5; ++j) acc[s2][j] = (f32x4){0.f, 0.f, 0.f, 0.f};
        float ssq[2] = {0.f, 0.f};
        f32x4 xa[2][2], xn[2][2]; bf16x8 bh[5], bl[5], bhn[5], bln[5];
        auto loadop = [&](int ks, f32x4 (&x)[2][2], bf16x8 (&h)[5], bf16x8 (&l)[5]) {
#pragma unroll
            for (int s2 = 0; s2 < 2; ++s2) { const float* xp = x1 + (size_t)(tb + 16 * s2 + fr) * 2048 + 32 * ks + 8 * fq; x[s2][0] = *(const f32x4*)xp; x[s2][1] = *(const f32x4*)(xp + 4); }
            unsigned o = (unsigned)(ks * 512 + lane * 8); asm volatile("" : "+v"(o));
#pragma unroll
            for (int j = 0; j < 5; ++j) { h[j] = *(const bf16x8*)(wh + j * 32768 + o); l[j] = *(const bf16x8*)(wl + j * 32768 + o); } };
        auto stage = [&](int ks, const f32x4 (&x)[2][2], const bf16x8 (&h)[5], const bf16x8 (&l)[5]) {
            const f32x4 g0 = *(const LAS f32x4*)(gL + 32 * ks + 8 * fq), g1 = *(const LAS f32x4*)(gL + 32 * ks + 8 * fq + 4);
#pragma unroll
            for (int s2 = 0; s2 < 2; ++s2) { const f32x4 x0 = x[s2][0], x4 = x[s2][1];
                ssq[s2] += x0[0] * x0[0] + x0[1] * x0[1] + x0[2] * x0[2] + x0[3] * x0[3] + x4[0] * x4[0] + x4[1] * x4[1] + x4[2] * x4[2] + x4[3] * x4[3];
                const float a0 = x0[0] * g0[0], a1 = x0[1] * g0[1], a2 = x0[2] * g0[2], a3 = x0[3] * g0[3], a4 = x4[0] * g1[0], a5 = x4[1] * g1[1], a6 = x4[2] * g1[2], a7 = x4[3] * g1[3];
                u32x4 ph; ph.x = pack2(a0, a1); ph.y = pack2(a2, a3); ph.z = pack2(a4, a5); ph.w = pack2(a6, a7);
                u32x4 pl; pl.x = pack2(a0 - bflo(ph.x), a1 - bfhi(ph.x)); pl.y = pack2(a2 - bflo(ph.y), a3 - bfhi(ph.y));
                pl.z = pack2(a4 - bflo(ph.z), a5 - bfhi(ph.z)); pl.w = pack2(a6 - bflo(ph.w), a7 - bfhi(ph.w));
                *(u32x4*)(h2 + (size_t)(tb + 16 * s2 + fr) * 2048 + 32 * ks + 8 * fq) = ph;
                const bf16x8 ah = __builtin_bit_cast(bf16x8, ph), al = __builtin_bit_cast(bf16x8, pl);
#pragma unroll
                for (int j = 0; j < 5; ++j) {
                    acc[s2][j] = __builtin_amdgcn_mfma_f32_16x16x32_bf16(ah, h[j], acc[s2][j], 0, 0, 0);
                    acc[s2][j] = __builtin_amdgcn_mfma_f32_16x16x32_bf16(ah, l[j], acc[s2][j], 0, 0, 0);
                    acc[s2][j] = __builtin_amdgcn_mfma_f32_16x16x32_bf16(al, h[j], acc[s2][j], 0, 0, 0); } } };
        const int rot = c & 7;
        loadop(8 * rot + w, xa, bh, bl);
#pragma unroll 1
        for (int kk = 0; kk < 8; kk += 2) { const int k0 = 8 * ((kk + rot) & 7) + w, k1 = 8 * ((kk + 1 + rot) & 7) + w, k2 = 8 * ((kk + 2 + rot) & 7) + w;
            loadop(k1, xn, bhn, bln);
            __builtin_amdgcn_sched_barrier(0);
            stage(k0, xa, bh, bl);
            __builtin_amdgcn_sched_barrier(0);
            loadop(k2, xa, bh, bl);
            __builtin_amdgcn_sched_barrier(0);
            stage(k1, xn, bhn, bln);
            __builtin_amdgcn_sched_barrier(0); }
#pragma unroll
        for (int s2 = 0; s2 < 2; ++s2) { ssq[s2] += shfl_xor_(ssq[s2], 16); ssq[s2] += shfl_xor_(ssq[s2], 32); }
        __syncthreads();
#pragma unroll
        for (int s2 = 0; s2 < 2; ++s2) {
#pragma unroll
            for (int j = 0; j < 5; ++j)
#pragma unroll
                for (int r = 0; r < 4; ++r) red[(w * 32 + 16 * s2 + 4 * fq + r) * 81 + 16 * j + fr] = acc[s2][j][r];
            if (fq == 0) red[(w * 32 + 16 * s2 + fr) * 81 + 80] = ssq[s2]; }
        __syncthreads();
#pragma clang loop vectorize(disable) interleave(disable)
        for (int o = tid; o < 32 * 81; o += 512) { float sacc = 0.f;
#pragma unroll
            for (int ww = 0; ww < 8; ++ww) sacc += red[ww * (32 * 81) + o];
            lgt[o] = sacc; }
        __syncthreads();
        if (tid < 32) { const int t = tb + tid; LAS float* l = lgt + tid * 81;
            const float rs = rsqrtf(l[80] * (1.0f / 2048.0f) + EPS);
            float gmax = -3.0e38f; int gs = 0; float gl[8];
#pragma unroll
            for (int g = 0; g < 8; ++g) { gl[g] = l[64 + g] * rs + p.b_group[g]; if (gl[g] > gmax) { gmax = gl[g]; gs = g; } }
            float gsum = 0.f;
#pragma unroll
            for (int g = 0; g < 8; ++g) gsum += __expf(gl[g] - gmax);
            const float pg = 1.0f / gsum;
            float el[8]; float m1 = -3.0e38f, m2 = -3.0e38f; int i1 = 0, i2 = 0;
#pragma unroll
            for (int e = 0; e < 8; ++e) { el[e] = l[gs * 8 + e] * rs + p.b_router[gs * 8 + e]; }
#pragma unroll
            for (int e = 0; e < 8; ++e) if (el[e] > m1) { m1 = el[e]; i1 = e; }
#pragma unroll
            for (int e = 0; e < 8; ++e) if (e != i1 && el[e] > m2) { m2 = el[e]; i2 = e; }
            const float e2 = __expf(m2 - m1); const float w1 = pg / (1.0f + e2), w2 = pg * e2 / (1.0f + e2);
            const int ex1 = gs * 8 + i1, ex2 = gs * 8 + i2;
            rexp[t * 2] = ex1; rexp[t * 2 + 1] = ex2; rwt[t * 2] = w1; rwt[t * 2 + 1] = w2; rstab[t] = rs;
            exl[2 * tid] = ex1; exl[2 * tid + 1] = ex2;
            asm volatile("s_waitcnt lgkmcnt(0)" ::: "memory");
            int r1 = 0, r2 = 0;
            for (int j = 0; j < 2 * tid; ++j) { const int xx = exl[j]; r1 += xx == ex1 ? 1 : 0; r2 += xx == ex2 ? 1 : 0; }
            rpos[t * 2] = r1; rpos[t * 2 + 1] = r2; }
        if (tid < 64) { asm volatile("s_waitcnt lgkmcnt(0)" ::: "memory"); int cn = 0;
            for (int j = 0; j < 64; ++j) cn += exl[j] == tid ? 1 : 0;
            cntT[tile * 64 + tid] = (unsigned)cn; }
    }
}

__device__ __forceinline__ void expert_starts(const unsigned* ecnt, LAS int* pstart, int tid) {
    if (tid < 64) { const int cn = (int)ecnt[tid]; const int pad = (cn + 127) / 128 * 128; int s = pad;
        for (int o = 1; o < 64; o <<= 1) { const int u = shfl_up_(s, o); if (tid >= o) s += u; }
        pstart[tid] = s - pad; if (tid == 63) pstart[64] = s; }
}
__device__ __forceinline__ void phase_slots(const Params& p, LAS unsigned char* lds) {
    const int G = gridDim.x, c = blockIdx.x, tid = tid_(), e = tid & 63, part = tid >> 6;
    unsigned char* ws = opq(p.ws); unsigned* ecnt = (unsigned*)(ws + OFF_SMALL + SM_CTRL); const unsigned* cntT = (const unsigned*)(ws + OFF_SMALL + SM_KIDX);
    const int* rexp = (const int*)(ws + OFF_SMALL + SM_ROUTE); int* rpos = (int*)(ws + OFF_SMALL + SM_ROUTE + 256 * 1024); int* rowtok = (int*)(ws + OFF_ROWTOK);
    LAS int* pstart = (LAS int*)lds; LAS int* part8 = (LAS int*)(lds + 1024);
    constexpr int NTILE = T_ / 32;
    __syncthreads();
    { int tot = 0;
#pragma clang loop vectorize(disable) interleave(disable)
      for (int t = part; t < NTILE; t += 8) tot += (int)cntT[t * 64 + e];
      part8[part * 64 + e] = tot; }
    __syncthreads();
    if (tid < 64) { int cn = 0;
#pragma unroll
        for (int q = 0; q < 8; ++q) cn += part8[q * 64 + tid];
        if (c == 0) ecnt[tid] = (unsigned)cn;
        const int pad = (cn + 127) / 128 * 128; int sc = pad;
        for (int o = 1; o < 64; o <<= 1) { const int u = shfl_up_(sc, o); if (tid >= o) sc += u; }
        pstart[tid] = sc - pad; if (tid == 63) pstart[64] = sc; }
    for (int tile = c; tile < NTILE; tile += G) {
        __syncthreads();
        { int pre = 0;
#pragma clang loop vectorize(disable) interleave(disable)
          for (int t = part; t < tile; t += 8) pre += (int)cntT[t * 64 + e];
          part8[part * 64 + e] = pre; }
        __syncthreads();
        if (tid < 64) { const int a = tile * 64 + tid; const int ex = rexp[a]; int base = pstart[ex];
#pragma unroll
            for (int q = 0; q < 8; ++q) base += part8[q * 64 + ex];
            const int pos = base + rpos[a]; rpos[a] = pos; rowtok[pos] = a >> 1; }
    }
}

#define MOE_BAR() do { asm volatile("s_waitcnt lgkmcnt(0)" ::: "memory"); __builtin_amdgcn_s_barrier(); asm volatile("" ::: "memory"); } while (0)
__device__ __forceinline__ void vm_wait(int n) {
    if (n >= 20) asm volatile("s_waitcnt vmcnt(20)" ::: "memory"); else if (n >= 16) asm volatile("s_waitcnt vmcnt(16)" ::: "memory");
    else if (n >= 14) asm volatile("s_waitcnt vmcnt(14)" ::: "memory"); else if (n >= 12) asm volatile("s_waitcnt vmcnt(12)" ::: "memory");
    else if (n >= 10) asm volatile("s_waitcnt vmcnt(10)" ::: "memory"); else if (n >= 8) asm volatile("s_waitcnt vmcnt(8)" ::: "memory");
    else if (n >= 6) asm volatile("s_waitcnt vmcnt(6)" ::: "memory"); else if (n >= 4) asm volatile("s_waitcnt vmcnt(4)" ::: "memory");
    else if (n >= 2) asm volatile("s_waitcnt vmcnt(2)" ::: "memory"); else asm volatile("s_waitcnt vmcnt(0)" ::: "memory");
}
template <int MODE, int NT>
__device__ __forceinline__ void moe_kloop(const Params& p, LAS unsigned char* lds, int e, int nt, int rs, int cnt) {
    constexpr int K = MODE == 0 ? 2048 : 512, NK = K / 64, WLD = MODE == 0 ? 512 : 2048, NA = NT ? NT : 1;
    const int tid = tid_(), w = __builtin_amdgcn_readfirstlane(tid >> 6), lane = tid & 63, fr = lane & 15, fq = lane >> 4;
    unsigned char* ws = opq(p.ws);
    LAS float* Rw = (LAS float*)(lds + w * 4096);
    LAS bf16_t* Wb0 = (LAS bf16_t*)(lds + 32768);
    LAS unsigned char* Ar = lds + 69632 + w * 10240;
    LAS int* tokl = (LAS int*)(lds + 151552);
    const bf16_t* Asrc = (const bf16_t*)(ws + (MODE == 0 ? OFF_H : OFF_ACT));
    const float* W0; const float* W1;
    if (MODE == 0) { W0 = p.w_exp_gate + (size_t)e * 2048 * 512 + nt * 64; W1 = p.w_exp_up + (size_t)e * 2048 * 512 + nt * 64; }
    else { W0 = p.w_exp_down + (size_t)e * 512 * 2048 + nt * 128; W1 = W0 + 64; }
    auto issueA = [&](int ks) {
        const int r0 = lane >> 3, cs0 = (lane & 7) ^ (r0 & 7);
        unsigned ro[NA][2];
#pragma unroll
        for (int mt = 0; mt < NT; ++mt)
#pragma unroll
            for (int i = 0; i < 2; ++i)
                ro[mt][i] = MODE == 0 ? (unsigned)tokl[mt * 128 + 16 * w + r0 + 8 * i] * 2048u : (unsigned)(rs + mt * 128 + 16 * w + r0 + 8 * i) * 512u;
#pragma unroll
        for (int mt = 0; mt < NT; ++mt) {
#pragma unroll
            for (int i = 0; i < 2; ++i)
                __builtin_amdgcn_global_load_lds((const unsigned*)(Asrc + (size_t)(ro[mt][i] + (unsigned)(ks * 64 + cs0 * 8))), (LAS unsigned*)(Ar + mt * 2048 + i * 1024), 16, 0, 0);
            __builtin_amdgcn_sched_barrier(0); } };
    auto issueW = [&](int ks) {
#pragma unroll
        for (int i = 0; i < 4; ++i) { const int pch = lane + 64 * i, r = pch >> 5, cc = pch & 31;
            const float* src = (cc < 16 ? W0 + 4 * cc : W1 + 4 * (cc - 16)) + (size_t)(ks * 64 + 8 * w + r) * WLD;
            __builtin_amdgcn_global_load_lds((const unsigned*)src, (LAS unsigned*)((LAS unsigned char*)Rw + i * 1024), 16, 0, 0); } };
    auto convertW = [&](int buf) {
        LAS bf16_t* Wb = Wb0 + buf * (128 * 72);
#pragma unroll
        for (int c2 = 0; c2 < 2; ++c2) { const int nm = lane + 64 * c2; float v[8];
#pragma unroll
            for (int r = 0; r < 8; ++r) v[r] = Rw[r * 128 + nm];
            const int nrow = MODE == 0 ? (((nm & 63) >> 4) * 2 + (nm >> 6)) * 16 + (nm & 15) : nm;
            u32x4 pk; pk.x = pack2(v[0], v[1]); pk.y = pack2(v[2], v[3]); pk.z = pack2(v[4], v[5]); pk.w = pack2(v[6], v[7]);
            *(LAS u32x4*)(Wb + nrow * 72 + 8 * w) = pk; } };
    auto rawpack = [&](int c2) -> u32x4 { const int nm = lane + 64 * c2; float v[8];
#pragma unroll
        for (int r = 0; r < 8; ++r) v[r] = Rw[r * 128 + nm];
        u32x4 pk; pk.x = pack2(v[0], v[1]); pk.y = pack2(v[2], v[3]); pk.z = pack2(v[4], v[5]); pk.w = pack2(v[6], v[7]); return pk; };
    auto wbstore = [&](int buf, int c2, u32x4 pk) { const int nm = lane + 64 * c2;
        const int nrow = MODE == 0 ? (((nm & 63) >> 4) * 2 + (nm >> 6)) * 16 + (nm & 15) : nm;
        *(LAS u32x4*)(Wb0 + buf * (128 * 72) + nrow * 72 + 8 * w) = pk; };
    f32x4 acc[NA][8];
#pragma unroll
    for (int a = 0; a < NA; ++a)
#pragma unroll
        for (int n = 0; n < 8; ++n) acc[a][n] = (f32x4){0.f, 0.f, 0.f, 0.f};
    issueA(0); issueW(0); asm volatile("s_waitcnt vmcnt(0)" ::: "memory"); convertW(0);
    asm volatile("s_waitcnt lgkmcnt(0)" ::: "memory");
    if (NK > 1) issueW(1);
#pragma unroll 1
    for (int ks = 0; ks < NK; ++ks) {
        MOE_BAR();
        const LAS bf16_t* Wb = Wb0 + (ks & 1) * (128 * 72);
        if (ks + 1 < NK) asm volatile("s_waitcnt vmcnt(4)" ::: "memory");
        else asm volatile("s_waitcnt vmcnt(0)" ::: "memory");
        bf16x8 af[NA][2];
#pragma unroll
        for (int mt = 0; mt < NT; ++mt)
#pragma unroll
            for (int k2 = 0; k2 < 2; ++k2) af[mt][k2] = *(const LAS bf16x8*)(Ar + mt * 2048 + (fr * 8 + ((4 * k2 + fq) ^ (fr & 7))) * 16);
        if (ks + 1 < NK) asm volatile("s_waitcnt vmcnt(0)" ::: "memory");
        const int ksn = ks + 1 < NK ? ks + 1 : ks;
        const int r0 = lane >> 3, cs0 = (lane & 7) ^ (r0 & 7);
        auto rowoff = [&](int l) -> unsigned { const int mt = l >> 1, i = l & 1;
            return MODE == 0 ? (unsigned)tokl[mt * 128 + 16 * w + r0 + 8 * i] * 2048u : (unsigned)(rs + mt * 128 + 16 * w + r0 + 8 * i) * 512u; };
        unsigned off = NT > 0 ? rowoff(0) : 0u;
        float rv[8];
        bf16x8 b = *(const LAS bf16x8*)(Wb + fr * 72 + 8 * fq);
        asm volatile("s_waitcnt lgkmcnt(0)" ::: "memory");
#pragma unroll
        for (int f = 0; f < 16; ++f) { const int k2 = f >> 3, n = f & 7; bf16x8 bn = b;
            if (f + 1 < 16) bn = *(const LAS bf16x8*)(Wb + (16 * ((f + 1) & 7) + fr) * 72 + 32 * ((f + 1) >> 3) + 8 * fq);
            if (f < 2 * NT) {
                __builtin_amdgcn_global_load_lds((const unsigned*)(Asrc + (size_t)(off + (unsigned)(ksn * 64 + cs0 * 8))), (LAS unsigned*)(Ar + (f >> 1) * 2048 + (f & 1) * 1024), 16, 0, 0);
                if (f + 1 < 2 * NT) off = rowoff(f + 1); }
            if (f == 0 || f == 4) {
#pragma unroll
                for (int r = 0; r < 8; ++r) rv[r] = Rw[r * 128 + lane + (f == 0 ? 0 : 64)]; }
            if (f == 3 || f == 7) { u32x4 pk; pk.x = pack2(rv[0], rv[1]); pk.y = pack2(rv[2], rv[3]); pk.z = pack2(rv[4], rv[5]); pk.w = pack2(rv[6], rv[7]);
                wbstore((ks + 1) & 1, f == 3 ? 0 : 1, pk); }
            __builtin_amdgcn_sched_barrier(6);
#pragma unroll
            for (int mt = 0; mt < NT; ++mt) acc[mt][n] = __builtin_amdgcn_mfma_f32_16x16x32_bf16(b, af[mt][k2], acc[mt][n], 0, 0, 0);
            __builtin_amdgcn_sched_barrier(6);
            b = bn; }
        asm volatile("s_waitcnt lgkmcnt(0)" ::: "memory");
        if (ks + 2 < NK) issueW(ks + 2);
    }
#pragma unroll
    for (int mt = 0; mt < NT; ++mt) { const int rl = mt * 128 + 16 * w + fr;
        if (rl < cnt) {
            if (MODE == 0) { bf16_t* dst = (bf16_t*)(ws + OFF_ACT) + (size_t)(rs + rl) * 512 + nt * 64 + 4 * fq;
                const float rr = ((const float*)(ws + OFF_SMALL + SM_ROUTE + 384 * 1024))[tokl[rl]];
#pragma unroll
                for (int g = 0; g < 4; ++g) { const f32x4 gt = acc[mt][2 * g], u = acc[mt][2 * g + 1];
                    u32x2 pk; pk.x = pack2(siluf_(gt[0] * rr) * (u[0] * rr), siluf_(gt[1] * rr) * (u[1] * rr)); pk.y = pack2(siluf_(gt[2] * rr) * (u[2] * rr), siluf_(gt[3] * rr) * (u[3] * rr)); *(u32x2*)(dst + 16 * g) = pk; } }
            else { bf16_t* dst = (bf16_t*)(ws + OFF_YE) + (size_t)(rs + rl) * 2048 + nt * 128 + 4 * fq;
#pragma unroll
                for (int n = 0; n < 8; ++n) { const f32x4 v = acc[mt][n]; u32x2 pk; pk.x = pack2(v[0], v[1]); pk.y = pack2(v[2], v[3]); *(u32x2*)(dst + 16 * n) = pk; } } } }
    asm volatile("s_waitcnt vmcnt(0)" ::: "memory");
}
template <int MODE>
__device__ __forceinline__ void moe_item(const Params& p, LAS unsigned char* lds, int e, int nt, int rs, int cnt) {
    const int tid = tid_(), w = __builtin_amdgcn_readfirstlane(tid >> 6);
    unsigned char* ws = opq(p.ws); LAS int* tokl = (LAS int*)(lds + 151552);
    MOE_BAR();
    if (MODE == 0) { const int* rowtok = (const int*)(ws + OFF_ROWTOK); for (int i = tid; i < 640; i += 512) tokl[i] = rowtok[rs + (i < cnt ? i : 0)]; }
    MOE_BAR();
    const int mine = cnt - 16 * w; const int ntw = mine <= 0 ? 0 : (mine + 127) >> 7;
    if (ntw >= 5) moe_kloop<MODE, 5>(p, lds, e, nt, rs, cnt);
    else if (ntw == 4) moe_kloop<MODE, 4>(p, lds, e, nt, rs, cnt);
    else if (ntw == 3) moe_kloop<MODE, 3>(p, lds, e, nt, rs, cnt);
    else if (ntw == 2) moe_kloop<MODE, 2>(p, lds, e, nt, rs, cnt);
    else if (ntw == 1) moe_kloop<MODE, 1>(p, lds, e, nt, rs, cnt);
    else moe_kloop<MODE, 0>(p, lds, e, nt, rs, cnt);
}
template <int MODE>
__device__ __forceinline__ void phase_moe(const Params& p, LAS unsigned char* lds) {
    const int G = gridDim.x, c = blockIdx.x, tid = tid_();
    unsigned char* ws = opq(p.ws); const unsigned* ecnt = (const unsigned*)(ws + OFF_SMALL + SM_CTRL);
    LAS int* pstart = (LAS int*)(lds + 154112); LAS int* order = pstart + 80;
    __syncthreads();
    expert_starts(ecnt, pstart, tid);
    if (tid < 64) { const unsigned mine = ecnt[tid]; int rk = 0;
        for (int j = 0; j < 64; ++j) { const unsigned o = ecnt[j]; rk += (o > mine || (o == mine && j < tid)) ? 1 : 0; }
        order[rk] = tid; }
    __syncthreads();
    constexpr int PER = MODE == 0 ? 8 : 16;
    if (G == 256) {
        const int x = c & 7, sl = c >> 3, kk = sl / PER, nt = sl % PER; constexpr int EPR = 256 / PER;
        for (int j = 0; j < 64 / EPR; ++j) { const int within = 8 * kk + x; const int rnk = EPR * j + ((j & 1) ? EPR - 1 - within : within);
            const int e = order[rnk]; const int cn = (int)ecnt[e], rs = pstart[e];
            for (int seg = 0; seg < cn; seg += 640) moe_item<MODE>(p, lds, e, nt, rs + seg, min(cn - seg, 640)); }
    } else {
        for (int it = c; it < 64 * PER; it += G) { const int e = it / PER, nt = it % PER; const int cn = (int)ecnt[e], rs = pstart[e];
            for (int seg = 0; seg < cn; seg += 640) moe_item<MODE>(p, lds, e, nt, rs + seg, min(cn - seg, 640)); }
    }
    __syncthreads();
}

__device__ __forceinline__ void phase_final(const Params& p) {
    const int G = gridDim.x, c = blockIdx.x, tid = tid_(), w = tid >> 6, lane = tid & 63;
    unsigned char* ws = opq(p.ws); const float* x1 = (const float*)(ws + OFF_X1); const bf16_t* ye = (const bf16_t*)(ws + OFF_YE);
    const float* rwt = (const float*)(ws + OFF_SMALL + SM_ROUTE + 128 * 1024); const int* rpos = (const int*)(ws + OFF_SMALL + SM_ROUTE + 256 * 1024);
    for (int t = c * 8 + w; t < T_; t += G * 8) {
        const float w0 = rwt[t * 2], w1 = rwt[t * 2 + 1]; const bf16_t* y0 = ye + (size_t)rpos[t * 2] * 2048; const bf16_t* y1 = ye + (size_t)rpos[t * 2 + 1] * 2048;
        f32x4 v[8]; float ss = 0.f;
#pragma unroll
        for (int i = 0; i < 8; ++i) { const int k = i * 256 + 4 * lane; v[i] = *(const f32x4*)(x1 + (size_t)t * 2048 + k);
            const u32x2 a = *(const u32x2*)(y0 + k), b = *(const u32x2*)(y1 + k);
            v[i][0] += w0 * bflo(a.x) + w1 * bflo(b.x); v[i][1] += w0 * bfhi(a.x) + w1 * bfhi(b.x); v[i][2] += w0 * bflo(a.y) + w1 * bflo(b.y); v[i][3] += w0 * bfhi(a.y) + w1 * bfhi(b.y);
            ss += v[i][0] * v[i][0] + v[i][1] * v[i][1] + v[i][2] * v[i][2] + v[i][3] * v[i][3]; }
        ss = wave_sum(ss); const float rs = rsqrtf(ss * (1.0f / 2048.0f) + EPS);
#pragma unroll
        for (int i = 0; i < 8; ++i) { const int k = i * 256 + 4 * lane; const f32x4 g = *(const f32x4*)(p.norm_final + k);
            f32x4 o; o[0] = v[i][0] * rs * g[0]; o[1] = v[i][1] * rs * g[1]; o[2] = v[i][2] * rs * g[2]; o[3] = v[i][3] * rs * g[3];
            *(f32x4*)(p.out + (size_t)t * 2048 + k) = o; }
    }
}

template <int PH>
__device__ __forceinline__ void run_phase(const Params& p, LAS unsigned char* lds) {
    const int G = gridDim.x, c = blockIdx.x; unsigned char* ws = opq(p.ws);
    if constexpr (PH == 0) phase0(p, lds);
    if constexpr (PH == 1) { pg8::DenseOrder S; S.init(ws + OFF_H, ws + OFF_WT_IN, T_, LDP, 2048, G, c); EpiProj E; E.O = (bf16_t*)(ws + OFF_PROJ); pg8::gemm_phase(lds, 2048, S, E); }
    if constexpr (PH == 2) { phase_rope(p); u32x4 xr[3][2][4]; float ba[2]; if (c < NITEM) dn_prep_load(p, c, xr, ba);
        for (int item = c; item < NITEM; item += G) dn_prep_item(p, item, item + G < NITEM ? item + G : -1, lds, xr, ba); }
    if constexpr (PH == 3) phase3(p, lds);
    if constexpr (PH == 4) phase_attn(p, lds);
    if constexpr (PH == 5) { pg8::DenseOrder S; S.init(ws + OFF_Y, ws + OFF_WT_DN, T_, 2048, 1024, G, c); EpiMerge<0> E; E.M = (bf16_t*)(ws + OFF_H); E.proj = (const bf16_t*)(ws + OFF_PROJ); E.bg = p.b_gates; pg8::gemm_phase(lds, 1024, S, E);
              pg8::DenseOrder S2; S2.init(ws + OFF_Y + 32 * MB, ws + OFF_WT_AT, T_, 2048, 1024, G, c); EpiMerge<1> E2; E2.M = E.M; E2.proj = E.proj; E2.bg = p.b_gates; pg8::gemm_phase(lds, 1024, S2, E2); }
    if constexpr (PH == 6) { pg8::DenseOrder S; S.init(ws + OFF_H, ws + OFF_WT_OUT, T_, 2048, 2048, G, c); EpiResid E; E.X1 = (float*)(ws + OFF_X1); E.X = p.x; pg8::gemm_phase(lds, 2048, S, E); }
    if constexpr (PH == 7) phase_router(p, lds);
    if constexpr (PH == 8) phase_slots(p, lds);
    if constexpr (PH == 9) phase_moe<0>(p, lds);
    if constexpr (PH == 10) phase_moe<1>(p, lds);
    if constexpr (PH == 11) phase_final(p);
}

template <int PH>
__device__ __forceinline__ void phase_step(const Params& p, LAS unsigned char* lds, cg::grid_group& grid, const XcdBarrier& xb, unsigned long long& tp) {
#ifdef ONLY_PHASE
    if constexpr (PH != ONLY_PHASE) return;
#endif
    unsigned long long t0 = 0;
    if constexpr (PH == PROBE_PHASE) t0 = __builtin_amdgcn_s_memrealtime();
    run_phase<PH>(p, lds);
    if constexpr (PH + 1 < NPHASE) { if constexpr (PH == 0) grid.sync(); else xcd_barrier(xb); }
    if constexpr (PH == PROBE_PHASE) tp = __builtin_amdgcn_s_memrealtime() - t0;
}

__global__ void __launch_bounds__(512, 2) mega_kernel(Params p) {
    extern __shared__ __attribute__((aligned(16))) unsigned char shm[];
    LAS unsigned char* lds = (LAS unsigned char*)shm;
    cg::grid_group grid = cg::this_grid();
    volatile LAS unsigned* xst = (volatile LAS unsigned*)(lds + LDS_BYTES - 16);
    if (threadIdx.x == 0) { xst[0] = 0u; xst[1] = 0u; }
    __syncthreads();
    const XcdBarrier xb = xcd_barrier_post((unsigned*)(p.ws + OFF_SMALL + SM_BAR), xst);
    unsigned long long tp = 0;
    phase_step<0>(p, lds, grid, xb, tp); phase_step<1>(p, lds, grid, xb, tp); phase_step<2>(p, lds, grid, xb, tp); phase_step<3>(p, lds, grid, xb, tp);
    phase_step<4>(p, lds, grid, xb, tp); phase_step<5>(p, lds, grid, xb, tp); phase_step<6>(p, lds, grid, xb, tp); phase_step<7>(p, lds, grid, xb, tp);
    phase_step<8>(p, lds, grid, xb, tp); phase_step<9>(p, lds, grid, xb, tp); phase_step<10>(p, lds, grid, xb, tp); phase_step<11>(p, lds, grid, xb, tp);
#if PROBE_PHASE >= 0
    if (blockIdx.x == 0) { const unsigned long long te = __builtin_amdgcn_s_memrealtime(); while (__builtin_amdgcn_s_memrealtime() - te < (unsigned long long)PROBE_MULT * tp) __builtin_amdgcn_s_sleep(8); }
#endif
}

extern "C" void kernel_launch(void* const* d_in, const int* in_sizes, int n_in, void* d_out, int out_size, void* d_ws, size_t ws_size, hipStream_t stream) {
    (void)in_sizes; (void)n_in; (void)out_size;
    static int grid_blocks = 0;
    if (!grid_blocks) {
        int dev = 0, cus = 0, per_cu = 0;
        hipGetDevice(&dev);
        hipDeviceGetAttribute(&cus, hipDeviceAttributeMultiprocessorCount, dev);
        hipFuncSetAttribute((const void*)mega_kernel, hipFuncAttributeMaxDynamicSharedMemorySize, LDS_BYTES);
        hipOccupancyMaxActiveBlocksPerMultiprocessor(&per_cu, mega_kernel, 512, LDS_BYTES);
        if (per_cu > 1) per_cu = 1;
        grid_blocks = cus * per_cu;
        if (grid_blocks <= 0) { fprintf(stderr, "occupancy query failed\n"); grid_blocks = 0; return; }
    }
    if (ws_size < WS_NEED) { fprintf(stderr, "workspace too small: %zu < %zu\n", ws_size, (size_t)WS_NEED); return; }
    Params p{};
    p.x = (const float*)d_in[0]; p.positions = (const int*)d_in[1]; p.norm_mix = (const float*)d_in[2]; p.w_in = (const float*)d_in[3]; p.b_gates = (const float*)d_in[4];
    p.conv_w = (const float*)d_in[5]; p.a_log = (const float*)d_in[6]; p.dt_bias = (const float*)d_in[7]; p.dn_norm_w = (const float*)d_in[8]; p.idx_k_norm = (const float*)d_in[9];
    p.w_proj_dn = (const float*)d_in[10]; p.w_proj_att = (const float*)d_in[11]; p.w_out = (const float*)d_in[12]; p.norm_ffn = (const float*)d_in[13]; p.w_group = (const float*)d_in[14];
    p.b_group = (const float*)d_in[15]; p.w_router = (const float*)d_in[16]; p.b_router = (const float*)d_in[17]; p.w_exp_gate = (const float*)d_in[18]; p.w_exp_up = (const float*)d_in[19];
    p.w_exp_down = (const float*)d_in[20]; p.norm_final = (const float*)d_in[21]; p.out = (float*)d_out; p.ws = (unsigned char*)d_ws;
    (void)hipMemsetAsync((unsigned char*)d_ws + OFF_SMALL + SM_BAR, 0, XCD_BAR_WORDS * 4, stream);
    void* args[] = {&p};
    hipError_t e = hipLaunchCooperativeKernel((const void*)mega_kernel, dim3(grid_blocks), dim3(512), args, LDS_BYTES, stream);
    if (e != hipSuccess) fprintf(stderr, "cooperative launch failed: %s (grid %d)\n", hipGetErrorString(e), grid_blocks);
}
```

```cpp
#include <hip/hip_runtime.h>
#include <hip/hip_cooperative_groups.h>
#include <cstdio>
#include <cstdint>
namespace cg = cooperative_groups;

#define LAS __attribute__((address_space(3)))
typedef unsigned short bf16_t;
typedef short bf16x8 __attribute__((ext_vector_type(8)));
typedef float f32x4 __attribute__((ext_vector_type(4)));
typedef float f32x2 __attribute__((ext_vector_type(2)));
typedef unsigned u32x4 __attribute__((ext_vector_type(4)));
typedef unsigned u32x2 __attribute__((ext_vector_type(2)));

#ifndef PROBE_PHASE
#define PROBE_PHASE -1
#endif
#define PROBE_MULT 8
#ifndef SINGLE_LAUNCH
#define SINGLE_LAUNCH 1
#endif

constexpr int T_ = 16384, D_ = 2048, IN_COLS = 11864, LDP = 12032;
constexpr int C_DNQ = 0, C_DNK = 1024, C_DNV = 2048, C_Z = 3072, C_AQ = 4096, C_AK = 5120, C_AV = 6144, C_IQ = 7168,
              C_G0 = 7680, C_G1 = 9728, C_IK = 11776, C_B = 11840, C_A = 11848, C_IW = 11856;
constexpr int NITEM = 2048;
constexpr int PMAX = 40960;
constexpr float EPS = 1e-6f;
constexpr int LDS_BYTES = 156 * 1024;
constexpr int NPHASE = 12;

constexpr size_t MB = 1ull << 20;
constexpr size_t OFF_WT_IN  = 0;
constexpr size_t OFF_WT_DN  = 50 * MB;
constexpr size_t OFF_WT_AT  = 55 * MB;
constexpr size_t OFF_WT_OUT = 60 * MB;
constexpr size_t OFF_COS    = 54 * MB;
constexpr size_t OFF_SIN    = 59 * MB;
constexpr size_t OFF_WR     = 68 * MB;
constexpr size_t OFF_SMALL  = 69 * MB;
constexpr size_t OFF_H      = 72 * MB;
constexpr size_t OFF_PROJ   = 136 * MB;
constexpr size_t OFF_DNP    = 512 * MB;
constexpr size_t OFF_SCAN   = 656 * MB;
constexpr size_t OFF_Y      = 752 * MB;
constexpr size_t OFF_X1     = 816 * MB;
constexpr size_t WS_NEED    = 944 * MB;
constexpr size_t OFF_MASK   = 816 * MB;
constexpr size_t OFF_ROWTOK = 520 * MB;
constexpr size_t OFF_YE     = 528 * MB;
constexpr size_t OFF_ACT    = 712 * MB;
constexpr size_t SM_KIDX   = 0;
constexpr size_t SM_WQ     = 2 * MB;
constexpr size_t SM_ROUTE  = 2 * MB + 512 * 1024;
constexpr size_t SM_GLAST  = 2 * MB + 960 * 1024;
constexpr size_t SM_CTRL   = 2 * MB + 1000 * 1024;
constexpr size_t SM_BAR    = 2 * MB + 1008 * 1024;
constexpr size_t DNP_W = 0, DNP_UT = 32 * MB, DNP_QD = 64 * MB, DNP_KDT = 96 * MB, DNP_ATT = 128 * MB;

struct Params {
    const float* x; const int* positions; const float* norm_mix; const float* w_in; const float* b_gates; const float* conv_w;
    const float* a_log; const float* dt_bias; const float* dn_norm_w; const float* idx_k_norm; const float* w_proj_dn;
    const float* w_proj_att; const float* w_out; const float* norm_ffn; const float* w_group; const float* b_group;
    const float* w_router; const float* b_router; const float* w_exp_gate; const float* w_exp_up; const float* w_exp_down;
    const float* norm_final; float* out; unsigned char* ws;
};

#define LBAR() do { asm volatile("s_waitcnt lgkmcnt(0)" ::: "memory"); __builtin_amdgcn_s_barrier(); asm volatile("" ::: "memory"); } while (0)
__device__ __forceinline__ int tid_() { int t = threadIdx.x; asm volatile("" : "+v"(t)); return t; }
__device__ __forceinline__ unsigned char* opq(unsigned char* q) { unsigned long long z = 0ull; asm volatile("" : "+s"(z)); return q + z; }
typedef __bf16 hwbf2_t __attribute__((ext_vector_type(2)));
__device__ __forceinline__ bf16_t f2bf(float f) { const __bf16 b = (__bf16)f; return __builtin_bit_cast(bf16_t, b); }
__device__ __forceinline__ float bf2f(bf16_t b) { return __uint_as_float(((unsigned)b) << 16); }
__device__ __forceinline__ unsigned pack2(float lo, float hi) { const f32x2 v = {lo, hi}; const hwbf2_t b = __builtin_convertvector(v, hwbf2_t); return __builtin_bit_cast(unsigned, b); }
__device__ __forceinline__ float bflo(unsigned w) { return __uint_as_float(w << 16); }
__device__ __forceinline__ float bfhi(unsigned w) { return __uint_as_float(w & 0xffff0000u); }
__device__ __forceinline__ float sigmoidf_(float x) { return __builtin_amdgcn_rcpf(1.0f + __expf(-x)); }
__device__ __forceinline__ float siluf_(float x) { return x * __builtin_amdgcn_rcpf(1.0f + __expf(-x)); }
template <int CTRL> __device__ __forceinline__ float dpp_f(float v) { return __int_as_float(__builtin_amdgcn_update_dpp(0, __float_as_int(v), CTRL, 0xf, 0xf, true)); }
__device__ __forceinline__ float sum16(float v) {
    v += dpp_f<0xB1>(v); v += dpp_f<0x4E>(v); v += dpp_f<0x141>(v); v += dpp_f<0x140>(v); return v;
}
__device__ __forceinline__ int lane_() { return tid_() & 63; }
__device__ __forceinline__ int bperm_i(int srclane, int v) { return __builtin_amdgcn_ds_bpermute(srclane << 2, v); }
__device__ __forceinline__ float shfl_xor_(float v, int o) { return __int_as_float(bperm_i(lane_() ^ o, __float_as_int(v))); }
__device__ __forceinline__ int shfl_xor_(int v, int o) { return bperm_i(lane_() ^ o, v); }
__device__ __forceinline__ float shfl_(float v, int src) { return __int_as_float(bperm_i(src, __float_as_int(v))); }
__device__ __forceinline__ int shfl_(int v, int src) { return bperm_i(src, v); }
__device__ __forceinline__ float shfl_up_(float v, int o) { return __int_as_float(bperm_i((lane_() - o) & 63, __float_as_int(v))); }
__device__ __forceinline__ int shfl_up_(int v, int o) { return bperm_i((lane_() - o) & 63, v); }
__device__ __forceinline__ float wave_sum(float v) { for (int o = 32; o >= 1; o >>= 1) v += shfl_xor_(v, o); return v; }

#define XB_TMO      128
#define XB_XCNT(j)  (256  + 64 * (j))
#define XB_XSUB(j)  (1280 + 64 * (j))
#define XB_XGEN(j)  (2304 + 64 * (j))
#define XB_TOP      3328
#define XB_TOPGEN   3392
#define XCD_BAR_WORDS 3456
#define XB_SPIN_CAP (1u << 18)

__device__ __forceinline__ unsigned xb_ld(unsigned* p)              { return __hip_atomic_load(p, __ATOMIC_RELAXED, __HIP_MEMORY_SCOPE_AGENT); }
__device__ __forceinline__ unsigned xb_add(unsigned* p, unsigned v) { return __hip_atomic_fetch_add(p, v, __ATOMIC_RELAXED, __HIP_MEMORY_SCOPE_AGENT); }
__device__ __forceinline__ unsigned xb_xcc_id() { return (unsigned)__builtin_amdgcn_s_getreg((3 << 11) | 20) & 0xFu; }
#define XB_SPIN(cond, bar) do { unsigned _sp = 0; while (cond) { __builtin_amdgcn_s_sleep(1); \
    if ((++_sp & 255u) == 0u) { if (xb_ld(&(bar)[XB_TMO])) break; if (_sp > XB_SPIN_CAP) { atomicAdd(&(bar)[XB_TMO], 1u); break; } } } } while (0)

struct XcdBarrier {
    unsigned* bar; unsigned x;
    volatile LAS unsigned* st;
};

__device__ __forceinline__ XcdBarrier xcd_barrier_post(unsigned* bar, volatile LAS unsigned* st) {
    XcdBarrier b; b.bar = bar; b.x = xb_xcc_id(); b.st = st;
    if (threadIdx.x == 0) (void)xb_add(&bar[XB_XCNT(b.x)], 1u);
    return b;
}
__device__ __forceinline__ void xcd_barrier_complete(unsigned* bar, unsigned x, unsigned& nloc, unsigned& nx) {
    const unsigned G = gridDim.x * gridDim.y * gridDim.z;
    unsigned sum, cnt, mine, sp = 0u;
    for (;;) {
        sum = 0u; cnt = 0u; mine = 0u;
#pragma unroll
        for (unsigned j = 0; j < 16; ++j) { const unsigned c = xb_ld(&bar[XB_XCNT(j)]); sum += c; cnt += (c > 0u) ? 1u : 0u; mine = (j == x) ? c : mine; }
        if (sum == G) break;
        __builtin_amdgcn_s_sleep(1);
        if ((++sp & 255u) == 0u) { if (xb_ld(&bar[XB_TMO])) break; if (sp > XB_SPIN_CAP) { atomicAdd(&bar[XB_TMO], 1u); break; } }
    }
    nloc = mine > 0u ? mine : 1u; nx = cnt > 0u ? cnt : 1u;
}

__device__ __forceinline__ void xcd_barrier(const XcdBarrier& b) {
    asm volatile("s_waitcnt vmcnt(0)" ::: "memory");
    __syncthreads();
    if (threadIdx.x == 0) {
        unsigned* bar = b.bar;
        __builtin_amdgcn_s_waitcnt(0);
        unsigned nloc = b.st[0], nx = b.st[1];
        if (nloc == 0u) { xcd_barrier_complete(bar, b.x, nloc, nx); b.st[0] = nloc; b.st[1] = nx; }
        const unsigned old = xb_add(&bar[XB_XSUB(b.x)], 1u);
        const unsigned gen = old / nloc;
        if (old + 1u == (gen + 1u) * nloc) {
            __builtin_amdgcn_fence(__ATOMIC_RELEASE, "agent");
            asm volatile("s_waitcnt vmcnt(0)" ::: "memory");
            const unsigned og = xb_add(&bar[XB_TOP], 1u);
            const unsigned tg = og / nx;
            if (og + 1u == (tg + 1u) * nx) xb_add(&bar[XB_TOPGEN], 1u);
            else XB_SPIN(xb_ld(&bar[XB_TOPGEN]) == tg, bar);
            __builtin_amdgcn_fence(__ATOMIC_ACQUIRE, "agent");
            xb_add(&bar[XB_XGEN(b.x)], 1u);
            asm volatile("s_waitcnt vmcnt(0)" ::: "memory");
        } else {
            XB_SPIN(xb_ld(&bar[XB_XGEN(b.x)]) == gen, bar);
            __builtin_amdgcn_fence(__ATOMIC_ACQUIRE, "agent");
            asm volatile("s_waitcnt vmcnt(0)" ::: "memory");
        }
    }
    __syncthreads();
}

namespace pg8 {
constexpr int BM = 256, BK = 64, HALF = 128, HTB = HALF * BK * 2, STAGE_BYTES = 8 * HTB, NXCD = 8, WGM = 8;
__device__ __forceinline__ int lds_byte(int r, int c) { const int st = (r >> 4) * 2 + (c >> 5), rr = r & 15, cc = c & 31, ob = rr * 64 + cc * 2; return st * 1024 + (ob ^ (((ob >> 9) & 1) << 5)); }
__device__ __forceinline__ void stage_rc(int b, int& R, int& C) { const int st = b / 1024, sb = b % 1024, swz = sb ^ (((sb >> 9) & 1) << 5); R = (st >> 1) * 16 + swz / 64; C = (st & 1) * 32 + (swz % 64) / 2; }
__device__ __forceinline__ int perm32(int rho) { const int n = rho >> 4, i = rho & 15; return 8 * (i >> 2) + 4 * n + (i & 3); }

struct Unit { int pm, pn; const char* A; const char* B; };

struct DenseOrder {
    int nM, nN, nwg, G, c, K; const char* A; const char* Bt;
    __device__ void init(const void* A_, const void* Bt_, int M, int N, int K_, int G_, int c_) { A = (const char*)A_; Bt = (const char*)Bt_; nM = M / BM; nN = N / BM; nwg = nM * nN; G = G_; c = c_; K = K_; }
    __device__ bool next(int i, Unit& u) const {
        const long L = (long)i * G + c; if (L >= nwg) return false;
        int wgid = (int)L; { const int q = nwg / NXCD, r = nwg % NXCD, xcd = wgid % NXCD, off = wgid / NXCD; wgid = (xcd < r ? xcd * (q + 1) : r * (q + 1) + (xcd - r) * q) + off; }
        const int nig = WGM * nN, gid = wgid / nig, fm = gid * WGM, gsz = (nM - fm) < WGM ? (nM - fm) : WGM;
        u.pm = fm + ((wgid % nig) % gsz); u.pn = (wgid % nig) / gsz;
        u.A = A + (size_t)u.pm * 256 * K * 2; u.B = Bt + (size_t)u.pn * 256 * K * 2; return true;
    }
};
template <class Epi, class Sched>
__device__ __forceinline__ void gemm_phase(LAS unsigned char* lds, const int K, const Sched& S, const Epi& E) {
    const int tid = tid_(), wid = __builtin_amdgcn_readfirstlane(tid >> 6), lane = tid & 63, wr = wid >> 2, wc = wid & 3, fr = lane & 15, fq = lane >> 4;
    const int nt = K / BK;
    unsigned voffA[2], voffB[2];
#pragma unroll
    for (int i = 0; i < 2; ++i) { int R, C; stage_rc(tid * 16 + i * 8192, R, C); const int Rb = Epi::PERM ? ((R & ~31) + perm32(R & 31)) : R;
        voffA[i] = (unsigned)(R * K + C) * 2u; voffB[i] = (unsigned)(Rb * K + C) * 2u; }
    const size_t kstep = (size_t)(BK * 2);
    const size_t hstep = (size_t)HALF * K * 2;
    const unsigned ldsw = (unsigned)wid * 1024u;
    const int aoff = lds_byte(wr * 64 + fr, fq * 8), boff = lds_byte(wc * 32 + fr, fq * 8);
#define PG8_SA(b, h) (((b) * 2 + (h)) * HTB)
#define PG8_SB(b, h) ((4 + (b) * 2 + (h)) * HTB)
#define PG8_STAGE(bufoff, gbase, voff) do { _Pragma("unroll") for (int _i = 0; _i < 2; ++_i) \
        __builtin_amdgcn_global_load_lds((const unsigned*)((const char*)(gbase) + (voff)[_i]), (LAS unsigned*)(lds + (bufoff) + ldsw + _i * 8192), 16, 0, 0); } while (0)
#define PG8_LDA(dst, b, h) do { _Pragma("unroll") for (int m = 0; m < 4; ++m) _Pragma("unroll") for (int k = 0; k < 2; ++k) dst[m][k] = *(const LAS bf16x8*)(lds + PG8_SA(b, h) + aoff + m * 2048 + k * 1024); } while (0)
#define PG8_LDB(dst, b, h) do { _Pragma("unroll") for (int n = 0; n < 2; ++n) _Pragma("unroll") for (int k = 0; k < 2; ++k) dst[n][k] = *(const LAS bf16x8*)(lds + PG8_SB(b, h) + boff + n * 2048 + k * 1024); } while (0)
#define PG8_MMA(ai, bj, At, Bt) do { __builtin_amdgcn_s_setprio(1); _Pragma("unroll") for (int m = 0; m < 4; ++m) _Pragma("unroll") for (int n = 0; n < 2; ++n) _Pragma("unroll") for (int k = 0; k < 2; ++k) \
        acc[ai][bj][m][n] = __builtin_amdgcn_mfma_f32_16x16x32_bf16(Bt[n][k], At[m][k], acc[ai][bj][m][n], 0, 0, 0); __builtin_amdgcn_s_setprio(0); } while (0)
#define PG8_WAIT_V(n) asm volatile("s_waitcnt vmcnt(" #n ")" ::: "memory")
#define PG8_WAIT_L(n) asm volatile("s_waitcnt lgkmcnt(" #n ")" ::: "memory")
#define PG8_BAR __builtin_amdgcn_s_barrier()
#define PG8_SCHED __builtin_amdgcn_sched_barrier(0)
    Unit cur, nxt; int ui = 0;
    if (!S.next(0, cur)) return;
    f32x4 acc[2][2][4][2];
#pragma unroll
    for (int a = 0; a < 2; ++a)
#pragma unroll
        for (int b = 0; b < 2; ++b)
#pragma unroll
            for (int m = 0; m < 4; ++m)
#pragma unroll
                for (int n = 0; n < 2; ++n) acc[a][b][m][n] = (f32x4){0.f, 0.f, 0.f, 0.f};
    bf16x8 At[4][2], B0[2][2], B1[2][2];
    const char* cA = cur.A; const char* cB = cur.B;
    PG8_STAGE(PG8_SB(0, 0), cB, voffB); PG8_STAGE(PG8_SA(0, 0), cA, voffA); PG8_STAGE(PG8_SB(0, 1), cB + hstep, voffB); PG8_STAGE(PG8_SA(0, 1), cA + hstep, voffA);
    if (wr == 1) PG8_BAR;
    PG8_WAIT_V(4); PG8_BAR;
    PG8_STAGE(PG8_SB(1, 0), cB + kstep, voffB); PG8_STAGE(PG8_SA(1, 0), cA + kstep, voffA); PG8_STAGE(PG8_SB(1, 1), cB + hstep + kstep, voffB);
    PG8_WAIT_V(6); PG8_BAR;
    for (;;) {
        const bool has_next = S.next(ui + 1, nxt);
        const char* nA = has_next ? nxt.A : cA; const char* nB = has_next ? nxt.B : cB;
        for (int t = 0; t < nt; t += 2) {
            const bool last = (t == nt - 2);
            const char* a1 = cA + (size_t)(t + 1) * kstep;
            const char* a2 = last ? nA : cA + (size_t)(t + 2) * kstep; const char* b2 = last ? nB : cB + (size_t)(t + 2) * kstep;
            const char* a3 = a2 + kstep; const char* b3 = b2 + kstep;
            PG8_LDB(B0, 0, 0); PG8_SCHED; PG8_LDA(At, 0, 0); PG8_STAGE(PG8_SA(1, 1), a1 + hstep, voffA);
            PG8_WAIT_L(8); PG8_BAR; PG8_WAIT_L(0); PG8_MMA(0, 0, At, B0); PG8_BAR; PG8_SCHED;
            PG8_LDB(B1, 0, 1); PG8_STAGE(PG8_SB(0, 0), b2, voffB);
            PG8_BAR; PG8_WAIT_L(0); PG8_MMA(0, 1, At, B1); PG8_BAR;
            PG8_LDA(At, 0, 1); PG8_STAGE(PG8_SA(0, 0), a2, voffA);
            PG8_BAR; PG8_WAIT_L(0); PG8_MMA(1, 0, At, B0); PG8_BAR; PG8_SCHED;
            PG8_STAGE(PG8_SB(0, 1), b2 + hstep, voffB);
            PG8_WAIT_V(6); PG8_BAR; PG8_MMA(1, 1, At, B1); PG8_BAR;
            PG8_LDB(B0, 1, 0); PG8_SCHED; PG8_LDA(At, 1, 0); PG8_STAGE(PG8_SA(0, 1), a2 + hstep, voffA);
            PG8_WAIT_L(8); PG8_BAR; PG8_WAIT_L(0); PG8_MMA(0, 0, At, B0); PG8_BAR; PG8_SCHED;
            PG8_LDB(B1, 1, 1); PG8_STAGE(PG8_SB(1, 0), b3, voffB);
            PG8_BAR; PG8_WAIT_L(0); PG8_MMA(0, 1, At, B1); PG8_BAR;
            PG8_LDA(At, 1, 1); PG8_STAGE(PG8_SA(1, 0), a3, voffA);
            PG8_BAR; PG8_WAIT_L(0); PG8_MMA(1, 0, At, B0); PG8_BAR; PG8_SCHED;
            PG8_STAGE(PG8_SB(1, 1), b3 + hstep, voffB);
            PG8_WAIT_V(6); PG8_BAR; PG8_MMA(1, 1, At, B1); PG8_BAR;
        }
        E(acc, cur, wr, wc, fr, fq);
        if (!has_next) break;
#pragma unroll
        for (int a = 0; a < 2; ++a)
#pragma unroll
            for (int b = 0; b < 2; ++b)
#pragma unroll
                for (int m = 0; m < 4; ++m)
#pragma unroll
                    for (int n = 0; n < 2; ++n) acc[a][b][m][n] = (f32x4){0.f, 0.f, 0.f, 0.f};
        cur = nxt; cA = nA; cB = nB; ++ui;
    }
    PG8_WAIT_V(0);
    if (wr == 0) PG8_BAR;
    PG8_BAR;
#undef PG8_SA
#undef PG8_SB
#undef PG8_STAGE
#undef PG8_LDA
#undef PG8_LDB
#undef PG8_MMA
#undef PG8_WAIT_V
#undef PG8_WAIT_L
#undef PG8_BAR
#undef PG8_SCHED
}
}
using pg8::Unit;

struct EpiProj {
    static constexpr bool PERM = true; bf16_t* O;
    __device__ __forceinline__ void operator()(const f32x4 (&acc)[2][2][4][2], const Unit& u, int wr, int wc, int fr, int fq) const {
        const int row0 = u.pm * 256 + wr * 64 + fr, col0 = u.pn * 256 + wc * 32 + 8 * fq;
#pragma unroll
        for (int ai = 0; ai < 2; ++ai)
#pragma unroll
            for (int m = 0; m < 4; ++m) { bf16_t* rowp = O + (size_t)(row0 + ai * 128 + m * 16) * LDP + col0;
#pragma unroll
                for (int bj = 0; bj < 2; ++bj) { const f32x4 v0 = acc[ai][bj][m][0], v1 = acc[ai][bj][m][1];
                    u32x4 w; w.x = pack2(v0[0], v0[1]); w.y = pack2(v0[2], v0[3]); w.z = pack2(v1[0], v1[1]); w.w = pack2(v1[2], v1[3]);
                    *(u32x4*)(rowp + bj * 128) = w; } }
    }
};
template <int PASS> struct EpiMerge {
    static constexpr bool PERM = true; bf16_t* M; const bf16_t* proj; const float* bg;
    __device__ __forceinline__ bool operator()(f32x4 (&acc)[2][2][4][2], const Unit& u, int wr, int wc, int fr, int fq) const {
        const int row0 = u.pm * 256 + wr * 64 + fr, col0 = u.pn * 256 + wc * 32 + 8 * fq;
#pragma unroll
        for (int ai = 0; ai < 2; ++ai)
#pragma unroll
            for (int m = 0; m < 4; ++m) { const int row = row0 + ai * 128 + m * 16;
#pragma unroll
                for (int bj = 0; bj < 2; ++bj) { const int col = col0 + bj * 128;
                    const u32x4 gw = *(const u32x4*)(proj + (size_t)row * LDP + (PASS ? C_G1 : C_G0) + col);
                    const f32x4 b0 = *(const f32x4*)(bg + PASS * 2048 + col), b1 = *(const f32x4*)(bg + PASS * 2048 + col + 4);
                    bf16_t* dst = M + (size_t)row * 2048 + col;
                    u32x4 old = {0u, 0u, 0u, 0u}; if (PASS) old = *(const u32x4*)dst;
                    const f32x4 v0 = acc[ai][bj][m][0], v1 = acc[ai][bj][m][1];
                    u32x4 w;
                    w.x = pack2(bflo(old.x) + sigmoidf_(bflo(gw.x) + b0[0]) * v0[0], bfhi(old.x) + sigmoidf_(bfhi(gw.x) + b0[1]) * v0[1]);
                    w.y = pack2(bflo(old.y) + sigmoidf_(bflo(gw.y) + b0[2]) * v0[2], bfhi(old.y) + sigmoidf_(bfhi(gw.y) + b0[3]) * v0[3]);
                    w.z = pack2(bflo(old.z) + sigmoidf_(bflo(gw.z) + b1[0]) * v1[0], bfhi(old.z) + sigmoidf_(bfhi(gw.z) + b1[1]) * v1[1]);
                    w.w = pack2(bflo(old.w) + sigmoidf_(bflo(gw.w) + b1[2]) * v1[2], bfhi(old.w) + sigmoidf_(bfhi(gw.w) + b1[3]) * v1[3]);
                    *(u32x4*)dst = w; }
                asm volatile("" ::: "memory"); }
        return false;
    }
};
struct EpiResid {
    static constexpr bool PERM = true; float* X1; const float* X;
    __device__ __forceinline__ bool operator()(f32x4 (&acc)[2][2][4][2], const Unit& u, int wr, int wc, int fr, int fq) const {
        const int row0 = u.pm * 256 + wr * 64 + fr, col0 = u.pn * 256 + wc * 32 + 8 * fq;
#pragma unroll
        for (int ai = 0; ai < 2; ++ai)
#pragma unroll
            for (int m = 0; m < 4; ++m) { const size_t ro = (size_t)(row0 + ai * 128 + m * 16) * 2048 + col0;
#pragma unroll
                for (int bj = 0; bj < 2; ++bj)
#pragma unroll
                    for (int n = 0; n < 2; ++n) { const size_t o = ro + bj * 128 + n * 4; *(f32x4*)(X1 + o) = *(const f32x4*)(X + o) + acc[ai][bj][m][n]; } }
        return false;
    }
};

namespace att {
constexpr int D = 128, ASTR = LDP, OSTR = 1024, MSTR = T_;
constexpr float SCALE = 0.08838834764831845f, THR = 8.f;
constexpr bool WSKIP = false;
constexpr int NW = 8, QBLK = 32, KVBLK = 64, QB = NW * QBLK;
constexpr int SHM_V = KVBLK * D * 2, SHM_K = KVBLK * D * 2;
constexpr int ATT_LDS = 2 * SHM_V + 2 * SHM_K + NW * 64 * 4;
typedef short s16x4 __attribute__((ext_vector_type(4)));
typedef float f32x16 __attribute__((ext_vector_type(16)));
template <class A, class Bt> struct same_t { static constexpr bool v = false; };
template <class A> struct same_t<A, A> { static constexpr bool v = true; };
#define KSWZ(row, colB) ((row) * 256 + ((colB) ^ (((row) & 7) << 4)))
#define SBAR() __builtin_amdgcn_sched_barrier(0)
__device__ __forceinline__ int v_st(int k, int c) { const int kk = (k & ~0xC) | ((k & 4) << 1) | ((k & 8) >> 1); return ((kk >> 3) * 4 + (c >> 5)) * 512 + ((kk & 7) * 32 + (c & 31)) * 2; }
__device__ __forceinline__ int v_rd_base(int lane) { return ((lane & 3) << 3) | (((lane >> 2) & 3) << 6) | (((lane >> 4) & 1) << 5) | (((lane >> 5) & 1) << 8); }
constexpr int v_rd_off(int d0, int ks, int half) { return d0 * 512 + ks * 4096 + half * 2048; }
__device__ __forceinline__ int crow(int r, int hi) { return (r & 3) + 8 * (r >> 2) + 4 * hi; }
__device__ __forceinline__ unsigned cvtpk(float lo, float hi) {
    unsigned r; asm volatile("v_cvt_pk_bf16_f32 %0, %1, %2" : "=v"(r) : "v"(lo), "v"(hi)); return r;
}
__device__ __forceinline__ bf16x8 pack8(f32x4 a, f32x4 b) {
    u32x4 w = {cvtpk(a[0], a[1]), cvtpk(a[2], a[3]), cvtpk(b[0], b[1]), cvtpk(b[2], b[3])};
    return *reinterpret_cast<bf16x8*>(&w);
}
template <class T> __device__ __forceinline__ bf16x8 load8(const T* p) {
    if constexpr (same_t<T, float>::v) { return pack8(*(const f32x4*)p, *(const f32x4*)(p + 4)); }
    else { return *reinterpret_cast<const bf16x8*>(p); }
}
__device__ __forceinline__ void mask_tile(f32x16& p0, f32x16& p1, int dq, unsigned W) {
    const float NEG = -__builtin_inff();
#pragma unroll
    for (int r = 0; r < 16; ++r) {
        const int c = (r & 3) + 8 * (r >> 2);
        if ((unsigned)(dq - c) >= W) p0[r] = NEG;
        if ((unsigned)(dq - c - 32) >= W) p1[r] = NEG;
    }
}
__device__ __forceinline__ void mask_bits(f32x16& p0, f32x16& p1, unsigned long long mw, int hi) {
    const float NEG = -__builtin_inff(); const unsigned lo = (unsigned)mw >> (4 * hi), hw = (unsigned)(mw >> 32) >> (4 * hi);
#pragma unroll
    for (int r = 0; r < 16; ++r) { const int c = (r & 3) + 8 * (r >> 2);
        if (!((lo >> c) & 1u)) p0[r] = NEG;
        if (!((hw >> c) & 1u)) p1[r] = NEG; }
}
__device__ __forceinline__ void partialSM(f32x16& p0, f32x16& p1, float& m_reg, float& mn, float& alpha) {
    float pmax = p0[0]; for (int r = 1; r < 16; ++r) pmax = fmaxf(pmax, p0[r]); for (int r = 0; r < 16; ++r) pmax = fmaxf(pmax, p1[r]);
    { auto rr = __builtin_amdgcn_permlane32_swap(__float_as_uint(pmax), __float_as_uint(pmax), false, false);
      pmax = fmaxf(__uint_as_float(rr[0]), __uint_as_float(rr[1])); }
    constexpr float C2 = 1.4426950408889634f * SCALE;
    if (__builtin_expect(__all((pmax - m_reg) * SCALE <= THR), 1)) { mn = m_reg; alpha = 1.f; }
    else { mn = fmaxf(m_reg, pmax); alpha = __builtin_amdgcn_exp2f((m_reg - mn) * C2); m_reg = mn; }
    const float mnL = -mn * C2;
    for (int r = 0; r < 16; ++r) p0[r] = fmaf(p0[r], C2, mnL); for (int r = 0; r < 16; ++r) p1[r] = fmaf(p1[r], C2, mnL);
    for (int r = 0; r < 16; ++r) p0[r] = __builtin_amdgcn_exp2f(p0[r]);
}
__device__ __forceinline__ void finishSM(f32x16& p0, f32x16& p1, float alpha, float& l_reg, bf16x8& pa0, bf16x8& pa1, bf16x8& pa2, bf16x8& pa3) {
    for (int r = 0; r < 16; ++r) p1[r] = __builtin_amdgcn_exp2f(p1[r]);
    float ps = 0; for (int r = 0; r < 16; ++r) ps += p0[r]; for (int r = 0; r < 16; ++r) ps += p1[r];
    { auto rr = __builtin_amdgcn_permlane32_swap(__float_as_uint(ps), __float_as_uint(ps), false, false);
      ps = __uint_as_float(rr[0]) + __uint_as_float(rr[1]); }
    l_reg = l_reg * alpha + ps;
#define PK4(P, B_, OUT) do { unsigned a0 = cvtpk(P[B_+0], P[B_+1]), a1 = cvtpk(P[B_+2], P[B_+3]);                          \
        unsigned b0 = cvtpk(P[B_+4], P[B_+5]), b1 = cvtpk(P[B_+6], P[B_+7]);                                             \
        auto r0 = __builtin_amdgcn_permlane32_swap(a0, b0, false, false); auto r1 = __builtin_amdgcn_permlane32_swap(a1, b1, false, false); \
        u32x4 w = {r0[0], r1[0], r0[1], r1[1]}; OUT = *reinterpret_cast<bf16x8*>(&w); } while (0)
    PK4(p0, 0, pa0); PK4(p0, 8, pa1); PK4(p1, 0, pa2); PK4(p1, 8, pa3);
#undef PK4
}
template <int KB, bool SK>
__device__ __forceinline__ void qkt(f32x16& p0, f32x16& p1, const char* K_lds, int r32, int hi, const bf16x8* qr, bool act) {
    if (SK && !act) { const float NEG = -__builtin_inff();
#pragma unroll
        for (int r = 0; r < 16; ++r) { p0[r] = NEG; p1[r] = NEG; } return; }
    p0 = f32x16{}; p1 = f32x16{};
    const char* kb[4];
#pragma unroll
    for (int dd = 0; dd < 4; ++dd) kb[dd] = K_lds + KB * SHM_K + KSWZ(r32, (dd * 16 + hi * 8) * 2);
#pragma unroll
    for (int d0 = 0; d0 < 8; ++d0) { const char* a = kb[d0 & 3] + (d0 >> 2) * 128;
        bf16x8 b0 = *reinterpret_cast<const bf16x8*>(a);
        bf16x8 b1 = *reinterpret_cast<const bf16x8*>(a + 32 * 256);
        p0 = __builtin_amdgcn_mfma_f32_32x32x16_bf16(b0, qr[d0], p0, 0, 0, 0);
        p1 = __builtin_amdgcn_mfma_f32_32x32x16_bf16(b1, qr[d0], p1, 0, 0, 0); }
}
template <int VB, bool SK>
__device__ __forceinline__ void pv_tile(f32x16* o, int vb0, bf16x8 pa0, bf16x8 pa1, bf16x8 pa2, bf16x8 pa3, bool act) {
    if (SK && !act) return;
#define TRRD(dst, off) asm volatile("ds_read_b64_tr_b16 %0, %1 offset:%2" : "=&v"(dst) : "v"(vb0), "i"(off) : "memory")
#define PV_D0(d0) do { s16x4 l0, l1, l2, l3, h0, h1, h2, h3; constexpr int b_ = VB * SHM_V + v_rd_off(d0, 0, 0);     \
        TRRD(l0, b_); TRRD(h0, b_ + 2048); TRRD(l1, b_ + 4096); TRRD(h1, b_ + 6144); TRRD(l2, b_ + 8192); TRRD(h2, b_ + 10240); TRRD(l3, b_ + 12288); TRRD(h3, b_ + 14336); \
        asm volatile("s_waitcnt lgkmcnt(0)" ::: "memory"); SBAR();                 \
        o[d0] = __builtin_amdgcn_mfma_f32_32x32x16_bf16(pa0, (bf16x8){l0[0], l0[1], l0[2], l0[3], h0[0], h0[1], h0[2], h0[3]}, o[d0], 0, 0, 0);   \
        o[d0] = __builtin_amdgcn_mfma_f32_32x32x16_bf16(pa1, (bf16x8){l1[0], l1[1], l1[2], l1[3], h1[0], h1[1], h1[2], h1[3]}, o[d0], 0, 0, 0);   \
        o[d0] = __builtin_amdgcn_mfma_f32_32x32x16_bf16(pa2, (bf16x8){l2[0], l2[1], l2[2], l2[3], h2[0], h2[1], h2[2], h2[3]}, o[d0], 0, 0, 0);   \
        o[d0] = __builtin_amdgcn_mfma_f32_32x32x16_bf16(pa3, (bf16x8){l3[0], l3[1], l3[2], l3[3], h3[0], h3[1], h3[2], h3[3]}, o[d0], 0, 0, 0); } while (0)
    PV_D0(0); PV_D0(1); PV_D0(2); PV_D0(3);
#undef PV_D0
#undef TRRD
}

template <class TIn, class TOut> struct BlockRef { const TIn* Q; const TIn* K; const TIn* V; TOut* O; int P0; const unsigned long long* MK; };
template <class TIn> struct Seam {
    bf16x8 qr[8];
    bf16x8 st_v0, st_v1, st_k0, st_k1; f32x4 sf0, sf1, sf2, sf3;
    f32x4 tq[16];
};
__device__ __forceinline__ int swa_jlo(int P0, int W) { const int lowk = P0 - W + 1; return lowk > 0 ? lowk / KVBLK : 0; }
#define ROW(p, k0, rr) ((p) + (size_t)((k0) + (rr)) * ASTR + sc)
#define VMW() asm volatile("s_waitcnt vmcnt(0)" ::: "memory")
#define VMWN(n) asm volatile("s_waitcnt vmcnt(%0)" :: "i"(n) : "memory")
#define SLOAD_H(Kp, Vp, k0) do { S.st_v0 = load8<TIn>(ROW(Vp, k0, sr)); S.st_v1 = load8<TIn>(ROW(Vp, k0, 32 + sr));              \
                         S.st_k0 = load8<TIn>(ROW(Kp, k0, sr)); S.st_k1 = load8<TIn>(ROW(Kp, k0, 32 + sr)); } while (0)
#define SWRITE_HK(bf) do { *(bf16x8*)(K_lds + (bf) * SHM_K + kws) = S.st_k0; *(bf16x8*)(K_lds + (bf) * SHM_K + kws + 32 * 256) = S.st_k1; } while (0)
#define SWRITE_HV(bf) do { *(bf16x8*)(V_lds + (bf) * SHM_V + vst0) = S.st_v0; *(bf16x8*)(V_lds + (bf) * SHM_V + vst1) = S.st_v1; } while (0)
#define SWRITE_H(bf) do { SWRITE_HV(bf); SWRITE_HK(bf); } while (0)
#define SLOAD_F(p, k0) do { S.sf0 = *(const f32x4*)ROW(p, k0, sr); S.sf1 = *(const f32x4*)(ROW(p, k0, sr) + 4);                \
                            S.sf2 = *(const f32x4*)ROW(p, k0, 32 + sr); S.sf3 = *(const f32x4*)(ROW(p, k0, 32 + sr) + 4); } while (0)
#define SWRITE_KF(bf) do { *(bf16x8*)(K_lds + (bf) * SHM_K + kws) = pack8(S.sf0, S.sf1); *(bf16x8*)(K_lds + (bf) * SHM_K + kws + 32 * 256) = pack8(S.sf2, S.sf3); } while (0)
#define SWRITE_VF(bf) do { *(bf16x8*)(V_lds + (bf) * SHM_V + vst0) = pack8(S.sf0, S.sf1); *(bf16x8*)(V_lds + (bf) * SHM_V + vst1) = pack8(S.sf2, S.sf3); } while (0)
template <class TIn, class TOut>
__device__ __forceinline__ void causal_swa_prime(const BlockRef<TIn, TOut>& cur, int W, char* lds, Seam<TIn>& S) {
    constexpr bool F32 = same_t<TIn, float>::v;
    const int tid = tid_(), wid = __builtin_amdgcn_readfirstlane(tid >> 6), lane = tid & 63, r32 = lane & 31, hi = lane >> 5;
    const int sr = tid >> 4, sc = (tid & 15) * 8, kws = KSWZ(sr, sc * 2); char* K_lds = lds + 2 * SHM_V;
    const int kb0 = swa_jlo(cur.P0, W) * KVBLK;
    for (int d0 = 0; d0 < 8; ++d0) S.qr[d0] = load8<TIn>(cur.Q + (size_t)(wid * QBLK + r32) * ASTR + d0 * 16 + hi * 8);
    if constexpr (F32) { SLOAD_F((const float*)cur.K, kb0); VMW(); SWRITE_KF(0); SBAR(); SLOAD_F((const float*)cur.V, kb0); }
    else { SLOAD_H(cur.K, cur.V, kb0); VMW(); SWRITE_HK(0); }
    __syncthreads();
}
template <class TIn, class TOut>
__device__ __forceinline__ void causal_swa_block(const BlockRef<TIn, TOut>& cur, const BlockRef<TIn, TOut>& nxt, int skv, int W, char* lds, Seam<TIn>& S) {
    constexpr bool F32 = same_t<TIn, float>::v;
    const int tid = tid_(), wid = __builtin_amdgcn_readfirstlane(tid >> 6), lane = tid & 63, r32 = lane & 31, hi = lane >> 5;
    const int j_lo = swa_jlo(cur.P0, W);
    int j_hi = (cur.P0 + QB - 1) / KVBLK + 1; if (j_hi > skv / KVBLK) j_hi = skv / KVBLK;
    const int NT = j_hi - j_lo;
    const int kbn = swa_jlo(nxt.P0, W) * KVBLK;
    const int qlo = cur.P0 + wid * QBLK, qm = qlo + r32 - 4 * hi;
    char* V_lds = lds; char* K_lds = lds + 2 * SHM_V;
    float* ws = (float*)(lds + 2 * SHM_V + 2 * SHM_K) + wid * 64; float* li_l = ws, * al_l = ws + 32;
    float m_reg = -1e30f, l_reg = 0; f32x16 o[4] = {};
    const int sr = tid >> 4, sc = (tid & 15) * 8, vst0 = v_st(sr, sc), vst1 = v_st(32 + sr, sc), kws = KSWZ(sr, sc * 2);
    const int vb0 = (int)(uintptr_t)V_lds + v_rd_base(lane);
    const TIn* Kh = cur.K; const TIn* Vh = cur.V;
#define RESC(a) do { if (__any((a) < 1.f)) { if (hi == 0) al_l[r32] = (a); asm volatile("s_waitcnt lgkmcnt(0)" ::: "memory");              \
                     for (int d_ = 0; d_ < 4; ++d_) for (int r = 0; r < 16; ++r) o[d_][r] *= al_l[crow(r, hi)]; } } while (0)
#define KBASE(t) ((j_lo + (t)) * KVBLK)
#define ACT(t) (KBASE(t) <= qlo + QBLK - 1 && KBASE(t) + KVBLK - 1 >= qlo - W + 1)
#define MASKT(P0_, P1_, t) do { mask_bits(P0_, P1_, mw, hi); } while (0)
#define MLOAD(t) do { mw = cur.MK[(size_t)(j_lo + (t)) * MSTR + wid * QBLK + r32]; } while (0)
    constexpr int NQL = F32 ? 16 : 8;
    constexpr bool SK = WSKIP && !F32;
#define SEAM_K0() do { VMWN(NQL); if constexpr (F32) { SWRITE_KF(0); SBAR(); SLOAD_F((const float*)nxt.V, kbn); } else { SWRITE_HK(0); } SBAR(); } while (0)
    f32x16 pA0, pA1, pB0, pB1; float mnA, mnB, alA, alB; bf16x8 pa0, pa1, pa2, pa3; unsigned long long mw = 0ull;
    if constexpr (F32) { VMW(); SWRITE_VF(0); SBAR(); } else { SWRITE_HV(0); SBAR(); }
    if (NT > 1) { if constexpr (F32) SLOAD_F((const float*)Kh, KBASE(1)); else SLOAD_H(Kh, Vh, KBASE(1)); }
    MLOAD(0); SBAR(); qkt<0, SK>(pA0, pA1, K_lds, r32, hi, S.qr, ACT(0));
    if constexpr (F32) { if (NT > 1) { VMW(); SWRITE_KF(1); SBAR(); SLOAD_F((const float*)Vh, KBASE(1)); } }
    MASKT(pA0, pA1, 0); partialSM(pA0, pA1, m_reg, mnA, alA);
    if (NT > 1) { VMW(); if constexpr (F32) { SWRITE_VF(1); SBAR(); if (NT > 2) SLOAD_F((const float*)Kh, KBASE(2)); } else SWRITE_H(1); }
    __syncthreads();
#define HALF_STEP(PX0, PX1, mnX, alX, PY0, PY1, alY, t, KB, VB, SB) do {                                                      \
        MLOAD(t); SBAR(); qkt<KB, SK>(PX0, PX1, K_lds, r32, hi, S.qr, ACT(t));                                             \
        finishSM(PY0, PY1, alY, l_reg, pa0, pa1, pa2, pa3); SBAR();                                                           \
        if ((t) + 1 < NT) { if constexpr (F32) { VMW(); SWRITE_KF(SB); SBAR(); SLOAD_F((const float*)Vh, KBASE((t) + 1)); }  \
                            else { SLOAD_H(Kh, Vh, KBASE((t) + 1)); } SBAR(); }                                               \
        pv_tile<VB, SK>(o, vb0, pa0, pa1, pa2, pa3, ACT((t) - 1)); MASKT(PX0, PX1, (t)); partialSM(PX0, PX1, m_reg, mnX, alX);                                        \
        __syncthreads();                                                                                                      \
        if ((t) + 1 < NT) { VMW(); if constexpr (F32) { SWRITE_VF(SB); SBAR(); if ((t) + 2 < NT) SLOAD_F((const float*)Kh, KBASE((t) + 2)); } \
                            else { SWRITE_H(SB); } }                                                                          \
        RESC(alX); __syncthreads(); } while (0)
    for (int t = 1; t + 1 < NT; t += 2) {
        HALF_STEP(pB0, pB1, mnB, alB, pA0, pA1, alA, t, 1, 0, 0);
        HALF_STEP(pA0, pA1, mnA, alA, pB0, pB1, alB, t + 1, 0, 1, 1);
    }
    const bool even = (NT & 1) == 0;
    if (even) { MLOAD(NT - 1); SBAR(); qkt<1, SK>(pB0, pB1, K_lds, r32, hi, S.qr, ACT(NT - 1)); SBAR(); }
#define QROW(e) (nxt.Q + (size_t)(wid * QBLK + r32) * ASTR + ((e) >> 1) * 16 + hi * 8 + ((e) & 1) * 4)
    if constexpr (F32) { SLOAD_F((const float*)nxt.K, kbn); SBAR();
#pragma unroll
        for (int e = 0; e < 8; ++e) S.tq[e] = *(const f32x4*)QROW(e); }
    else { SLOAD_H(nxt.K, nxt.V, kbn); SBAR();
#pragma unroll
        for (int d0 = 0; d0 < 8; ++d0) S.qr[d0] = load8<TIn>(nxt.Q + (size_t)(wid * QBLK + r32) * ASTR + d0 * 16 + hi * 8); }
    SBAR();
    finishSM(pA0, pA1, alA, l_reg, pa0, pa1, pa2, pa3); SBAR();
    if constexpr (F32) {
#pragma unroll
        for (int e = 8; e < 16; ++e) S.tq[e] = *(const f32x4*)QROW(e); SBAR(); }
#undef QROW
    pv_tile<0, SK>(o, vb0, pa0, pa1, pa2, pa3, ACT(even ? NT - 2 : NT - 1));
    if (even) { MASKT(pB0, pB1, NT - 1); partialSM(pB0, pB1, m_reg, mnB, alB); __syncthreads(); RESC(alB);
        finishSM(pB0, pB1, alB, l_reg, pa0, pa1, pa2, pa3); SBAR(); pv_tile<1, SK>(o, vb0, pa0, pa1, pa2, pa3, ACT(NT - 1)); }
    SBAR(); SEAM_K0();
    if (hi == 0) li_l[r32] = l_reg; asm volatile("s_waitcnt lgkmcnt(0)" ::: "memory");
    float rli[16];
#pragma unroll
    for (int r = 0; r < 16; ++r) rli[r] = __builtin_amdgcn_rcpf(li_l[crow(r, hi)]);
    TOut* Ow = cur.O + (size_t)(wid * QBLK) * OSTR;
#pragma unroll
    for (int r = 0; r < 16; ++r) { const int orow = crow(r, hi);
#pragma unroll
        for (int d0 = 0; d0 < 4; ++d0) { const float v = o[d0][r] * rli[r];
            if constexpr (same_t<TOut, float>::v) { Ow[(size_t)orow * OSTR + d0 * 32 + r32] = v; }
            else { const float vn = dpp_f<0xB1>(v);
                   if ((r32 & 1) == 0) *(unsigned*)(Ow + (size_t)orow * OSTR + d0 * 32 + r32) = cvtpk(v, vn); } } }
    if constexpr (F32) {
#pragma unroll
        for (int d0 = 0; d0 < 8; ++d0) S.qr[d0] = pack8(S.tq[2 * d0], S.tq[2 * d0 + 1]); }
    __syncthreads();
#undef RESC
#undef KBASE
#undef ACT
#undef MASKT
#undef MLOAD
#undef SEAM_K0
#undef HALF_STEP
}
#undef ROW
#undef VMW
#undef VMWN
#undef SLOAD_H
#undef SWRITE_HK
#undef SWRITE_HV
#undef SWRITE_H
#undef SLOAD_F
#undef SWRITE_KF
#undef SWRITE_VF
}

template <class Load4, class DstRow>
__device__ __forceinline__ void convert_tiles(LAS float* tile  , bf16_t* dst, int K, int N, Load4 load4, DstRow dstrow, int c, int G, int& tile_counter) {
    const int tid = tid_(), nk = K / 64, total = nk * (N / 256);
    const int kr = tid >> 6, n4 = (tid & 63) * 4;
    int tt = (c - tile_counter % G + G) % G;
    tile_counter += total;
    f32x4 ra[8], rb[8];
    auto issue = [&](int t, f32x4 (&r)[8]) { const int k0 = (t % nk) * 64, n0 = (t / nk) * 256;
#pragma unroll
        for (int i = 0; i < 8; ++i) r[i] = load4(k0 + kr + 8 * i, n0 + n4); };
    auto emit = [&](int t, const f32x4 (&r)[8]) { const int k0 = (t % nk) * 64, n0 = (t / nk) * 256;
        __syncthreads();
#pragma unroll
        for (int i = 0; i < 8; ++i) { LAS float* q = tile + (kr + 8 * i) * 257 + n4; q[0] = r[i][0]; q[1] = r[i][1]; q[2] = r[i][2]; q[3] = r[i][3]; } };
    auto flush = [&](int t) { const int k0 = (t % nk) * 64, n0 = (t / nk) * 256;
        __syncthreads();
        const int kc = tid & 7;
#pragma unroll
        for (int i = 0; i < 4; ++i) { const int nl = (tid >> 3) + 64 * i; float v[8];
#pragma unroll
            for (int j = 0; j < 8; ++j) v[j] = tile[(kc * 8 + j) * 257 + nl];
            u32x4 w; w.x = pack2(v[0], v[1]); w.y = pack2(v[2], v[3]); w.z = pack2(v[4], v[5]); w.w = pack2(v[6], v[7]);
            *(u32x4*)(dst + (size_t)dstrow(n0 + nl) * K + k0 + kc * 8) = w; } };
    if (tt < total) issue(tt, ra);
    if (tt + G < total) issue(tt + G, rb);
#pragma unroll 1
    while (tt < total) {
        emit(tt, ra);
        if (tt + 2 * G < total) issue(tt + 2 * G, ra);
        __builtin_amdgcn_sched_barrier(0);
        flush(tt);
        __builtin_amdgcn_sched_barrier(0);
        tt += G; if (tt >= total) break;
        emit(tt, rb);
        if (tt + 2 * G < total) issue(tt + 2 * G, rb);
        __builtin_amdgcn_sched_barrier(0);
        flush(tt);
        __builtin_amdgcn_sched_barrier(0);
        tt += G; }
}

__device__ __forceinline__ int in_col_map(int n) {
    if (n < 4096) return n;
    if (n < 7680) return n + 16;
    if (n < 11776) return n + 88;
    if (n < 11840) return 7696 + (n - 11776);
    if (n < 11848) return 4096 + (n - 11840);
    if (n < 11856) return 4104 + (n - 11848);
    if (n < 11864) return 7760 + (n - 11856);
    return -1;
}

__device__ __forceinline__ void phase0(const Params& p, LAS unsigned char* lds) {
    const int G = gridDim.x, c = blockIdx.x, tid = tid_();
    unsigned char* ws = opq(p.ws);
    if (c == 0 && tid < 256) ((unsigned*)(ws + OFF_SMALL + SM_CTRL))[tid] = 0u;
    int counter = 0;
    { const float* w = p.w_in;
      convert_tiles((LAS float*)lds, (bf16_t*)(ws + OFF_WT_IN), 2048, LDP, [w](int k, int n) -> f32x4 {
          const float* row = w + (size_t)k * IN_COLS;
          if (n < 11776) { const int o = n < 4096 ? n : (n < 7680 ? n + 16 : n + 88); return *(const f32x4*)(row + o); }
          f32x4 v;
#pragma unroll
          for (int j = 0; j < 4; ++j) { const int o = in_col_map(n + j); v[j] = o < 0 ? 0.f : row[o]; }
          return v; }, [](int n) { return n; }, c, G, counter); }
    { const float* w = p.w_proj_dn; convert_tiles((LAS float*)lds, (bf16_t*)(ws + OFF_WT_DN), 1024, 2048, [w](int k, int n) -> f32x4 { return *(const f32x4*)(w + (size_t)k * 2048 + n); }, [](int n) { return n; }, c, G, counter); }
    { const float* w = p.w_proj_att; convert_tiles((LAS float*)lds, (bf16_t*)(ws + OFF_WT_AT), 1024, 2048, [w](int k, int n) -> f32x4 { return *(const f32x4*)(w + (size_t)k * 2048 + n); }, [](int n) { return n; }, c, G, counter); }
    { const float* w = p.w_out; convert_tiles((LAS float*)lds, (bf16_t*)(ws + OFF_WT_OUT), 2048, 2048, [w](int k, int n) -> f32x4 { return *(const f32x4*)(w + (size_t)k * 2048 + n); }, [](int n) { return n; }, c, G, counter); }
    { bf16_t* wh = (bf16_t*)(ws + OFF_WR); bf16_t* wl = (bf16_t*)(ws + OFF_WR + 512 * 1024);
      for (int i = c * 512 + tid; i < 5 * 64 * 64 * 8; i += G * 512) { const int e = i & 7, ln = (i >> 3) & 63, kk = (i >> 9) & 63, j = i >> 15;
          const int k = 32 * kk + 8 * (ln >> 4) + e, col = 16 * j + (ln & 15);
          const float v = col < 64 ? p.w_router[(size_t)k * 64 + col] : (col < 72 ? p.w_group[(size_t)k * 8 + col - 64] : 0.f);
          const bf16_t hi = f2bf(v); wh[i] = hi; wl[i] = f2bf(v - bf2f(hi)); } }
    { float* ct = (float*)(ws + OFF_COS); float* st = (float*)(ws + OFF_SIN);
      for (int i = c * 512 + tid; i < T_ * 16; i += G * 512) { const int t = i >> 4;
          const float invf = exp2f(-(float)(i & 15) * 1.1832230355827609f);
          const float ang = (float)p.positions[t] * invf;
          double r = (double)ang * 0.15915494309189535; r -= floor(r);
          ct[i] = __builtin_amdgcn_cosf((float)r); st[i] = __builtin_amdgcn_sinf((float)r); } }
    const int wid = __builtin_amdgcn_readfirstlane(tid >> 6), lane = tid & 63; bf16_t* h = (bf16_t*)(ws + OFF_H);
    f32x4 gm[8];
#pragma unroll
    for (int i = 0; i < 8; ++i) gm[i] = *(const f32x4*)(p.norm_mix + i * 256 + 4 * lane);
    f32x4 va[8], vb[8];
    auto issue = [&](int row, f32x4 (&v)[8]) { const float* xr = p.x + (size_t)row * 2048;
#pragma unroll
        for (int i = 0; i < 8; ++i) v[i] = *(const f32x4*)(xr + i * 256 + 4 * lane); };
    auto finish = [&](int row, const f32x4 (&v)[8]) { float ss = 0.f;
#pragma unroll
        for (int i = 0; i < 8; ++i) ss += v[i][0] * v[i][0] + v[i][1] * v[i][1] + v[i][2] * v[i][2] + v[i][3] * v[i][3];
        ss = wave_sum(ss); const float rs = rsqrtf(ss * (1.0f / 2048.0f) + EPS);
#pragma unroll
        for (int i = 0; i < 8; ++i) { u32x2 wv; wv.x = pack2(v[i][0] * rs * gm[i][0], v[i][1] * rs * gm[i][1]); wv.y = pack2(v[i][2] * rs * gm[i][2], v[i][3] * rs * gm[i][3]);
            *(u32x2*)(h + (size_t)row * 2048 + i * 256 + 4 * lane) = wv; } };
    const int step = G * 8; int row = c * 8 + wid;
    if (row < T_) issue(row, va);
#pragma unroll 1
    while (row < T_) {
        const int r1 = row + step, r2 = row + 2 * step;
        if (r1 < T_) issue(r1, vb);
        __builtin_amdgcn_sched_barrier(0);
        finish(row, va);
        __builtin_amdgcn_sched_barrier(0);
        if (r1 >= T_) break;
        if (r2 < T_) issue(r2, va);
        __builtin_amdgcn_sched_barrier(0);
        finish(r1, vb);
        __builtin_amdgcn_sched_barrier(0);
        row = r2; }
}

__device__ __forceinline__ void phase_rope(const Params& p) {
    const int G = gridDim.x, c = blockIdx.x, tid = tid_();
    unsigned char* ws = opq(p.ws); bf16_t* proj = (bf16_t*)(ws + OFF_PROJ); bf16_t* kidx = (bf16_t*)(ws + OFF_SMALL + SM_KIDX); float* wq = (float*)(ws + OFF_SMALL + SM_WQ);
    const float* ct = (const float*)(ws + OFF_COS); const float* st = (const float*)(ws + OFF_SIN);
    const int gtid = c * 512 + tid, gsz = G * 512;
    for (int id = gtid; id < 2 * T_ * 8; id += gsz) { const int tsel = id >= T_ * 8, rem = id - tsel * T_ * 8, t = rem >> 3, hh = rem & 7;
        bf16_t* q = proj + (size_t)t * LDP + (tsel ? C_AK : C_AQ) + hh * 128;
        u32x4 d[4]; f32x4 cv[4], sv[4];
#pragma unroll
        for (int i = 0; i < 4; ++i) { d[i] = *(const u32x4*)(q + 8 * i); cv[i] = *(const f32x4*)(ct + (size_t)t * 16 + 4 * i); sv[i] = *(const f32x4*)(st + (size_t)t * 16 + 4 * i); }
#pragma unroll
        for (int hf = 0; hf < 2; ++hf) { u32x4& a = d[hf]; u32x4& bq = d[hf + 2];
#pragma unroll
            for (int j = 0; j < 4; ++j) { const unsigned wa = a[j], wb = bq[j]; const int i0 = 8 * hf + 2 * j;
                const float c0 = cv[i0 >> 2][i0 & 3], s0 = sv[i0 >> 2][i0 & 3], c1 = cv[(i0 + 1) >> 2][(i0 + 1) & 3], s1 = sv[(i0 + 1) >> 2][(i0 + 1) & 3];
                const float x10 = bflo(wa), x11 = bfhi(wa), x20 = bflo(wb), x21 = bfhi(wb);
                a[j] = pack2(x10 * c0 - x20 * s0, x11 * c1 - x21 * s1); bq[j] = pack2(x20 * c0 + x10 * s0, x21 * c1 + x11 * s1); } }
#pragma unroll
        for (int i = 0; i < 4; ++i) *(u32x4*)(q + 8 * i) = d[i]; }
    for (int id = gtid; id < T_ * 8; id += gsz) { const int t = id >> 3, hh = id & 7;
        bf16_t* q = proj + (size_t)t * LDP + C_IQ + hh * 64;
        u32x4 a = *(const u32x4*)q, bq = *(const u32x4*)(q + 8); f32x4 cv[4], sv[4];
#pragma unroll
        for (int i = 0; i < 4; ++i) { cv[i] = *(const f32x4*)(ct + (size_t)t * 16 + 4 * i); sv[i] = *(const f32x4*)(st + (size_t)t * 16 + 4 * i); }
#pragma unroll
        for (int j = 0; j < 4; ++j) { const unsigned wa = a[j], wb = bq[j];
            const float c0 = cv[j][0], s0 = sv[j][0], c1 = cv[j][2], s1 = sv[j][2];
            const float x10 = bflo(wa), x11 = bfhi(wa), x20 = bflo(wb), x21 = bfhi(wb);
            a[j] = pack2(x10 * c0 - x20 * s0, x11 * c1 - x21 * s1); bq[j] = pack2(x20 * c0 + x10 * s0, x21 * c1 + x11 * s1); }
        *(u32x4*)q = a; *(u32x4*)(q + 8) = bq; }
    for (int t = gtid; t < T_; t += gsz) { const bf16_t* row = proj + (size_t)t * LDP;
        float v[64]; float ss = 0.f;
#pragma unroll
        for (int i = 0; i < 8; ++i) { const u32x4 dd = *(const u32x4*)(row + C_IK + 8 * i);
#pragma unroll
            for (int j = 0; j < 4; ++j) { v[8 * i + 2 * j] = bflo(dd[j]); v[8 * i + 2 * j + 1] = bfhi(dd[j]); ss += v[8 * i + 2 * j] * v[8 * i + 2 * j] + v[8 * i + 2 * j + 1] * v[8 * i + 2 * j + 1]; } }
        const float rs = rsqrtf(ss * (1.0f / 64.0f) + EPS);
#pragma unroll
        for (int d = 0; d < 64; ++d) v[d] = v[d] * rs * p.idx_k_norm[d];
#pragma unroll
        for (int i = 0; i < 8; ++i) { const float cc = ct[(size_t)t * 16 + 2 * i], sn = st[(size_t)t * 16 + 2 * i]; const float x1 = v[i], x2 = v[8 + i]; v[i] = x1 * cc - x2 * sn; v[8 + i] = x2 * cc + x1 * sn; }
#pragma unroll
        for (int ch = 0; ch < 8; ++ch) { const int kk = ch >> 2, fq2 = ch & 3; u32x4 w; w.x = pack2(v[8 * ch], v[8 * ch + 1]); w.y = pack2(v[8 * ch + 2], v[8 * ch + 3]); w.z = pack2(v[8 * ch + 4], v[8 * ch + 5]); w.w = pack2(v[8 * ch + 6], v[8 * ch + 7]);
            *(u32x4*)(kidx + ((size_t)((t >> 4) * 2 + kk) * 64 + fq2 * 16 + (t & 15)) * 8) = w; }
        const u32x4 ww = *(const u32x4*)(row + C_IW); const float sc = 0.044194173824159216f;
        f32x4 w0 = {bflo(ww.x) * sc, bfhi(ww.x) * sc, bflo(ww.y) * sc, bfhi(ww.y) * sc}, w1 = {bflo(ww.z) * sc, bfhi(ww.z) * sc, bflo(ww.w) * sc, bfhi(ww.w) * sc};
        *(f32x4*)(wq + (size_t)t * 8) = w0; *(f32x4*)(wq + (size_t)t * 8 + 4) = w1; }
}

__device__ __forceinline__ bf16x8 ldfrag(const LAS bf16_t* X, int stride, int rt, int ks, int fr, int fq) { return *(const LAS bf16x8*)(X + (16 * rt + fr) * stride + 32 * ks + 8 * fq); }
__device__ __forceinline__ void dn_prep_load(const Params& p, int item, u32x4 (&xr)[3][2][4], float (&ba)[2]) {
    const int tid = tid_(), n = item >> 3, h = item & 7, t0 = n * 64, c = tid & 15, i0 = tid >> 4;
    const bf16_t* proj = (const bf16_t*)(opq(p.ws) + OFF_PROJ);
#pragma unroll
    for (int sel = 0; sel < 3; ++sel) { const int col = sel * 1024 + h * 128 + 8 * c;
#pragma unroll
        for (int rr = 0; rr < 2; ++rr)
#pragma unroll
            for (int j = 0; j < 4; ++j) { const int tt = t0 + i0 + 32 * rr - 3 + j; xr[sel][rr][j] = (u32x4){0u, 0u, 0u, 0u}; if (tt >= 0) xr[sel][rr][j] = *(const u32x4*)(proj + (size_t)tt * LDP + col); } }
    ba[0] = 0.f; ba[1] = 0.f;
    if (tid < 64) { const int t = t0 + tid; ba[0] = bf2f(proj[(size_t)t * LDP + C_B + h]); ba[1] = bf2f(proj[(size_t)t * LDP + C_A + h]); }
}
__device__ __forceinline__ void dn_prep_item(const Params& p, int item, int next_item, LAS unsigned char* lds, u32x4 (&xr)[3][2][4], float (&ba)[2]) {
    const int tid = tid_(), w = tid >> 6, lane = tid & 63, fr = lane & 15, fq = lane >> 4, n = item >> 3, h = item & 7, t0 = n * 64;
    unsigned char* ws = opq(p.ws); const bf16_t* proj = (const bf16_t*)(ws + OFF_PROJ);
    LAS bf16_t* Kr = (LAS bf16_t*)lds; LAS bf16_t* Qr = Kr + 64 * 136; LAS bf16_t* KTs = Qr + 64 * 136; LAS bf16_t* VTs = KTs + 128 * 72;
    LAS bf16_t* Pb = VTs + 128 * 72;
    LAS float* Gs = (LAS float*)(Pb + 6 * 64 * 72); LAS float* bs = Gs + 64; LAS float* eg = bs + 64;
    bf16_t* wb = (bf16_t*)(ws + OFF_DNP + DNP_W) + (size_t)item * 8192; bf16_t* uT = (bf16_t*)(ws + OFF_DNP + DNP_UT) + (size_t)item * 8192;
    bf16_t* qd = (bf16_t*)(ws + OFF_DNP + DNP_QD) + (size_t)item * 8192; bf16_t* kdT = (bf16_t*)(ws + OFF_DNP + DNP_KDT) + (size_t)item * 8192;
    bf16_t* attn = (bf16_t*)(ws + OFF_DNP + DNP_ATT) + (size_t)item * 4096;
    LBAR();
    if (tid < 64) { const float bl = ba[0], al = ba[1] + p.dt_bias[h];
        const float sp = fmaxf(al, 0.f) + log1pf(__expf(-fabsf(al))); float g = -__expf(p.a_log[h]) * sp;
        for (int o = 1; o < 64; o <<= 1) { const float u = shfl_up_(g, o); if (tid >= o) g += u; }
        Gs[tid] = g; bs[tid] = sigmoidf_(bl); eg[tid] = __expf(g);
        if (tid == 63) ((float*)(ws + OFF_SMALL + SM_GLAST))[item] = __expf(g); }
    LBAR();
    { const int c = tid & 15, i0 = tid >> 4;
#pragma unroll
      for (int sel = 0; sel < 3; ++sel) { const int col = sel * 1024 + h * 128 + 8 * c;
          f32x4 wv[4][2];
#pragma unroll
          for (int j = 0; j < 4; ++j) { wv[j][0] = *(const f32x4*)(p.conv_w + j * 3072 + col); wv[j][1] = *(const f32x4*)(p.conv_w + j * 3072 + col + 4); }
#pragma unroll
          for (int rr = 0; rr < 2; ++rr) { const int i = i0 + 32 * rr; float y[8];
#pragma unroll
              for (int e = 0; e < 8; ++e) y[e] = 0.f;
#pragma unroll
              for (int j = 0; j < 4; ++j) { const u32x4 xv = xr[sel][rr][j];
                  y[0] += wv[j][0][0] * bflo(xv.x); y[1] += wv[j][0][1] * bfhi(xv.x); y[2] += wv[j][0][2] * bflo(xv.y); y[3] += wv[j][0][3] * bfhi(xv.y);
                  y[4] += wv[j][1][0] * bflo(xv.z); y[5] += wv[j][1][1] * bfhi(xv.z); y[6] += wv[j][1][2] * bflo(xv.w); y[7] += wv[j][1][3] * bfhi(xv.w); }
              float ss = 0.f;
#pragma unroll
              for (int e = 0; e < 8; ++e) { y[e] = siluf_(y[e]); ss += y[e] * y[e]; }
              const float bi = bs[i], ei = eg[i];
              if (sel < 2) { ss = sum16(ss); const float rn = rsqrtf(ss + EPS) * (sel == 0 ? 0.08838834764831845f : 1.0f);
#pragma unroll
                  for (int e = 0; e < 8; ++e) y[e] *= rn; }
              if (sel == 0) { u32x4 pk; pk.x = pack2(y[0], y[1]); pk.y = pack2(y[2], y[3]); pk.z = pack2(y[4], y[5]); pk.w = pack2(y[6], y[7]);
                  *(LAS u32x4*)(Qr + i * 136 + 8 * c) = pk;
                  u32x4 pd; pd.x = pack2(y[0] * ei, y[1] * ei); pd.y = pack2(y[2] * ei, y[3] * ei); pd.z = pack2(y[4] * ei, y[5] * ei); pd.w = pack2(y[6] * ei, y[7] * ei);
                  *(u32x4*)(qd + i * 128 + 8 * c) = pd; }
              else if (sel == 1) { u32x4 pk; pk.x = pack2(y[0], y[1]); pk.y = pack2(y[2], y[3]); pk.z = pack2(y[4], y[5]); pk.w = pack2(y[6], y[7]);
                  *(LAS u32x4*)(Kr + i * 136 + 8 * c) = pk; const float f = bi * ei;
#pragma unroll
                  for (int e = 0; e < 8; ++e) KTs[(8 * c + e) * 72 + i] = f2bf(y[e] * f); }
              else {
#pragma unroll
                  for (int e = 0; e < 8; ++e) VTs[(8 * c + e) * 72 + i] = f2bf(y[e] * bi); } } } }
    if (next_item >= 0) dn_prep_load(p, next_item, xr, ba);
    LBAR();
    { const float g63 = Gs[63];
#pragma unroll
      for (int rr = 0; rr < 2; ++rr) { const int u = tid + 512 * rr, d = u >> 3, ic = u & 7; float v[8];
#pragma unroll
          for (int e = 0; e < 8; ++e) v[e] = bf2f(Kr[(8 * ic + e) * 136 + d]) * __expf(g63 - Gs[8 * ic + e]);
          u32x4 pk; pk.x = pack2(v[0], v[1]); pk.y = pack2(v[2], v[3]); pk.z = pack2(v[4], v[5]); pk.w = pack2(v[6], v[7]);
          *(u32x4*)(kdT + d * 64 + 8 * ic) = pk; } }
    LAS bf16_t* P0 = Pb; LAS bf16_t* P1 = Pb + 64 * 72; LAS bf16_t* PT0 = Pb + 2 * 64 * 72; LAS bf16_t* PT1 = Pb + 3 * 64 * 72; LAS bf16_t* TT0 = Pb + 4 * 64 * 72; LAS bf16_t* TT1 = Pb + 5 * 64 * 72;
#pragma unroll
    for (int pp = 0; pp < 2; ++pp) { const int pr = 2 * w + pp, it = pr >> 2, jt = pr & 3;
        f32x4 akk = {0.f, 0.f, 0.f, 0.f}, aqk = {0.f, 0.f, 0.f, 0.f};
#pragma unroll
        for (int ks = 0; ks < 4; ++ks) { const bf16x8 ki = ldfrag(Kr, 136, it, ks, fr, fq), kj = ldfrag(Kr, 136, jt, ks, fr, fq), qi = ldfrag(Qr, 136, it, ks, fr, fq);
            akk = __builtin_amdgcn_mfma_f32_16x16x32_bf16(ki, kj, akk, 0, 0, 0);
            aqk = __builtin_amdgcn_mfma_f32_16x16x32_bf16(kj, qi, aqk, 0, 0, 0); }
        { const int j = 16 * jt + fr; const float Gj = Gs[j]; float mv[4];
#pragma unroll
          for (int r = 0; r < 4; ++r) { const int i = 16 * it + 4 * fq + r; mv[r] = j < i ? -bs[i] * akk[r] * __expf(Gs[i] - Gj) : 0.f; P0[i * 72 + j] = f2bf(mv[r]); }
          u32x2 pk; pk.x = pack2(mv[0], mv[1]); pk.y = pack2(mv[2], mv[3]); *(LAS u32x2*)(PT0 + j * 72 + 16 * it + 4 * fq) = pk; }
        { const int i = 16 * it + fr; const float Gi = Gs[i]; float av[4];
#pragma unroll
          for (int r = 0; r < 4; ++r) { const int j = 16 * jt + 4 * fq + r; av[r] = j <= i ? aqk[r] * __expf(Gi - Gs[j]) : 0.f; }
          u32x2 pk; pk.x = pack2(av[0], av[1]); pk.y = pack2(av[2], av[3]); *(u32x2*)(attn + i * 64 + 16 * jt + 4 * fq) = pk; } }
    f32x4 tm[2];
#pragma unroll
    for (int pp = 0; pp < 2; ++pp) { const int pr = 2 * w + pp, it = pr >> 2, jt = pr & 3;
#pragma unroll
        for (int r = 0; r < 4; ++r) tm[pp][r] = (16 * it + 4 * fq + r == 16 * jt + fr) ? 1.f : 0.f;
        u32x2 pk; pk.x = pack2(tm[pp][0], tm[pp][1]); pk.y = pack2(tm[pp][2], tm[pp][3]); *(LAS u32x2*)(TT0 + (16 * jt + fr) * 72 + 16 * it + 4 * fq) = pk; }
    LBAR();
#pragma unroll
    for (int k = 0; k < 6; ++k) {
        const LAS bf16_t* Pc = (k & 1) ? P1 : P0; const LAS bf16_t* PTc = (k & 1) ? PT1 : PT0; const LAS bf16_t* TTc = (k & 1) ? TT1 : TT0;
        LAS bf16_t* Pn = (k & 1) ? P0 : P1; LAS bf16_t* PTn = (k & 1) ? PT0 : PT1; LAS bf16_t* TTn = (k & 1) ? TT0 : TT1;
#pragma unroll
        for (int pp = 0; pp < 2; ++pp) { const int pr = 2 * w + pp, it = pr >> 2, jt = pr & 3;
            f32x4 x = {0.f, 0.f, 0.f, 0.f}, y = {0.f, 0.f, 0.f, 0.f};
#pragma unroll
            for (int ks = 0; ks < 2; ++ks) { const bf16x8 pa = ldfrag(Pc, 72, it, ks, fr, fq);
                x = __builtin_amdgcn_mfma_f32_16x16x32_bf16(pa, ldfrag(TTc, 72, jt, ks, fr, fq), x, 0, 0, 0);
                if (k < 5) y = __builtin_amdgcn_mfma_f32_16x16x32_bf16(pa, ldfrag(PTc, 72, jt, ks, fr, fq), y, 0, 0, 0); }
            tm[pp] += x;
            if (k < 5) { u32x2 pk; pk.x = pack2(tm[pp][0], tm[pp][1]); pk.y = pack2(tm[pp][2], tm[pp][3]); *(LAS u32x2*)(TTn + (16 * jt + fr) * 72 + 16 * it + 4 * fq) = pk;
#pragma unroll
                for (int r = 0; r < 4; ++r) Pn[(16 * it + 4 * fq + r) * 72 + 16 * jt + fr] = f2bf(y[r]);
                u32x2 pq; pq.x = pack2(y[0], y[1]); pq.y = pack2(y[2], y[3]); *(LAS u32x2*)(PTn + (16 * jt + fr) * 72 + 16 * it + 4 * fq) = pq; }
            else {
#pragma unroll
                for (int r = 0; r < 4; ++r) P0[(16 * it + 4 * fq + r) * 72 + 16 * jt + fr] = f2bf(tm[pp][r]); } }
        LBAR();
    }
#pragma unroll
    for (int q4 = 0; q4 < 4; ++q4) { const int tl = 4 * w + q4;
        { const int dt = tl >> 2, it = tl & 3; f32x4 a = {0.f, 0.f, 0.f, 0.f};
#pragma unroll
          for (int ks = 0; ks < 2; ++ks) a = __builtin_amdgcn_mfma_f32_16x16x32_bf16(ldfrag(KTs, 72, dt, ks, fr, fq), ldfrag(P0, 72, it, ks, fr, fq), a, 0, 0, 0);
          u32x2 pk; pk.x = pack2(a[0], a[1]); pk.y = pack2(a[2], a[3]); *(u32x2*)(wb + (16 * it + fr) * 128 + 16 * dt + 4 * fq) = pk; }
        { const int it = tl >> 3, vt = tl & 7; f32x4 a = {0.f, 0.f, 0.f, 0.f};
#pragma unroll
          for (int ks = 0; ks < 2; ++ks) a = __builtin_amdgcn_mfma_f32_16x16x32_bf16(ldfrag(P0, 72, it, ks, fr, fq), ldfrag(VTs, 72, vt, ks, fr, fq), a, 0, 0, 0);
          u32x2 pk; pk.x = pack2(a[0], a[1]); pk.y = pack2(a[2], a[3]); *(u32x2*)(uT + (16 * vt + fr) * 64 + 16 * it + 4 * fq) = pk; } }
}

__device__ __forceinline__ void dn_scan(const Params& p, int b, LAS unsigned char* lds) {
    const int tid = tid_(), w = tid >> 6, lane = tid & 63, fr = lane & 15, fq = lane >> 4, h = b >> 2, e0 = (b & 3) * 32;
    unsigned char* ws = opq(p.ws);
    const bf16_t* wbuf = (const bf16_t*)(ws + OFF_DNP + DNP_W); const bf16_t* uT = (const bf16_t*)(ws + OFF_DNP + DNP_UT); const bf16_t* kdT = (const bf16_t*)(ws + OFF_DNP + DNP_KDT);
    const float* glast = (const float*)(ws + OFF_SMALL + SM_GLAST);
    bf16_t* Sold = (bf16_t*)(ws + OFF_SCAN); bf16_t* vnT = (bf16_t*)(ws + OFF_SCAN + 64 * MB);
    LAS bf16_t* Sb = (LAS bf16_t*)lds;
    LAS bf16_t* Vn = (LAS bf16_t*)(lds + 32 * 136 * 2);
    f32x4 S[2] = {{0.f, 0.f, 0.f, 0.f}, {0.f, 0.f, 0.f, 0.f}};
    __syncthreads();
    bf16x8 kda[2], wfa[4], kdb[2], wfb[4]; u32x2 u4a[2] = {{0u, 0u}, {0u, 0u}}, u4b[2] = {{0u, 0u}, {0u, 0u}}; float gla = 0.f, glb = 0.f;
#define DN_LOAD(KD, WF, U4, GL, n_) do { const int it_ = (n_) * 8 + h;                                                                               \
        _Pragma("unroll") for (int kk = 0; kk < 2; ++kk) KD[kk] = *(const bf16x8*)(kdT + (size_t)it_ * 8192 + (16 * w + fr) * 64 + kk * 32 + 8 * fq); \
        if (w < 4) { _Pragma("unroll") for (int kk = 0; kk < 4; ++kk) WF[kk] = *(const bf16x8*)(wbuf + (size_t)it_ * 8192 + (16 * w + fr) * 128 + kk * 32 + 8 * fq); \
            _Pragma("unroll") for (int sl = 0; sl < 2; ++sl) U4[sl] = *(const u32x2*)(uT + (size_t)it_ * 8192 + (e0 + 16 * sl + fr) * 64 + 16 * w + 4 * fq); } \
        GL = glast[it_]; } while (0)
    auto step = [&](int n, const bf16x8 (&kd)[2], const bf16x8 (&wf)[4], const u32x2 (&u4)[2], float gl) {
        const int item = n * 8 + h;
#pragma unroll
        for (int sl = 0; sl < 2; ++sl) { u32x2 sw; sw.x = pack2(S[sl][0], S[sl][1]); sw.y = pack2(S[sl][2], S[sl][3]);
            *(LAS u32x2*)(Sb + (16 * sl + fr) * 136 + 16 * w + 4 * fq) = sw;
            *(u32x2*)(Sold + (size_t)item * 16384 + (e0 + 16 * sl + fr) * 128 + 16 * w + 4 * fq) = sw; }
        __syncthreads();
        if (w < 4) {
#pragma unroll
            for (int sl = 0; sl < 2; ++sl) { f32x4 va = {0.f, 0.f, 0.f, 0.f};
#pragma unroll
                for (int kk = 0; kk < 4; ++kk) { const bf16x8 bb = *(const LAS bf16x8*)(Sb + (16 * sl + fr) * 136 + kk * 32 + 8 * fq); va = __builtin_amdgcn_mfma_f32_16x16x32_bf16(wf[kk], bb, va, 0, 0, 0); }
                u32x2 vw; vw.x = pack2(bflo(u4[sl].x) - va[0], bfhi(u4[sl].x) - va[1]); vw.y = pack2(bflo(u4[sl].y) - va[2], bfhi(u4[sl].y) - va[3]);
                *(LAS u32x2*)(Vn + (16 * sl + fr) * 72 + 16 * w + 4 * fq) = vw;
                *(u32x2*)(vnT + (size_t)item * 8192 + (e0 + 16 * sl + fr) * 64 + 16 * w + 4 * fq) = vw; } }
        __syncthreads();
#pragma unroll
        for (int sl = 0; sl < 2; ++sl) { S[sl] = S[sl] * gl;
#pragma unroll
            for (int kk = 0; kk < 2; ++kk) { const bf16x8 bb = *(const LAS bf16x8*)(Vn + (16 * sl + fr) * 72 + kk * 32 + 8 * fq); S[sl] = __builtin_amdgcn_mfma_f32_16x16x32_bf16(kd[kk], bb, S[sl], 0, 0, 0); } } };
    DN_LOAD(kda, wfa, u4a, gla, 0);
#pragma unroll 1
    for (int n = 0; n < 256; n += 2) {
        DN_LOAD(kdb, wfb, u4b, glb, n + 1);
        __builtin_amdgcn_sched_barrier(0);
        step(n, kda, wfa, u4a, gla);
        __builtin_amdgcn_sched_barrier(0);
        if (n + 2 < 256) DN_LOAD(kda, wfa, u4a, gla, n + 2);
        __builtin_amdgcn_sched_barrier(0);
        step(n + 1, kdb, wfb, u4b, glb);
        __builtin_amdgcn_sched_barrier(0);
    }
#undef DN_LOAD
}

__device__ __forceinline__ float relu_(float x) { const int i = __float_as_int(x); return __int_as_float(i > 0 ? i : 0); }
__device__ __forceinline__ float unsortable(unsigned u) { return __uint_as_float((u & 0x80000000u) ? (u ^ 0x80000000u) : ~u); }
__device__ __forceinline__ unsigned sortable(float f) { const unsigned u = __float_as_uint(f); return (u & 0x80000000u) ? ~u : (u | 0x80000000u); }

template <bool EXACT>
__device__ __forceinline__ unsigned compact_q(LAS unsigned* kq, LAS unsigned* iq, int n, int lane, int& nkeep) {
    unsigned key[8], idx[8]; bool val[8];
#pragma unroll
    for (int i = 0; i < 8; ++i) { const int e = lane + 64 * i; val[i] = e < n; key[i] = val[i] ? kq[e] : 0u; idx[i] = val[i] ? iq[e] : 0xffffffffu; }
    unsigned th = 0u; int cur = n;
#pragma unroll 1
    for (int b = 31; b >= 0; --b) { const unsigned cand = th | (1u << b); int c = 0;
#pragma unroll
        for (int i = 0; i < 8; ++i) c += __popcll(__ballot(val[i] && key[i] >= cand));
        if (c >= 256) { th = cand; cur = c; if (!EXACT && c <= 288) break; } }
    if (!EXACT) { int base = 0;
#pragma unroll
        for (int i = 0; i < 8; ++i) { const bool keep = val[i] && key[i] >= th; const unsigned long long m = __ballot(keep);
            const int pos = base + __popcll(m & ((1ull << lane) - 1ull)); if (keep) { kq[pos] = key[i]; iq[pos] = idx[i]; } base += __popcll(m); }
        nkeep = cur; return th - 1u; }
    int cgt = 0, ceq = 0;
#pragma unroll
    for (int i = 0; i < 8; ++i) { cgt += __popcll(__ballot(val[i] && key[i] > th)); ceq += __popcll(__ballot(val[i] && key[i] == th)); }
    const int need = 256 - cgt; unsigned beta = 0xffffffffu;
    if (ceq > need) { beta = 0u;
#pragma unroll 1
        for (int b = 14; b >= 0; --b) { const unsigned cand = beta | (1u << b); int c = 0;
#pragma unroll
            for (int i = 0; i < 8; ++i) c += __popcll(__ballot(val[i] && key[i] == th && idx[i] < cand));
            if (c < need) beta = cand; } }
    int base = 0;
#pragma unroll
    for (int i = 0; i < 8; ++i) { const bool keep = val[i] && (key[i] > th || (key[i] == th && idx[i] <= beta)); const unsigned long long m = __ballot(keep);
        const int pos = base + __popcll(m & ((1ull << lane) - 1ull)); if (keep) { kq[pos] = key[i]; iq[pos] = idx[i]; } base += __popcll(m); }
    nkeep = 256; return th;
}

__device__ __forceinline__ unsigned compact_hist(LAS unsigned* kq, LAS unsigned* iq, int n, int lane, int& nkeep, LAS unsigned* hist, unsigned lo) {
    unsigned key[8], idx[8]; bool val[8]; unsigned mx = 0u;
#pragma unroll
    for (int i = 0; i < 8; ++i) { const int e = lane + 64 * i; val[i] = e < n; key[i] = val[i] ? kq[e] : 0u; idx[i] = val[i] ? iq[e] : 0xffffffffu; mx = key[i] > mx ? key[i] : mx; }
#pragma unroll
    for (int o = 32; o >= 1; o >>= 1) { const unsigned t = (unsigned)shfl_xor_((int)mx, o); mx = t > mx ? t : mx; }
    const unsigned range = mx - lo; const int nb = 32 - __clz((int)(range | 1u)); const int sh = nb > 8 ? nb - 8 : 0;
#pragma unroll
    for (int i = 0; i < 4; ++i) hist[lane + 64 * i] = 0u;
#pragma unroll
    for (int i = 0; i < 8; ++i) if (val[i]) { unsigned b = (key[i] - lo) >> sh; b = b < 255u ? b : 255u; __hip_atomic_fetch_add(hist + b, 1u, __ATOMIC_RELAXED, __HIP_MEMORY_SCOPE_WORKGROUP); }
    const u32x4 cb = *(const LAS u32x4*)(hist + 4 * lane);
    int S = (int)(cb.x + cb.y + cb.z + cb.w);
#pragma unroll
    for (int o = 1; o < 64; o <<= 1) { const int t = bperm_i((lane + o) & 63, S); if (lane + o < 64) S += t; }
    const unsigned long long ge = __ballot(S >= 256); const int L = 63 - __clzll((long long)ge);
    int above = bperm_i((L + 1) & 63, S); if (L == 63) above = 0;
    const unsigned c3 = (unsigned)bperm_i(L, (int)cb.w), c2 = (unsigned)bperm_i(L, (int)cb.z), c1 = (unsigned)bperm_i(L, (int)cb.y), c0 = (unsigned)bperm_i(L, (int)cb.x);
    int bsel, cur;
    if (above + (int)c3 >= 256) { bsel = 3; cur = above + (int)c3; } else if (above + (int)(c3 + c2) >= 256) { bsel = 2; cur = above + (int)(c3 + c2); }
    else if (above + (int)(c3 + c2 + c1) >= 256) { bsel = 1; cur = above + (int)(c3 + c2 + c1); } else { bsel = 0; cur = above + (int)(c3 + c2 + c1 + c0); }
    if (cur > 352) return compact_q<false>(kq, iq, n, lane, nkeep);
    const unsigned th = lo + ((unsigned)(4 * L + bsel) << sh);
    int base = 0;
#pragma unroll
    for (int i = 0; i < 8; ++i) { const bool keep = val[i] && key[i] >= th; const unsigned long long m = __ballot(keep);
        const int pos = base + __popcll(m & ((1ull << lane) - 1ull)); if (keep) { kq[pos] = key[i]; iq[pos] = idx[i]; } base += __popcll(m); }
    nkeep = cur; return th - 1u;
}

__device__ __forceinline__ void dsa_block(const Params& p, int qb, LAS unsigned char* lds) {
    const int tid = tid_(), w = tid >> 6, lane = tid & 63, fr = lane & 15, fq = lane >> 4, t0 = qb * 32;
    unsigned char* ws = opq(p.ws); const bf16_t* proj = (const bf16_t*)(ws + OFF_PROJ); const bf16_t* kidx = (const bf16_t*)(ws + OFF_SMALL + SM_KIDX); const float* wq = (const float*)(ws + OFF_SMALL + SM_WQ);
    LAS unsigned* ckey = (LAS unsigned*)lds;
    LAS unsigned* cidx = (LAS unsigned*)(lds + 65536);
    LAS unsigned* cnt = (LAS unsigned*)(lds + 131072);
    __syncthreads();
    bf16x8 af[2][2]; f32x4 wr[2]; int tmy[2];
    const int hb = fq & 1, qoff = (fq >> 1) ? w + 8 : w;
#pragma unroll
    for (int m = 0; m < 2; ++m) { const int tqr = t0 + 16 * m + ((fr >> 3) ? w + 8 : w);
#pragma unroll
        for (int kk = 0; kk < 2; ++kk) af[m][kk] = *(const bf16x8*)(proj + (size_t)tqr * LDP + C_IQ + (fr & 7) * 64 + kk * 32 + 8 * fq);
        tmy[m] = t0 + 16 * m + qoff; wr[m] = *(const f32x4*)(wq + (size_t)tmy[m] * 8 + 4 * hb); }
    const unsigned msk = hb ? 0xffffffffu : 0u, lt = (1u << (lane & 31)) - 1u;
    unsigned tauu[2] = {0u, 0u};
    LAS unsigned* hist = (LAS unsigned*)(lds + 132096 + w * 1024);
    float tauf[2] = {-__builtin_inff(), -__builtin_inff()};
    if (tid < 32) cnt[tid] = 0u;
    __syncthreads();
    const int ntile = (t0 + 31) / 128 + 1;
    bf16x8 bfa[8][2], bfb[8][2]; int cn[2] = {0, 0};
    auto ldtile = [&](int kt, bf16x8 (&bf)[8][2]) {
#pragma unroll
        for (int j = 0; j < 8; ++j)
#pragma unroll
            for (int kk = 0; kk < 2; ++kk) bf[j][kk] = *(const bf16x8*)(kidx + ((size_t)((kt * 8 + j) * 2 + kk) * 64 + lane) * 8); };
    auto process = [&](int kt, const bf16x8 (&bf)[8][2]) {
        const bool lastt = kt == ntile - 1; const int lim = lastt ? 256 : 384;
#pragma unroll
        for (int m = 0; m < 2; ++m) {
            float pt[8];
#pragma unroll
            for (int j = 0; j < 8; ++j) { f32x4 a = {0.f, 0.f, 0.f, 0.f};
                a = __builtin_amdgcn_mfma_f32_16x16x32_bf16(af[m][0], bf[j][0], a, 0, 0, 0); a = __builtin_amdgcn_mfma_f32_16x16x32_bf16(af[m][1], bf[j][1], a, 0, 0, 0);
                pt[j] = wr[m][0] * relu_(a[0]) + wr[m][1] * relu_(a[1]) + wr[m][2] * relu_(a[2]) + wr[m][3] * relu_(a[3]); }
            const int myq = 16 * m + qoff; LAS unsigned* kq = ckey + myq * 512; LAS unsigned* iq = cidx + myq * 512; bool anyapp = false;
#pragma unroll
            for (int i = 0; i < 4; ++i) {
                const auto sw = __builtin_amdgcn_permlane16_swap(__float_as_uint(pt[i]), __float_as_uint(pt[4 + i]), false, false);
                const float v = __uint_as_float(sw[0]) + __uint_as_float(sw[1]);
                const int s = kt * 128 + 16 * (4 * hb + i) + fr;
                const bool app = s <= tmy[m] && v > tauf[m];
                const unsigned long long bm = __ballot(app);
                if (bm) {
                    const unsigned half = lane < 32 ? (unsigned)bm : (unsigned)(bm >> 32); anyapp = true;
                    if (app) { const unsigned pos = (unsigned)cn[m] + (unsigned)__popc(half & lt);
                        if (pos < 512u) { kq[pos] = sortable(v); iq[pos] = (unsigned)s; } }
                    cn[m] += __popc(half); } }
            if (!anyapp && !lastt) continue;
            const int c0 = __builtin_amdgcn_readlane(cn[m], 0), c1 = __builtin_amdgcn_readlane(cn[m], 32);
            if (c0 > lim) { int nk; const int n0 = c0 < 512 ? c0 : 512; const unsigned lo0 = (unsigned)__builtin_amdgcn_readlane((int)tauu[m], 0);
                const unsigned th = lastt ? compact_q<true>(ckey + (16 * m + w) * 512, cidx + (16 * m + w) * 512, n0, lane, nk) : compact_hist(ckey + (16 * m + w) * 512, cidx + (16 * m + w) * 512, n0, lane, nk, hist, lo0);
                if (lane < 32) { cn[m] = nk; tauf[m] = unsortable(th); tauu[m] = th; } }
            if (c1 > lim) { int nk; const int n1 = c1 < 512 ? c1 : 512; const unsigned lo1 = (unsigned)__builtin_amdgcn_readlane((int)tauu[m], 32);
                const unsigned th = lastt ? compact_q<true>(ckey + (16 * m + w + 8) * 512, cidx + (16 * m + w + 8) * 512, n1, lane, nk) : compact_hist(ckey + (16 * m + w + 8) * 512, cidx + (16 * m + w + 8) * 512, n1, lane, nk, hist, lo1);
                if (lane >= 32) { cn[m] = nk; tauf[m] = unsortable(th); tauu[m] = th; } }
        }
    };
    ldtile(0, bfa);
#pragma unroll 1
    for (int kt = 0; kt < ntile; kt += 2) {
        if (kt + 1 < ntile) ldtile(kt + 1, bfb);
        __builtin_amdgcn_sched_barrier(0);
        process(kt, bfa);
        __builtin_amdgcn_sched_barrier(0);
        if (kt + 1 >= ntile) break;
        if (kt + 2 < ntile) ldtile(kt + 2, bfa);
        __builtin_amdgcn_sched_barrier(0);
        process(kt + 1, bfb);
        __builtin_amdgcn_sched_barrier(0);
    }
#pragma unroll
    for (int m = 0; m < 2; ++m) if ((lane & 31) == 0) cnt[16 * m + qoff] = (unsigned)cn[m];
    __syncthreads();
    LAS unsigned* mk = ckey;
    for (int i = tid; i < 32 * 512; i += 512) mk[i] = 0u;
    __syncthreads();
#pragma unroll 1
    for (int rep = 0; rep < 4; ++rep) { const int q = w + 8 * rep; const int n = min((int)cnt[q], 256);
        for (int e = lane; e < n; e += 64) { const unsigned s = cidx[q * 512 + e]; __hip_atomic_fetch_or(mk + q * 512 + (s >> 5), 1u << (s & 31u), __ATOMIC_RELAXED, __HIP_MEMORY_SCOPE_WORKGROUP); } }
    __syncthreads();
    unsigned long long* mg = (unsigned long long*)(ws + OFF_MASK);
    const int nkt = (((t0 & ~255) + 255) >> 6) + 1;
    for (int i = tid; i < nkt * 32; i += 512) { const int kt = i >> 5, q = i & 31; const unsigned long long lo = mk[q * 512 + 2 * kt], hi2 = mk[q * 512 + 2 * kt + 1];
        mg[(size_t)kt * T_ + t0 + q] = lo | (hi2 << 32); }
}

__device__ __forceinline__ void phase3(const Params& p, LAS unsigned char* lds) {
    const int c = blockIdx.x, tid = tid_();
    if (c < 32) dn_scan(p, c, lds);
    unsigned* queue = (unsigned*)(opq(p.ws) + OFF_SMALL + SM_CTRL) + 200;
    LAS int* tk = (LAS int*)(lds + 131072 + 512);
    for (;;) {
        __syncthreads();
        if (tid == 0) *tk = (int)atomicAdd(queue, 1u);
        __syncthreads();
        const int ticket = *tk;
        if (ticket >= 512) break;
        dsa_block(p, 511 - ticket, lds);
    }
}

struct DnOutOps { bf16x8 qa[4], aa[2], sb[4][4], vb[2][4]; };
__device__ __forceinline__ void dn_out_load(const Params& p, int item, DnOutOps& o) {
    const int tid = tid_(), w = tid >> 6, lane = tid & 63, fr = lane & 15, fq = lane >> 4, m = w & 3, nh = w >> 2;
    unsigned char* ws = opq(p.ws);
    const bf16_t* qd = (const bf16_t*)(ws + OFF_DNP + DNP_QD) + (size_t)item * 8192; const bf16_t* attn = (const bf16_t*)(ws + OFF_DNP + DNP_ATT) + (size_t)item * 4096;
    const bf16_t* Sold = (const bf16_t*)(ws + OFF_SCAN) + (size_t)item * 16384; const bf16_t* vnT = (const bf16_t*)(ws + OFF_SCAN + 64 * MB) + (size_t)item * 8192;
#pragma unroll
    for (int kk = 0; kk < 4; ++kk) { o.qa[kk] = *(const bf16x8*)(qd + (16 * m + fr) * 128 + kk * 32 + 8 * fq);
#pragma unroll
        for (int nt = 0; nt < 4; ++nt) o.sb[kk][nt] = *(const bf16x8*)(Sold + (size_t)(16 * (4 * nh + nt) + fr) * 128 + kk * 32 + 8 * fq); }
#pragma unroll
    for (int kk = 0; kk < 2; ++kk) { o.aa[kk] = *(const bf16x8*)(attn + (16 * m + fr) * 64 + kk * 32 + 8 * fq);
#pragma unroll
        for (int nt = 0; nt < 4; ++nt) o.vb[kk][nt] = *(const bf16x8*)(vnT + (size_t)(16 * (4 * nh + nt) + fr) * 64 + kk * 32 + 8 * fq); }
}
__device__ __forceinline__ void dn_out_item(const Params& p, int item, int next_item, DnOutOps& o, LAS unsigned char* lds) {
    const int tid = tid_(), w = tid >> 6, lane = tid & 63, fr = lane & 15, fq = lane >> 4, m = w & 3, nh = w >> 2, n = item >> 3, h = item & 7;
    unsigned char* ws = opq(p.ws); const bf16_t* proj = (const bf16_t*)(ws + OFF_PROJ);
    bf16_t* ydn = (bf16_t*)(ws + OFF_Y);
    LAS float* red = (LAS float*)lds;
    bf16_t zv[4][4];
#pragma unroll
    for (int j = 0; j < 4; ++j) { const int t = n * 64 + 16 * m + 4 * fq + j;
#pragma unroll
        for (int nt = 0; nt < 4; ++nt) zv[j][nt] = proj[(size_t)t * LDP + C_Z + h * 128 + 16 * (4 * nh + nt) + fr]; }
    f32x4 acc[4];
#pragma unroll
    for (int nt = 0; nt < 4; ++nt) acc[nt] = (f32x4){0.f, 0.f, 0.f, 0.f};
#pragma unroll
    for (int kk = 0; kk < 4; ++kk)
#pragma unroll
        for (int nt = 0; nt < 4; ++nt) acc[nt] = __builtin_amdgcn_mfma_f32_16x16x32_bf16(o.qa[kk], o.sb[kk][nt], acc[nt], 0, 0, 0);
#pragma unroll
    for (int kk = 0; kk < 2; ++kk)
#pragma unroll
        for (int nt = 0; nt < 4; ++nt) acc[nt] = __builtin_amdgcn_mfma_f32_16x16x32_bf16(o.aa[kk], o.vb[kk][nt], acc[nt], 0, 0, 0);
    __builtin_amdgcn_sched_barrier(0);
    if (next_item >= 0) dn_out_load(p, next_item, o);
    __builtin_amdgcn_sched_barrier(0);
    float ssq[4];
#pragma unroll
    for (int j = 0; j < 4; ++j) { float s = 0.f;
#pragma unroll
        for (int nt = 0; nt < 4; ++nt) s += acc[nt][j] * acc[nt][j];
        ssq[j] = sum16(s); }
    __syncthreads();
    if (fr == 0) {
#pragma unroll
        for (int j = 0; j < 4; ++j) red[(16 * m + 4 * fq + j) * 2 + nh] = ssq[j]; }
    __syncthreads();
#pragma unroll
    for (int j = 0; j < 4; ++j) { const int i = 16 * m + 4 * fq + j, t = n * 64 + i; const float rs = rsqrtf((red[i * 2] + red[i * 2 + 1]) * (1.0f / 128.0f) + EPS);
#pragma unroll
        for (int nt = 0; nt < 4; ++nt) { const int dv = 16 * (4 * nh + nt) + fr; const float z = bf2f(zv[j][nt]);
            ydn[(size_t)t * 1024 + h * 128 + dv] = f2bf(acc[nt][j] * rs * p.dn_norm_w[dv] * siluf_(z)); } }
}

__device__ __forceinline__ void phase_attn(const Params& p, LAS unsigned char* lds) {
    const int G = gridDim.x, c = blockIdx.x; unsigned char* ws = opq(p.ws);
    const bf16_t* proj = (const bf16_t*)(ws + OFF_PROJ); bf16_t* yat = (bf16_t*)(ws + OFF_Y + 32 * MB); const unsigned long long* mk = (const unsigned long long*)(ws + OFF_MASK);
    typedef att::BlockRef<bf16_t, bf16_t> BR;
    auto mkref = [&](int L, int pass) { const int h = L & 7, x = L >> 3, qb = pass ? 63 - x : x; BR r;
        r.Q = proj + (size_t)qb * 256 * LDP + C_AQ + h * 128; r.K = proj + C_AK + h * 128; r.V = proj + C_AV + h * 128;
        r.O = yat + (size_t)qb * 256 * 1024 + h * 128; r.P0 = qb * 256; r.MK = mk + qb * 256; return r; };
    int L = c;
    if (L < 256) {
        int pass = 0; BR cur = mkref(L, 0); att::Seam<bf16_t> S;
        att::causal_swa_prime<bf16_t, bf16_t>(cur, 1 << 30, (char*)lds, S);
        for (;;) {
            const bool more_pass = pass == 0, more_item = L + G < 256, last = !more_pass && !more_item;
            int passn = pass + 1, Ln = L; if (!more_pass) { passn = 0; Ln = more_item ? L + G : L; }
            const BR nxt = last ? cur : mkref(Ln, passn);
            att::causal_swa_block<bf16_t, bf16_t>(cur, nxt, T_, 1 << 30, (char*)lds, S);
            if (last) break;
            cur = nxt; pass = passn; L = Ln;
        }
    }
    __syncthreads();
    { DnOutOps ops; if (c < NITEM) dn_out_load(p, c, ops);
      for (int item = c; item < NITEM; item += G) dn_out_item(p, item, item + G < NITEM ? item + G : -1, ops, lds); }
}

__device__ __forceinline__ void phase_router(const Params& p, LAS unsigned char* lds) {
    const int G = gridDim.x, c = blockIdx.x, tid = tid_(), w = tid >> 6, lane = tid & 63, fr = lane & 15, fq = lane >> 4;
    unsigned char* ws = opq(p.ws); const float* x1 = (const float*)(ws + OFF_X1); bf16_t* h2 = (bf16_t*)(ws + OFF_H);
    int* rexp = (int*)(ws + OFF_SMALL + SM_ROUTE); float* rwt = (float*)(ws + OFF_SMALL + SM_ROUTE + 128 * 1024); float* rstab = (float*)(ws + OFF_SMALL + SM_ROUTE + 384 * 1024);
    int* rpos = (int*)(ws + OFF_SMALL + SM_ROUTE + 256 * 1024); unsigned* cntT = (unsigned*)(ws + OFF_SMALL + SM_KIDX);
    LAS int* exl = (LAS int*)(lds + 104 * 1024);
    const bf16_t* wh = (const bf16_t*)(ws + OFF_WR); const bf16_t* wl = (const bf16_t*)(ws + OFF_WR + 512 * 1024);
    LAS float* red = (LAS float*)lds;
    LAS float* lgt = (LAS float*)(lds + 8 * 32 * 81 * 4);
    LAS float* gL = (LAS float*)(lds + 96 * 1024);
#pragma clang loop vectorize(disable) interleave(disable)
    for (int i = tid; i < 2048; i += 512) gL[i] = p.norm_ffn[i];
    LAS float* bL = (LAS float*)(lds + 104 * 1024 + 512);
    if (tid < 64) bL[tid] = p.b_router[tid]; else if (tid < 72) bL[tid] = p.b_group[tid - 64];
    __syncthreads();
    for (int tile = c; tile < T_ / 32; tile += G) {
        const int tb = tile * 32;
        f32x4 acc[2][5];
#pragma unroll
        for (int s2 = 0; s2 < 2; ++s2)
#pragma unroll
            for (int j = 0; j < 5; ++j) acc[s2][j] = (f32x4){0.f, 0.f, 0.f, 0.f};
        float ssq[2] = {0.f, 0.f};
        f32x4 xs[3][2][2]; bf16x8 bhs[2][5], bls[2][5];
        auto loadA = [&](int ks, f32x4 (&x)[2][2]) {
#pragma unroll
            for (int s2 = 0; s2 < 2; ++s2) { const float* xp = x1 + (size_t)(tb + 16 * s2 + fr) * 2048 + 32 * ks + 8 * fq; x[s2][0] = *(const f32x4*)xp; x[s2][1] = *(const f32x4*)(xp + 4); } };
        auto loadB = [&](int ks, bf16x8 (&h)[5], bf16x8 (&l)[5]) {
            unsigned o = (unsigned)(ks * 512 + lane * 8); asm volatile("" : "+v"(o));
#pragma unroll
            for (int j = 0; j < 5; ++j) { h[j] = *(const bf16x8*)(wh + j * 32768 + o); l[j] = *(const bf16x8*)(wl + j * 32768 + o); } };
        auto stage = [&](int ks, const f32x4 (&x)[2][2], const bf16x8 (&h)[5], const bf16x8 (&l)[5]) {
            const f32x4 g0 = *(const LAS f32x4*)(gL + 32 * ks + 8 * fq), g1 = *(const LAS f32x4*)(gL + 32 * ks + 8 * fq + 4);
#pragma unroll
            for (int s2 = 0; s2 < 2; ++s2) { const f32x4 x0 = x[s2][0], x4 = x[s2][1];
                ssq[s2] += x0[0] * x0[0] + x0[1] * x0[1] + x0[2] * x0[2] + x0[3] * x0[3] + x4[0] * x4[0] + x4[1] * x4[1] + x4[2] * x4[2] + x4[3] * x4[3];
                const float a0 = x0[0] * g0[0], a1 = x0[1] * g0[1], a2 = x0[2] * g0[2], a3 = x0[3] * g0[3], a4 = x4[0] * g1[0], a5 = x4[1] * g1[1], a6 = x4[2] * g1[2], a7 = x4[3] * g1[3];
                u32x4 ph; ph.x = pack2(a0, a1); ph.y = pack2(a2, a3); ph.z = pack2(a4, a5); ph.w = pack2(a6, a7);
                u32x4 pl; pl.x = pack2(a0 - bflo(ph.x), a1 - bfhi(ph.x)); pl.y = pack2(a2 - bflo(ph.y), a3 - bfhi(ph.y));
                pl.z = pack2(a4 - bflo(ph.z), a5 - bfhi(ph.z)); pl.w = pack2(a6 - bflo(ph.w), a7 - bfhi(ph.w));
                *(u32x4*)(h2 + (size_t)(tb + 16 * s2 + fr) * 2048 + 32 * ks + 8 * fq) = ph;
                const bf16x8 ah = __builtin_bit_cast(bf16x8, ph), al = __builtin_bit_cast(bf16x8, pl);
#pragma unroll
                for (int j = 0; j < 5; ++j) {
                    acc[s2][j] = __builtin_amdgcn_mfma_f32_16x16x32_bf16(ah, h[j], acc[s2][j], 0, 0, 0);
                    acc[s2][j] = __builtin_amdgcn_mfma_f32_16x16x32_bf16(ah, l[j], acc[s2][j], 0, 0, 0);
                    acc[s2][j] = __builtin_amdgcn_mfma_f32_16x16x32_bf16(al, h[j], acc[s2][j], 0, 0, 0); } } };
        const int rot = c & 7;
        auto kstep = [&](int i) { return 8 * ((i + rot) & 7) + w; };
        loadA(kstep(0), xs[0]); loadB(kstep(0), bhs[0], bls[0]); loadA(kstep(1), xs[1]);
#pragma unroll
        for (int kk = 0; kk < 8; ++kk) {
            loadB(kstep(kk + 1), bhs[(kk + 1) & 1], bls[(kk + 1) & 1]); loadA(kstep(kk + 2), xs[(kk + 2) % 3]);
            __builtin_amdgcn_sched_barrier(0);
            stage(kstep(kk), xs[kk % 3], bhs[kk & 1], bls[kk & 1]);
            __builtin_amdgcn_sched_barrier(0); }
#pragma unroll
        for (int s2 = 0; s2 < 2; ++s2) { ssq[s2] += shfl_xor_(ssq[s2], 16); ssq[s2] += shfl_xor_(ssq[s2], 32); }
        __syncthreads();
        { const int t2 = tid_(), w2 = t2 >> 6, fr2 = t2 & 15, fq2 = (t2 >> 4) & 3;
#pragma unroll
        for (int s2 = 0; s2 < 2; ++s2) {
#pragma unroll
            for (int j = 0; j < 5; ++j)
#pragma unroll
                for (int r = 0; r < 4; ++r) red[(w2 * 32 + 16 * s2 + 4 * fq2 + r) * 81 + 16 * j + fr2] = acc[s2][j][r];
            if (fq2 == 0) red[(w2 * 32 + 16 * s2 + fr2) * 81 + 80] = ssq[s2]; } }
        __syncthreads();
#pragma clang loop vectorize(disable) interleave(disable)
        for (int o = tid_(); o < 32 * 81; o += 512) { float sacc = 0.f;
#pragma unroll
            for (int ww = 0; ww < 8; ++ww) sacc += red[ww * (32 * 81) + o];
            lgt[o] = sacc; }
        __syncthreads();
        if (tid < 32) { const int t = tb + tid; LAS float* l = lgt + tid * 81;
            const float rs = rsqrtf(l[80] * (1.0f / 2048.0f) + EPS);
            float gmax = -3.0e38f; int gs = 0; float gl[8];
#pragma unroll
            for (int g = 0; g < 8; ++g) { gl[g] = l[64 + g] * rs + bL[64 + g]; if (gl[g] > gmax) { gmax = gl[g]; gs = g; } }
            float gsum = 0.f;
#pragma unroll
            for (int g = 0; g < 8; ++g) gsum += __expf(gl[g] - gmax);
            const float pg = 1.0f / gsum;
            float el[8]; float m1 = -3.0e38f, m2 = -3.0e38f; int i1 = 0, i2 = 0;
#pragma unroll
            for (int e = 0; e < 8; ++e) { el[e] = l[gs * 8 + e] * rs + bL[gs * 8 + e]; }
#pragma unroll
            for (int e = 0; e < 8; ++e) if (el[e] > m1) { m1 = el[e]; i1 = e; }
#pragma unroll
            for (int e = 0; e < 8; ++e) if (e != i1 && el[e] > m2) { m2 = el[e]; i2 = e; }
            const float e2 = __expf(m2 - m1); const float w1 = pg / (1.0f + e2), w2 = pg * e2 / (1.0f + e2);
            const int ex1 = gs * 8 + i1, ex2 = gs * 8 + i2;
            rexp[t * 2] = ex1; rexp[t * 2 + 1] = ex2; rwt[t * 2] = w1; rwt[t * 2 + 1] = w2; rstab[t] = rs;
            exl[2 * tid] = ex1; exl[2 * tid + 1] = ex2;
            asm volatile("s_waitcnt lgkmcnt(0)" ::: "memory");
            int r1 = 0, r2 = 0;
            for (int j = 0; j < 2 * tid; ++j) { const int xx = exl[j]; r1 += xx == ex1 ? 1 : 0; r2 += xx == ex2 ? 1 : 0; }
            rpos[t * 2] = r1; rpos[t * 2 + 1] = r2; }
        if (tid < 64) { asm volatile("s_waitcnt lgkmcnt(0)" ::: "memory"); int cn = 0;
            for (int j = 0; j < 64; ++j) cn += exl[j] == tid ? 1 : 0;
            cntT[tile * 64 + tid] = (unsigned)cn; }
    }
}

__device__ __forceinline__ void expert_starts(const unsigned* ecnt, LAS int* pstart, int tid) {
    if (tid < 64) { const int cn = (int)ecnt[tid]; const int pad = (cn + 127) / 128 * 128; int s = pad;
        for (int o = 1; o < 64; o <<= 1) { const int u = shfl_up_(s, o); if (tid >= o) s += u; }
        pstart[tid] = s - pad; if (tid == 63) pstart[64] = s; }
}
__device__ __forceinline__ void phase_slots(const Params& p, LAS unsigned char* lds) {
    const int G = gridDim.x, c = blockIdx.x, tid = tid_(), e = tid & 63, part = tid >> 6;
    unsigned char* ws = opq(p.ws); unsigned* ecnt = (unsigned*)(ws + OFF_SMALL + SM_CTRL); const unsigned* cntT = (const unsigned*)(ws + OFF_SMALL + SM_KIDX);
    const int* rexp = (const int*)(ws + OFF_SMALL + SM_ROUTE); int* rpos = (int*)(ws + OFF_SMALL + SM_ROUTE + 256 * 1024); int* rowtok = (int*)(ws + OFF_ROWTOK);
    LAS int* pstart = (LAS int*)lds; LAS int* part8 = (LAS int*)(lds + 1024);
    constexpr int NTILE = T_ / 32;
    __syncthreads();
    { int tot = 0;
#pragma unroll 1
      for (int t0 = part; t0 < NTILE; t0 += 64) { unsigned v[8];
#pragma unroll
          for (int q = 0; q < 8; ++q) v[q] = cntT[(t0 + 8 * q) * 64 + e];
#pragma unroll
          for (int q = 0; q < 8; ++q) tot += (int)v[q]; }
      part8[part * 64 + e] = tot; }
    __syncthreads();
    if (tid < 64) { int cn = 0;
#pragma unroll
        for (int q = 0; q < 8; ++q) cn += part8[q * 64 + tid];
        if (c == 0) ecnt[tid] = (unsigned)cn;
        const int pad = (cn + 127) / 128 * 128; int sc = pad;
        for (int o = 1; o < 64; o <<= 1) { const int u = shfl_up_(sc, o); if (tid >= o) sc += u; }
        pstart[tid] = sc - pad; if (tid == 63) pstart[64] = sc; }
    for (int tile = c; tile < NTILE; tile += G) {
        __syncthreads();
        { int pre = 0;
#pragma unroll 1
          for (int t0 = part; t0 < tile; t0 += 64) { unsigned v[8];
#pragma unroll
              for (int q = 0; q < 8; ++q) { const int t = t0 + 8 * q; v[q] = t < tile ? cntT[t * 64 + e] : 0u; }
#pragma unroll
              for (int q = 0; q < 8; ++q) pre += (int)v[q]; }
          part8[part * 64 + e] = pre; }
        __syncthreads();
        if (tid < 64) { const int a = tile * 64 + tid; const int ex = rexp[a]; int base = pstart[ex];
#pragma unroll
            for (int q = 0; q < 8; ++q) base += part8[q * 64 + ex];
            const int pos = base + rpos[a]; rpos[a] = pos; rowtok[pos] = a >> 1; }
    }
}

#define MOE_BAR() do { asm volatile("s_waitcnt lgkmcnt(0)" ::: "memory"); __builtin_amdgcn_s_barrier(); asm volatile("" ::: "memory"); } while (0)
__device__ __forceinline__ void vm_wait(int n) {
    if (n >= 20) asm volatile("s_waitcnt vmcnt(20)" ::: "memory"); else if (n >= 16) asm volatile("s_waitcnt vmcnt(16)" ::: "memory");
    else if (n >= 14) asm volatile("s_waitcnt vmcnt(14)" ::: "memory"); else if (n >= 12) asm volatile("s_waitcnt vmcnt(12)" ::: "memory");
    else if (n >= 10) asm volatile("s_waitcnt vmcnt(10)" ::: "memory"); else if (n >= 8) asm volatile("s_waitcnt vmcnt(8)" ::: "memory");
    else if (n >= 6) asm volatile("s_waitcnt vmcnt(6)" ::: "memory"); else if (n >= 4) asm volatile("s_waitcnt vmcnt(4)" ::: "memory");
    else if (n >= 2) asm volatile("s_waitcnt vmcnt(2)" ::: "memory"); else asm volatile("s_waitcnt vmcnt(0)" ::: "memory");
}
template <int MODE, int NT>
__device__ __forceinline__ void moe_kloop(const Params& p, LAS unsigned char* lds, int e, int nt, int rs, int cnt) {
    constexpr int K = MODE == 0 ? 2048 : 512, NK = K / 64, WLD = MODE == 0 ? 512 : 2048, NA = NT ? NT : 1;
    const int tid = tid_(), w = __builtin_amdgcn_readfirstlane(tid >> 6), lane = tid & 63, fr = lane & 15, fq = lane >> 4;
    unsigned char* ws = opq(p.ws);
    LAS float* Rw = (LAS float*)(lds + w * 4096);
    LAS bf16_t* Wb0 = (LAS bf16_t*)(lds + 32768);
    LAS unsigned char* Ar = lds + 69632 + w * 10240;
    LAS int* tokl = (LAS int*)(lds + 151552);
    const bf16_t* Asrc = (const bf16_t*)(ws + (MODE == 0 ? OFF_H : OFF_ACT));
    const float* W0; const float* W1;
    if (MODE == 0) { W0 = p.w_exp_gate + (size_t)e * 2048 * 512 + nt * 64; W1 = p.w_exp_up + (size_t)e * 2048 * 512 + nt * 64; }
    else { W0 = p.w_exp_down + (size_t)e * 512 * 2048 + nt * 128; W1 = W0 + 64; }
    auto issueA = [&](int ks) {
        const int r0 = lane >> 3, cs0 = (lane & 7) ^ (r0 & 7);
        unsigned ro[NA][2];
#pragma unroll
        for (int mt = 0; mt < NT; ++mt)
#pragma unroll
            for (int i = 0; i < 2; ++i)
                ro[mt][i] = MODE == 0 ? (unsigned)tokl[mt * 128 + 16 * w + r0 + 8 * i] * 2048u : (unsigned)(rs + mt * 128 + 16 * w + r0 + 8 * i) * 512u;
#pragma unroll
        for (int mt = 0; mt < NT; ++mt) {
#pragma unroll
            for (int i = 0; i < 2; ++i)
                __builtin_amdgcn_global_load_lds((const unsigned*)(Asrc + (size_t)(ro[mt][i] + (unsigned)(ks * 64 + cs0 * 8))), (LAS unsigned*)(Ar + mt * 2048 + i * 1024), 16, 0, 0);
            __builtin_amdgcn_sched_barrier(0); } };
    auto issueW = [&](int ks) {
#pragma unroll
        for (int i = 0; i < 4; ++i) { const int pch = lane + 64 * i, r = pch >> 5, cc = pch & 31;
            const float* src = (cc < 16 ? W0 + 4 * cc : W1 + 4 * (cc - 16)) + (size_t)(ks * 64 + 8 * w + r) * WLD;
            __builtin_amdgcn_global_load_lds((const unsigned*)src, (LAS unsigned*)((LAS unsigned char*)Rw + i * 1024), 16, 0, 0); } };
    auto convertW = [&](int buf) {
        LAS bf16_t* Wb = Wb0 + buf * (128 * 72);
#pragma unroll
        for (int c2 = 0; c2 < 2; ++c2) { const int nm = lane + 64 * c2; float v[8];
#pragma unroll
            for (int r = 0; r < 8; ++r) v[r] = Rw[r * 128 + nm];
            const int nrow = MODE == 0 ? (((nm & 63) >> 4) * 2 + (nm >> 6)) * 16 + (nm & 15) : nm;
            u32x4 pk; pk.x = pack2(v[0], v[1]); pk.y = pack2(v[2], v[3]); pk.z = pack2(v[4], v[5]); pk.w = pack2(v[6], v[7]);
            *(LAS u32x4*)(Wb + nrow * 72 + 8 * w) = pk; } };
    auto rawpack = [&](int c2) -> u32x4 { const int nm = lane + 64 * c2; float v[8];
#pragma unroll
        for (int r = 0; r < 8; ++r) v[r] = Rw[r * 128 + nm];
        u32x4 pk; pk.x = pack2(v[0], v[1]); pk.y = pack2(v[2], v[3]); pk.z = pack2(v[4], v[5]); pk.w = pack2(v[6], v[7]); return pk; };
    auto wbstore = [&](int buf, int c2, u32x4 pk) { const int nm = lane + 64 * c2;
        const int nrow = MODE == 0 ? (((nm & 63) >> 4) * 2 + (nm >> 6)) * 16 + (nm & 15) : nm;
        *(LAS u32x4*)(Wb0 + buf * (128 * 72) + nrow * 72 + 8 * w) = pk; };
    f32x4 acc[NA][8];
#pragma unroll
    for (int a = 0; a < NA; ++a)
#pragma unroll
        for (int n = 0; n < 8; ++n) acc[a][n] = (f32x4){0.f, 0.f, 0.f, 0.f};
    issueA(0); issueW(0); asm volatile("s_waitcnt vmcnt(0)" ::: "memory"); convertW(0);
    asm volatile("s_waitcnt lgkmcnt(0)" ::: "memory");
    if (NK > 1) issueW(1);
#pragma unroll 1
    for (int ks = 0; ks < NK; ++ks) {
        MOE_BAR();
        const LAS bf16_t* Wb = Wb0 + (ks & 1) * (128 * 72);
        if (ks + 1 < NK) asm volatile("s_waitcnt vmcnt(4)" ::: "memory");
        else asm volatile("s_waitcnt vmcnt(0)" ::: "memory");
        bf16x8 af[NA][2];
#pragma unroll
        for (int mt = 0; mt < NT; ++mt)
#pragma unroll
            for (int k2 = 0; k2 < 2; ++k2) af[mt][k2] = *(const LAS bf16x8*)(Ar + mt * 2048 + (fr * 8 + ((4 * k2 + fq) ^ (fr & 7))) * 16);
        if (ks + 1 < NK) asm volatile("s_waitcnt vmcnt(0)" ::: "memory");
        const int ksn = ks + 1 < NK ? ks + 1 : ks;
        const int r0 = lane >> 3, cs0 = (lane & 7) ^ (r0 & 7);
        auto rowoff = [&](int l) -> unsigned { const int mt = l >> 1, i = l & 1;
            return MODE == 0 ? (unsigned)tokl[mt * 128 + 16 * w + r0 + 8 * i] * 2048u : (unsigned)(rs + mt * 128 + 16 * w + r0 + 8 * i) * 512u; };
        unsigned off = NT > 0 ? rowoff(0) : 0u;
        float rv[8];
        bf16x8 b = *(const LAS bf16x8*)(Wb + fr * 72 + 8 * fq);
        asm volatile("s_waitcnt lgkmcnt(0)" ::: "memory");
#pragma unroll
        for (int f = 0; f < 16; ++f) { const int k2 = f >> 3, n = f & 7; bf16x8 bn = b;
            if (f + 1 < 16) bn = *(const LAS bf16x8*)(Wb + (16 * ((f + 1) & 7) + fr) * 72 + 32 * ((f + 1) >> 3) + 8 * fq);
            if (f < 2 * NT) {
                __builtin_amdgcn_global_load_lds((const unsigned*)(Asrc + (size_t)(off + (unsigned)(ksn * 64 + cs0 * 8))), (LAS unsigned*)(Ar + (f >> 1) * 2048 + (f & 1) * 1024), 16, 0, 0);
                if (f + 1 < 2 * NT) off = rowoff(f + 1); }
            if (f == 0 || f == 4) {
#pragma unroll
                for (int r = 0; r < 8; ++r) rv[r] = Rw[r * 128 + lane + (f == 0 ? 0 : 64)]; }
            if (f == 3 || f == 7) { u32x4 pk; pk.x = pack2(rv[0], rv[1]); pk.y = pack2(rv[2], rv[3]); pk.z = pack2(rv[4], rv[5]); pk.w = pack2(rv[6], rv[7]);
                wbstore((ks + 1) & 1, f == 3 ? 0 : 1, pk); }
            __builtin_amdgcn_sched_barrier(6);
            __builtin_amdgcn_s_setprio(1);
#pragma unroll
            for (int mt = 0; mt < NT; ++mt) acc[mt][n] = __builtin_amdgcn_mfma_f32_16x16x32_bf16(b, af[mt][k2], acc[mt][n], 0, 0, 0);
            __builtin_amdgcn_s_setprio(0);
            __builtin_amdgcn_sched_barrier(6);
            b = bn; }
        asm volatile("s_waitcnt lgkmcnt(0)" ::: "memory");
        if (ks + 2 < NK) issueW(ks + 2);
    }
#pragma unroll
    for (int mt = 0; mt < NT; ++mt) { const int rl = mt * 128 + 16 * w + fr;
        if (rl < cnt) {
            if (MODE == 0) { bf16_t* dst = (bf16_t*)(ws + OFF_ACT) + (size_t)(rs + rl) * 512 + nt * 64 + 4 * fq;
                const float rr = ((const float*)(ws + OFF_SMALL + SM_ROUTE + 384 * 1024))[tokl[rl]];
#pragma unroll
                for (int g = 0; g < 4; ++g) { const f32x4 gt = acc[mt][2 * g], u = acc[mt][2 * g + 1];
                    u32x2 pk; pk.x = pack2(siluf_(gt[0] * rr) * (u[0] * rr), siluf_(gt[1] * rr) * (u[1] * rr)); pk.y = pack2(siluf_(gt[2] * rr) * (u[2] * rr), siluf_(gt[3] * rr) * (u[3] * rr)); *(u32x2*)(dst + 16 * g) = pk; } }
            else { bf16_t* dst = (bf16_t*)(ws + OFF_YE) + (size_t)(rs + rl) * 2048 + nt * 128 + 4 * fq;
#pragma unroll
                for (int n = 0; n < 8; ++n) { const f32x4 v = acc[mt][n]; u32x2 pk; pk.x = pack2(v[0], v[1]); pk.y = pack2(v[2], v[3]); *(u32x2*)(dst + 16 * n) = pk; } } } }
    asm volatile("s_waitcnt vmcnt(0)" ::: "memory");
}
template <int MODE>
__device__ __forceinline__ void moe_item(const Params& p, LAS unsigned char* lds, int e, int nt, int rs, int cnt) {
    const int tid = tid_(), w = __builtin_amdgcn_readfirstlane(tid >> 6);
    unsigned char* ws = opq(p.ws); LAS int* tokl = (LAS int*)(lds + 151552);
    MOE_BAR();
    if (MODE == 0) { const int* rowtok = (const int*)(ws + OFF_ROWTOK); for (int i = tid; i < 640; i += 512) tokl[i] = rowtok[rs + (i < cnt ? i : 0)]; }
    MOE_BAR();
    const int mine = cnt - 16 * w; const int ntw = mine <= 0 ? 0 : (mine + 127) >> 7;
    if (ntw >= 5) moe_kloop<MODE, 5>(p, lds, e, nt, rs, cnt);
    else if (ntw == 4) moe_kloop<MODE, 4>(p, lds, e, nt, rs, cnt);
    else if (ntw == 3) moe_kloop<MODE, 3>(p, lds, e, nt, rs, cnt);
    else if (ntw == 2) moe_kloop<MODE, 2>(p, lds, e, nt, rs, cnt);
    else if (ntw == 1) moe_kloop<MODE, 1>(p, lds, e, nt, rs, cnt);
    else moe_kloop<MODE, 0>(p, lds, e, nt, rs, cnt);
}
template <int MODE>
__device__ __forceinline__ void phase_moe(const Params& p, LAS unsigned char* lds) {
    const int G = gridDim.x, c = blockIdx.x, tid = tid_();
    unsigned char* ws = opq(p.ws); const unsigned* ecnt = (const unsigned*)(ws + OFF_SMALL + SM_CTRL);
    LAS int* pstart = (LAS int*)(lds + 154112); LAS int* order = pstart + 80;
    __syncthreads();
    expert_starts(ecnt, pstart, tid);
    if (tid < 64) { const unsigned mine = ecnt[tid]; int rk = 0;
        for (int j = 0; j < 64; ++j) { const unsigned o = ecnt[j]; rk += (o > mine || (o == mine && j < tid)) ? 1 : 0; }
        order[rk] = tid; }
    __syncthreads();
    constexpr int PER = MODE == 0 ? 8 : 16;
    if (G == 256) {
        const int x = c & 7, sl = c >> 3, kk = sl / PER, nt = sl % PER; constexpr int EPR = 256 / PER;
        for (int j = 0; j < 64 / EPR; ++j) { const int within = 8 * kk + x; const int rnk = EPR * j + ((j & 1) ? EPR - 1 - within : within);
            const int e = order[rnk]; const int cn = (int)ecnt[e], rs = pstart[e];
            for (int seg = 0; seg < cn; seg += 640) moe_item<MODE>(p, lds, e, nt, rs + seg, min(cn - seg, 640)); }
    } else {
        for (int it = c; it < 64 * PER; it += G) { const int e = it / PER, nt = it % PER; const int cn = (int)ecnt[e], rs = pstart[e];
            for (int seg = 0; seg < cn; seg += 640) moe_item<MODE>(p, lds, e, nt, rs + seg, min(cn - seg, 640)); }
    }
    __syncthreads();
}

__device__ __forceinline__ void phase_final(const Params& p) {
    const int G = gridDim.x, c = blockIdx.x, tid = tid_(), w = __builtin_amdgcn_readfirstlane(tid >> 6), lane = tid & 63;
    unsigned char* ws = opq(p.ws); const float* x1 = (const float*)(ws + OFF_X1); const bf16_t* ye = (const bf16_t*)(ws + OFF_YE);
    const float* rwt = (const float*)(ws + OFF_SMALL + SM_ROUTE + 128 * 1024); const int* rpos = (const int*)(ws + OFF_SMALL + SM_ROUTE + 256 * 1024);
    f32x4 g[8];
#pragma unroll
    for (int i = 0; i < 8; ++i) g[i] = *(const f32x4*)(p.norm_final + i * 256 + 4 * lane);
    f32x4 xa[8], xb[8]; u32x2 ya0[8], ya1[8], yb0[8], yb1[8]; float wa0 = 0.f, wa1 = 0.f, wb0 = 0.f, wb1 = 0.f;
    auto issue = [&](int t, f32x4 (&x)[8], u32x2 (&y0)[8], u32x2 (&y1)[8], float& w0, float& w1) {
        w0 = rwt[t * 2]; w1 = rwt[t * 2 + 1]; const bf16_t* r0 = ye + (size_t)rpos[t * 2] * 2048; const bf16_t* r1 = ye + (size_t)rpos[t * 2 + 1] * 2048;
#pragma unroll
        for (int i = 0; i < 8; ++i) { const int k = i * 256 + 4 * lane; x[i] = *(const f32x4*)(x1 + (size_t)t * 2048 + k); y0[i] = *(const u32x2*)(r0 + k); y1[i] = *(const u32x2*)(r1 + k); } };
    auto finish = [&](int t, const f32x4 (&x)[8], const u32x2 (&y0)[8], const u32x2 (&y1)[8], float w0, float w1) {
        f32x4 v[8]; float ss = 0.f;
#pragma unroll
        for (int i = 0; i < 8; ++i) { const u32x2 a = y0[i], b = y1[i]; v[i] = x[i];
            v[i][0] += w0 * bflo(a.x) + w1 * bflo(b.x); v[i][1] += w0 * bfhi(a.x) + w1 * bfhi(b.x); v[i][2] += w0 * bflo(a.y) + w1 * bflo(b.y); v[i][3] += w0 * bfhi(a.y) + w1 * bfhi(b.y);
            ss += v[i][0] * v[i][0] + v[i][1] * v[i][1] + v[i][2] * v[i][2] + v[i][3] * v[i][3]; }
        ss = wave_sum(ss); const float rs = rsqrtf(ss * (1.0f / 2048.0f) + EPS);
#pragma unroll
        for (int i = 0; i < 8; ++i) { const int k = i * 256 + 4 * lane;
            f32x4 o; o[0] = v[i][0] * rs * g[i][0]; o[1] = v[i][1] * rs * g[i][1]; o[2] = v[i][2] * rs * g[i][2]; o[3] = v[i][3] * rs * g[i][3];
            *(f32x4*)(p.out + (size_t)t * 2048 + k) = o; } };
    const int step = G * 8; int t = c * 8 + w;
    if (t < T_) issue(t, xa, ya0, ya1, wa0, wa1);
#pragma unroll 1
    while (t < T_) {
        const int t1 = t + step, t2 = t + 2 * step;
        if (t1 < T_) issue(t1, xb, yb0, yb1, wb0, wb1);
        __builtin_amdgcn_sched_barrier(0);
        finish(t, xa, ya0, ya1, wa0, wa1);
        __builtin_amdgcn_sched_barrier(0);
        if (t1 >= T_) break;
        if (t2 < T_) issue(t2, xa, ya0, ya1, wa0, wa1);
        __builtin_amdgcn_sched_barrier(0);
        finish(t1, xb, yb0, yb1, wb0, wb1);
        __builtin_amdgcn_sched_barrier(0);
        t = t2; }
}

template <int PH>
__device__ __forceinline__ void run_phase(const Params& p, LAS unsigned char* lds) {
    const int G = gridDim.x, c = blockIdx.x; unsigned char* ws = opq(p.ws);
    if constexpr (PH == 0) phase0(p, lds);
    if constexpr (PH == 1) { pg8::DenseOrder S; S.init(ws + OFF_H, ws + OFF_WT_IN, T_, LDP, 2048, G, c); EpiProj E; E.O = (bf16_t*)(ws + OFF_PROJ); pg8::gemm_phase(lds, 2048, S, E); }
    if constexpr (PH == 2) { phase_rope(p); u32x4 xr[3][2][4]; float ba[2]; if (c < NITEM) dn_prep_load(p, c, xr, ba);
        for (int item = c; item < NITEM; item += G) dn_prep_item(p, item, item + G < NITEM ? item + G : -1, lds, xr, ba); }
    if constexpr (PH == 3) phase3(p, lds);
    if constexpr (PH == 4) phase_attn(p, lds);
    if constexpr (PH == 5) { pg8::DenseOrder S; S.init(ws + OFF_Y, ws + OFF_WT_DN, T_, 2048, 1024, G, c); EpiMerge<0> E; E.M = (bf16_t*)(ws + OFF_H); E.proj = (const bf16_t*)(ws + OFF_PROJ); E.bg = p.b_gates; pg8::gemm_phase(lds, 1024, S, E);
              pg8::DenseOrder S2; S2.init(ws + OFF_Y + 32 * MB, ws + OFF_WT_AT, T_, 2048, 1024, G, c); EpiMerge<1> E2; E2.M = E.M; E2.proj = E.proj; E2.bg = p.b_gates; pg8::gemm_phase(lds, 1024, S2, E2); }
    if constexpr (PH == 6) { pg8::DenseOrder S; S.init(ws + OFF_H, ws + OFF_WT_OUT, T_, 2048, 2048, G, c); EpiResid E; E.X1 = (float*)(ws + OFF_X1); E.X = p.x; pg8::gemm_phase(lds, 2048, S, E); }
    if constexpr (PH == 7) phase_router(p, lds);
    if constexpr (PH == 8) phase_slots(p, lds);
    if constexpr (PH == 9) phase_moe<0>(p, lds);
    if constexpr (PH == 10) phase_moe<1>(p, lds);
    if constexpr (PH == 11) phase_final(p);
}

typedef const __attribute__((address_space(4))) Params* KParams;
#define KP_F(T, f) p.f = (T*)(__attribute__((address_space(1))) T*)kp->f
__device__ __forceinline__ void load_params(Params& p) {
    KParams kp = (KParams)__builtin_amdgcn_kernarg_segment_ptr();
    asm volatile("" : "+s"(kp));
    KP_F(const float, x); KP_F(const int, positions); KP_F(const float, norm_mix); KP_F(const float, w_in); KP_F(const float, b_gates); KP_F(const float, conv_w);
    KP_F(const float, a_log); KP_F(const float, dt_bias); KP_F(const float, dn_norm_w); KP_F(const float, idx_k_norm); KP_F(const float, w_proj_dn);
    KP_F(const float, w_proj_att); KP_F(const float, w_out); KP_F(const float, norm_ffn); KP_F(const float, w_group); KP_F(const float, b_group);
    KP_F(const float, w_router); KP_F(const float, b_router); KP_F(const float, w_exp_gate); KP_F(const float, w_exp_up); KP_F(const float, w_exp_down);
    KP_F(const float, norm_final); KP_F(float, out); KP_F(unsigned char, ws);
}
template <int PH>
__device__ __forceinline__ void phase_step(LAS unsigned char* lds, cg::grid_group& grid, const XcdBarrier& xb, unsigned long long& tp) {
    Params p; load_params(p);
#ifdef ONLY_PHASE
    if constexpr (PH != ONLY_PHASE) return;
#endif
    unsigned long long t0 = 0;
    if constexpr (PH == PROBE_PHASE) t0 = __builtin_amdgcn_s_memrealtime();
    run_phase<PH>(p, lds);
    if constexpr (PH + 1 < NPHASE) { if constexpr (PH == 0) grid.sync(); else xcd_barrier(xb); }
    if constexpr (PH == PROBE_PHASE) tp = __builtin_amdgcn_s_memrealtime() - t0;
}

__global__ void __launch_bounds__(512, 2) mega_kernel(Params p) {
    extern __shared__ __attribute__((aligned(16))) unsigned char shm[];
    LAS unsigned char* lds = (LAS unsigned char*)shm;
    cg::grid_group grid = cg::this_grid();
    volatile LAS unsigned* xst = (volatile LAS unsigned*)(lds + LDS_BYTES - 16);
    if (threadIdx.x == 0) { xst[0] = 0u; xst[1] = 0u; }
    __syncthreads();
    const XcdBarrier xb = xcd_barrier_post((unsigned*)(p.ws + OFF_SMALL + SM_BAR), xst);
    unsigned long long tp = 0;
    phase_step<0>(lds, grid, xb, tp); phase_step<1>(lds, grid, xb, tp); phase_step<2>(lds, grid, xb, tp); phase_step<3>(lds, grid, xb, tp);
    phase_step<4>(lds, grid, xb, tp); phase_step<5>(lds, grid, xb, tp); phase_step<6>(lds, grid, xb, tp); phase_step<7>(lds, grid, xb, tp);
    phase_step<8>(lds, grid, xb, tp); phase_step<9>(lds, grid, xb, tp); phase_step<10>(lds, grid, xb, tp); phase_step<11>(lds, grid, xb, tp);
#if PROBE_PHASE >= 0
    if (blockIdx.x == 0) { const unsigned long long te = __builtin_amdgcn_s_memrealtime(); while (__builtin_amdgcn_s_memrealtime() - te < (unsigned long long)PROBE_MULT * tp) __builtin_amdgcn_s_sleep(8); }
#endif
}

extern "C" void kernel_launch(void* const* d_in, const int* in_sizes, int n_in, void* d_out, int out_size, void* d_ws, size_t ws_size, hipStream_t stream) {
    (void)in_sizes; (void)n_in; (void)out_size;
    static int grid_blocks = 0;
    if (!grid_blocks) {
        int dev = 0, cus = 0, per_cu = 0;
        hipGetDevice(&dev);
        hipDeviceGetAttribute(&cus, hipDeviceAttributeMultiprocessorCount, dev);
        hipFuncSetAttribute((const void*)mega_kernel, hipFuncAttributeMaxDynamicSharedMemorySize, LDS_BYTES);
        hipOccupancyMaxActiveBlocksPerMultiprocessor(&per_cu, mega_kernel, 512, LDS_BYTES);
        if (per_cu > 1) per_cu = 1;
        grid_blocks = cus * per_cu;
        if (grid_blocks <= 0) { fprintf(stderr, "occupancy query failed\n"); grid_blocks = 0; return; }
    }
    if (ws_size < WS_NEED) { fprintf(stderr, "workspace too small: %zu < %zu\n", ws_size, (size_t)WS_NEED); return; }
    Params p{};
    p.x = (const float*)d_in[0]; p.positions = (const int*)d_in[1]; p.norm_mix = (const float*)d_in[2]; p.w_in = (const float*)d_in[3]; p.b_gates = (const float*)d_in[4];
    p.conv_w = (const float*)d_in[5]; p.a_log = (const float*)d_in[6]; p.dt_bias = (const float*)d_in[7]; p.dn_norm_w = (const float*)d_in[8]; p.idx_k_norm = (const float*)d_in[9];
    p.w_proj_dn = (const float*)d_in[10]; p.w_proj_att = (const float*)d_in[11]; p.w_out = (const float*)d_in[12]; p.norm_ffn = (const float*)d_in[13]; p.w_group = (const float*)d_in[14];
    p.b_group = (const float*)d_in[15]; p.w_router = (const float*)d_in[16]; p.b_router = (const float*)d_in[17]; p.w_exp_gate = (const float*)d_in[18]; p.w_exp_up = (const float*)d_in[19];
    p.w_exp_down = (const float*)d_in[20]; p.norm_final = (const float*)d_in[21]; p.out = (float*)d_out; p.ws = (unsigned char*)d_ws;
    (void)hipMemsetAsync((unsigned char*)d_ws + OFF_SMALL + SM_BAR, 0, XCD_BAR_WORDS * 4, stream);
    void* args[] = {&p};
    hipError_t e = hipLaunchCooperativeKernel((const void*)mega_kernel, dim3(grid_blocks), dim3(512), args, LDS_BYTES, stream);
    if (e != hipSuccess) fprintf(stderr, "cooperative launch failed: %s (grid %d)\n", hipGetErrorString(e), grid_blocks);
}
```
